# Optimizing an MI355X kernel written in HIP

```python
import math
import jax, jax.numpy as jnp
from jax import lax
import numpy as np

D_MODEL = 1024
BATCH = 16
SEQ = 256
DEPTH = 4
DEC_BATCH = 2
DEC_SEQ = 1024
PAST_LEN = 256

GRID_W = 64
DN_HEADS = D_MODEL // 128
DN_DK = 128
DN_DV = 128
DN_CHUNK = 64
CONV_K = 3
SC_WIDTH = D_MODEL
ATT_HEADS = D_MODEL // 128
ATT_KV_HEADS = ATT_HEADS // 4
HEAD_DIM = 128
Q_BLOCK = 128
ROPE_THETA = 10000.0
MLP_HIDDEN = 4 * D_MODEL
N_BRANCH = 3
RMS_EPS = 1e-6
IN_SIZES = (DN_HEADS * DN_DK, DN_HEADS * DN_DK, DN_HEADS * DN_DV, DN_HEADS * DN_DV, 2 * DN_HEADS, 2 * DN_HEADS, SC_WIDTH, SC_WIDTH, SC_WIDTH, ATT_HEADS * HEAD_DIM, ATT_KV_HEADS * HEAD_DIM, ATT_KV_HEADS * HEAD_DIM, N_BRANCH * D_MODEL)
IN_TOTAL = sum(IN_SIZES)

kernel_name = "hybrid_flow_prefix_trunk_step"


def split_cols(t, sizes):
    out, start = [], 0
    for s in sizes:
        out.append(t[..., start:start + s])
        start += s
    return out


def rmsnorm(x, g):
    xf = x.astype(jnp.float32)
    y = xf * lax.rsqrt(jnp.mean(xf * xf, axis=-1, keepdims=True) + RMS_EPS)
    return (y * g.astype(jnp.float32)).astype(x.dtype)


def l2norm(x):
    xf = x.astype(jnp.float32)
    return (xf * lax.rsqrt(jnp.sum(xf * xf, axis=-1, keepdims=True) + RMS_EPS)).astype(x.dtype)


def dwconv_centred(x, w):
    K, C = w.shape
    return lax.conv_general_dilated(x, w.reshape(K, 1, C).astype(x.dtype), window_strides=(1,), padding=((K // 2, K // 2),), dimension_numbers=("NWC", "WIO", "NWC"), feature_group_count=C)


def gated_delta_rule(q, k, v, g, beta, s0):
    B, L, H, DK = q.shape
    DV = v.shape[-1]
    C = DN_CHUNK
    N = L // C
    f32 = jnp.float32

    def chunks(t):
        t = t.astype(f32).reshape((B, N, C, H) + t.shape[3:])
        return jnp.moveaxis(t, (1, 3), (0, 2))

    qc = chunks(q) * (DK ** -0.5)
    kc = chunks(k)
    vc = chunks(v)
    bc = chunks(beta)
    gc = jnp.cumsum(chunks(g), axis=-1)
    incl = jnp.tril(jnp.ones((C, C), dtype=bool))
    strict = jnp.tril(jnp.ones((C, C), dtype=bool), -1)
    diff = gc[..., :, None] - gc[..., None, :]
    decay = jnp.where(incl, jnp.exp(jnp.where(incl, diff, 0.0)), 0.0)
    kb = kc * bc[..., None]
    m = jnp.where(strict, jnp.einsum("nbhid,nbhjd->nbhij", kb, kc) * decay, 0.0)
    a = m + jnp.eye(C, dtype=f32)
    u = lax.linalg.triangular_solve(a, vc * bc[..., None], left_side=True, lower=True)
    w = lax.linalg.triangular_solve(a, kb * jnp.exp(gc)[..., None], left_side=True, lower=True)
    qk = jnp.einsum("nbhid,nbhjd->nbhij", qc, kc) * decay
    q_dec = qc * jnp.exp(gc)[..., None]
    k_dec = kc * jnp.exp(gc[..., -1:] - gc)[..., None]
    g_last = jnp.exp(gc[..., -1])[..., None, None]

    def step(s, xs):
        u_n, w_n, qk_n, qd_n, kd_n, gl_n = xs
        v_new = u_n - jnp.einsum("bhcd,bhdv->bhcv", w_n, s)
        o_n = jnp.einsum("bhcd,bhdv->bhcv", qd_n, s) + jnp.einsum("bhij,bhjv->bhiv", qk_n, v_new)
        s = s * gl_n + jnp.einsum("bhcd,bhcv->bhdv", kd_n, v_new)
        return s, o_n

    s_fin, o = lax.scan(step, s0.astype(f32), (u, w, qk, q_dec, k_dec, g_last))
    o = jnp.moveaxis(o, (0, 2), (1, 3)).reshape(B, L, H, DV)
    return o.astype(v.dtype), s_fin.astype(s0.dtype)


def axial_angles(n_tokens):
    rows = n_tokens // GRID_W
    row = jnp.repeat(jnp.arange(rows), GRID_W).astype(jnp.float32)
    col = jnp.tile(jnp.arange(GRID_W), rows).astype(jnp.float32)
    n_freq = HEAD_DIM // 4
    freqs = ROPE_THETA ** (-jnp.arange(n_freq, dtype=jnp.float32) / n_freq)
    return row[:, None] * freqs, col[:, None] * freqs


def rope_axis(x, ang):
    m = ang.shape[-1]
    cos = jnp.cos(ang)[None, :, None, :]
    sin = jnp.sin(ang)[None, :, None, :]
    x1 = x[..., :m].astype(jnp.float32)
    x2 = x[..., m:].astype(jnp.float32)
    return jnp.concatenate([x1 * cos - x2 * sin, x1 * sin + x2 * cos], axis=-1).astype(x.dtype)


def rope2d(x, ang_row, ang_col):
    h = x.shape[-1] // 2
    return jnp.concatenate([rope_axis(x[..., :h], ang_row), rope_axis(x[..., h:], ang_col)], axis=-1)


def block_attention(q, keys, vals):
    B, Lq, H, HD = q.shape
    KV = keys.shape[2]
    G = H // KV
    nb = Lq // Q_BLOCK
    qb = jnp.moveaxis(q.reshape(B, nb, Q_BLOCK, KV, G, HD), 1, 0)

    def one_block(qblk):
        s = jnp.einsum("bqkgd,bskd->bkgqs", qblk, keys).astype(jnp.float32) * (HD ** -0.5)
        p = jax.nn.softmax(s, axis=-1).astype(vals.dtype)
        return jnp.einsum("bkgqs,bskd->bqkgd", p, vals)

    o = lax.map(one_block, qb)
    return jnp.moveaxis(o, 0, 1).reshape(B, Lq, H * HD)


def trunk_layer(x, cond, lw, ctx=None, rope=None):
    B, L, _ = x.shape
    mod = (jnp.dot(jax.nn.silu(cond), lw["w_mod"]) + lw["b_mod"]).reshape(-1, 1, 6 * D_MODEL)
    sh1, sc1, gt1, sh2, sc2, gt2 = jnp.split(mod, 6, axis=-1)
    h = rmsnorm(x, lw["g_pre_mix"]) * (1.0 + sc1) + sh1
    (dq, dk, dv, dgate, dbeta, dalpha, sb, scg, sx, aq, ak, av, mg) = split_cols(jnp.dot(h, lw["w_in"]), IN_SIZES)

    qkv = jax.nn.silu(dwconv_centred(jnp.concatenate([dq, dk, dv], axis=-1), lw["w_conv_dn"]))
    q, k, v = split_cols(qkv, IN_SIZES[:3])
    q = l2norm(q.reshape(B, L, DN_HEADS, DN_DK))
    k = l2norm(k.reshape(B, L, DN_HEADS, DN_DK))
    v = v.reshape(B, L, DN_HEADS, DN_DV)
    beta = jax.nn.sigmoid(dbeta.reshape(B, L, 2, DN_HEADS))
    g = -jnp.exp(lw["a_log"]) * jax.nn.softplus(dalpha.reshape(B, L, 2, DN_HEADS) + lw["dt_bias"])
    if ctx is None:
        s0 = jnp.zeros((B, 2, DN_HEADS, DN_DK, DN_DV), x.dtype)
    else:
        s0 = ctx[2]
    o_f, s_f = gated_delta_rule(q, k, v, g[:, :, 0], beta[:, :, 0], s0[:, 0])
    rev = lambda t: jnp.flip(t, axis=1)
    o_b, s_b = gated_delta_rule(rev(q), rev(k), rev(v), rev(g[:, :, 1]), rev(beta[:, :, 1]), s0[:, 1])
    o_dn = rmsnorm(o_f + rev(o_b), lw["g_dn_out"]) * jax.nn.silu(dgate.reshape(B, L, DN_HEADS, DN_DV))
    y_a = jnp.dot(o_dn.reshape(B, L, DN_HEADS * DN_DV), lw["w_br_dn"])

    y_b = jnp.dot(sb * dwconv_centred(scg * sx, lw["w_conv_sc"]), lw["w_br_sc"])

    qa = rmsnorm(aq.reshape(B, L, ATT_HEADS, HEAD_DIM), lw["g_q"])
    ka = rmsnorm(ak.reshape(B, L, ATT_KV_HEADS, HEAD_DIM), lw["g_k"])
    va = av.reshape(B, L, ATT_KV_HEADS, HEAD_DIM)
    if ctx is None:
        o_att = block_attention(qa, ka, va)
    else:
        ang_row, ang_col = rope
        keys = jnp.concatenate([ctx[0], rope2d(ka, ang_row, ang_col)], axis=1)
        vals = jnp.concatenate([ctx[1], va], axis=1)
        o_att = block_attention(rope2d(qa, ang_row, ang_col), keys, vals)
    y_c = jnp.dot(o_att, lw["w_br_att"])

    g_a, g_b, g_c = jnp.split(jax.nn.sigmoid(mg), 3, axis=-1)
    mix = jnp.dot(g_a * y_a + g_b * y_b + g_c * y_c, lw["w_out"])
    x = x + gt1 * rmsnorm(mix, lw["g_post_mix"])

    h2 = rmsnorm(x, lw["g_pre_mlp"]) * (1.0 + sc2) + sh2
    u = jax.nn.relu(jnp.dot(h2, lw["w_mlp_up"]))
    x = x + gt2 * rmsnorm(jnp.dot(u * u, lw["w_mlp_down"]), lw["g_post_mlp"])
    if ctx is None:
        return x, (ka, va, jnp.stack([s_f, s_b], axis=1))
    return x


def setup_inputs(seed: int = 0) -> dict:
    key = jax.random.key(seed)
    ks = jax.random.split(key, 32)
    f32 = jnp.float32

    def nrm(k, shape, scale):
        return scale * jax.random.normal(k, shape, f32)

    def gain(k, shape):
        return 1.0 + 0.05 * jax.random.normal(k, shape, f32)

    dt = jnp.exp(jax.random.uniform(ks[16], (DEPTH, 2, DN_HEADS), f32, math.log(1e-3), math.log(1e-1)))
    dt_bias = dt + jnp.log(-jnp.expm1(-dt))
    a_log = jnp.log(jax.random.uniform(ks[17], (DEPTH, 2, DN_HEADS), f32, 1.0, 16.0))
    return {
        "x_prompt": nrm(ks[0], (BATCH, SEQ, D_MODEL), 1.0),
        "x_sample": nrm(ks[1], (DEC_BATCH, DEC_SEQ, D_MODEL), 1.0),
        "cache_k": nrm(ks[2], (DEC_BATCH, DEPTH, PAST_LEN, ATT_KV_HEADS, HEAD_DIM), 1.0),
        "cache_v": nrm(ks[3], (DEC_BATCH, DEPTH, PAST_LEN, ATT_KV_HEADS, HEAD_DIM), 1.0),
        "state_dn": nrm(ks[4], (DEC_BATCH, DEPTH, 2, DN_HEADS, DN_DK, DN_DV), 0.1),
        "c": nrm(ks[5], (DEC_BATCH, D_MODEL), 1.0),
        "c_ctx": nrm(ks[6], (D_MODEL,), 1.0),
        "w_mod": nrm(ks[7], (DEPTH, D_MODEL, 6 * D_MODEL), 0.5 * D_MODEL ** -0.5),
        "b_mod": nrm(ks[8], (DEPTH, 6 * D_MODEL), 0.02),
        "g_pre_mix": gain(ks[9], (DEPTH, D_MODEL)),
        "g_post_mix": gain(ks[10], (DEPTH, D_MODEL)),
        "g_pre_mlp": gain(ks[11], (DEPTH, D_MODEL)),
        "g_post_mlp": gain(ks[12], (DEPTH, D_MODEL)),
        "w_in": nrm(ks[13], (DEPTH, D_MODEL, IN_TOTAL), D_MODEL ** -0.5),
        "w_conv_dn": nrm(ks[14], (DEPTH, CONV_K, 2 * DN_HEADS * DN_DK + DN_HEADS * DN_DV), CONV_K ** -0.5),
        "a_log": a_log,
        "dt_bias": dt_bias,
        "g_dn_out": gain(ks[15], (DEPTH, DN_DV)),
        "w_conv_sc": nrm(ks[18], (DEPTH, CONV_K, SC_WIDTH), CONV_K ** -0.5),
        "g_q": gain(ks[19], (DEPTH, HEAD_DIM)),
        "g_k": gain(ks[20], (DEPTH, HEAD_DIM)),
        "w_br_dn": nrm(ks[21], (DEPTH, DN_HEADS * DN_DV, D_MODEL), (DN_HEADS * DN_DV) ** -0.5),
        "w_br_sc": nrm(ks[22], (DEPTH, SC_WIDTH, D_MODEL), SC_WIDTH ** -0.5),
        "w_br_att": nrm(ks[23], (DEPTH, ATT_HEADS * HEAD_DIM, D_MODEL), (ATT_HEADS * HEAD_DIM) ** -0.5),
        "w_out": nrm(ks[24], (DEPTH, D_MODEL, D_MODEL), D_MODEL ** -0.5),
        "w_mlp_up": nrm(ks[25], (DEPTH, D_MODEL, MLP_HIDDEN), D_MODEL ** -0.5),
        "w_mlp_down": nrm(ks[26], (DEPTH, MLP_HIDDEN, D_MODEL), MLP_HIDDEN ** -0.5),
    }


def reference(x_prompt, x_sample, cache_k, cache_v, state_dn, c, c_ctx, w_mod, b_mod, g_pre_mix, g_post_mix, g_pre_mlp, g_post_mlp, w_in, w_conv_dn, a_log, dt_bias, g_dn_out, w_conv_sc, g_q, g_k, w_br_dn, w_br_sc, w_br_att, w_out, w_mlp_up, w_mlp_down):
    def layer_weights(l):
        return {"w_mod": w_mod[l], "b_mod": b_mod[l], "g_pre_mix": g_pre_mix[l], "g_post_mix": g_post_mix[l], "g_pre_mlp": g_pre_mlp[l], "g_post_mlp": g_post_mlp[l], "w_in": w_in[l], "w_conv_dn": w_conv_dn[l], "a_log": a_log[l], "dt_bias": dt_bias[l], "g_dn_out": g_dn_out[l], "w_conv_sc": w_conv_sc[l], "g_q": g_q[l], "g_k": g_k[l], "w_br_dn": w_br_dn[l], "w_br_sc": w_br_sc[l], "w_br_att": w_br_att[l], "w_out": w_out[l], "w_mlp_up": w_mlp_up[l], "w_mlp_down": w_mlp_down[l]}

    y_prompt = x_prompt
    ks, vs, ss = [], [], []
    for l in range(DEPTH):
        y_prompt, (k_l, v_l, s_l) = trunk_layer(y_prompt, c_ctx, layer_weights(l))
        ks.append(k_l)
        vs.append(v_l)
        ss.append(s_l)
    new_cache_k = jnp.stack(ks, axis=1)
    new_cache_v = jnp.stack(vs, axis=1)
    new_state_dn = jnp.stack(ss, axis=1)

    ang_row, ang_col = axial_angles(x_sample.shape[1])
    y_sample = x_sample
    for l in range(DEPTH):
        y_sample = trunk_layer(y_sample, c, layer_weights(l), ctx=(cache_k[:, l], cache_v[:, l], state_dn[:, l]), rope=(ang_row, ang_col))

    return (y_prompt, y_sample, new_cache_k, new_cache_v, new_state_dn)
```

```cpp
#define OPT 127
#include <hip/hip_runtime.h>
#include <hip/hip_bf16.h>
#include <hip/hip_cooperative_groups.h>
#include <cstdio>
#include <cstdint>
namespace cg = cooperative_groups;

typedef unsigned short bfr;
using bf16x8 = __attribute__((ext_vector_type(8))) short;
using s16x4  = __attribute__((ext_vector_type(4))) short;
using f32x4  = __attribute__((ext_vector_type(4))) float;
using f32x16 = __attribute__((ext_vector_type(16))) float;
using u32x4  = __attribute__((ext_vector_type(4))) unsigned;
using u32x2  = __attribute__((ext_vector_type(2))) unsigned;

constexpr int DM = 1024, NTOK = 6144, NCTX = 4096, DEPTH = 4;
constexpr int NIN = 11808;
constexpr int NP = 11776;
constexpr int NPAD = 12032;
constexpr int HID = 4096;
constexpr float EPS = 1e-6f;
constexpr int C_DQ = 0, C_DK = 1024, C_DV = 2048, C_DG = 3072, C_SB = 4096, C_SCG = 5120, C_SX = 6144,
              C_AQ = 7168, C_AK = 8192, C_AV = 8448, C_MG = 8704;

constexpr int REC_U = 0, REC_W = 16384, REC_QD = 32768, REC_QK = 49152, REC_KD = 57344, REC_BYTES = 73728;

struct Params {
  const float *x_prompt, *x_sample, *cache_k, *cache_v, *state_dn, *c, *c_ctx, *w_mod, *b_mod;
  const float *g_pre_mix, *g_post_mix, *g_pre_mlp, *g_post_mlp, *w_in, *w_conv_dn, *a_log, *dt_bias, *g_dn_out;
  const float *w_conv_sc, *g_q, *g_k, *w_br_dn, *w_br_sc, *w_br_att, *w_out, *w_mlp_up, *w_mlp_down;
  float *xbuf;
  float *out_ck, *out_cv, *out_state;
  bfr *wt_in, *wt_br, *wt_out, *wt_up, *wt_dn;
  float *mod;
  bfr *h;
  bfr *P;
  float *small;
  char *dnrec;
  float *glast;
  bfr *opart;
  bfr *obr;
  bfr *Q;
  bfr *Kc, *Vc;
  bfr *Ks, *Vs;
  bfr *merged;
  float *R;
  bfr *u2;
  unsigned *bar;
};

__device__ __forceinline__ bfr f2bf(float f) { unsigned u = __float_as_uint(f); u += 0x7fffu + ((u >> 16) & 1u); return (bfr)(u >> 16); }
__device__ __forceinline__ float bf2f(bfr b) { return __uint_as_float(((unsigned)b) << 16); }
__device__ __forceinline__ unsigned pack2(float a, float b) { return (unsigned)f2bf(a) | ((unsigned)f2bf(b) << 16); }
__device__ __forceinline__ float sigmoidf_(float x) { return 1.f / (1.f + __expf(-x)); }
__device__ __forceinline__ float siluf_(float x) { return x / (1.f + __expf(-x)); }
__device__ __forceinline__ float softplusf_(float x) { return x > 20.f ? x : log1pf(__expf(x)); }

__device__ __forceinline__ int tok_modrow(int t) { return t < NCTX ? 0 : 1 + ((t - NCTX) >> 10); }
__device__ __forceinline__ int tok_L(int t) { return t < NCTX ? 256 : 1024; }
__device__ __forceinline__ int tok_pos(int t) { return t < NCTX ? (t & 255) : ((t - NCTX) & 1023); }

__host__ __device__ __forceinline__ int perm_col(int n) { return n < 4096 ? n : (n < 4128 ? NP + (n - 4096) : n - 32); }
#define NTHR 512

__device__ __forceinline__ void stage_mod(const Params& p, int bid, int nblk, char* lds) {
  float* s = (float*)lds;
  float* red = s + 3072;
  const int tid = threadIdx.x;
  for (int i = tid; i < 3072; i += NTHR) { int j = i >> 10, k = i & 1023; float c = (j == 0) ? p.c_ctx[k] : p.c[(j - 1) * 1024 + k]; s[i] = siluf_(c); }
  __syncthreads();
  for (int item = bid; item < 192; item += nblk) {
    const int l = item / 48, nb = item % 48, cq = tid & 31, ks = tid >> 5;
    const float* W = p.w_mod + ((size_t)l * 1024 + ks * 64) * 6144 + nb * 128 + cq * 4;
    float a[3][4] = {};
    for (int k = 0; k < 64; ++k) {
      const float4 w = *(const float4*)(W + (size_t)k * 6144);
#pragma unroll
      for (int j = 0; j < 3; ++j) { const float sv = s[j * 1024 + ks * 64 + k]; a[j][0] += sv * w.x; a[j][1] += sv * w.y; a[j][2] += sv * w.z; a[j][3] += sv * w.w; }
    }
    __syncthreads();
#pragma unroll
    for (int j = 0; j < 3; ++j)
#pragma unroll
      for (int q = 0; q < 4; ++q) red[(ks * 3 + j) * 128 + cq * 4 + q] = a[j][q];
    __syncthreads();
    if (tid < 384) { const int j = tid >> 7, n = tid & 127; float sum = 0; for (int q = 0; q < 16; ++q) sum += red[(q * 3 + j) * 128 + n];
      p.mod[(size_t)(l * 3 + j) * 6144 + nb * 128 + n] = sum + p.b_mod[l * 6144 + nb * 128 + n]; }
  }
  __syncthreads();
}

__device__ __forceinline__ float wave_sum(float v) {
#pragma unroll
  for (int o = 32; o > 0; o >>= 1) v += __shfl_xor(v, o);
  return v;
}

__device__ __forceinline__ void stage_row(const Params& p, int l, int mode, int bid, int nblk) {
  const int wid = threadIdx.x >> 6, lane = threadIdx.x & 63;
  for (int row = bid * 8 + wid; row < NTOK; row += nblk * 8) {
    const float* modr = p.mod + (size_t)(l * 3 + tok_modrow(row)) * 6144;
    const float* xin = (l == 0 && mode <= 1) ? (row < NCTX ? p.x_prompt + (size_t)row * DM : p.x_sample + (size_t)(row - NCTX) * DM) : p.xbuf + (size_t)row * DM;
    float4 x[4];
#pragma unroll
    for (int i = 0; i < 4; ++i) x[i] = *(const float4*)(xin + lane * 4 + 256 * i);
    if (mode != 0) {
      const float* rr = p.R + (size_t)row * DM;
      const float* gpost = (mode == 1 ? p.g_post_mix : p.g_post_mlp) + l * DM;
      const float* gate = modr + (mode == 1 ? 2048 : 5120);
      float4 r[4]; float ss = 0;
#pragma unroll
      for (int i = 0; i < 4; ++i) { r[i] = *(const float4*)(rr + lane * 4 + 256 * i); ss += r[i].x * r[i].x + r[i].y * r[i].y + r[i].z * r[i].z + r[i].w * r[i].w; }
      ss = wave_sum(ss);
      const float nrm = rsqrtf(ss * (1.f / DM) + EPS);
#pragma unroll
      for (int i = 0; i < 4; ++i) {
        const float4 g = *(const float4*)(gpost + lane * 4 + 256 * i), gt = *(const float4*)(gate + lane * 4 + 256 * i);
        x[i].x += gt.x * (r[i].x * nrm * g.x); x[i].y += gt.y * (r[i].y * nrm * g.y); x[i].z += gt.z * (r[i].z * nrm * g.z); x[i].w += gt.w * (r[i].w * nrm * g.w);
        *(float4*)(p.xbuf + (size_t)row * DM + lane * 4 + 256 * i) = x[i];
      }
    }
    if (mode == 2 && l == DEPTH - 1) continue;
    const int ln = (mode == 2) ? l + 1 : l;
    const float* modn = p.mod + (size_t)(ln * 3 + tok_modrow(row)) * 6144;
    const float* gpre = (mode == 1 ? p.g_pre_mlp : p.g_pre_mix) + ln * DM;
    const float* sh = modn + (mode == 1 ? 3072 : 0);
    const float* sc = modn + (mode == 1 ? 4096 : 1024);
    float ss = 0;
#pragma unroll
    for (int i = 0; i < 4; ++i) ss += x[i].x * x[i].x + x[i].y * x[i].y + x[i].z * x[i].z + x[i].w * x[i].w;
    ss = wave_sum(ss);
    const float nrm = rsqrtf(ss * (1.f / DM) + EPS);
#pragma unroll
    for (int i = 0; i < 4; ++i) {
      const float4 g = *(const float4*)(gpre + lane * 4 + 256 * i), s1 = *(const float4*)(sc + lane * 4 + 256 * i), s0 = *(const float4*)(sh + lane * 4 + 256 * i);
      const float h0 = x[i].x * nrm * g.x * (1.f + s1.x) + s0.x, h1 = x[i].y * nrm * g.y * (1.f + s1.y) + s0.y;
      const float h2 = x[i].z * nrm * g.z * (1.f + s1.z) + s0.z, h3 = x[i].w * nrm * g.w * (1.f + s1.w) + s0.w;
      u32x2 o = {pack2(h0, h1), pack2(h2, h3)};
      *(u32x2*)(p.h + (size_t)row * DM + lane * 4 + 256 * i) = o;
    }
  }
}

__device__ __forceinline__ void unpack8(const u32x4 v, float* f) {
#pragma unroll
  for (int i = 0; i < 4; ++i) { f[2 * i] = __uint_as_float(v[i] << 16); f[2 * i + 1] = __uint_as_float(v[i] & 0xffff0000u); }
}
__device__ __forceinline__ u32x4 pack8(const float* f) { u32x4 v = {pack2(f[0], f[1]), pack2(f[2], f[3]), pack2(f[4], f[5]), pack2(f[6], f[7])}; return v; }

__device__ __forceinline__ void light_prep_item(const Params& p, int l, int c) {
  const int tid = threadIdx.x, t0 = c * 64;
  const bool samp = t0 >= NCTX;
  {
    const float* wsc = p.w_conv_sc + (size_t)l * 3 * DM;
    bfr* scin = p.obr + (size_t)1 * NTOK * DM;
    for (int idx = tid; idx < 64 * 128; idx += NTHR) {
      const int r = idx >> 7, g = idx & 127, t = t0 + r, pos = tok_pos(t), L = tok_L(t);
      float acc[8] = {};
#pragma unroll
      for (int k = -1; k <= 1; ++k) {
        if (pos + k < 0 || pos + k >= L) continue;
        const bfr* row = p.P + (size_t)(t + k) * NP;
        float a[8], b[8]; unpack8(*(const u32x4*)(row + C_SCG + g * 8), a); unpack8(*(const u32x4*)(row + C_SX + g * 8), b);
        const float4 w0 = *(const float4*)(wsc + (k + 1) * DM + g * 8), w1 = *(const float4*)(wsc + (k + 1) * DM + g * 8 + 4);
        acc[0] += w0.x * a[0] * b[0]; acc[1] += w0.y * a[1] * b[1]; acc[2] += w0.z * a[2] * b[2]; acc[3] += w0.w * a[3] * b[3];
        acc[4] += w1.x * a[4] * b[4]; acc[5] += w1.y * a[5] * b[5]; acc[6] += w1.z * a[6] * b[6]; acc[7] += w1.w * a[7] * b[7];
      }
      float sb[8]; unpack8(*(const u32x4*)(p.P + (size_t)t * NP + C_SB + g * 8), sb);
#pragma unroll
      for (int q = 0; q < 8; ++q) acc[q] *= sb[q];
      *(u32x4*)(scin + (size_t)t * DM + g * 8) = pack8(acc);
    }
  }
  {
    const int sub = tid & 15;
    for (int pr = tid >> 4; pr < 64 * 10; pr += NTHR / 16) {
      const int r = pr / 10, hh = pr % 10, t = t0 + r;
      const bool isq = hh < 8;
      const bfr* src = p.P + (size_t)t * NP + (isq ? C_AQ + hh * 128 : C_AK + (hh - 8) * 128) + sub * 8;
      float x[8]; unpack8(*(const u32x4*)src, x);
      float ss = 0;
#pragma unroll
      for (int q = 0; q < 8; ++q) ss += x[q] * x[q];
      ss += __shfl_xor(ss, 1); ss += __shfl_xor(ss, 2); ss += __shfl_xor(ss, 4); ss += __shfl_xor(ss, 8);
      const float nrm = rsqrtf(ss * (1.f / 128.f) + EPS);
      const float* g = (isq ? p.g_q : p.g_k) + l * 128 + sub * 8;
#pragma unroll
      for (int q = 0; q < 8; ++q) x[q] = x[q] * nrm * g[q];
      if (samp) {
        const int pos = tok_pos(t);
        const float pidx = (sub < 8) ? (float)(pos >> 6) : (float)(pos & 63);
        const int s8 = sub & 7;
        const bool lo = s8 < 4;
        float y[8];
#pragma unroll
        for (int q = 0; q < 8; ++q) {
          const float other = __shfl_xor(x[q], 4);
          const int fi = (s8 & 3) * 8 + q;
          const float freq = exp2f(-(float)fi * (13.287712379549449f / 32.f));
          const float ang = pidx * freq;
          float sn, cs; __sincosf(ang, &sn, &cs);
          y[q] = lo ? (x[q] * cs - other * sn) : (other * sn + x[q] * cs);
        }
#pragma unroll
        for (int q = 0; q < 8; ++q) x[q] = y[q];
      }
      if (isq) {
        *(u32x4*)(p.Q + (size_t)t * DM + hh * 128 + sub * 8) = pack8(x);
      } else {
        const int kvh = hh - 8;
        if (!samp) {
          *(u32x4*)(p.Kc + (size_t)t * 256 + kvh * 128 + sub * 8) = pack8(x);
          const int b = t >> 8, pos = t & 255;
          float* o = p.out_ck + ((((size_t)b * DEPTH + l) * 256 + pos) * 2 + kvh) * 128 + sub * 8;
          *(float4*)o = make_float4(x[0], x[1], x[2], x[3]); *(float4*)(o + 4) = make_float4(x[4], x[5], x[6], x[7]);
        } else {
          const int s = t - NCTX, b = s >> 10, pos = s & 1023;
          *(u32x4*)(p.Ks + ((size_t)b * 1280 + 256 + pos) * 256 + kvh * 128 + sub * 8) = pack8(x);
        }
      }
    }
  }
  for (int idx = tid; idx < 64 * 32; idx += NTHR) {
    const int r = idx >> 5, g = idx & 31, t = t0 + r;
    const u32x4 v = *(const u32x4*)(p.P + (size_t)t * NP + C_AV + g * 8);
    if (!samp) {
      *(u32x4*)(p.Vc + (size_t)t * 256 + g * 8) = v;
      float f[8]; unpack8(v, f);
      const int b = t >> 8, pos = t & 255;
      float* o = p.out_cv + (((size_t)b * DEPTH + l) * 256 + pos) * 256 + g * 8;
      *(float4*)o = make_float4(f[0], f[1], f[2], f[3]); *(float4*)(o + 4) = make_float4(f[4], f[5], f[6], f[7]);
    } else {
      const int s = t - NCTX, b = s >> 10, pos = s & 1023;
      *(u32x4*)(p.Vs + ((size_t)b * 1280 + 256 + pos) * 256 + g * 8) = v;
    }
  }
  if (samp) {
    const int cs = c - 64, b = cs >> 4, pos0 = (cs & 15) * 16;
    for (int idx = tid; idx < 2 * 16 * 32; idx += NTHR) {
      const int which = idx >> 9, r = (idx >> 5) & 15, g = idx & 31, pos = pos0 + r;
      const float* src = (which ? p.cache_v : p.cache_k) + (((size_t)b * DEPTH + l) * 256 + pos) * 256 + g * 8;
      float f[8]; *(float4*)f = *(const float4*)src; *(float4*)(f + 4) = *(const float4*)(src + 4);
      *(u32x4*)((which ? p.Vs : p.Ks) + ((size_t)b * 1280 + pos) * 256 + g * 8) = pack8(f);
    }
  }
}

__device__ __forceinline__ void dn_finalize(const Params& p, int l, int t0, int n, int h, int tid0, int nthr) {
  const int sub = tid0 & 15;
  const float* g = p.g_dn_out + l * 128 + sub * 8;
  for (int r = tid0 >> 4; r < n; r += nthr / 16) {
    const int t = t0 + r;
    float a[8], b[8], dg[8];
    unpack8(*(const u32x4*)(p.opart + (size_t)t * DM + h * 128 + sub * 8), a);
    unpack8(*(const u32x4*)(p.opart + (size_t)NTOK * DM + (size_t)t * DM + h * 128 + sub * 8), b);
    unpack8(*(const u32x4*)(p.P + (size_t)t * NP + C_DG + h * 128 + sub * 8), dg);
    float ss = 0;
#pragma unroll
    for (int q = 0; q < 8; ++q) { a[q] += b[q]; ss += a[q] * a[q]; }
    ss += __shfl_xor(ss, 1); ss += __shfl_xor(ss, 2); ss += __shfl_xor(ss, 4); ss += __shfl_xor(ss, 8);
    const float nrm = rsqrtf(ss * (1.f / 128.f) + EPS);
#pragma unroll
    for (int q = 0; q < 8; ++q) a[q] = a[q] * nrm * g[q] * siluf_(dg[q]);
    *(u32x4*)(p.obr + (size_t)t * DM + h * 128 + sub * 8) = pack8(a);
  }
}
extern __shared__ __attribute__((aligned(16))) char smem[];
constexpr int HT_BYTES = 128 * 64 * 2;

__device__ __forceinline__ int lds_byte(int r, int c) {
  int st = (r >> 4) * 2 + (c >> 5), rr = r & 15, cc = c & 31, ob = rr * 64 + cc * 2;
  return st * 1024 + (ob ^ (((ob >> 9) & 1) << 5));
}
__device__ __forceinline__ void stage_rc(int b, int& R, int& C) {
  int st = b / 1024, sb = b % 1024, swz = sb ^ (((sb >> 9) & 1) << 5);
  R = (st >> 1) * 16 + swz / 64; C = (st & 1) * 32 + (swz % 64) / 2;
}
__device__ __forceinline__ void stage_half(const bfr* G, long ld, int row0, int k0, int loff) {
#pragma unroll
  for (int i = 0; i < 2; ++i) {
    const int b = threadIdx.x * 16 + i * 8192; int r, c; stage_rc(b, r, c);
    __builtin_amdgcn_global_load_lds((const unsigned*)(G + (long)(row0 + r) * ld + k0 + c), (__attribute__((address_space(3))) unsigned*)(smem + loff + b), 16, 0, 0);
  }
}

template <int NB, class AccT>
__device__ __forceinline__ void gemm_mainloop(const bfr* A, long lda, const bfr* Bt, long ldb, int K, int brow, int bcol, AccT& acc) {
  const int wid = threadIdx.x >> 6, lane = threadIdx.x & 63, wr = wid >> 2, wc = wid & 3, fr = lane & 15, fq = lane >> 4;
  constexpr int STG = (2 + NB) * HT_BYTES;
  const int nt = K / 64;
  auto stage = [&](int s, int kt) {
    stage_half(A, lda, brow, kt * 64, s * STG);
    stage_half(A, lda, brow + 128, kt * 64, s * STG + HT_BYTES);
#pragma unroll
    for (int j = 0; j < NB; ++j) stage_half(Bt, ldb, bcol + j * 128, kt * 64, s * STG + (2 + j) * HT_BYTES);
  };
  stage(0, 0);
  asm volatile("s_waitcnt vmcnt(0)" ::: "memory");
  __syncthreads();
  for (int t = 0; t < nt; ++t) {
    const int s = t & 1;
    if (t + 1 < nt) stage(s ^ 1, t + 1);
    const char* base = smem + s * STG;
    bf16x8 Bf[NB][2][2];
#pragma unroll
    for (int j = 0; j < NB; ++j)
#pragma unroll
      for (int n = 0; n < 2; ++n)
#pragma unroll
        for (int k = 0; k < 2; ++k) Bf[j][n][k] = *(const bf16x8*)(base + (2 + j) * HT_BYTES + lds_byte(wc * 32 + n * 16 + fr, k * 32 + fq * 8));
#pragma unroll
    for (int ai = 0; ai < 2; ++ai) {
      bf16x8 Af[4][2];
#pragma unroll
      for (int m = 0; m < 4; ++m)
#pragma unroll
        for (int k = 0; k < 2; ++k) Af[m][k] = *(const bf16x8*)(base + ai * HT_BYTES + lds_byte(wr * 64 + m * 16 + fr, k * 32 + fq * 8));
#pragma unroll
      for (int j = 0; j < NB; ++j)
#pragma unroll
        for (int m = 0; m < 4; ++m)
#pragma unroll
          for (int n = 0; n < 2; ++n)
#pragma unroll
            for (int k = 0; k < 2; ++k) acc.a[ai][j][m][n] = __builtin_amdgcn_mfma_f32_16x16x32_bf16(Af[m][k], Bf[j][n][k], acc.a[ai][j][m][n], 0, 0, 0);
    }
    asm volatile("s_waitcnt vmcnt(0)" ::: "memory");
    __syncthreads();
  }
}
template <int NB> struct Acc { f32x4 a[2][NB][4][2]; };
template <int NB> __device__ __forceinline__ void acc_zero(Acc<NB>& acc) {
#pragma unroll
  for (int ai = 0; ai < 2; ++ai)
#pragma unroll
    for (int j = 0; j < NB; ++j)
#pragma unroll
      for (int m = 0; m < 4; ++m)
#pragma unroll
        for (int n = 0; n < 2; ++n) acc.a[ai][j][m][n] = f32x4{0.f, 0.f, 0.f, 0.f};
}
template <int NB, class F> __device__ __forceinline__ void acc_foreach(Acc<NB>& acc, int brow, int bcol, F f) {
  const int wid = threadIdx.x >> 6, lane = threadIdx.x & 63, wr = wid >> 2, wc = wid & 3, fr = lane & 15, fq = lane >> 4;
#pragma unroll
  for (int ai = 0; ai < 2; ++ai)
#pragma unroll
    for (int j = 0; j < NB; ++j)
#pragma unroll
      for (int m = 0; m < 4; ++m)
#pragma unroll
        for (int n = 0; n < 2; ++n)
#pragma unroll
          for (int q = 0; q < 4; ++q) f(brow + ai * 128 + wr * 64 + m * 16 + fq * 4 + q, bcol + j * 128 + wc * 32 + n * 16 + fr, acc.a[ai][j][m][n][q]);
}

template <class MapF>
__device__ __forceinline__ void convert_tile(const float* W, int N, int kt, int ntile, bfr* dst, int ldd, MapF mapf) {
  float* tile = (float*)smem;
  const int tid = threadIdx.x;
  __syncthreads();
#pragma unroll
  for (int pass = 0; pass < 2; ++pass) {
    const int idx = tid + pass * 512, kr = idx >> 4, c4 = idx & 15, n = ntile * 64 + c4 * 4;
    float4 v = make_float4(0.f, 0.f, 0.f, 0.f);
    if (n < N) v = *(const float4*)(W + (size_t)(kt * 64 + kr) * N + n);
    tile[kr * 65 + c4 * 4 + 0] = v.x; tile[kr * 65 + c4 * 4 + 1] = v.y; tile[kr * 65 + c4 * 4 + 2] = v.z; tile[kr * 65 + c4 * 4 + 3] = v.w;
  }
  __syncthreads();
  const int nn = tid >> 3, kg = tid & 7, n = ntile * 64 + nn;
  if (n < N) {
    float f[8];
#pragma unroll
    for (int j = 0; j < 8; ++j) f[j] = tile[(kg * 8 + j) * 65 + nn];
    *(u32x4*)(dst + (size_t)mapf(n) * ldd + kt * 64 + kg * 8) = pack8(f);
  }
}
constexpr int CONV_ITEMS = 6088;
__device__ __forceinline__ void convert_item(const Params& p, int l, int it) {
  if (it < 2960) { const int kt = it / 185, nt = it % 185; convert_tile(p.w_in + (size_t)l * DM * NIN, NIN, kt, nt, p.wt_in + (size_t)l * NPAD * DM, DM, [](int n) { return perm_col(n); }); }
  else if (it < 3728) { const int j = it - 2960, br = j >> 8, kt = (j >> 4) & 15, nt = j & 15;
    const float* W = p.w_br_dn; if (br == 1) W = p.w_br_sc; if (br == 2) W = p.w_br_att; W += (size_t)l * DM * DM;
    convert_tile(W, DM, kt, nt, p.wt_br + ((size_t)l * 3 + br) * DM * DM, DM, [](int n) { return n; }); }
  else if (it < 3984) { const int j = it - 3728, kt = j >> 4, nt = j & 15; convert_tile(p.w_out + (size_t)l * DM * DM, DM, kt, nt, p.wt_out + (size_t)l * DM * DM, DM, [](int n) { return n; }); }
  else if (it < 5008) { const int j = it - 3984, kt = j >> 6, nt = j & 63; convert_tile(p.w_mlp_up + (size_t)l * DM * HID, HID, kt, nt, p.wt_up + (size_t)l * HID * DM, DM, [](int n) { return n; }); }
  else if (it < 6032) { const int j = it - 5008, kt = j >> 4, nt = j & 15; convert_tile(p.w_mlp_down + (size_t)l * HID * DM, DM, kt, nt, p.wt_dn + (size_t)l * DM * HID, HID, [](int n) { return n; }); }
  else { const int j = it - 6032;
    bfr* d = p.wt_in + ((size_t)l * NPAD + NP + 32 + j * 4) * DM;
    *(u32x4*)(d + threadIdx.x * 8) = u32x4{0u, 0u, 0u, 0u}; }
}

__device__ __forceinline__ void gemm_in_tile(const Params& p, int l, int tile) {
  const int mt = tile % 24, nt = tile / 24, brow = mt * 256, bcol = nt * 256;
  Acc<2> acc; acc_zero(acc);
  gemm_mainloop<2>(p.h, DM, p.wt_in + (size_t)l * NPAD * DM, DM, DM, brow, bcol, acc);
  if (nt < 34) acc_foreach(acc, brow, bcol, [&](int r, int c, float v) { p.P[(size_t)r * NP + c] = f2bf(v); });
  else if (nt < 46) acc_foreach(acc, brow, bcol, [&](int r, int c, float v) { p.P[(size_t)r * NP + c] = f2bf(sigmoidf_(v)); });
  else acc_foreach(acc, brow, bcol, [&](int r, int c, float v) { if (c < NP + 32) p.small[(size_t)r * 32 + (c - NP)] = v; });
}
__device__ __forceinline__ void gemm_up_tile(const Params& p, int l, int tile) {
  const int mt = tile % 24, nt = tile / 24, brow = mt * 256, bcol = nt * 256;
  Acc<2> acc; acc_zero(acc);
  gemm_mainloop<2>(p.h, DM, p.wt_up + (size_t)l * HID * DM, DM, DM, brow, bcol, acc);
  acc_foreach(acc, brow, bcol, [&](int r, int c, float v) { const float x = fmaxf(v, 0.f); p.u2[(size_t)r * HID + c] = f2bf(x * x); });
}
__device__ __forceinline__ void gemm_out_tile(const Params& p, int l, int tile) {
  const int mt = tile % 24, nt = tile / 24, brow = mt * 256, bcol = nt * 128;
  Acc<1> acc; acc_zero(acc);
  gemm_mainloop<1>(p.merged, DM, p.wt_out + (size_t)l * DM * DM, DM, DM, brow, bcol, acc);
  acc_foreach(acc, brow, bcol, [&](int r, int c, float v) { p.R[(size_t)r * DM + c] = v; });
}
__device__ __forceinline__ void gemm_down_tile(const Params& p, int l, int tile) {
  const int mt = tile % 24, nt = tile / 24, brow = mt * 256, bcol = nt * 128;
  Acc<1> acc; acc_zero(acc);
  gemm_mainloop<1>(p.u2, HID, p.wt_dn + (size_t)l * DM * HID, HID, HID, brow, bcol, acc);
  acc_foreach(acc, brow, bcol, [&](int r, int c, float v) { p.R[(size_t)r * DM + c] = v; });
}
__device__ __forceinline__ void gemm_br_tile(const Params& p, int l, int tile) {
  const int mt = tile % 24, nt = tile / 24, brow = mt * 256, bcol = nt * 128;
  Acc<1> tot; acc_zero(tot);
#pragma unroll 1
  for (int br = 0; br < 3; ++br) {
    Acc<1> acc; acc_zero(acc);
    gemm_mainloop<1>(p.obr + (size_t)br * NTOK * DM, DM, p.wt_br + ((size_t)l * 3 + br) * DM * DM, DM, DM, brow, bcol, acc);
    const bfr* G = p.P + C_MG + br * DM;
    const int wid = threadIdx.x >> 6, lane = threadIdx.x & 63, wr = wid >> 2, wc = wid & 3, fr = lane & 15, fq = lane >> 4;
    const bfr* Gl = G + (size_t)(brow + wr * 64 + fq * 4) * NP + bcol + wc * 32 + fr;
#pragma unroll
    for (int ai = 0; ai < 2; ++ai)
#pragma unroll
      for (int m = 0; m < 4; ++m) {
        const bfr* Gm = Gl + (size_t)(ai * 128 + m * 16) * NP;
        asm volatile("" : "+v"(Gm) :: "memory");
#pragma unroll
        for (int n = 0; n < 2; ++n)
#pragma unroll
          for (int q = 0; q < 4; ++q) tot.a[ai][0][m][n][q] += bf2f(Gm[q * NP + n * 16]) * acc.a[ai][0][m][n][q];
      }
  }
  acc_foreach(tot, brow, bcol, [&](int r, int c, float v) { p.merged[(size_t)r * DM + c] = f2bf(v); });
}
namespace att {
constexpr int D = 128, NW = 8, QBLK = 32, KVBLK = 64;
constexpr float SCALE = 0.088388347648318440f;
constexpr float THR = 8.f;
constexpr int SDEPTH = 2;
constexpr int LDQ = 1024, LDK = 256, LDO = 1024;
constexpr size_t SHM_V = KVBLK * D * 2, SHM_K = KVBLK * D * 2, SHM_ATTN = 2 * SHM_V + 2 * SHM_K + NW * 64 * 4;
using bf16 = bfr;
using f32x8  = __attribute__((ext_vector_type(8))) float;
#define KSWZ(row, colB) ((row) * 256 + ((colB) ^ (((row) & 7) << 4)))
#define SBAR() __builtin_amdgcn_sched_barrier(0)
__device__ __forceinline__ int crow(int r, int hi) { return (r & 3) + 8 * (r >> 2) + 4 * hi; }
__device__ __forceinline__ unsigned cvtpk(float lo, float hi) {
  unsigned r; asm volatile("v_cvt_pk_bf16_f32 %0, %1, %2" : "=v"(r) : "v"(lo), "v"(hi)); return r;
}
template <typename TIn> struct Stage;
template <> struct Stage<bf16>  { using T = bf16x8;
  __device__ static __forceinline__ T ld8(const bf16* p) { return *reinterpret_cast<const bf16x8*>(p); }
  __device__ static __forceinline__ bf16x8 tobf(T x) { return x; } };
template <> struct Stage<float> { using T = f32x8;
  __device__ static __forceinline__ T ld8(const float* p) { return *reinterpret_cast<const f32x8*>(p); }
  __device__ static __forceinline__ bf16x8 tobf(T x) {
    u32x4 w = {cvtpk(x[0], x[1]), cvtpk(x[2], x[3]), cvtpk(x[4], x[5]), cvtpk(x[6], x[7])}; return *reinterpret_cast<bf16x8*>(&w); } };

__device__ __forceinline__ void partialSM(f32x16& p0, f32x16& p1, float& m_reg, float& mn, float& alpha) {
  constexpr float C = SCALE * 1.4426950408889634f;
  float pmax = p0[0]; for (int r = 1; r < 16; ++r) pmax = fmaxf(pmax, p0[r]); for (int r = 0; r < 16; ++r) pmax = fmaxf(pmax, p1[r]);
  { auto rr = __builtin_amdgcn_permlane32_swap(__float_as_uint(pmax), __float_as_uint(pmax), false, false);
    pmax = fmaxf(__uint_as_float(rr[0]), __uint_as_float(rr[1])); }
  if (__builtin_expect(__all(pmax - m_reg <= THR / SCALE), 1)) { mn = m_reg; alpha = 1.f; }
  else { mn = fmaxf(m_reg, pmax); alpha = __builtin_amdgcn_exp2f((m_reg - mn) * C); m_reg = mn; }
  float mnC = -mn * C;
  for (int r = 0; r < 16; ++r) p0[r] = fmaf(p0[r], C, mnC); for (int r = 0; r < 16; ++r) p1[r] = fmaf(p1[r], C, mnC);
  for (int r = 0; r < 16; ++r) p0[r] = __builtin_amdgcn_exp2f(p0[r]);
}
__device__ __forceinline__ void finishSM(f32x16& p0, f32x16& p1, float alpha, float& l_reg, bf16x8& pa0, bf16x8& pa1, bf16x8& pa2, bf16x8& pa3) {
  for (int r = 0; r < 16; ++r) p1[r] = __builtin_amdgcn_exp2f(p1[r]);
  float ps = 0; for (int r = 0; r < 16; ++r) ps += p0[r]; for (int r = 0; r < 16; ++r) ps += p1[r];
  { auto rr = __builtin_amdgcn_permlane32_swap(__float_as_uint(ps), __float_as_uint(ps), false, false);
    ps = __uint_as_float(rr[0]) + __uint_as_float(rr[1]); }
  l_reg = l_reg * alpha + ps;
#define PK4(P, BASE, OUT) do { unsigned a0 = cvtpk(P[BASE + 0], P[BASE + 1]), a1 = cvtpk(P[BASE + 2], P[BASE + 3]);   \
    unsigned b0 = cvtpk(P[BASE + 4], P[BASE + 5]), b1 = cvtpk(P[BASE + 6], P[BASE + 7]);                              \
    auto r0 = __builtin_amdgcn_permlane32_swap(a0, b0, false, false); auto r1 = __builtin_amdgcn_permlane32_swap(a1, b1, false, false); \
    u32x4 w = {r0[0], r1[0], r0[1], r1[1]}; OUT = *reinterpret_cast<bf16x8*>(&w); } while (0)
  PK4(p0, 0, pa0); PK4(p0, 8, pa1); PK4(p1, 0, pa2); PK4(p1, 8, pa3);
#undef PK4
}
__device__ __forceinline__ void qkt(f32x16& p0, f32x16& p1, const bf16* Ks, const bf16x8* qr, int r32, int hi) {
  p0 = f32x16{}; p1 = f32x16{};
  for (int d0 = 0; d0 < 8; ++d0) { int cb = (d0 * 16 + hi * 8) * 2;
    bf16x8 b0 = *reinterpret_cast<const bf16x8*>((const char*)Ks + KSWZ(r32, cb));
    bf16x8 b1 = *reinterpret_cast<const bf16x8*>((const char*)Ks + KSWZ(32 + r32, cb));
    p0 = __builtin_amdgcn_mfma_f32_32x32x16_bf16(b0, qr[d0], p0, 0, 0, 0);
    p1 = __builtin_amdgcn_mfma_f32_32x32x16_bf16(b1, qr[d0], p1, 0, 0, 0); }
}
__device__ __forceinline__ int v_st(int k, int c) { const int kk = (k & ~0xC) | ((k & 4) << 1) | ((k & 8) >> 1); return ((kk >> 3) * 4 + (c >> 5)) * 512 + ((kk & 7) * 32 + (c & 31)) * 2; }
__device__ __forceinline__ int v_rd_base(int lane) { return ((lane & 3) << 3) | (((lane >> 2) & 3) << 6) | (((lane >> 4) & 1) << 5) | (((lane >> 5) & 1) << 8); }
constexpr int v_rd_off(int d0, int ks, int half) { return d0 * 512 + ks * 4096 + half * 2048; }
template <int OFF> __device__ __forceinline__ s16x4 tr_read(int vb) {
  s16x4 r; asm volatile("ds_read_b64_tr_b16 %0, %1 offset:%2" : "=&v"(r) : "v"(vb), "i"(OFF) : "memory"); return r;
}
template <int D0> __device__ __forceinline__ void pv_one(f32x16& od, int vb, bf16x8 pa0, bf16x8 pa1, bf16x8 pa2, bf16x8 pa3) {
  const s16x4 l0 = tr_read<v_rd_off(D0, 0, 0)>(vb), h0 = tr_read<v_rd_off(D0, 0, 1)>(vb), l1 = tr_read<v_rd_off(D0, 1, 0)>(vb), h1 = tr_read<v_rd_off(D0, 1, 1)>(vb);
  const s16x4 l2 = tr_read<v_rd_off(D0, 2, 0)>(vb), h2 = tr_read<v_rd_off(D0, 2, 1)>(vb), l3 = tr_read<v_rd_off(D0, 3, 0)>(vb), h3 = tr_read<v_rd_off(D0, 3, 1)>(vb);
  asm volatile("s_waitcnt lgkmcnt(0)" ::: "memory"); SBAR();
#define PK(L, H) (bf16x8){L[0], L[1], L[2], L[3], H[0], H[1], H[2], H[3]}
  od = __builtin_amdgcn_mfma_f32_32x32x16_bf16(pa0, PK(l0, h0), od, 0, 0, 0);
  od = __builtin_amdgcn_mfma_f32_32x32x16_bf16(pa1, PK(l1, h1), od, 0, 0, 0);
  od = __builtin_amdgcn_mfma_f32_32x32x16_bf16(pa2, PK(l2, h2), od, 0, 0, 0);
  od = __builtin_amdgcn_mfma_f32_32x32x16_bf16(pa3, PK(l3, h3), od, 0, 0, 0);
#undef PK
}
__device__ __forceinline__ void pv_d0(f32x16* o, int vb, bf16x8 pa0, bf16x8 pa1, bf16x8 pa2, bf16x8 pa3) {
  pv_one<0>(o[0], vb, pa0, pa1, pa2, pa3); pv_one<1>(o[1], vb, pa0, pa1, pa2, pa3); pv_one<2>(o[2], vb, pa0, pa1, pa2, pa3); pv_one<3>(o[3], vb, pa0, pa1, pa2, pa3);
}

template <typename TQ>
__device__ __forceinline__ void attn_dense_body(const TQ* __restrict__ Qb, const bf16* __restrict__ Kh, const bf16* __restrict__ Vh,
                                                bfr* __restrict__ Ob, int seq, char* lds) {
  using St = Stage<bf16>; using SQ = Stage<TQ>;
  const int tid = threadIdx.x, wid = tid >> 6, lane = tid & 63, r32 = lane & 31, hi = lane >> 5;
  bf16* V_lds = (bf16*)lds; bf16* K_lds = (bf16*)(lds + 2 * SHM_V);
  float* ws = (float*)(lds + 2 * SHM_V + 2 * SHM_K) + wid * 64; float* li_l = ws; float* al_l = ws + 32;
  float m_reg = -1e30f, l_reg = 0; f32x16 o[4] = {}; bf16x8 qr[8];
  const TQ* Qw = Qb + (long)(wid * QBLK + r32) * LDQ + hi * 8;
#pragma unroll
  for (int d0 = 0; d0 < 8; ++d0) qr[d0] = SQ::tobf(SQ::ld8(Qw + d0 * 16));
  const int sr = tid >> 4, sc = (tid & 15) * 8, vst0 = v_st(sr, sc), vst1 = v_st(32 + sr, sc);
  const int vb0 = (int)(uintptr_t)V_lds + v_rd_base(lane);
  struct { typename St::T vs0, vs1, ks0, ks1; } sr_[SDEPTH];
#define SLOAD(i, k0) do { sr_[i].vs0 = St::ld8(&Vh[(long)((k0) + sr) * LDK + sc]); sr_[i].vs1 = St::ld8(&Vh[(long)((k0) + 32 + sr) * LDK + sc]); \
    sr_[i].ks0 = St::ld8(&Kh[(long)((k0) + sr) * LDK + sc]); sr_[i].ks1 = St::ld8(&Kh[(long)((k0) + 32 + sr) * LDK + sc]); } while (0)
#define SWRITE(b, i) do { *(bf16x8*)((char*)V_lds + (b) * SHM_V + vst0) = St::tobf(sr_[i].vs0);          \
    *(bf16x8*)((char*)V_lds + (b) * SHM_V + vst1) = St::tobf(sr_[i].vs1); int kc = sc * 2;               \
    *(bf16x8*)((char*)K_lds + (b) * SHM_K + KSWZ(sr, kc)) = St::tobf(sr_[i].ks0);                       \
    *(bf16x8*)((char*)K_lds + (b) * SHM_K + KSWZ(32 + sr, kc)) = St::tobf(sr_[i].ks1); } while (0)
#define SWAIT() do { if constexpr (SDEPTH == 2) asm volatile("s_waitcnt vmcnt(4)" ::: "memory"); else asm volatile("s_waitcnt vmcnt(0)" ::: "memory"); } while (0)
#define RESC(a) do { if (__any((a) < 1.f)) { if (hi == 0) al_l[r32] = (a); asm volatile("s_waitcnt lgkmcnt(0)" ::: "memory"); \
    for (int d = 0; d < 4; ++d) for (int r = 0; r < 16; ++r) o[d][r] *= al_l[crow(r, hi)]; } } while (0)
  f32x16 pA0, pA1, pB0, pB1; float mnA, mnB, alA, alB; bf16x8 pa0, pa1, pa2, pa3; const int NT = seq / KVBLK;
  constexpr int SE = 0, SO = SDEPTH - 1;
  SLOAD(SE, 0); asm volatile("s_waitcnt vmcnt(0)" ::: "memory"); SWRITE(0, SE); __syncthreads();
  qkt(pA0, pA1, K_lds, qr, r32, hi); partialSM(pA0, pA1, m_reg, mnA, alA);
  SLOAD(SO, KVBLK); if constexpr (SDEPTH == 2) { if (2 < NT) SLOAD(SE, 2 * KVBLK); }
  SWAIT(); SWRITE(1, SO); __syncthreads();
  for (int j = 1; j + 1 < NT; j += 2) {
    SBAR(); qkt(pB0, pB1, (bf16*)((char*)K_lds + SHM_K), qr, r32, hi);
    finishSM(pA0, pA1, alA, l_reg, pa0, pa1, pa2, pa3); SBAR();
    SLOAD(SO, (j + SDEPTH) * KVBLK); SBAR();
    pv_d0(o, vb0, pa0, pa1, pa2, pa3); partialSM(pB0, pB1, m_reg, mnB, alB);
    __syncthreads(); SWAIT(); SWRITE(0, SE);
    RESC(alB); __syncthreads();
    SBAR(); qkt(pA0, pA1, K_lds, qr, r32, hi);
    finishSM(pB0, pB1, alB, l_reg, pa0, pa1, pa2, pa3); SBAR();
    if (SDEPTH == 1 || j + 3 < NT) SLOAD(SE, (j + 1 + SDEPTH) * KVBLK); SBAR();
    pv_d0(o, vb0 + (int)SHM_V, pa0, pa1, pa2, pa3); partialSM(pA0, pA1, m_reg, mnA, alA);
    __syncthreads(); SWAIT(); SWRITE(1, SO);
    RESC(alA); __syncthreads();
  }
  SBAR(); qkt(pB0, pB1, (bf16*)((char*)K_lds + SHM_K), qr, r32, hi);
  finishSM(pA0, pA1, alA, l_reg, pa0, pa1, pa2, pa3); SBAR();
  pv_d0(o, vb0, pa0, pa1, pa2, pa3); partialSM(pB0, pB1, m_reg, mnB, alB);
  __syncthreads(); RESC(alB);
  finishSM(pB0, pB1, alB, l_reg, pa0, pa1, pa2, pa3); SBAR();
  pv_d0(o, vb0 + (int)SHM_V, pa0, pa1, pa2, pa3);
  if (hi == 0) li_l[r32] = l_reg; asm volatile("s_waitcnt lgkmcnt(0)" ::: "memory");
  float rli[16];
#pragma unroll
  for (int r = 0; r < 16; ++r) rli[r] = __builtin_amdgcn_rcpf(li_l[crow(r, hi)]);
  bfr* Ow = Ob + (long)(wid * QBLK) * LDO;
#pragma unroll
  for (int r = 0; r < 16; ++r) { int orow = crow(r, hi);
    for (int d0 = 0; d0 < 4; ++d0) Ow[(long)orow * LDO + d0 * 32 + r32] = f2bf(o[d0][r] * rli[r]); }
#undef SLOAD
#undef SWRITE
#undef SWAIT
#undef RESC
}

}

__device__ __forceinline__ void attn_item(const Params& p, int item) {
  __syncthreads();
  if (item < 64) {
    const int b = item >> 5, h = (item >> 2) & 7, qb = item & 3; const size_t t0 = NCTX + b * 1024 + qb * 256;
    att::attn_dense_body<bfr>(p.Q + t0 * DM + h * 128, p.Ks + (size_t)b * 1280 * 256 + (h >> 2) * 128, p.Vs + (size_t)b * 1280 * 256 + (h >> 2) * 128,
                              p.obr + (size_t)2 * NTOK * DM + t0 * DM + h * 128, 1280, smem);
  } else {
    const int j = item - 64, b = j >> 3, h = j & 7; const size_t t0 = b * 256;
    att::attn_dense_body<bfr>(p.Q + t0 * DM + h * 128, p.Kc + (size_t)b * 256 * 256 + (h >> 2) * 128, p.Vc + (size_t)b * 256 * 256 + (h >> 2) * 128,
                              p.obr + (size_t)2 * NTOK * DM + t0 * DM + h * 128, 256, smem);
  }
}
constexpr float SCALEQ = 0.08838834764831845f;
constexpr int PQH = 0, PKH = 17408, PVH = 34816, PKK = 52224, PQK = 68864, PXS = 52224, PMD = 117760, PMB = 125952, PGC = 142336, PRS = 0;
constexpr int LROW = 272;

__device__ __forceinline__ float ld_bf(const char* base, int byteoff) { return bf2f(*(const bfr*)(base + byteoff)); }

template <int B>
__device__ __forceinline__ void solve_block(int d, int e, int wid, int lane) {
  const int fr = lane & 15, hq = lane >> 4;
  char* xcol = smem + PXS + ((d * 256 + e) * 64 + 16 * B) * 2;
  float acc[16];
  { const u32x4 a = *(const u32x4*)xcol, b = *(const u32x4*)(xcol + 16); unpack8(a, acc); unpack8(b, acc + 8); }
  if (B > 0) {
    constexpr int NKS = (B + 1) / 2;
    f32x4 R[4];
#pragma unroll
    for (int ct = 0; ct < 4; ++ct) R[ct] = f32x4{0.f, 0.f, 0.f, 0.f};
#pragma unroll
    for (int ks = 0; ks < NKS; ++ks) {
      const bf16x8 a = *(const bf16x8*)(smem + PMB + ((d * 64 + 16 * B + fr) * 64 + ks * 32 + 8 * hq) * 2);
#pragma unroll
      for (int ct = 0; ct < 4; ++ct) {
        const bf16x8 b = *(const bf16x8*)(smem + PXS + ((d * 256 + (wid & 3) * 64 + ct * 16 + fr) * 64 + ks * 32 + 8 * hq) * 2);
        R[ct] = __builtin_amdgcn_mfma_f32_16x16x32_bf16(a, b, R[ct], 0, 0, 0);
      }
    }
    float* rs = (float*)(smem + PRS + wid * 4096);
#pragma unroll
    for (int ct = 0; ct < 4; ++ct)
#pragma unroll
      for (int r = 0; r < 4; ++r) rs[(4 * hq + r) * 64 + ct * 16 + fr] = R[ct][r];
    asm volatile("s_waitcnt lgkmcnt(0)" ::: "memory");
#pragma unroll
    for (int r = 0; r < 16; ++r) acc[r] -= rs[r * 64 + lane];
  }
  const float4* md = (const float4*)(smem + PMD) + ((d * 4 + B) * 16) * 4;
#pragma unroll
  for (int r2 = 0; r2 < 15; ++r2) {
#pragma unroll
    for (int q = (r2 + 1) / 4; q < 4; ++q) {
      const float4 m = md[r2 * 4 + q];
      if (4 * q + 0 > r2) acc[4 * q + 0] -= m.x * acc[r2];
      if (4 * q + 1 > r2) acc[4 * q + 1] -= m.y * acc[r2];
      if (4 * q + 2 > r2) acc[4 * q + 2] -= m.z * acc[r2];
      if (4 * q + 3 > r2) acc[4 * q + 3] -= m.w * acc[r2];
    }
  }
  *(u32x4*)xcol = pack8(acc); *(u32x4*)(xcol + 16) = pack8(acc + 8);
  asm volatile("s_waitcnt lgkmcnt(0)" ::: "memory");
}

__device__ __forceinline__ void dn_prep_item(const Params& p, int l, int c, int h) {
  const int tid = threadIdx.x, wid = tid >> 6, lane = tid & 63;
  const int t0 = c * 64;
  __syncthreads();
  {
    const int grp = tid & 15;
    const float* wc = p.w_conv_dn + (size_t)l * 3 * 3072 + h * 128 + grp * 8;
#pragma unroll 1
    for (int X = 0; X < 3; ++X) {
      float w[3][8];
#pragma unroll
      for (int k = 0; k < 3; ++k) { *(float4*)&w[k][0] = *(const float4*)(wc + k * 3072 + X * 1024); *(float4*)&w[k][4] = *(const float4*)(wc + k * 3072 + X * 1024 + 4); }
#pragma unroll 1
      for (int pass = 0; pass < 2; ++pass) {
        const int r = (tid >> 4) + pass * 32, t = t0 + r, pos = tok_pos(t), L = tok_L(t);
        float acc[8] = {};
#pragma unroll
        for (int k = -1; k <= 1; ++k) {
          if (pos + k < 0 || pos + k >= L) continue;
          float x[8]; unpack8(*(const u32x4*)(p.P + (size_t)(t + k) * NP + X * 1024 + h * 128 + grp * 8), x);
#pragma unroll
          for (int q = 0; q < 8; ++q) acc[q] += w[k + 1][q] * x[q];
        }
        float ss = 0;
#pragma unroll
        for (int q = 0; q < 8; ++q) { acc[q] = siluf_(acc[q]); ss += acc[q] * acc[q]; }
        if (X < 2) {
          ss += __shfl_xor(ss, 1); ss += __shfl_xor(ss, 2); ss += __shfl_xor(ss, 4); ss += __shfl_xor(ss, 8);
          const float nrm = rsqrtf(ss + EPS);
#pragma unroll
          for (int q = 0; q < 8; ++q) acc[q] *= nrm;
        }
        *(u32x4*)(smem + X * 17408 + r * LROW + grp * 16) = pack8(acc);
      }
    }
  }
  if (wid < 2) {
    const int d = wid, ti = d ? 63 - lane : lane, t = t0 + ti;
    const float A = __expf(p.a_log[(l * 2 + d) * 8 + h]), dtb = p.dt_bias[(l * 2 + d) * 8 + h];
    const float beta = sigmoidf_(p.small[(size_t)t * 32 + d * 8 + h]);
    float g = -A * softplusf_(p.small[(size_t)t * 32 + 16 + d * 8 + h] + dtb);
#pragma unroll
    for (int o = 1; o < 64; o <<= 1) { const float v = __shfl_up(g, o); if (lane >= o) g += v; }
    float* G = (float*)(smem + PGC);
    G[d * 64 + lane] = g; G[128 + d * 64 + lane] = beta; G[256 + d * 64 + lane] = __expf(g);
  }
  __syncthreads();
  {
    const int mat = wid >> 2, rt = wid & 3, fr = lane & 15, fq = lane >> 4;
    const char* Ab = smem + (mat ? PQH : PKH);
    f32x4 acc[4];
#pragma unroll
    for (int ct = 0; ct < 4; ++ct) acc[ct] = f32x4{0.f, 0.f, 0.f, 0.f};
#pragma unroll
    for (int ks = 0; ks < 4; ++ks) {
      const bf16x8 a = *(const bf16x8*)(Ab + (rt * 16 + fr) * LROW + (ks * 32 + fq * 8) * 2);
#pragma unroll
      for (int ct = 0; ct < 4; ++ct) {
        const bf16x8 b = *(const bf16x8*)(smem + PKH + (ct * 16 + fr) * LROW + (ks * 32 + fq * 8) * 2);
        acc[ct] = __builtin_amdgcn_mfma_f32_16x16x32_bf16(a, b, acc[ct], 0, 0, 0);
      }
    }
    float* Dst = (float*)(smem + (mat ? PQK : PKK));
#pragma unroll
    for (int ct = 0; ct < 4; ++ct)
#pragma unroll
      for (int r = 0; r < 4; ++r) Dst[(rt * 16 + fq * 4 + r) * 65 + ct * 16 + fr] = acc[ct][r];
  }
  __syncthreads();
  const int d = tid >> 8, e = tid & 255;
  const float* GC = (const float*)(smem + PGC) + d * 64;
  const float* BETA = (const float*)(smem + PGC) + 128 + d * 64;
  const float* EG = (const float*)(smem + PGC) + 256 + d * 64;
  const float* KKs = (const float*)(smem + PKK);
  const float* QKs = (const float*)(smem + PQK);
  char* rec = p.dnrec + (size_t)((c * 8 + h) * 2 + d) * REC_BYTES;
  {
    const int i = e >> 2, jq = e & 3, j0 = jq * 16, ti = d ? 63 - i : i, ib = i >> 4;
    const float bi = BETA[i], gi = GC[i];
    float mv[16];
#pragma unroll
    for (int jj = 0; jj < 16; ++jj) {
      const int j = j0 + jj, tj = d ? 63 - j : j;
      mv[jj] = (j < i) ? bi * KKs[ti * 65 + tj] * __expf(gi - GC[j]) : 0.f;
    }
    float* mdt = (float*)(smem + PMD) + ((d * 4 + ib) * 16) * 16 + (i & 15);
    if (jq == ib) {
#pragma unroll
      for (int jj = 0; jj < 16; ++jj) mdt[jj * 16] = mv[jj];
    }
    float mo[16];
#pragma unroll
    for (int jj = 0; jj < 16; ++jj) mo[jj] = (jq < ib) ? mv[jj] : 0.f;
    char* mb = smem + PMB + ((d * 64 + i) * 64 + j0) * 2;
    *(u32x4*)mb = pack8(mo); *(u32x4*)(mb + 16) = pack8(mo + 8);
#pragma unroll 1
    for (int rep = 0; rep < 2; ++rep) {
      const int f = e + rep * 256, ln = f & 63, fi = f >> 6, mt = fi >> 1, ks = fi & 1;
      const int ii = mt * 16 + (ln & 15), tii = d ? 63 - ii : ii, hq = ln >> 4;
      const float gii = GC[ii];
      float v[8];
#pragma unroll
      for (int j = 0; j < 8; ++j) {
        const int jp = ks * 32 + (j >> 2) * 16 + 4 * hq + (j & 3), tj = d ? 63 - jp : jp;
        v[j] = (jp <= ii) ? SCALEQ * QKs[tii * 65 + tj] * __expf(gii - GC[jp]) : 0.f;
      }
      *(u32x4*)(rec + REC_QK + f * 16) = pack8(v);
    }
    if (e == 0) p.glast[(c * 8 + h) * 2 + d] = EG[63];
    const float gl = GC[63];
#pragma unroll 1
    for (int rep = 0; rep < 4; ++rep) {
      const int f = e + rep * 256, ln = f & 63, fi = f >> 6, hq = ln >> 4;
      {
        const int mt = fi >> 2, ks = fi & 3, ii = mt * 16 + (ln & 15), tii = d ? 63 - ii : ii;
        const float sc = SCALEQ * EG[ii];
        const char* qrow = smem + PQH + tii * LROW + (ks * 32 + 4 * hq) * 2;
        const u32x2 lo = *(const u32x2*)qrow, hi = *(const u32x2*)(qrow + 32);
        float v[8] = {__uint_as_float(lo[0] << 16), __uint_as_float(lo[0] & 0xffff0000u), __uint_as_float(lo[1] << 16), __uint_as_float(lo[1] & 0xffff0000u),
                      __uint_as_float(hi[0] << 16), __uint_as_float(hi[0] & 0xffff0000u), __uint_as_float(hi[1] << 16), __uint_as_float(hi[1] & 0xffff0000u)};
#pragma unroll
        for (int j = 0; j < 8; ++j) v[j] *= sc;
        *(u32x4*)(rec + REC_QD + f * 16) = pack8(v);
      }
      {
        const int mt = fi >> 1, ks = fi & 1, dk = mt * 16 + (ln & 15);
        float v[8];
#pragma unroll
        for (int j = 0; j < 8; ++j) {
          const int ip = ks * 32 + (j >> 2) * 16 + 4 * hq + (j & 3), tip = d ? 63 - ip : ip;
          v[j] = ld_bf(smem + PKH, tip * LROW + dk * 2) * __expf(gl - GC[ip]);
        }
        *(u32x4*)(rec + REC_KD + f * 16) = pack8(v);
      }
    }
  }
  __syncthreads();
  {
    const int col = e & 127; const bool isw = e >= 128;
    const char* src = smem + (isw ? PKH : PVH) + col * 2;
    char* xcol = smem + PXS + ((d * 256 + e) * 64) * 2;
#pragma unroll 1
    for (int i8 = 0; i8 < 8; ++i8) {
      float v[8];
#pragma unroll
      for (int q = 0; q < 8; ++q) { const int i = i8 * 8 + q, ti = d ? 63 - i : i; v[q] = ld_bf(src, ti * LROW) * (isw ? BETA[i] * EG[i] : BETA[i]); }
      *(u32x4*)(xcol + i8 * 16) = pack8(v);
    }
  }
  __syncthreads();
  solve_block<0>(d, e, wid, lane); solve_block<1>(d, e, wid, lane); solve_block<2>(d, e, wid, lane); solve_block<3>(d, e, wid, lane);
  __syncthreads();
  {
    const char* XS = smem + PXS + d * 256 * 128;
#pragma unroll 1
    for (int rep = 0; rep < 8; ++rep) {
      const int f = e + rep * 256, ln = f & 63, fi = f >> 6, ws = fi >> 3, rt = (fi >> 1) & 3, ct = fi & 1;
      const int i0 = rt * 16 + 4 * (ln >> 4), dv = ws * 32 + ct * 16 + (ln & 15);
      *(u32x2*)(rec + REC_U + f * 8) = *(const u32x2*)(XS + dv * 128 + i0 * 2);
    }
#pragma unroll 1
    for (int rep = 0; rep < 4; ++rep) {
      const int f = e + rep * 256, ln = f & 63, fi = f >> 6, mt = fi >> 2, ks = fi & 3, hq = ln >> 4;
      const char* wc = XS + (128 + ks * 32 + 4 * hq) * 128 + (mt * 16 + (ln & 15)) * 2;
      unsigned q[8];
#pragma unroll
      for (int j = 0; j < 8; ++j) q[j] = *(const bfr*)(wc + ((j >> 2) * 16 + (j & 3)) * 128);
      u32x4 o = {q[0] | (q[1] << 16), q[2] | (q[3] << 16), q[4] | (q[5] << 16), q[6] | (q[7] << 16)};
      *(u32x4*)(rec + REC_W + f * 16) = o;
    }
  }
}

__device__ __forceinline__ bf16x8 pack_b(const f32x4& a, const f32x4& b) {
  u32x4 w = {pack2(a[0], a[1]), pack2(a[2], a[3]), pack2(b[0], b[1]), pack2(b[2], b[3])};
  return *reinterpret_cast<bf16x8*>(&w);
}

__device__ __forceinline__ void dn_scan_item(const Params& p, int l, int s, int h) {
  const int tid = threadIdx.x, wid = tid >> 6, lane = tid & 63, d = wid >> 2, ws = wid & 3, fr = lane & 15, hq = lane >> 4, e = tid & 255;
  const bool samp = s >= 16;
  const int N = samp ? 16 : 4, cb = samp ? 64 + (s - 16) * 16 : s * 4, tbase = samp ? NCTX + (s - 16) * 1024 : s * 256;
  f32x4 S[8][2];
  if (samp) {
    const float* s0 = p.state_dn + ((((size_t)(s - 16) * DEPTH + l) * 2 + d) * 8 + h) * 16384;
#pragma unroll
    for (int dt = 0; dt < 8; ++dt) {
      const float* q = s0 + (dt * 16 + 4 * hq) * 128 + ws * 32 + fr;
      asm volatile("" : "+v"(q) :: "memory");
#pragma unroll
      for (int ct = 0; ct < 2; ++ct)
#pragma unroll
        for (int r = 0; r < 4; ++r) S[dt][ct][r] = q[r * 128 + ct * 16];
    }
  } else {
#pragma unroll
    for (int dt = 0; dt < 8; ++dt)
#pragma unroll
      for (int ct = 0; ct < 2; ++ct) S[dt][ct] = f32x4{0.f, 0.f, 0.f, 0.f};
  }
  const char* Lb = smem + d * 57344;
#pragma unroll 1
  for (int n = 0; n < N; ++n) {
    const int c = cb + (d ? N - 1 - n : n);
    const int ri = (c * 8 + h) * 2 + d;
    const char* rec = p.dnrec + (size_t)ri * REC_BYTES;
    __syncthreads();
#pragma unroll
    for (int i = 0; i < 14; ++i)
      __builtin_amdgcn_global_load_lds((const unsigned*)(rec + REC_W + (i * 256 + e) * 16), (__attribute__((address_space(3))) unsigned*)(smem + d * 57344 + (i * 256 + e) * 16), 16, 0, 0);
    u32x2 U[4][2];
#pragma unroll
    for (int rt = 0; rt < 4; ++rt)
#pragma unroll
      for (int ct = 0; ct < 2; ++ct) U[rt][ct] = *(const u32x2*)(rec + REC_U + ((((ws * 4 + rt) * 2 + ct) * 64) + lane) * 8);
    const float gl = p.glast[ri];
    asm volatile("s_waitcnt vmcnt(0)" ::: "memory");
    __syncthreads();
    f32x4 P[4][2], O[4][2];
#pragma unroll
    for (int rt = 0; rt < 4; ++rt)
#pragma unroll
      for (int ct = 0; ct < 2; ++ct) { P[rt][ct] = f32x4{0.f, 0.f, 0.f, 0.f}; O[rt][ct] = f32x4{0.f, 0.f, 0.f, 0.f}; }
#pragma unroll
    for (int ks = 0; ks < 4; ++ks) {
      const bf16x8 sb0 = pack_b(S[2 * ks][0], S[2 * ks + 1][0]), sb1 = pack_b(S[2 * ks][1], S[2 * ks + 1][1]);
#pragma unroll
      for (int rt = 0; rt < 4; ++rt) {
        const bf16x8 aw = *(const bf16x8*)(Lb + ((rt * 4 + ks) * 64 + lane) * 16);
        const bf16x8 aq = *(const bf16x8*)(Lb + 16384 + ((rt * 4 + ks) * 64 + lane) * 16);
        P[rt][0] = __builtin_amdgcn_mfma_f32_16x16x32_bf16(aw, sb0, P[rt][0], 0, 0, 0);
        P[rt][1] = __builtin_amdgcn_mfma_f32_16x16x32_bf16(aw, sb1, P[rt][1], 0, 0, 0);
        O[rt][0] = __builtin_amdgcn_mfma_f32_16x16x32_bf16(aq, sb0, O[rt][0], 0, 0, 0);
        O[rt][1] = __builtin_amdgcn_mfma_f32_16x16x32_bf16(aq, sb1, O[rt][1], 0, 0, 0);
      }
      asm volatile("" ::: "memory");
    }
#pragma unroll
    for (int rt = 0; rt < 4; ++rt)
#pragma unroll
      for (int ct = 0; ct < 2; ++ct) {
        const u32x2 u = U[rt][ct];
        P[rt][ct][0] = __uint_as_float(u[0] << 16) - P[rt][ct][0]; P[rt][ct][1] = __uint_as_float(u[0] & 0xffff0000u) - P[rt][ct][1];
        P[rt][ct][2] = __uint_as_float(u[1] << 16) - P[rt][ct][2]; P[rt][ct][3] = __uint_as_float(u[1] & 0xffff0000u) - P[rt][ct][3];
      }
    bf16x8 VB[2][2];
#pragma unroll
    for (int ks = 0; ks < 2; ++ks)
#pragma unroll
      for (int ct = 0; ct < 2; ++ct) VB[ks][ct] = pack_b(P[2 * ks][ct], P[2 * ks + 1][ct]);
#pragma unroll
    for (int rt = 0; rt < 4; ++rt)
#pragma unroll
      for (int ks = 0; ks < 2; ++ks) {
        const bf16x8 a = *(const bf16x8*)(Lb + 32768 + ((rt * 2 + ks) * 64 + lane) * 16);
#pragma unroll
        for (int ct = 0; ct < 2; ++ct) O[rt][ct] = __builtin_amdgcn_mfma_f32_16x16x32_bf16(a, VB[ks][ct], O[rt][ct], 0, 0, 0);
        asm volatile("" ::: "memory");
      }
#pragma unroll
    for (int dt = 0; dt < 8; ++dt) {
#pragma unroll
      for (int ct = 0; ct < 2; ++ct) S[dt][ct] *= gl;
#pragma unroll
      for (int ks = 0; ks < 2; ++ks) {
        const bf16x8 a = *(const bf16x8*)(Lb + 40960 + ((dt * 2 + ks) * 64 + lane) * 16);
#pragma unroll
        for (int ct = 0; ct < 2; ++ct) S[dt][ct] = __builtin_amdgcn_mfma_f32_16x16x32_bf16(a, VB[ks][ct], S[dt][ct], 0, 0, 0);
      }
      asm volatile("" ::: "memory");
    }
    bfr* ob = p.opart + (size_t)d * NTOK * DM + (size_t)(c * 64) * DM + h * 128 + ws * 32 + fr;
#pragma unroll
    for (int rt = 0; rt < 4; ++rt) {
      const int ip0 = rt * 16 + 4 * hq;
      bfr* q = ob + (size_t)(d ? 63 - ip0 : ip0) * DM;
      const long stp = d ? -(long)DM : (long)DM;
      asm volatile("" : "+v"(q) :: "memory");
#pragma unroll
      for (int r = 0; r < 4; ++r)
#pragma unroll
        for (int ct = 0; ct < 2; ++ct) q[r * stp + ct * 16] = f2bf(O[rt][ct][r]);
    }
  }
  if (!samp) {
    float* so = p.out_state + ((((size_t)s * DEPTH + l) * 2 + d) * 8 + h) * 16384;
#pragma unroll
    for (int dt = 0; dt < 8; ++dt) {
      float* q = so + (dt * 16 + 4 * hq) * 128 + ws * 32 + fr;
      asm volatile("" : "+v"(q) :: "memory");
#pragma unroll
      for (int ct = 0; ct < 2; ++ct)
#pragma unroll
        for (int r = 0; r < 4; ++r) q[r * 128 + ct * 16] = S[dt][ct][r];
    }
  }
  __syncthreads();
  dn_finalize(p, l, tbase, samp ? 1024 : 256, h, tid, NTHR);
}
template <class Epi>
__device__ void naive_gemm_tile(const bfr* A, int lda, const float* W, int ldw, int K, int m0, int n0, int ncols, float* lds, Epi epi) {
  float* As = lds;
  float* Ws = lds + 16 * 65;
  const int tid = threadIdx.x, tx = tid & 15, ty = tid >> 4;
  float acc[4][4] = {};
  for (int k0 = 0; k0 < K; k0 += 16) {
    for (int i = tid; i < 1024; i += 256) { const int r = i >> 4, kk = i & 15; As[kk * 65 + r] = bf2f(A[(size_t)(m0 + r) * lda + k0 + kk]); }
    for (int i = tid; i < 1024; i += 256) { const int kk = i >> 6, cc = i & 63; Ws[kk * 65 + cc] = (n0 + cc < ncols) ? W[(size_t)(k0 + kk) * ldw + n0 + cc] : 0.f; }
    __syncthreads();
#pragma unroll
    for (int kk = 0; kk < 16; ++kk) {
      float a[4], b[4];
#pragma unroll
      for (int i = 0; i < 4; ++i) { a[i] = As[kk * 65 + ty * 4 + i]; b[i] = Ws[kk * 65 + tx * 4 + i]; }
#pragma unroll
      for (int i = 0; i < 4; ++i)
#pragma unroll
        for (int j = 0; j < 4; ++j) acc[i][j] += a[i] * bf2f(f2bf(b[j]));
    }
    __syncthreads();
  }
#pragma unroll
  for (int i = 0; i < 4; ++i)
#pragma unroll
    for (int j = 0; j < 4; ++j) if (n0 + tx * 4 + j < ncols) epi(m0 + ty * 4 + i, n0 + tx * 4 + j, acc[i][j]);
}

__global__ __launch_bounds__(256) void naive_gemm_in(Params p, int l) {
  __shared__ float lds[2 * 16 * 65];
  const int m0 = blockIdx.y * 64, n0 = blockIdx.x * 64;
  naive_gemm_tile(p.h, DM, p.w_in + (size_t)l * DM * NIN, NIN, DM, m0, n0, NIN, lds, [&](int m, int n, float v) {
    const int pc = perm_col(n);
    if (pc >= NP) p.small[(size_t)m * 32 + (pc - NP)] = v;
    else p.P[(size_t)m * NP + pc] = f2bf(pc >= C_MG ? sigmoidf_(v) : v);
  });
}
__global__ __launch_bounds__(256) void naive_gemm_br(Params p, int l) {
  __shared__ float lds[2 * 16 * 65];
  const int m0 = blockIdx.y * 64, n0 = blockIdx.x * 64;
  const int tid = threadIdx.x, tx = tid & 15, ty = tid >> 4;
  float tot[4][4] = {};
  for (int br = 0; br < 3; ++br) {
    const float* W = (br == 0 ? p.w_br_dn : br == 1 ? p.w_br_sc : p.w_br_att) + (size_t)l * DM * DM;
    naive_gemm_tile(p.obr + (size_t)br * NTOK * DM, DM, W, DM, DM, m0, n0, DM, lds, [&](int m, int n, float v) {
      const float g = bf2f(p.P[(size_t)m * NP + C_MG + br * DM + n]);
      tot[m - m0 - ty * 4][n - n0 - tx * 4] += g * v;
    });
  }
  for (int i = 0; i < 4; ++i) for (int j = 0; j < 4; ++j) p.merged[(size_t)(m0 + ty * 4 + i) * DM + n0 + tx * 4 + j] = f2bf(tot[i][j]);
}
__global__ __launch_bounds__(256) void naive_gemm_out(Params p, int l) {
  __shared__ float lds[2 * 16 * 65];
  naive_gemm_tile(p.merged, DM, p.w_out + (size_t)l * DM * DM, DM, DM, blockIdx.y * 64, blockIdx.x * 64, DM, lds,
                  [&](int m, int n, float v) { p.R[(size_t)m * DM + n] = v; });
}
__global__ __launch_bounds__(256) void naive_gemm_up(Params p, int l) {
  __shared__ float lds[2 * 16 * 65];
  naive_gemm_tile(p.h, DM, p.w_mlp_up + (size_t)l * DM * HID, HID, DM, blockIdx.y * 64, blockIdx.x * 64, HID, lds,
                  [&](int m, int n, float v) { const float r = fmaxf(v, 0.f); p.u2[(size_t)m * HID + n] = f2bf(r * r); });
}
__global__ __launch_bounds__(256) void naive_gemm_down(Params p, int l) {
  __shared__ float lds[2 * 16 * 65];
  naive_gemm_tile(p.u2, HID, p.w_mlp_down + (size_t)l * HID * DM, DM, HID, blockIdx.y * 64, blockIdx.x * 64, DM, lds,
                  [&](int m, int n, float v) { p.R[(size_t)m * DM + n] = v; });
}

__global__ __launch_bounds__(128) void naive_dn(Params p, int l) {
  __shared__ float qs[128], ks[128], red[4];
  const int item = blockIdx.x, dir = item & 1, sh = item >> 1, h = sh & 7, seq = sh >> 3;
  const int L = seq < 16 ? 256 : 1024, tbase = seq < 16 ? seq * 256 : NCTX + (seq - 16) * 1024;
  const int j = threadIdx.x, lane = j & 63, wv = j >> 6;
  float S[128];
  if (seq < 16) { for (int d = 0; d < 128; ++d) S[d] = 0.f; }
  else { const float* s0 = p.state_dn + ((((size_t)(seq - 16) * DEPTH + l) * 2 + dir) * 8 + h) * 16384; for (int d = 0; d < 128; ++d) S[d] = s0[d * 128 + j]; }
  const float A = __expf(p.a_log[(l * 2 + dir) * 8 + h]), dtb = p.dt_bias[(l * 2 + dir) * 8 + h];
  const float* wc = p.w_conv_dn + (size_t)l * 3 * 3072;
  float wq[3], wk[3], wvv[3];
  for (int k = 0; k < 3; ++k) { wq[k] = wc[k * 3072 + h * 128 + j]; wk[k] = wc[k * 3072 + 1024 + h * 128 + j]; wvv[k] = wc[k * 3072 + 2048 + h * 128 + j]; }
  for (int step = 0; step < L; ++step) {
    const int pos = dir ? L - 1 - step : step, t = tbase + pos;
    float q = 0, k = 0, v = 0;
    for (int kk = -1; kk <= 1; ++kk) {
      if (pos + kk < 0 || pos + kk >= L) continue;
      const bfr* row = p.P + (size_t)(t + kk) * NP + h * 128 + j;
      q += wq[kk + 1] * bf2f(row[C_DQ]); k += wk[kk + 1] * bf2f(row[C_DK]); v += wvv[kk + 1] * bf2f(row[C_DV]);
    }
    q = siluf_(q); k = siluf_(k); v = siluf_(v);
    float sq = wave_sum(q * q), sk = wave_sum(k * k);
    __syncthreads();
    if (lane == 0) { red[wv * 2] = sq; red[wv * 2 + 1] = sk; }
    __syncthreads();
    sq = red[0] + red[2]; sk = red[1] + red[3];
    q *= rsqrtf(sq + EPS); k *= rsqrtf(sk + EPS);
    qs[j] = q; ks[j] = k;
    __syncthreads();
    const float beta = sigmoidf_(p.small[(size_t)t * 32 + dir * 8 + h]);
    const float g = -A * softplusf_(p.small[(size_t)t * 32 + 16 + dir * 8 + h] + dtb);
    const float a = __expf(g);
    float kS = 0;
#pragma unroll
    for (int d = 0; d < 128; ++d) kS += ks[d] * S[d];
    const float vn = beta * (v - a * kS);
    float o = 0;
#pragma unroll
    for (int d = 0; d < 128; ++d) { S[d] = a * S[d] + ks[d] * vn; o += qs[d] * S[d]; }
    p.opart[(size_t)dir * NTOK * DM + (size_t)t * DM + h * 128 + j] = f2bf(o * 0.08838834764831845f);
  }
  if (seq < 16) { float* so = p.out_state + ((((size_t)seq * DEPTH + l) * 2 + dir) * 8 + h) * 16384; for (int d = 0; d < 128; ++d) so[d * 128 + j] = S[d]; }
}
__global__ __launch_bounds__(512) void naive_dn_finalize(Params p, int l) {
  const int c = blockIdx.x >> 3, h = blockIdx.x & 7;
  dn_finalize(p, l, c * 64, 64, h, threadIdx.x, 512);
}

__global__ __launch_bounds__(256) void naive_attn(Params p, int l) {
  __shared__ float sc[4][1280 + 128];
  const int wv = threadIdx.x >> 6, lane = threadIdx.x & 63;
  const int pair = blockIdx.x * 4 + wv, t = pair >> 3, h = pair & 7, kvh = h >> 2;
  float* myq = sc[wv] + 1280; float* mys = sc[wv];
  const bfr* K; const bfr* V; int nk;
  if (t < NCTX) { const int b = t >> 8; K = p.Kc + (size_t)b * 256 * 256 + kvh * 128; V = p.Vc + (size_t)b * 256 * 256 + kvh * 128; nk = 256; }
  else { const int b = (t - NCTX) >> 10; K = p.Ks + (size_t)b * 1280 * 256 + kvh * 128; V = p.Vs + (size_t)b * 1280 * 256 + kvh * 128; nk = 1280; }
  myq[lane * 2] = bf2f(p.Q[(size_t)t * DM + h * 128 + lane * 2]); myq[lane * 2 + 1] = bf2f(p.Q[(size_t)t * DM + h * 128 + lane * 2 + 1]);
  __syncthreads();
  float mx = -1e30f;
  for (int kk = lane; kk < nk; kk += 64) {
    float s = 0; const bfr* kr = K + (size_t)kk * 256;
    for (int d = 0; d < 128; ++d) s += myq[d] * bf2f(kr[d]);
    s *= 0.08838834764831845f; mys[kk] = s; mx = fmaxf(mx, s);
  }
  for (int o = 32; o > 0; o >>= 1) mx = fmaxf(mx, __shfl_xor(mx, o));
  float sum = 0;
  for (int kk = lane; kk < nk; kk += 64) { const float e = __expf(mys[kk] - mx); mys[kk] = e; sum += e; }
  sum = wave_sum(sum);
  __syncthreads();
  float o0 = 0, o1 = 0;
  for (int kk = 0; kk < nk; ++kk) { const float pr = mys[kk]; const unsigned vv = *(const unsigned*)(V + (size_t)kk * 256 + lane * 2); o0 += pr * __uint_as_float(vv << 16); o1 += pr * __uint_as_float(vv & 0xffff0000u); }
  const float inv = 1.f / sum;
  *(unsigned*)(p.obr + (size_t)2 * NTOK * DM + (size_t)t * DM + h * 128 + lane * 2) = pack2(o0 * inv, o1 * inv);
}
constexpr int DYN_LDS = 147456;
enum { ST_MOD = 0, ST_CONV, ST_ROW, ST_LIGHT, ST_GEMM_IN, ST_GEMM_BR, ST_GEMM_OUT, ST_GEMM_UP, ST_GEMM_DOWN, ST_DN_PREP, ST_DN_SCAN, ST_ATTN };
__global__ __launch_bounds__(512) void k_stage(Params p_arg, int stage, int l, int arg) {
  const Params& p = *(const Params*)__builtin_amdgcn_kernarg_segment_ptr();
  const int bid = blockIdx.x, nblk = gridDim.x;
  switch (stage) {
    case ST_MOD: stage_mod(p, bid, nblk, smem); break;
    case ST_CONV: for (int it = bid; it < CONV_ITEMS * DEPTH; it += nblk) convert_item(p, it / CONV_ITEMS, it % CONV_ITEMS); break;
    case ST_ROW: stage_row(p, l, arg, bid, nblk); break;
    case ST_LIGHT: for (int c = bid; c < 96; c += nblk) light_prep_item(p, l, c); break;
    case ST_GEMM_IN: for (int t = bid; t < 24 * 47; t += nblk) gemm_in_tile(p, l, t); break;
    case ST_GEMM_BR: for (int t = bid; t < 192; t += nblk) gemm_br_tile(p, l, t); break;
    case ST_GEMM_OUT: for (int t = bid; t < 192; t += nblk) gemm_out_tile(p, l, t); break;
    case ST_GEMM_UP: for (int t = bid; t < 24 * 16; t += nblk) gemm_up_tile(p, l, t); break;
    case ST_GEMM_DOWN: for (int t = bid; t < 192; t += nblk) gemm_down_tile(p, l, t); break;
    case ST_DN_PREP: for (int it = bid; it < 768; it += nblk) dn_prep_item(p, l, it >> 3, it & 7); break;
    case ST_DN_SCAN: for (int it = bid; it < 144; it += nblk) { if (it < 16) dn_scan_item(p, l, 16 + (it >> 3), it & 7); else dn_scan_item(p, l, (it - 16) >> 3, (it - 16) & 7); } break;
    case ST_ATTN: for (int it = bid; it < 192; it += nblk) attn_item(p, it); break;
  }
}
__global__ void diag_fill(float* out, long n, float v) { for (long i = blockIdx.x * 256L + threadIdx.x; i < n; i += gridDim.x * 256L) out[i] = (i == 0) ? v : 0.f; }
static size_t align_up(size_t x) { return (x + 255) & ~(size_t)255; }
static bool make_params(Params& p, void* const* d_in, void* d_out, void* d_ws, size_t ws_size) {
  const float** in = (const float**)d_in;
  p.x_prompt = in[0]; p.x_sample = in[1]; p.cache_k = in[2]; p.cache_v = in[3]; p.state_dn = in[4]; p.c = in[5]; p.c_ctx = in[6];
  p.w_mod = in[7]; p.b_mod = in[8]; p.g_pre_mix = in[9]; p.g_post_mix = in[10]; p.g_pre_mlp = in[11]; p.g_post_mlp = in[12];
  p.w_in = in[13]; p.w_conv_dn = in[14]; p.a_log = in[15]; p.dt_bias = in[16]; p.g_dn_out = in[17]; p.w_conv_sc = in[18];
  p.g_q = in[19]; p.g_k = in[20]; p.w_br_dn = in[21]; p.w_br_sc = in[22]; p.w_br_att = in[23]; p.w_out = in[24];
  p.w_mlp_up = in[25]; p.w_mlp_down = in[26];
  float* out = (float*)d_out;
  p.xbuf = out; p.out_ck = out + 6291456; p.out_cv = p.out_ck + 4194304; p.out_state = p.out_cv + 4194304;
  char* w = (char*)d_ws; size_t off = 0;
  auto take = [&](size_t bytes) { char* r = w + off; off = align_up(off + bytes); return r; };
  p.bar   = (unsigned*)take(65536);
  p.wt_in = (bfr*)take((size_t)DEPTH * NPAD * DM * 2);
  p.wt_br = (bfr*)take((size_t)DEPTH * 3 * DM * DM * 2);
  p.wt_out= (bfr*)take((size_t)DEPTH * DM * DM * 2);
  p.wt_up = (bfr*)take((size_t)DEPTH * HID * DM * 2);
  p.wt_dn = (bfr*)take((size_t)DEPTH * DM * HID * 2);
  p.mod   = (float*)take((size_t)DEPTH * 3 * 6144 * 4);
  p.h     = (bfr*)take((size_t)NTOK * DM * 2);
  p.P     = (bfr*)take((size_t)NTOK * NP * 2);
  p.u2    = p.P;
  p.small = (float*)take((size_t)NTOK * 32 * 4);
  p.dnrec = take((size_t)1536 * REC_BYTES);
  p.glast = (float*)take(1536 * 4);
  p.opart = (bfr*)take((size_t)2 * NTOK * DM * 2);
  p.obr   = (bfr*)take((size_t)3 * NTOK * DM * 2);
  p.Q     = (bfr*)take((size_t)NTOK * DM * 2);
  p.Kc    = (bfr*)take((size_t)NCTX * 256 * 2);
  p.Vc    = (bfr*)take((size_t)NCTX * 256 * 2);
  p.Ks    = (bfr*)take((size_t)2 * 1280 * 256 * 2);
  p.Vs    = (bfr*)take((size_t)2 * 1280 * 256 * 2);
  p.merged= (bfr*)take((size_t)NTOK * DM * 2);
  p.R     = (float*)take((size_t)NTOK * DM * 4);
  return off <= ws_size;
}
#define LAUNCH_ST(st, l, arg) k_stage<<<256, 512, DYN_LDS, stream>>>(p, st, l, arg)
extern "C" void kernel_launch(void* const* d_in, const int* in_sizes, int n_in, void* d_out, int out_size, void* d_ws, size_t ws_size, hipStream_t stream) {
  Params p{};
  if (n_in != 27 || out_size != 31457280) { diag_fill<<<1024, 256, 0, stream>>>((float*)d_out, (long)out_size, 3.0e6f + n_in); return; }
  if (!make_params(p, d_in, d_out, d_ws, ws_size)) { diag_fill<<<1024, 256, 0, stream>>>((float*)d_out, (long)out_size, (float)(ws_size >> 20)); return; }
  static int attr_done = 0;
  if (!attr_done) { (void)hipFuncSetAttribute((const void*)k_stage, hipFuncAttributeMaxDynamicSharedMemorySize, DYN_LDS); attr_done = 1; }
  LAUNCH_ST(ST_MOD, 0, 0);
  LAUNCH_ST(ST_CONV, 0, 0);
  LAUNCH_ST(ST_ROW, 0, 0);
  for (int l = 0; l < DEPTH; ++l) {
#if OPT & 1
    LAUNCH_ST(ST_GEMM_IN, l, 0);
#else
    naive_gemm_in<<<dim3(185, 96), 256, 0, stream>>>(p, l);
#endif
    LAUNCH_ST(ST_LIGHT, l, 0);
#if OPT & 32
    LAUNCH_ST(ST_DN_PREP, l, 0);
    LAUNCH_ST(ST_DN_SCAN, l, 0);
#else
    naive_dn<<<288, 128, 0, stream>>>(p, l);
    naive_dn_finalize<<<768, 512, 0, stream>>>(p, l);
#endif
#if OPT & 64
    LAUNCH_ST(ST_ATTN, l, 0);
#else
    naive_attn<<<12288, 256, 0, stream>>>(p, l);
#endif
#if OPT & 2
    LAUNCH_ST(ST_GEMM_BR, l, 0);
#else
    naive_gemm_br<<<dim3(16, 96), 256, 0, stream>>>(p, l);
#endif
#if OPT & 4
    LAUNCH_ST(ST_GEMM_OUT, l, 0);
#else
    naive_gemm_out<<<dim3(16, 96), 256, 0, stream>>>(p, l);
#endif
    LAUNCH_ST(ST_ROW, l, 1);
#if OPT & 8
    LAUNCH_ST(ST_GEMM_UP, l, 0);
#else
    naive_gemm_up<<<dim3(64, 96), 256, 0, stream>>>(p, l);
#endif
#if OPT & 16
    LAUNCH_ST(ST_GEMM_DOWN, l, 0);
#else
    naive_gemm_down<<<dim3(16, 96), 256, 0, stream>>>(p, l);
#endif
    LAUNCH_ST(ST_ROW, l, 2);
  }
  const hipError_t le = hipPeekAtLastError();
  if (le != hipSuccess) fprintf(stderr, "kernel_launch: launch failed: %s\n", hipGetErrorName(le));
}
```

```cpp
#define USE_CG_SYNC 0
#include <hip/hip_runtime.h>
#include <hip/hip_bf16.h>
#include <hip/hip_cooperative_groups.h>
#include <cstdio>
#include <cstdint>
namespace cg = cooperative_groups;

typedef unsigned short bfr;
using bf16x8 = __attribute__((ext_vector_type(8))) short;
using s16x4  = __attribute__((ext_vector_type(4))) short;
using f32x4  = __attribute__((ext_vector_type(4))) float;
using f32x16 = __attribute__((ext_vector_type(16))) float;
using u32x4  = __attribute__((ext_vector_type(4))) unsigned;
using u32x2  = __attribute__((ext_vector_type(2))) unsigned;

constexpr int DM = 1024, NTOK = 6144, NCTX = 4096, DEPTH = 4;
constexpr int NIN = 11808;
constexpr int NP = 11776;
constexpr int NPAD = 12032;
constexpr int HID = 4096;
constexpr float EPS = 1e-6f;
constexpr int C_DQ = 0, C_DK = 1024, C_DV = 2048, C_DG = 3072, C_SB = 4096, C_SCG = 5120, C_SX = 6144,
              C_AQ = 7168, C_AK = 8192, C_AV = 8448, C_MG = 8704;

constexpr int REC_U = 0, REC_W = 16384, REC_QD = 32768, REC_QK = 49152, REC_KD = 57344, REC_BYTES = 73728;

struct Params {
  const float *x_prompt, *x_sample, *cache_k, *cache_v, *state_dn, *c, *c_ctx, *w_mod, *b_mod;
  const float *g_pre_mix, *g_post_mix, *g_pre_mlp, *g_post_mlp, *w_in, *w_conv_dn, *a_log, *dt_bias, *g_dn_out;
  const float *w_conv_sc, *g_q, *g_k, *w_br_dn, *w_br_sc, *w_br_att, *w_out, *w_mlp_up, *w_mlp_down;
  float *xbuf;
  float *out_ck, *out_cv, *out_state;
  bfr *wt_in, *wt_br, *wt_out, *wt_up, *wt_dn;
  float *mod;
  bfr *h;
  bfr *P;
  float *small;
  char *dnrec;
  float *glast;
  bfr *opart;
  bfr *obr;
  bfr *Q;
  bfr *Kc, *Vc;
  bfr *Ks, *Vs;
  bfr *merged;
  float *R;
  bfr *u2;
  unsigned *bar;
};

__device__ __forceinline__ bfr f2bf(float f) { unsigned u = __float_as_uint(f); u += 0x7fffu + ((u >> 16) & 1u); return (bfr)(u >> 16); }
__device__ __forceinline__ float bf2f(bfr b) { return __uint_as_float(((unsigned)b) << 16); }
__device__ __forceinline__ unsigned pack2(float a, float b) { return (unsigned)f2bf(a) | ((unsigned)f2bf(b) << 16); }
__device__ __forceinline__ float sigmoidf_(float x) { return 1.f / (1.f + __expf(-x)); }
__device__ __forceinline__ float siluf_(float x) { return x / (1.f + __expf(-x)); }
__device__ __forceinline__ float softplusf_(float x) { return x > 20.f ? x : log1pf(__expf(x)); }

__device__ __forceinline__ int tok_modrow(int t) { return t < NCTX ? 0 : 1 + ((t - NCTX) >> 10); }
__device__ __forceinline__ int tok_L(int t) { return t < NCTX ? 256 : 1024; }
__device__ __forceinline__ int tok_pos(int t) { return t < NCTX ? (t & 255) : ((t - NCTX) & 1023); }

__host__ __device__ __forceinline__ int perm_col(int n) { return n < 4096 ? n : (n < 4128 ? NP + (n - 4096) : n - 32); }

__device__ __forceinline__ int tid_opaque() { int t = threadIdx.x; asm volatile("" : "+v"(t)); return t; }
#define NTHR 512

__device__ __forceinline__ void stage_mod(const Params& p, int bid, int nblk, char* lds) {
  float* s = (float*)lds;
  float* red = s + 3072;
  const int tid = tid_opaque();
  for (int i = tid; i < 3072; i += NTHR) { int j = i >> 10, k = i & 1023; float c = (j == 0) ? p.c_ctx[k] : p.c[(j - 1) * 1024 + k]; s[i] = siluf_(c); }
  __syncthreads();
  for (int item = bid; item < 192; item += nblk) {
    const int l = item / 48, nb = item % 48, cq = tid & 31, ks = tid >> 5;
    const float* W = p.w_mod + ((size_t)l * 1024 + ks * 64) * 6144 + nb * 128 + cq * 4;
    float a[3][4] = {};
    for (int k = 0; k < 64; ++k) {
      const float4 w = *(const float4*)(W + (size_t)k * 6144);
#pragma unroll
      for (int j = 0; j < 3; ++j) { const float sv = s[j * 1024 + ks * 64 + k]; a[j][0] += sv * w.x; a[j][1] += sv * w.y; a[j][2] += sv * w.z; a[j][3] += sv * w.w; }
    }
    __syncthreads();
#pragma unroll
    for (int j = 0; j < 3; ++j)
#pragma unroll
      for (int q = 0; q < 4; ++q) red[(ks * 3 + j) * 128 + cq * 4 + q] = a[j][q];
    __syncthreads();
    if (tid < 384) { const int j = tid >> 7, n = tid & 127; float sum = 0; for (int q = 0; q < 16; ++q) sum += red[(q * 3 + j) * 128 + n];
      p.mod[(size_t)(l * 3 + j) * 6144 + nb * 128 + n] = sum + p.b_mod[l * 6144 + nb * 128 + n]; }
  }
  __syncthreads();
}

__device__ __forceinline__ float wave_sum(float v) {
#pragma unroll
  for (int o = 32; o > 0; o >>= 1) v += __shfl_xor(v, o);
  return v;
}

__device__ __forceinline__ void stage_row(const Params& p, int l, int mode, int bid, int nblk) {
  const int tx_ = tid_opaque(), wid = tx_ >> 6, lane = tx_ & 63;
  for (int row = bid * 8 + wid; row < NTOK; row += nblk * 8) {
    const float* modr = p.mod + (size_t)(l * 3 + tok_modrow(row)) * 6144;
    const float* xin = (l == 0 && mode <= 1) ? (row < NCTX ? p.x_prompt + (size_t)row * DM : p.x_sample + (size_t)(row - NCTX) * DM) : p.xbuf + (size_t)row * DM;
    float4 x[4];
#pragma unroll
    for (int i = 0; i < 4; ++i) x[i] = *(const float4*)(xin + lane * 4 + 256 * i);
    if (mode != 0) {
      const float* rr = p.R + (size_t)row * DM;
      const float* gpost = (mode == 1 ? p.g_post_mix : p.g_post_mlp) + l * DM;
      const float* gate = modr + (mode == 1 ? 2048 : 5120);
      float4 r[4]; float ss = 0;
#pragma unroll
      for (int i = 0; i < 4; ++i) { r[i] = *(const float4*)(rr + lane * 4 + 256 * i); ss += r[i].x * r[i].x + r[i].y * r[i].y + r[i].z * r[i].z + r[i].w * r[i].w; }
      ss = wave_sum(ss);
      const float nrm = rsqrtf(ss * (1.f / DM) + EPS);
#pragma unroll
      for (int i = 0; i < 4; ++i) {
        const float4 g = *(const float4*)(gpost + lane * 4 + 256 * i), gt = *(const float4*)(gate + lane * 4 + 256 * i);
        x[i].x += gt.x * (r[i].x * nrm * g.x); x[i].y += gt.y * (r[i].y * nrm * g.y); x[i].z += gt.z * (r[i].z * nrm * g.z); x[i].w += gt.w * (r[i].w * nrm * g.w);
        *(float4*)(p.xbuf + (size_t)row * DM + lane * 4 + 256 * i) = x[i];
      }
    }
    if (mode == 2 && l == DEPTH - 1) continue;
    const int ln = (mode == 2) ? l + 1 : l;
    const float* modn = p.mod + (size_t)(ln * 3 + tok_modrow(row)) * 6144;
    const float* gpre = (mode == 1 ? p.g_pre_mlp : p.g_pre_mix) + ln * DM;
    const float* sh = modn + (mode == 1 ? 3072 : 0);
    const float* sc = modn + (mode == 1 ? 4096 : 1024);
    float ss = 0;
#pragma unroll
    for (int i = 0; i < 4; ++i) ss += x[i].x * x[i].x + x[i].y * x[i].y + x[i].z * x[i].z + x[i].w * x[i].w;
    ss = wave_sum(ss);
    const float nrm = rsqrtf(ss * (1.f / DM) + EPS);
#pragma unroll
    for (int i = 0; i < 4; ++i) {
      const float4 g = *(const float4*)(gpre + lane * 4 + 256 * i), s1 = *(const float4*)(sc + lane * 4 + 256 * i), s0 = *(const float4*)(sh + lane * 4 + 256 * i);
      const float h0 = x[i].x * nrm * g.x * (1.f + s1.x) + s0.x, h1 = x[i].y * nrm * g.y * (1.f + s1.y) + s0.y;
      const float h2 = x[i].z * nrm * g.z * (1.f + s1.z) + s0.z, h3 = x[i].w * nrm * g.w * (1.f + s1.w) + s0.w;
      u32x2 o = {pack2(h0, h1), pack2(h2, h3)};
      *(u32x2*)(p.h + (size_t)row * DM + lane * 4 + 256 * i) = o;
    }
  }
}

__device__ __forceinline__ void unpack8(const u32x4 v, float* f) {
#pragma unroll
  for (int i = 0; i < 4; ++i) { f[2 * i] = __uint_as_float(v[i] << 16); f[2 * i + 1] = __uint_as_float(v[i] & 0xffff0000u); }
}
__device__ __forceinline__ u32x4 pack8(const float* f) { u32x4 v = {pack2(f[0], f[1]), pack2(f[2], f[3]), pack2(f[4], f[5]), pack2(f[6], f[7])}; return v; }

__device__ __forceinline__ void light_prep_item(const Params& p, int l, int c) {
  const int tid = tid_opaque(), t0 = c * 64;
  const bool samp = t0 >= NCTX;
  {
    const float* wsc = p.w_conv_sc + (size_t)l * 3 * DM;
    bfr* scin = p.obr + (size_t)1 * NTOK * DM;
    for (int idx = tid; idx < 64 * 128; idx += NTHR) {
      const int r = idx >> 7, g = idx & 127, t = t0 + r, pos = tok_pos(t), L = tok_L(t);
      float acc[8] = {};
#pragma unroll
      for (int k = -1; k <= 1; ++k) {
        if (pos + k < 0 || pos + k >= L) continue;
        const bfr* row = p.P + (size_t)(t + k) * NP;
        float a[8], b[8]; unpack8(*(const u32x4*)(row + C_SCG + g * 8), a); unpack8(*(const u32x4*)(row + C_SX + g * 8), b);
        const float4 w0 = *(const float4*)(wsc + (k + 1) * DM + g * 8), w1 = *(const float4*)(wsc + (k + 1) * DM + g * 8 + 4);
        acc[0] += w0.x * a[0] * b[0]; acc[1] += w0.y * a[1] * b[1]; acc[2] += w0.z * a[2] * b[2]; acc[3] += w0.w * a[3] * b[3];
        acc[4] += w1.x * a[4] * b[4]; acc[5] += w1.y * a[5] * b[5]; acc[6] += w1.z * a[6] * b[6]; acc[7] += w1.w * a[7] * b[7];
      }
      float sb[8]; unpack8(*(const u32x4*)(p.P + (size_t)t * NP + C_SB + g * 8), sb);
#pragma unroll
      for (int q = 0; q < 8; ++q) acc[q] *= sb[q];
      *(u32x4*)(scin + (size_t)t * DM + g * 8) = pack8(acc);
    }
  }
  {
    const int sub = tid & 15;
    for (int pr = tid >> 4; pr < 64 * 10; pr += NTHR / 16) {
      const int r = pr / 10, hh = pr % 10, t = t0 + r;
      const bool isq = hh < 8;
      const bfr* src = p.P + (size_t)t * NP + (isq ? C_AQ + hh * 128 : C_AK + (hh - 8) * 128) + sub * 8;
      float x[8]; unpack8(*(const u32x4*)src, x);
      float ss = 0;
#pragma unroll
      for (int q = 0; q < 8; ++q) ss += x[q] * x[q];
      ss += __shfl_xor(ss, 1); ss += __shfl_xor(ss, 2); ss += __shfl_xor(ss, 4); ss += __shfl_xor(ss, 8);
      const float nrm = rsqrtf(ss * (1.f / 128.f) + EPS);
      const float* g = (isq ? p.g_q : p.g_k) + l * 128 + sub * 8;
#pragma unroll
      for (int q = 0; q < 8; ++q) x[q] = x[q] * nrm * g[q];
      if (samp) {
        const int pos = tok_pos(t);
        const float pidx = (sub < 8) ? (float)(pos >> 6) : (float)(pos & 63);
        const int s8 = sub & 7;
        const bool lo = s8 < 4;
        float y[8];
#pragma unroll
        for (int q = 0; q < 8; ++q) {
          const float other = __shfl_xor(x[q], 4);
          const int fi = (s8 & 3) * 8 + q;
          const float freq = exp2f(-(float)fi * (13.287712379549449f / 32.f));
          const float ang = pidx * freq;
          float sn, cs; __sincosf(ang, &sn, &cs);
          y[q] = lo ? (x[q] * cs - other * sn) : (other * sn + x[q] * cs);
        }
#pragma unroll
        for (int q = 0; q < 8; ++q) x[q] = y[q];
      }
      if (isq) {
        *(u32x4*)(p.Q + (size_t)t * DM + hh * 128 + sub * 8) = pack8(x);
      } else {
        const int kvh = hh - 8;
        if (!samp) {
          *(u32x4*)(p.Kc + (size_t)t * 256 + kvh * 128 + sub * 8) = pack8(x);
          const int b = t >> 8, pos = t & 255;
          float* o = p.out_ck + ((((size_t)b * DEPTH + l) * 256 + pos) * 2 + kvh) * 128 + sub * 8;
          *(float4*)o = make_float4(x[0], x[1], x[2], x[3]); *(float4*)(o + 4) = make_float4(x[4], x[5], x[6], x[7]);
        } else {
          const int s = t - NCTX, b = s >> 10, pos = s & 1023;
          *(u32x4*)(p.Ks + ((size_t)b * 1280 + 256 + pos) * 256 + kvh * 128 + sub * 8) = pack8(x);
        }
      }
    }
  }
  for (int idx = tid; idx < 64 * 32; idx += NTHR) {
    const int r = idx >> 5, g = idx & 31, t = t0 + r;
    const u32x4 v = *(const u32x4*)(p.P + (size_t)t * NP + C_AV + g * 8);
    if (!samp) {
      *(u32x4*)(p.Vc + (size_t)t * 256 + g * 8) = v;
      float f[8]; unpack8(v, f);
      const int b = t >> 8, pos = t & 255;
      float* o = p.out_cv + (((size_t)b * DEPTH + l) * 256 + pos) * 256 + g * 8;
      *(float4*)o = make_float4(f[0], f[1], f[2], f[3]); *(float4*)(o + 4) = make_float4(f[4], f[5], f[6], f[7]);
    } else {
      const int s = t - NCTX, b = s >> 10, pos = s & 1023;
      *(u32x4*)(p.Vs + ((size_t)b * 1280 + 256 + pos) * 256 + g * 8) = v;
    }
  }
  if (samp) {
    const int cs = c - 64, b = cs >> 4, pos0 = (cs & 15) * 16;
    for (int idx = tid; idx < 2 * 16 * 32; idx += NTHR) {
      const int which = idx >> 9, r = (idx >> 5) & 15, g = idx & 31, pos = pos0 + r;
      const float* src = (which ? p.cache_v : p.cache_k) + (((size_t)b * DEPTH + l) * 256 + pos) * 256 + g * 8;
      float f[8]; *(float4*)f = *(const float4*)src; *(float4*)(f + 4) = *(const float4*)(src + 4);
      *(u32x4*)((which ? p.Vs : p.Ks) + ((size_t)b * 1280 + pos) * 256 + g * 8) = pack8(f);
    }
  }
}

__device__ __forceinline__ void dn_finalize(const Params& p, int l, int t0, int n, int h, int tid0, int nthr) {
  const int sub = tid0 & 15;
  const float* g = p.g_dn_out + l * 128 + sub * 8;
  for (int r = tid0 >> 4; r < n; r += nthr / 16) {
    const int t = t0 + r;
    float a[8], b[8], dg[8];
    unpack8(*(const u32x4*)(p.opart + (size_t)t * DM + h * 128 + sub * 8), a);
    unpack8(*(const u32x4*)(p.opart + (size_t)NTOK * DM + (size_t)t * DM + h * 128 + sub * 8), b);
    unpack8(*(const u32x4*)(p.P + (size_t)t * NP + C_DG + h * 128 + sub * 8), dg);
    float ss = 0;
#pragma unroll
    for (int q = 0; q < 8; ++q) { a[q] += b[q]; ss += a[q] * a[q]; }
    ss += __shfl_xor(ss, 1); ss += __shfl_xor(ss, 2); ss += __shfl_xor(ss, 4); ss += __shfl_xor(ss, 8);
    const float nrm = rsqrtf(ss * (1.f / 128.f) + EPS);
#pragma unroll
    for (int q = 0; q < 8; ++q) a[q] = a[q] * nrm * g[q] * siluf_(dg[q]);
    *(u32x4*)(p.obr + (size_t)t * DM + h * 128 + sub * 8) = pack8(a);
  }
}
extern __shared__ __attribute__((aligned(16))) char smem[];
constexpr int HT_BYTES = 128 * 64 * 2;

__device__ __forceinline__ int lds_byte(int r, int c) {
  int st = (r >> 4) * 2 + (c >> 5), rr = r & 15, cc = c & 31, ob = rr * 64 + cc * 2;
  return st * 1024 + (ob ^ (((ob >> 9) & 1) << 5));
}
__device__ __forceinline__ void stage_rc(int b, int& R, int& C) {
  int st = b / 1024, sb = b % 1024, swz = sb ^ (((sb >> 9) & 1) << 5);
  R = (st >> 1) * 16 + swz / 64; C = (st & 1) * 32 + (swz % 64) / 2;
}
__device__ __forceinline__ void stage_half(const bfr* G, long ld, int row0, int k0, int loff, int tx) {
#pragma unroll
  for (int i = 0; i < 2; ++i) {
    const int b = tx * 16 + i * 8192; int r, c; stage_rc(b, r, c);
    __builtin_amdgcn_global_load_lds((const unsigned*)(G + (long)(row0 + r) * ld + k0 + c), (__attribute__((address_space(3))) unsigned*)(smem + loff + b), 16, 0, 0);
  }
}

template <int NB, class AccT>
__device__ __forceinline__ void gemm_mainloop(const bfr* A, long lda, const bfr* Bt, long ldb, int K, int brow, int bcol, AccT& acc, int tx) {
  const int wid = tx >> 6, lane = tx & 63, wr = wid >> 2, wc = wid & 3, fr = lane & 15, fq = lane >> 4;
  constexpr int STG = (2 + NB) * HT_BYTES;
  const int nt = K / 64;
  auto stage = [&](int s, int kt) {
    stage_half(A, lda, brow, kt * 64, s * STG, tx);
    stage_half(A, lda, brow + 128, kt * 64, s * STG + HT_BYTES, tx);
#pragma unroll
    for (int j = 0; j < NB; ++j) stage_half(Bt, ldb, bcol + j * 128, kt * 64, s * STG + (2 + j) * HT_BYTES, tx);
  };
  stage(0, 0);
  asm volatile("s_waitcnt vmcnt(0)" ::: "memory");
  __syncthreads();
  for (int t = 0; t < nt; ++t) {
    const int s = t & 1;
    if (t + 1 < nt) stage(s ^ 1, t + 1);
    const char* base = smem + s * STG;
    bf16x8 Bf[NB][2][2];
#pragma unroll
    for (int j = 0; j < NB; ++j)
#pragma unroll
      for (int n = 0; n < 2; ++n)
#pragma unroll
        for (int k = 0; k < 2; ++k) Bf[j][n][k] = *(const bf16x8*)(base + (2 + j) * HT_BYTES + lds_byte(wc * 32 + n * 16 + fr, k * 32 + fq * 8));
#pragma unroll
    for (int ai = 0; ai < 2; ++ai) {
      bf16x8 Af[4][2];
#pragma unroll
      for (int m = 0; m < 4; ++m)
#pragma unroll
        for (int k = 0; k < 2; ++k) Af[m][k] = *(const bf16x8*)(base + ai * HT_BYTES + lds_byte(wr * 64 + m * 16 + fr, k * 32 + fq * 8));
#pragma unroll
      for (int j = 0; j < NB; ++j)
#pragma unroll
        for (int m = 0; m < 4; ++m)
#pragma unroll
          for (int n = 0; n < 2; ++n)
#pragma unroll
            for (int k = 0; k < 2; ++k) acc.a[ai][j][m][n] = __builtin_amdgcn_mfma_f32_16x16x32_bf16(Af[m][k], Bf[j][n][k], acc.a[ai][j][m][n], 0, 0, 0);
    }
    asm volatile("s_waitcnt vmcnt(0)" ::: "memory");
    __syncthreads();
  }
}
template <int NB> struct Acc { f32x4 a[2][NB][4][2]; };
template <int NB> __device__ __forceinline__ void acc_zero(Acc<NB>& acc) {
#pragma unroll
  for (int ai = 0; ai < 2; ++ai)
#pragma unroll
    for (int j = 0; j < NB; ++j)
#pragma unroll
      for (int m = 0; m < 4; ++m)
#pragma unroll
        for (int n = 0; n < 2; ++n) acc.a[ai][j][m][n] = f32x4{0.f, 0.f, 0.f, 0.f};
}
template <int NB, class F> __device__ __forceinline__ void acc_foreach(Acc<NB>& acc, int brow, int bcol, int tx, F f) {
  const int wid = tx >> 6, lane = tx & 63, wr = wid >> 2, wc = wid & 3, fr = lane & 15, fq = lane >> 4;
#pragma unroll
  for (int ai = 0; ai < 2; ++ai)
#pragma unroll
    for (int j = 0; j < NB; ++j)
#pragma unroll
      for (int m = 0; m < 4; ++m)
#pragma unroll
        for (int n = 0; n < 2; ++n)
#pragma unroll
          for (int q = 0; q < 4; ++q) f(brow + ai * 128 + wr * 64 + m * 16 + fq * 4 + q, bcol + j * 128 + wc * 32 + n * 16 + fr, acc.a[ai][j][m][n][q]);
}

template <class MapF>
__device__ __forceinline__ void convert_tile(const float* W, int N, int kt, int ntile, bfr* dst, int ldd, MapF mapf) {
  float* tile = (float*)smem;
  const int tid = tid_opaque();
  __syncthreads();
#pragma unroll
  for (int pass = 0; pass < 2; ++pass) {
    const int idx = tid + pass * 512, kr = idx >> 4, c4 = idx & 15, n = ntile * 64 + c4 * 4;
    float4 v = make_float4(0.f, 0.f, 0.f, 0.f);
    if (n < N) v = *(const float4*)(W + (size_t)(kt * 64 + kr) * N + n);
    tile[kr * 65 + c4 * 4 + 0] = v.x; tile[kr * 65 + c4 * 4 + 1] = v.y; tile[kr * 65 + c4 * 4 + 2] = v.z; tile[kr * 65 + c4 * 4 + 3] = v.w;
  }
  __syncthreads();
  const int nn = tid >> 3, kg = tid & 7, n = ntile * 64 + nn;
  if (n < N) {
    float f[8];
#pragma unroll
    for (int j = 0; j < 8; ++j) f[j] = tile[(kg * 8 + j) * 65 + nn];
    *(u32x4*)(dst + (size_t)mapf(n) * ldd + kt * 64 + kg * 8) = pack8(f);
  }
}
constexpr int CONV_ITEMS = 6088;
__device__ __forceinline__ void convert_item(const Params& p, int l, int it) {
  if (it < 2960) { const int kt = it / 185, nt = it % 185; convert_tile(p.w_in + (size_t)l * DM * NIN, NIN, kt, nt, p.wt_in + (size_t)l * NPAD * DM, DM, [](int n) { return perm_col(n); }); }
  else if (it < 3728) { const int j = it - 2960, br = j >> 8, kt = (j >> 4) & 15, nt = j & 15;
    const float* W = p.w_br_dn; if (br == 1) W = p.w_br_sc; if (br == 2) W = p.w_br_att; W += (size_t)l * DM * DM;
    convert_tile(W, DM, kt, nt, p.wt_br + ((size_t)l * 3 + br) * DM * DM, DM, [](int n) { return n; }); }
  else if (it < 3984) { const int j = it - 3728, kt = j >> 4, nt = j & 15; convert_tile(p.w_out + (size_t)l * DM * DM, DM, kt, nt, p.wt_out + (size_t)l * DM * DM, DM, [](int n) { return n; }); }
  else if (it < 5008) { const int j = it - 3984, kt = j >> 6, nt = j & 63; convert_tile(p.w_mlp_up + (size_t)l * DM * HID, HID, kt, nt, p.wt_up + (size_t)l * HID * DM, DM, [](int n) { return n; }); }
  else if (it < 6032) { const int j = it - 5008, kt = j >> 4, nt = j & 15; convert_tile(p.w_mlp_down + (size_t)l * HID * DM, DM, kt, nt, p.wt_dn + (size_t)l * DM * HID, HID, [](int n) { return n; }); }
  else { const int j = it - 6032;
    bfr* d = p.wt_in + ((size_t)l * NPAD + NP + 32 + j * 4) * DM;
    *(u32x4*)(d + tid_opaque() * 8) = u32x4{0u, 0u, 0u, 0u}; }
}

__device__ __forceinline__ void gemm_in_tile(const Params& p, int l, int tile) {
  const int mt = tile % 24, nt = tile / 24, brow = mt * 256, bcol = nt * 256;
  const int tx = tid_opaque(); Acc<2> acc; acc_zero(acc);
  gemm_mainloop<2>(p.h, DM, p.wt_in + (size_t)l * NPAD * DM, DM, DM, brow, bcol, acc, tx);
  if (nt < 34) acc_foreach(acc, brow, bcol, tx, [&](int r, int c, float v) { p.P[(size_t)r * NP + c] = f2bf(v); });
  else if (nt < 46) acc_foreach(acc, brow, bcol, tx, [&](int r, int c, float v) { p.P[(size_t)r * NP + c] = f2bf(sigmoidf_(v)); });
  else acc_foreach(acc, brow, bcol, tx, [&](int r, int c, float v) { if (c < NP + 32) p.small[(size_t)r * 32 + (c - NP)] = v; });
}
__device__ __forceinline__ void gemm_up_tile(const Params& p, int l, int tile) {
  const int mt = tile % 24, nt = tile / 24, brow = mt * 256, bcol = nt * 256;
  const int tx = tid_opaque(); Acc<2> acc; acc_zero(acc);
  gemm_mainloop<2>(p.h, DM, p.wt_up + (size_t)l * HID * DM, DM, DM, brow, bcol, acc, tx);
  acc_foreach(acc, brow, bcol, tx, [&](int r, int c, float v) { const float x = fmaxf(v, 0.f); p.u2[(size_t)r * HID + c] = f2bf(x * x); });
}
__device__ __forceinline__ void gemm_out_tile(const Params& p, int l, int tile) {
  const int mt = tile % 24, nt = tile / 24, brow = mt * 256, bcol = nt * 128;
  const int tx = tid_opaque(); Acc<1> acc; acc_zero(acc);
  gemm_mainloop<1>(p.merged, DM, p.wt_out + (size_t)l * DM * DM, DM, DM, brow, bcol, acc, tx);
  acc_foreach(acc, brow, bcol, tx, [&](int r, int c, float v) { p.R[(size_t)r * DM + c] = v; });
}
__device__ __forceinline__ void gemm_down_tile(const Params& p, int l, int tile) {
  const int mt = tile % 24, nt = tile / 24, brow = mt * 256, bcol = nt * 128;
  const int tx = tid_opaque(); Acc<1> acc; acc_zero(acc);
  gemm_mainloop<1>(p.u2, HID, p.wt_dn + (size_t)l * DM * HID, HID, HID, brow, bcol, acc, tx);
  acc_foreach(acc, brow, bcol, tx, [&](int r, int c, float v) { p.R[(size_t)r * DM + c] = v; });
}
__device__ __forceinline__ void gemm_br_tile(const Params& p, int l, int tile) {
  const int mt = tile % 24, nt = tile / 24, brow = mt * 256, bcol = nt * 128;
  const int tx = tid_opaque(); Acc<1> tot; acc_zero(tot);
#pragma unroll 1
  for (int br = 0; br < 3; ++br) {
    Acc<1> acc; acc_zero(acc);
    gemm_mainloop<1>(p.obr + (size_t)br * NTOK * DM, DM, p.wt_br + ((size_t)l * 3 + br) * DM * DM, DM, DM, brow, bcol, acc, tx);
    const bfr* G = p.P + C_MG + br * DM;
    const int wid = tx >> 6, lane = tx & 63, wr = wid >> 2, wc = wid & 3, fr = lane & 15, fq = lane >> 4;
    const bfr* Gl = G + (size_t)(brow + wr * 64 + fq * 4) * NP + bcol + wc * 32 + fr;
#pragma unroll
    for (int ai = 0; ai < 2; ++ai)
#pragma unroll
      for (int m = 0; m < 4; ++m) {
        const bfr* Gm = Gl + (size_t)(ai * 128 + m * 16) * NP;
        asm volatile("" : "+v"(Gm) :: "memory");
#pragma unroll
        for (int n = 0; n < 2; ++n)
#pragma unroll
          for (int q = 0; q < 4; ++q) tot.a[ai][0][m][n][q] += bf2f(Gm[q * NP + n * 16]) * acc.a[ai][0][m][n][q];
      }
  }
  acc_foreach(tot, brow, bcol, tx, [&](int r, int c, float v) { p.merged[(size_t)r * DM + c] = f2bf(v); });
}
namespace att {
constexpr int D = 128, NW = 8, QBLK = 32, KVBLK = 64;
constexpr float SCALE = 0.088388347648318440f;
constexpr float THR = 8.f;
constexpr int SDEPTH = 2;
constexpr int LDQ = 1024, LDK = 256, LDO = 1024;
constexpr size_t SHM_V = KVBLK * D * 2, SHM_K = KVBLK * D * 2, SHM_ATTN = 2 * SHM_V + 2 * SHM_K + NW * 64 * 4;
using bf16 = bfr;
using f32x8  = __attribute__((ext_vector_type(8))) float;
#define KSWZ(row, colB) ((row) * 256 + ((colB) ^ (((row) & 7) << 4)))
#define SBAR() __builtin_amdgcn_sched_barrier(0)
__device__ __forceinline__ int crow(int r, int hi) { return (r & 3) + 8 * (r >> 2) + 4 * hi; }
__device__ __forceinline__ unsigned cvtpk(float lo, float hi) {
  unsigned r; asm volatile("v_cvt_pk_bf16_f32 %0, %1, %2" : "=v"(r) : "v"(lo), "v"(hi)); return r;
}
template <typename TIn> struct Stage;
template <> struct Stage<bf16>  { using T = bf16x8;
  __device__ static __forceinline__ T ld8(const bf16* p) { return *reinterpret_cast<const bf16x8*>(p); }
  __device__ static __forceinline__ bf16x8 tobf(T x) { return x; } };
template <> struct Stage<float> { using T = f32x8;
  __device__ static __forceinline__ T ld8(const float* p) { return *reinterpret_cast<const f32x8*>(p); }
  __device__ static __forceinline__ bf16x8 tobf(T x) {
    u32x4 w = {cvtpk(x[0], x[1]), cvtpk(x[2], x[3]), cvtpk(x[4], x[5]), cvtpk(x[6], x[7])}; return *reinterpret_cast<bf16x8*>(&w); } };

__device__ __forceinline__ void partialSM(f32x16& p0, f32x16& p1, float& m_reg, float& mn, float& alpha) {
  constexpr float C = SCALE * 1.4426950408889634f;
  float pmax = p0[0]; for (int r = 1; r < 16; ++r) pmax = fmaxf(pmax, p0[r]); for (int r = 0; r < 16; ++r) pmax = fmaxf(pmax, p1[r]);
  { auto rr = __builtin_amdgcn_permlane32_swap(__float_as_uint(pmax), __float_as_uint(pmax), false, false);
    pmax = fmaxf(__uint_as_float(rr[0]), __uint_as_float(rr[1])); }
  if (__builtin_expect(__all(pmax - m_reg <= THR / SCALE), 1)) { mn = m_reg; alpha = 1.f; }
  else { mn = fmaxf(m_reg, pmax); alpha = __builtin_amdgcn_exp2f((m_reg - mn) * C); m_reg = mn; }
  float mnC = -mn * C;
  for (int r = 0; r < 16; ++r) p0[r] = fmaf(p0[r], C, mnC); for (int r = 0; r < 16; ++r) p1[r] = fmaf(p1[r], C, mnC);
  for (int r = 0; r < 16; ++r) p0[r] = __builtin_amdgcn_exp2f(p0[r]);
}
__device__ __forceinline__ void finishSM(f32x16& p0, f32x16& p1, float alpha, float& l_reg, bf16x8& pa0, bf16x8& pa1, bf16x8& pa2, bf16x8& pa3) {
  for (int r = 0; r < 16; ++r) p1[r] = __builtin_amdgcn_exp2f(p1[r]);
  float ps = 0; for (int r = 0; r < 16; ++r) ps += p0[r]; for (int r = 0; r < 16; ++r) ps += p1[r];
  { auto rr = __builtin_amdgcn_permlane32_swap(__float_as_uint(ps), __float_as_uint(ps), false, false);
    ps = __uint_as_float(rr[0]) + __uint_as_float(rr[1]); }
  l_reg = l_reg * alpha + ps;
#define PK4(P, BASE, OUT) do { unsigned a0 = cvtpk(P[BASE + 0], P[BASE + 1]), a1 = cvtpk(P[BASE + 2], P[BASE + 3]);   \
    unsigned b0 = cvtpk(P[BASE + 4], P[BASE + 5]), b1 = cvtpk(P[BASE + 6], P[BASE + 7]);                              \
    auto r0 = __builtin_amdgcn_permlane32_swap(a0, b0, false, false); auto r1 = __builtin_amdgcn_permlane32_swap(a1, b1, false, false); \
    u32x4 w = {r0[0], r1[0], r0[1], r1[1]}; OUT = *reinterpret_cast<bf16x8*>(&w); } while (0)
  PK4(p0, 0, pa0); PK4(p0, 8, pa1); PK4(p1, 0, pa2); PK4(p1, 8, pa3);
#undef PK4
}
__device__ __forceinline__ void qkt(f32x16& p0, f32x16& p1, const bf16* Ks, const bf16x8* qr, int r32, int hi) {
  p0 = f32x16{}; p1 = f32x16{};
  for (int d0 = 0; d0 < 8; ++d0) { int cb = (d0 * 16 + hi * 8) * 2;
    bf16x8 b0 = *reinterpret_cast<const bf16x8*>((const char*)Ks + KSWZ(r32, cb));
    bf16x8 b1 = *reinterpret_cast<const bf16x8*>((const char*)Ks + KSWZ(32 + r32, cb));
    p0 = __builtin_amdgcn_mfma_f32_32x32x16_bf16(b0, qr[d0], p0, 0, 0, 0);
    p1 = __builtin_amdgcn_mfma_f32_32x32x16_bf16(b1, qr[d0], p1, 0, 0, 0); }
}
__device__ __forceinline__ int v_st(int k, int c) { const int kk = (k & ~0xC) | ((k & 4) << 1) | ((k & 8) >> 1); return ((kk >> 3) * 4 + (c >> 5)) * 512 + ((kk & 7) * 32 + (c & 31)) * 2; }
__device__ __forceinline__ int v_rd_base(int lane) { return ((lane & 3) << 3) | (((lane >> 2) & 3) << 6) | (((lane >> 4) & 1) << 5) | (((lane >> 5) & 1) << 8); }
constexpr int v_rd_off(int d0, int ks, int half) { return d0 * 512 + ks * 4096 + half * 2048; }
template <int OFF> __device__ __forceinline__ s16x4 tr_read(int vb) {
  s16x4 r; asm volatile("ds_read_b64_tr_b16 %0, %1 offset:%2" : "=&v"(r) : "v"(vb), "i"(OFF) : "memory"); return r;
}
template <int D0> __device__ __forceinline__ void pv_one(f32x16& od, int vb, bf16x8 pa0, bf16x8 pa1, bf16x8 pa2, bf16x8 pa3) {
  const s16x4 l0 = tr_read<v_rd_off(D0, 0, 0)>(vb), h0 = tr_read<v_rd_off(D0, 0, 1)>(vb), l1 = tr_read<v_rd_off(D0, 1, 0)>(vb), h1 = tr_read<v_rd_off(D0, 1, 1)>(vb);
  const s16x4 l2 = tr_read<v_rd_off(D0, 2, 0)>(vb), h2 = tr_read<v_rd_off(D0, 2, 1)>(vb), l3 = tr_read<v_rd_off(D0, 3, 0)>(vb), h3 = tr_read<v_rd_off(D0, 3, 1)>(vb);
  asm volatile("s_waitcnt lgkmcnt(0)" ::: "memory"); SBAR();
#define PK(L, H) (bf16x8){L[0], L[1], L[2], L[3], H[0], H[1], H[2], H[3]}
  od = __builtin_amdgcn_mfma_f32_32x32x16_bf16(pa0, PK(l0, h0), od, 0, 0, 0);
  od = __builtin_amdgcn_mfma_f32_32x32x16_bf16(pa1, PK(l1, h1), od, 0, 0, 0);
  od = __builtin_amdgcn_mfma_f32_32x32x16_bf16(pa2, PK(l2, h2), od, 0, 0, 0);
  od = __builtin_amdgcn_mfma_f32_32x32x16_bf16(pa3, PK(l3, h3), od, 0, 0, 0);
#undef PK
}
__device__ __forceinline__ void pv_d0(f32x16* o, int vb, bf16x8 pa0, bf16x8 pa1, bf16x8 pa2, bf16x8 pa3) {
  pv_one<0>(o[0], vb, pa0, pa1, pa2, pa3); pv_one<1>(o[1], vb, pa0, pa1, pa2, pa3); pv_one<2>(o[2], vb, pa0, pa1, pa2, pa3); pv_one<3>(o[3], vb, pa0, pa1, pa2, pa3);
}

template <typename TQ>
__device__ __forceinline__ void attn_dense_body(const TQ* __restrict__ Qb, const bf16* __restrict__ Kh, const bf16* __restrict__ Vh,
                                                bfr* __restrict__ Ob, int seq, char* lds) {
  using St = Stage<bf16>; using SQ = Stage<TQ>;
  const int tid = tid_opaque(), wid = tid >> 6, lane = tid & 63, r32 = lane & 31, hi = lane >> 5;
  bf16* V_lds = (bf16*)lds; bf16* K_lds = (bf16*)(lds + 2 * SHM_V);
  float* ws = (float*)(lds + 2 * SHM_V + 2 * SHM_K) + wid * 64; float* li_l = ws; float* al_l = ws + 32;
  float m_reg = -1e30f, l_reg = 0; f32x16 o[4] = {}; bf16x8 qr[8];
  const TQ* Qw = Qb + (long)(wid * QBLK + r32) * LDQ + hi * 8;
#pragma unroll
  for (int d0 = 0; d0 < 8; ++d0) qr[d0] = SQ::tobf(SQ::ld8(Qw + d0 * 16));
  const int sr = tid >> 4, sc = (tid & 15) * 8, vst0 = v_st(sr, sc), vst1 = v_st(32 + sr, sc);
  const int vb0 = (int)(uintptr_t)V_lds + v_rd_base(lane);
  struct { typename St::T vs0, vs1, ks0, ks1; } sr_[SDEPTH];
#define SLOAD(i, k0) do { sr_[i].vs0 = St::ld8(&Vh[(long)((k0) + sr) * LDK + sc]); sr_[i].vs1 = St::ld8(&Vh[(long)((k0) + 32 + sr) * LDK + sc]); \
    sr_[i].ks0 = St::ld8(&Kh[(long)((k0) + sr) * LDK + sc]); sr_[i].ks1 = St::ld8(&Kh[(long)((k0) + 32 + sr) * LDK + sc]); } while (0)
#define SWRITE(b, i) do { *(bf16x8*)((char*)V_lds + (b) * SHM_V + vst0) = St::tobf(sr_[i].vs0);          \
    *(bf16x8*)((char*)V_lds + (b) * SHM_V + vst1) = St::tobf(sr_[i].vs1); int kc = sc * 2;               \
    *(bf16x8*)((char*)K_lds + (b) * SHM_K + KSWZ(sr, kc)) = St::tobf(sr_[i].ks0);                       \
    *(bf16x8*)((char*)K_lds + (b) * SHM_K + KSWZ(32 + sr, kc)) = St::tobf(sr_[i].ks1); } while (0)
#define SWAIT() do { if constexpr (SDEPTH == 2) asm volatile("s_waitcnt vmcnt(4)" ::: "memory"); else asm volatile("s_waitcnt vmcnt(0)" ::: "memory"); } while (0)
#define RESC(a) do { if (__any((a) < 1.f)) { if (hi == 0) al_l[r32] = (a); asm volatile("s_waitcnt lgkmcnt(0)" ::: "memory"); \
    for (int d = 0; d < 4; ++d) for (int r = 0; r < 16; ++r) o[d][r] *= al_l[crow(r, hi)]; } } while (0)
  f32x16 pA0, pA1, pB0, pB1; float mnA, mnB, alA, alB; bf16x8 pa0, pa1, pa2, pa3; const int NT = seq / KVBLK;
  constexpr int SE = 0, SO = SDEPTH - 1;
  SLOAD(SE, 0); asm volatile("s_waitcnt vmcnt(0)" ::: "memory"); SWRITE(0, SE); __syncthreads();
  qkt(pA0, pA1, K_lds, qr, r32, hi); partialSM(pA0, pA1, m_reg, mnA, alA);
  SLOAD(SO, KVBLK); if constexpr (SDEPTH == 2) { if (2 < NT) SLOAD(SE, 2 * KVBLK); }
  SWAIT(); SWRITE(1, SO); __syncthreads();
  for (int j = 1; j + 1 < NT; j += 2) {
    SBAR(); qkt(pB0, pB1, (bf16*)((char*)K_lds + SHM_K), qr, r32, hi);
    finishSM(pA0, pA1, alA, l_reg, pa0, pa1, pa2, pa3); SBAR();
    SLOAD(SO, (j + SDEPTH) * KVBLK); SBAR();
    pv_d0(o, vb0, pa0, pa1, pa2, pa3); partialSM(pB0, pB1, m_reg, mnB, alB);
    __syncthreads(); SWAIT(); SWRITE(0, SE);
    RESC(alB); __syncthreads();
    SBAR(); qkt(pA0, pA1, K_lds, qr, r32, hi);
    finishSM(pB0, pB1, alB, l_reg, pa0, pa1, pa2, pa3); SBAR();
    if (SDEPTH == 1 || j + 3 < NT) SLOAD(SE, (j + 1 + SDEPTH) * KVBLK); SBAR();
    pv_d0(o, vb0 + (int)SHM_V, pa0, pa1, pa2, pa3); partialSM(pA0, pA1, m_reg, mnA, alA);
    __syncthreads(); SWAIT(); SWRITE(1, SO);
    RESC(alA); __syncthreads();
  }
  SBAR(); qkt(pB0, pB1, (bf16*)((char*)K_lds + SHM_K), qr, r32, hi);
  finishSM(pA0, pA1, alA, l_reg, pa0, pa1, pa2, pa3); SBAR();
  pv_d0(o, vb0, pa0, pa1, pa2, pa3); partialSM(pB0, pB1, m_reg, mnB, alB);
  __syncthreads(); RESC(alB);
  finishSM(pB0, pB1, alB, l_reg, pa0, pa1, pa2, pa3); SBAR();
  pv_d0(o, vb0 + (int)SHM_V, pa0, pa1, pa2, pa3);
  if (hi == 0) li_l[r32] = l_reg; asm volatile("s_waitcnt lgkmcnt(0)" ::: "memory");
  float rli[16];
#pragma unroll
  for (int r = 0; r < 16; ++r) rli[r] = __builtin_amdgcn_rcpf(li_l[crow(r, hi)]);
  bfr* Ow = Ob + (long)(wid * QBLK) * LDO;
#pragma unroll
  for (int r = 0; r < 16; ++r) { int orow = crow(r, hi);
    for (int d0 = 0; d0 < 4; ++d0) Ow[(long)orow * LDO + d0 * 32 + r32] = f2bf(o[d0][r] * rli[r]); }
#undef SLOAD
#undef SWRITE
#undef SWAIT
#undef RESC
}

}

__device__ __forceinline__ void attn_item(const Params& p, int item) {
  __syncthreads();
  if (item < 64) {
    const int b = item >> 5, h = (item >> 2) & 7, qb = item & 3; const size_t t0 = NCTX + b * 1024 + qb * 256;
    att::attn_dense_body<bfr>(p.Q + t0 * DM + h * 128, p.Ks + (size_t)b * 1280 * 256 + (h >> 2) * 128, p.Vs + (size_t)b * 1280 * 256 + (h >> 2) * 128,
                              p.obr + (size_t)2 * NTOK * DM + t0 * DM + h * 128, 1280, smem);
  } else {
    const int j = item - 64, b = j >> 3, h = j & 7; const size_t t0 = b * 256;
    att::attn_dense_body<bfr>(p.Q + t0 * DM + h * 128, p.Kc + (size_t)b * 256 * 256 + (h >> 2) * 128, p.Vc + (size_t)b * 256 * 256 + (h >> 2) * 128,
                              p.obr + (size_t)2 * NTOK * DM + t0 * DM + h * 128, 256, smem);
  }
}
constexpr float SCALEQ = 0.08838834764831845f;
constexpr int PQH = 0, PKH = 17408, PVH = 34816, PKK = 52224, PQK = 68864, PXS = 52224, PMD = 117760, PMB = 125952, PGC = 142336, PRS = 0;
constexpr int LROW = 272;

__device__ __forceinline__ float ld_bf(const char* base, int byteoff) { return bf2f(*(const bfr*)(base + byteoff)); }

template <int B>
__device__ __forceinline__ void solve_block(int d, int e, int wid, int lane) {
  const int fr = lane & 15, hq = lane >> 4;
  char* xcol = smem + PXS + ((d * 256 + e) * 64 + 16 * B) * 2;
  float acc[16];
  { const u32x4 a = *(const u32x4*)xcol, b = *(const u32x4*)(xcol + 16); unpack8(a, acc); unpack8(b, acc + 8); }
  if (B > 0) {
    constexpr int NKS = (B + 1) / 2;
    f32x4 R[4];
#pragma unroll
    for (int ct = 0; ct < 4; ++ct) R[ct] = f32x4{0.f, 0.f, 0.f, 0.f};
#pragma unroll
    for (int ks = 0; ks < NKS; ++ks) {
      const bf16x8 a = *(const bf16x8*)(smem + PMB + ((d * 64 + 16 * B + fr) * 64 + ks * 32 + 8 * hq) * 2);
#pragma unroll
      for (int ct = 0; ct < 4; ++ct) {
        const bf16x8 b = *(const bf16x8*)(smem + PXS + ((d * 256 + (wid & 3) * 64 + ct * 16 + fr) * 64 + ks * 32 + 8 * hq) * 2);
        R[ct] = __builtin_amdgcn_mfma_f32_16x16x32_bf16(a, b, R[ct], 0, 0, 0);
      }
    }
    float* rs = (float*)(smem + PRS + wid * 4096);
#pragma unroll
    for (int ct = 0; ct < 4; ++ct)
#pragma unroll
      for (int r = 0; r < 4; ++r) rs[(4 * hq + r) * 64 + ct * 16 + fr] = R[ct][r];
    asm volatile("s_waitcnt lgkmcnt(0)" ::: "memory");
#pragma unroll
    for (int r = 0; r < 16; ++r) acc[r] -= rs[r * 64 + lane];
  }
  const float4* md = (const float4*)(smem + PMD) + ((d * 4 + B) * 16) * 4;
#pragma unroll
  for (int r2 = 0; r2 < 15; ++r2) {
#pragma unroll
    for (int q = (r2 + 1) / 4; q < 4; ++q) {
      const float4 m = md[r2 * 4 + q];
      if (4 * q + 0 > r2) acc[4 * q + 0] -= m.x * acc[r2];
      if (4 * q + 1 > r2) acc[4 * q + 1] -= m.y * acc[r2];
      if (4 * q + 2 > r2) acc[4 * q + 2] -= m.z * acc[r2];
      if (4 * q + 3 > r2) acc[4 * q + 3] -= m.w * acc[r2];
    }
  }
  *(u32x4*)xcol = pack8(acc); *(u32x4*)(xcol + 16) = pack8(acc + 8);
  asm volatile("s_waitcnt lgkmcnt(0)" ::: "memory");
}

__device__ __forceinline__ void dn_prep_item(const Params& p, int l, int c, int h) {
  const int tid = tid_opaque(), wid = tid >> 6, lane = tid & 63;
  const int t0 = c * 64;
  __syncthreads();
  {
    const int grp = tid & 15;
    const float* wc = p.w_conv_dn + (size_t)l * 3 * 3072 + h * 128 + grp * 8;
#pragma unroll 1
    for (int X = 0; X < 3; ++X) {
      float w[3][8];
#pragma unroll
      for (int k = 0; k < 3; ++k) { *(float4*)&w[k][0] = *(const float4*)(wc + k * 3072 + X * 1024); *(float4*)&w[k][4] = *(const float4*)(wc + k * 3072 + X * 1024 + 4); }
#pragma unroll 1
      for (int pass = 0; pass < 2; ++pass) {
        const int r = (tid >> 4) + pass * 32, t = t0 + r, pos = tok_pos(t), L = tok_L(t);
        float acc[8] = {};
#pragma unroll
        for (int k = -1; k <= 1; ++k) {
          if (pos + k < 0 || pos + k >= L) continue;
          float x[8]; unpack8(*(const u32x4*)(p.P + (size_t)(t + k) * NP + X * 1024 + h * 128 + grp * 8), x);
#pragma unroll
          for (int q = 0; q < 8; ++q) acc[q] += w[k + 1][q] * x[q];
        }
        float ss = 0;
#pragma unroll
        for (int q = 0; q < 8; ++q) { acc[q] = siluf_(acc[q]); ss += acc[q] * acc[q]; }
        if (X < 2) {
          ss += __shfl_xor(ss, 1); ss += __shfl_xor(ss, 2); ss += __shfl_xor(ss, 4); ss += __shfl_xor(ss, 8);
          const float nrm = rsqrtf(ss + EPS);
#pragma unroll
          for (int q = 0; q < 8; ++q) acc[q] *= nrm;
        }
        *(u32x4*)(smem + X * 17408 + r * LROW + grp * 16) = pack8(acc);
      }
    }
  }
  if (wid < 2) {
    const int d = wid, ti = d ? 63 - lane : lane, t = t0 + ti;
    const float A = __expf(p.a_log[(l * 2 + d) * 8 + h]), dtb = p.dt_bias[(l * 2 + d) * 8 + h];
    const float beta = sigmoidf_(p.small[(size_t)t * 32 + d * 8 + h]);
    float g = -A * softplusf_(p.small[(size_t)t * 32 + 16 + d * 8 + h] + dtb);
#pragma unroll
    for (int o = 1; o < 64; o <<= 1) { const float v = __shfl_up(g, o); if (lane >= o) g += v; }
    float* G = (float*)(smem + PGC);
    G[d * 64 + lane] = g; G[128 + d * 64 + lane] = beta; G[256 + d * 64 + lane] = __expf(g);
  }
  __syncthreads();
  {
    const int mat = wid >> 2, rt = wid & 3, fr = lane & 15, fq = lane >> 4;
    const char* Ab = smem + (mat ? PQH : PKH);
    f32x4 acc[4];
#pragma unroll
    for (int ct = 0; ct < 4; ++ct) acc[ct] = f32x4{0.f, 0.f, 0.f, 0.f};
#pragma unroll
    for (int ks = 0; ks < 4; ++ks) {
      const bf16x8 a = *(const bf16x8*)(Ab + (rt * 16 + fr) * LROW + (ks * 32 + fq * 8) * 2);
#pragma unroll
      for (int ct = 0; ct < 4; ++ct) {
        const bf16x8 b = *(const bf16x8*)(smem + PKH + (ct * 16 + fr) * LROW + (ks * 32 + fq * 8) * 2);
        acc[ct] = __builtin_amdgcn_mfma_f32_16x16x32_bf16(a, b, acc[ct], 0, 0, 0);
      }
    }
    float* Dst = (float*)(smem + (mat ? PQK : PKK));
#pragma unroll
    for (int ct = 0; ct < 4; ++ct)
#pragma unroll
      for (int r = 0; r < 4; ++r) Dst[(rt * 16 + fq * 4 + r) * 65 + ct * 16 + fr] = acc[ct][r];
  }
  __syncthreads();
  const int d = tid >> 8, e = tid & 255;
  const float* GC = (const float*)(smem + PGC) + d * 64;
  const float* BETA = (const float*)(smem + PGC) + 128 + d * 64;
  const float* EG = (const float*)(smem + PGC) + 256 + d * 64;
  const float* KKs = (const float*)(smem + PKK);
  const float* QKs = (const float*)(smem + PQK);
  char* rec = p.dnrec + (size_t)((c * 8 + h) * 2 + d) * REC_BYTES;
  {
    const int i = e >> 2, jq = e & 3, j0 = jq * 16, ti = d ? 63 - i : i, ib = i >> 4;
    const float bi = BETA[i], gi = GC[i];
    float mv[16];
#pragma unroll
    for (int jj = 0; jj < 16; ++jj) {
      const int j = j0 + jj, tj = d ? 63 - j : j;
      mv[jj] = (j < i) ? bi * KKs[ti * 65 + tj] * __expf(gi - GC[j]) : 0.f;
    }
    float* mdt = (float*)(smem + PMD) + ((d * 4 + ib) * 16) * 16 + (i & 15);
    if (jq == ib) {
#pragma unroll
      for (int jj = 0; jj < 16; ++jj) mdt[jj * 16] = mv[jj];
    }
    float mo[16];
#pragma unroll
    for (int jj = 0; jj < 16; ++jj) mo[jj] = (jq < ib) ? mv[jj] : 0.f;
    char* mb = smem + PMB + ((d * 64 + i) * 64 + j0) * 2;
    *(u32x4*)mb = pack8(mo); *(u32x4*)(mb + 16) = pack8(mo + 8);
#pragma unroll 1
    for (int rep = 0; rep < 2; ++rep) {
      const int f = e + rep * 256, ln = f & 63, fi = f >> 6, mt = fi >> 1, ks = fi & 1;
      const int ii = mt * 16 + (ln & 15), tii = d ? 63 - ii : ii, hq = ln >> 4;
      const float gii = GC[ii];
      float v[8];
#pragma unroll
      for (int j = 0; j < 8; ++j) {
        const int jp = ks * 32 + (j >> 2) * 16 + 4 * hq + (j & 3), tj = d ? 63 - jp : jp;
        v[j] = (jp <= ii) ? SCALEQ * QKs[tii * 65 + tj] * __expf(gii - GC[jp]) : 0.f;
      }
      *(u32x4*)(rec + REC_QK + f * 16) = pack8(v);
    }
    if (e == 0) p.glast[(c * 8 + h) * 2 + d] = EG[63];
    const float gl = GC[63];
#pragma unroll 1
    for (int rep = 0; rep < 4; ++rep) {
      const int f = e + rep * 256, ln = f & 63, fi = f >> 6, hq = ln >> 4;
      {
        const int mt = fi >> 2, ks = fi & 3, ii = mt * 16 + (ln & 15), tii = d ? 63 - ii : ii;
        const float sc = SCALEQ * EG[ii];
        const char* qrow = smem + PQH + tii * LROW + (ks * 32 + 4 * hq) * 2;
        const u32x2 lo = *(const u32x2*)qrow, hi = *(const u32x2*)(qrow + 32);
        float v[8] = {__uint_as_float(lo[0] << 16), __uint_as_float(lo[0] & 0xffff0000u), __uint_as_float(lo[1] << 16), __uint_as_float(lo[1] & 0xffff0000u),
                      __uint_as_float(hi[0] << 16), __uint_as_float(hi[0] & 0xffff0000u), __uint_as_float(hi[1] << 16), __uint_as_float(hi[1] & 0xffff0000u)};
#pragma unroll
        for (int j = 0; j < 8; ++j) v[j] *= sc;
        *(u32x4*)(rec + REC_QD + f * 16) = pack8(v);
      }
      {
        const int mt = fi >> 1, ks = fi & 1, dk = mt * 16 + (ln & 15);
        float v[8];
#pragma unroll
        for (int j = 0; j < 8; ++j) {
          const int ip = ks * 32 + (j >> 2) * 16 + 4 * hq + (j & 3), tip = d ? 63 - ip : ip;
          v[j] = ld_bf(smem + PKH, tip * LROW + dk * 2) * __expf(gl - GC[ip]);
        }
        *(u32x4*)(rec + REC_KD + f * 16) = pack8(v);
      }
    }
  }
  __syncthreads();
  {
    const int col = e & 127; const bool isw = e >= 128;
    const char* src = smem + (isw ? PKH : PVH) + col * 2;
    char* xcol = smem + PXS + ((d * 256 + e) * 64) * 2;
#pragma unroll 1
    for (int i8 = 0; i8 < 8; ++i8) {
      float v[8];
#pragma unroll
      for (int q = 0; q < 8; ++q) { const int i = i8 * 8 + q, ti = d ? 63 - i : i; v[q] = ld_bf(src, ti * LROW) * (isw ? BETA[i] * EG[i] : BETA[i]); }
      *(u32x4*)(xcol + i8 * 16) = pack8(v);
    }
  }
  __syncthreads();
  solve_block<0>(d, e, wid, lane); solve_block<1>(d, e, wid, lane); solve_block<2>(d, e, wid, lane); solve_block<3>(d, e, wid, lane);
  __syncthreads();
  {
    const char* XS = smem + PXS + d * 256 * 128;
#pragma unroll 1
    for (int rep = 0; rep < 8; ++rep) {
      const int f = e + rep * 256, ln = f & 63, fi = f >> 6, ws = fi >> 3, rt = (fi >> 1) & 3, ct = fi & 1;
      const int i0 = rt * 16 + 4 * (ln >> 4), dv = ws * 32 + ct * 16 + (ln & 15);
      *(u32x2*)(rec + REC_U + f * 8) = *(const u32x2*)(XS + dv * 128 + i0 * 2);
    }
#pragma unroll 1
    for (int rep = 0; rep < 4; ++rep) {
      const int f = e + rep * 256, ln = f & 63, fi = f >> 6, mt = fi >> 2, ks = fi & 3, hq = ln >> 4;
      const char* wc = XS + (128 + ks * 32 + 4 * hq) * 128 + (mt * 16 + (ln & 15)) * 2;
      unsigned q[8];
#pragma unroll
      for (int j = 0; j < 8; ++j) q[j] = *(const bfr*)(wc + ((j >> 2) * 16 + (j & 3)) * 128);
      u32x4 o = {q[0] | (q[1] << 16), q[2] | (q[3] << 16), q[4] | (q[5] << 16), q[6] | (q[7] << 16)};
      *(u32x4*)(rec + REC_W + f * 16) = o;
    }
  }
}

__device__ __forceinline__ bf16x8 pack_b(const f32x4& a, const f32x4& b) {
  u32x4 w = {pack2(a[0], a[1]), pack2(a[2], a[3]), pack2(b[0], b[1]), pack2(b[2], b[3])};
  return *reinterpret_cast<bf16x8*>(&w);
}

__device__ __forceinline__ void dn_scan_item(const Params& p, int l, int s, int h) {
  const int tid = tid_opaque(), wid = tid >> 6, lane = tid & 63, d = wid >> 2, ws = wid & 3, fr = lane & 15, hq = lane >> 4, e = tid & 255;
  const bool samp = s >= 16;
  const int N = samp ? 16 : 4, cb = samp ? 64 + (s - 16) * 16 : s * 4, tbase = samp ? NCTX + (s - 16) * 1024 : s * 256;
  f32x4 S[8][2];
  if (samp) {
    const float* s0 = p.state_dn + ((((size_t)(s - 16) * DEPTH + l) * 2 + d) * 8 + h) * 16384;
#pragma unroll
    for (int dt = 0; dt < 8; ++dt) {
      const float* q = s0 + (dt * 16 + 4 * hq) * 128 + ws * 32 + fr;
      asm volatile("" : "+v"(q) :: "memory");
#pragma unroll
      for (int ct = 0; ct < 2; ++ct)
#pragma unroll
        for (int r = 0; r < 4; ++r) S[dt][ct][r] = q[r * 128 + ct * 16];
    }
  } else {
#pragma unroll
    for (int dt = 0; dt < 8; ++dt)
#pragma unroll
      for (int ct = 0; ct < 2; ++ct) S[dt][ct] = f32x4{0.f, 0.f, 0.f, 0.f};
  }
  const char* Lb = smem + d * 57344;
#pragma unroll 1
  for (int n = 0; n < N; ++n) {
    const int c = cb + (d ? N - 1 - n : n);
    const int ri = (c * 8 + h) * 2 + d;
    const char* rec = p.dnrec + (size_t)ri * REC_BYTES;
    __syncthreads();
#pragma unroll
    for (int i = 0; i < 14; ++i)
      __builtin_amdgcn_global_load_lds((const unsigned*)(rec + REC_W + (i * 256 + e) * 16), (__attribute__((address_space(3))) unsigned*)(smem + d * 57344 + (i * 256 + e) * 16), 16, 0, 0);
    u32x2 U[4][2];
#pragma unroll
    for (int rt = 0; rt < 4; ++rt)
#pragma unroll
      for (int ct = 0; ct < 2; ++ct) U[rt][ct] = *(const u32x2*)(rec + REC_U + ((((ws * 4 + rt) * 2 + ct) * 64) + lane) * 8);
    const float gl = p.glast[ri];
    asm volatile("s_waitcnt vmcnt(0)" ::: "memory");
    __syncthreads();
    f32x4 P[4][2], O[4][2];
#pragma unroll
    for (int rt = 0; rt < 4; ++rt)
#pragma unroll
      for (int ct = 0; ct < 2; ++ct) { P[rt][ct] = f32x4{0.f, 0.f, 0.f, 0.f}; O[rt][ct] = f32x4{0.f, 0.f, 0.f, 0.f}; }
#pragma unroll
    for (int ks = 0; ks < 4; ++ks) {
      const bf16x8 sb0 = pack_b(S[2 * ks][0], S[2 * ks + 1][0]), sb1 = pack_b(S[2 * ks][1], S[2 * ks + 1][1]);
#pragma unroll
      for (int rt = 0; rt < 4; ++rt) {
        const bf16x8 aw = *(const bf16x8*)(Lb + ((rt * 4 + ks) * 64 + lane) * 16);
        const bf16x8 aq = *(const bf16x8*)(Lb + 16384 + ((rt * 4 + ks) * 64 + lane) * 16);
        P[rt][0] = __builtin_amdgcn_mfma_f32_16x16x32_bf16(aw, sb0, P[rt][0], 0, 0, 0);
        P[rt][1] = __builtin_amdgcn_mfma_f32_16x16x32_bf16(aw, sb1, P[rt][1], 0, 0, 0);
        O[rt][0] = __builtin_amdgcn_mfma_f32_16x16x32_bf16(aq, sb0, O[rt][0], 0, 0, 0);
        O[rt][1] = __builtin_amdgcn_mfma_f32_16x16x32_bf16(aq, sb1, O[rt][1], 0, 0, 0);
      }
      asm volatile("" ::: "memory");
    }
#pragma unroll
    for (int rt = 0; rt < 4; ++rt)
#pragma unroll
      for (int ct = 0; ct < 2; ++ct) {
        const u32x2 u = U[rt][ct];
        P[rt][ct][0] = __uint_as_float(u[0] << 16) - P[rt][ct][0]; P[rt][ct][1] = __uint_as_float(u[0] & 0xffff0000u) - P[rt][ct][1];
        P[rt][ct][2] = __uint_as_float(u[1] << 16) - P[rt][ct][2]; P[rt][ct][3] = __uint_as_float(u[1] & 0xffff0000u) - P[rt][ct][3];
      }
    bf16x8 VB[2][2];
#pragma unroll
    for (int ks = 0; ks < 2; ++ks)
#pragma unroll
      for (int ct = 0; ct < 2; ++ct) VB[ks][ct] = pack_b(P[2 * ks][ct], P[2 * ks + 1][ct]);
#pragma unroll
    for (int rt = 0; rt < 4; ++rt)
#pragma unroll
      for (int ks = 0; ks < 2; ++ks) {
        const bf16x8 a = *(const bf16x8*)(Lb + 32768 + ((rt * 2 + ks) * 64 + lane) * 16);
#pragma unroll
        for (int ct = 0; ct < 2; ++ct) O[rt][ct] = __builtin_amdgcn_mfma_f32_16x16x32_bf16(a, VB[ks][ct], O[rt][ct], 0, 0, 0);
        asm volatile("" ::: "memory");
      }
#pragma unroll
    for (int dt = 0; dt < 8; ++dt) {
#pragma unroll
      for (int ct = 0; ct < 2; ++ct) S[dt][ct] *= gl;
#pragma unroll
      for (int ks = 0; ks < 2; ++ks) {
        const bf16x8 a = *(const bf16x8*)(Lb + 40960 + ((dt * 2 + ks) * 64 + lane) * 16);
#pragma unroll
        for (int ct = 0; ct < 2; ++ct) S[dt][ct] = __builtin_amdgcn_mfma_f32_16x16x32_bf16(a, VB[ks][ct], S[dt][ct], 0, 0, 0);
      }
      asm volatile("" ::: "memory");
    }
    bfr* ob = p.opart + (size_t)d * NTOK * DM + (size_t)(c * 64) * DM + h * 128 + ws * 32 + fr;
#pragma unroll
    for (int rt = 0; rt < 4; ++rt) {
      const int ip0 = rt * 16 + 4 * hq;
      bfr* q = ob + (size_t)(d ? 63 - ip0 : ip0) * DM;
      const long stp = d ? -(long)DM : (long)DM;
      asm volatile("" : "+v"(q) :: "memory");
#pragma unroll
      for (int r = 0; r < 4; ++r)
#pragma unroll
        for (int ct = 0; ct < 2; ++ct) q[r * stp + ct * 16] = f2bf(O[rt][ct][r]);
    }
  }
  if (!samp) {
    float* so = p.out_state + ((((size_t)s * DEPTH + l) * 2 + d) * 8 + h) * 16384;
#pragma unroll
    for (int dt = 0; dt < 8; ++dt) {
      float* q = so + (dt * 16 + 4 * hq) * 128 + ws * 32 + fr;
      asm volatile("" : "+v"(q) :: "memory");
#pragma unroll
      for (int ct = 0; ct < 2; ++ct)
#pragma unroll
        for (int r = 0; r < 4; ++r) q[r * 128 + ct * 16] = S[dt][ct][r];
    }
  }
  __syncthreads();
  dn_finalize(p, l, tbase, samp ? 1024 : 256, h, tid, NTHR);
}
#define XB_TMO      128
#define XB_XCNT(j)  (256  + 64 * (j))
#define XB_XSUB(j)  (1280 + 64 * (j))
#define XB_XGEN(j)  (2304 + 64 * (j))
#define XB_TOP      3328
#define XB_TOPGEN   3392
#define XCD_BAR_WORDS 3456
#define XB_SPIN_CAP (1u << 20)
#define LAS __attribute__((address_space(3)))
constexpr int XB_LDS_OFF = 147456 - 16;

__device__ __forceinline__ unsigned xb_ld(unsigned* p)              { return __hip_atomic_load(p, __ATOMIC_RELAXED, __HIP_MEMORY_SCOPE_AGENT); }
__device__ __forceinline__ unsigned xb_add(unsigned* p, unsigned v) { return __hip_atomic_fetch_add(p, v, __ATOMIC_RELAXED, __HIP_MEMORY_SCOPE_AGENT); }
__device__ __forceinline__ unsigned xb_xcc_id() { return (unsigned)__builtin_amdgcn_s_getreg((3 << 11) | 20) & 0xFu; }
#define XB_SPIN(cond, bar) do { unsigned _sp = 0; while (cond) { __builtin_amdgcn_s_sleep(1); \
    if ((++_sp & 255u) == 0u) { if (xb_ld(&(bar)[XB_TMO])) break; if (_sp > XB_SPIN_CAP) { atomicAdd(&(bar)[XB_TMO], 1u); break; } } } } while (0)

__device__ __forceinline__ void xcd_barrier_post(unsigned* bar) {
  volatile LAS unsigned* st = (volatile LAS unsigned*)(smem + XB_LDS_OFF);
  if (tid_opaque() == 0) { st[0] = 0u; st[1] = 0u; (void)xb_add(&bar[XB_XCNT(xb_xcc_id())], 1u); }
  __syncthreads();
}
__device__ __forceinline__ void xcd_barrier_complete(unsigned* bar, unsigned x, unsigned& nloc, unsigned& nx) {
  const unsigned G = gridDim.x * gridDim.y * gridDim.z;
  unsigned sum, cnt, mine, sp = 0u;
  for (;;) {
    sum = 0u; cnt = 0u; mine = 0u;
#pragma unroll
    for (unsigned j = 0; j < 16; ++j) { const unsigned c = xb_ld(&bar[XB_XCNT(j)]); sum += c; cnt += (c > 0u) ? 1u : 0u; mine = (j == x) ? c : mine; }
    if (sum == G) break;
    __builtin_amdgcn_s_sleep(1);
    if ((++sp & 255u) == 0u) { if (xb_ld(&bar[XB_TMO])) break; if (sp > XB_SPIN_CAP) { atomicAdd(&bar[XB_TMO], 1u); break; } }
  }
  nloc = mine > 0u ? mine : 1u; nx = cnt > 0u ? cnt : 1u;
}
__device__ __forceinline__ void xcd_barrier(unsigned* bar) {
  asm volatile("s_waitcnt vmcnt(0)" ::: "memory");
  __syncthreads();
  if (tid_opaque() == 0) {
    volatile LAS unsigned* st = (volatile LAS unsigned*)(smem + XB_LDS_OFF);
    const unsigned x = xb_xcc_id();
    __builtin_amdgcn_s_waitcnt(0);
    unsigned nloc = st[0], nx = st[1];
    if (nloc == 0u) { xcd_barrier_complete(bar, x, nloc, nx); st[0] = nloc; st[1] = nx; }
    const unsigned old = xb_add(&bar[XB_XSUB(x)], 1u);
    const unsigned gen = old / nloc;
    if (old + 1u == (gen + 1u) * nloc) {
      __builtin_amdgcn_fence(__ATOMIC_RELEASE, "agent");
      asm volatile("s_waitcnt vmcnt(0)" ::: "memory");
      const unsigned og = xb_add(&bar[XB_TOP], 1u);
      const unsigned tg = og / nx;
      if (og + 1u == (tg + 1u) * nx) xb_add(&bar[XB_TOPGEN], 1u);
      else XB_SPIN(xb_ld(&bar[XB_TOPGEN]) == tg, bar);
      __builtin_amdgcn_fence(__ATOMIC_ACQUIRE, "agent");
      xb_add(&bar[XB_XGEN(x)], 1u);
      asm volatile("s_waitcnt vmcnt(0)" ::: "memory");
    } else {
      XB_SPIN(xb_ld(&bar[XB_XGEN(x)]) == gen, bar);
      __builtin_amdgcn_fence(__ATOMIC_ACQUIRE, "agent");
      asm volatile("s_waitcnt vmcnt(0)" ::: "memory");
    }
  }
  __syncthreads();
}
constexpr int DYN_LDS = 147456;
#ifndef USE_CG_SYNC
#define USE_CG_SYNC 1
#endif
#if USE_CG_SYNC
#define GRID_SYNC() do { cg::this_grid().sync(); } while (0)
#else
#define GRID_SYNC() do { unsigned* bar_; { PHASE_PARAMS(pb); bar_ = pb.bar; } xcd_barrier(bar_); } while (0)
#endif

typedef const __attribute__((address_space(4))) Params* CParamsPtr;
#define PHASE_PARAMS(p) CParamsPtr p##_c = (CParamsPtr)__builtin_amdgcn_kernarg_segment_ptr(); asm volatile("" : "+s"(p##_c)); const Params& p = *(const Params*)p##_c

template <int l> __device__ __forceinline__ void run_layer(const int bid, const int nblk) {
  { PHASE_PARAMS(p); for (int t = bid; t < 24 * 47; t += nblk) gemm_in_tile(p, l, t); }
  GRID_SYNC();
  { PHASE_PARAMS(p); for (int it = bid; it < 768; it += nblk) dn_prep_item(p, l, it >> 3, it & 7); }
  { PHASE_PARAMS(p); for (int it = bid; it < 96; it += nblk) light_prep_item(p, l, it); }
  GRID_SYNC();
#pragma unroll 1
  for (int round = 0; round < 2; ++round) {
    const int it = round == 0 ? bid : 256 + (nblk - 1 - bid);
    if (round == 1 && (it >= 336 || nblk != 256)) break;
    const bool is_attn = it < 64 || (it >= 80 && it < 208);
    if (is_attn) { PHASE_PARAMS(p); attn_item(p, it < 64 ? it : it - 80 + 64); }
    else { PHASE_PARAMS(p); const int j = it < 80 ? it - 64 : it - 208; dn_scan_item(p, l, (it < 80 ? 16 : 0) + (j >> 3), j & 7); }
  }
  GRID_SYNC();
  { PHASE_PARAMS(p); for (int t = bid; t < 192; t += nblk) gemm_br_tile(p, l, t); }
  GRID_SYNC();
  { PHASE_PARAMS(p); for (int t = bid; t < 192; t += nblk) gemm_out_tile(p, l, t); }
  GRID_SYNC();
  { PHASE_PARAMS(p); stage_row(p, l, 1, bid, nblk); }
  GRID_SYNC();
  { PHASE_PARAMS(p); for (int t = bid; t < 24 * 16; t += nblk) gemm_up_tile(p, l, t); }
  GRID_SYNC();
  { PHASE_PARAMS(p); for (int t = bid; t < 192; t += nblk) gemm_down_tile(p, l, t); }
  GRID_SYNC();
  { PHASE_PARAMS(p); stage_row(p, l, 2, bid, nblk); }
  if (l + 1 < DEPTH) GRID_SYNC();
}

__global__ __launch_bounds__(512) void mega_kernel(Params p_arg) {
#if USE_CG_SYNC
  cg::grid_group grid = cg::this_grid();
#endif
  const int bid = blockIdx.x, nblk = gridDim.x;
#if !USE_CG_SYNC
  { PHASE_PARAMS(pb); xcd_barrier_post(pb.bar); }
  cg::this_grid().sync();
#endif
  { PHASE_PARAMS(p); stage_mod(p, bid, nblk, smem); }
  { PHASE_PARAMS(p); for (int it = bid; it < CONV_ITEMS * DEPTH; it += nblk) convert_item(p, it / CONV_ITEMS, it % CONV_ITEMS); }
  GRID_SYNC();
  { PHASE_PARAMS(p); stage_row(p, 0, 0, bid, nblk); }
  GRID_SYNC();
  run_layer<0>(bid, nblk); run_layer<1>(bid, nblk); run_layer<2>(bid, nblk); run_layer<3>(bid, nblk);
}

__global__ void diag_fill(float* out, long n, float v) { for (long i = blockIdx.x * 256L + threadIdx.x; i < n; i += gridDim.x * 256L) out[i] = (i == 0) ? v : 0.f; }
static size_t align_up(size_t x) { return (x + 255) & ~(size_t)255; }
static bool make_params(Params& p, void* const* d_in, void* d_out, void* d_ws, size_t ws_size) {
  const float** in = (const float**)d_in;
  p.x_prompt = in[0]; p.x_sample = in[1]; p.cache_k = in[2]; p.cache_v = in[3]; p.state_dn = in[4]; p.c = in[5]; p.c_ctx = in[6];
  p.w_mod = in[7]; p.b_mod = in[8]; p.g_pre_mix = in[9]; p.g_post_mix = in[10]; p.g_pre_mlp = in[11]; p.g_post_mlp = in[12];
  p.w_in = in[13]; p.w_conv_dn = in[14]; p.a_log = in[15]; p.dt_bias = in[16]; p.g_dn_out = in[17]; p.w_conv_sc = in[18];
  p.g_q = in[19]; p.g_k = in[20]; p.w_br_dn = in[21]; p.w_br_sc = in[22]; p.w_br_att = in[23]; p.w_out = in[24];
  p.w_mlp_up = in[25]; p.w_mlp_down = in[26];
  float* out = (float*)d_out;
  p.xbuf = out; p.out_ck = out + 6291456; p.out_cv = p.out_ck + 4194304; p.out_state = p.out_cv + 4194304;
  char* w = (char*)d_ws; size_t off = 0;
  auto take = [&](size_t bytes) { char* r = w + off; off = align_up(off + bytes); return r; };
  p.bar   = (unsigned*)take(65536);
  p.wt_in = (bfr*)take((size_t)DEPTH * NPAD * DM * 2);
  p.wt_br = (bfr*)take((size_t)DEPTH * 3 * DM * DM * 2);
  p.wt_out= (bfr*)take((size_t)DEPTH * DM * DM * 2);
  p.wt_up = (bfr*)take((size_t)DEPTH * HID * DM * 2);
  p.wt_dn = (bfr*)take((size_t)DEPTH * DM * HID * 2);
  p.mod   = (float*)take((size_t)DEPTH * 3 * 6144 * 4);
  p.h     = (bfr*)take((size_t)NTOK * DM * 2);
  p.P     = (bfr*)take((size_t)NTOK * NP * 2);
  p.u2    = p.P;
  p.small = (float*)take((size_t)NTOK * 32 * 4);
  p.dnrec = take((size_t)1536 * REC_BYTES);
  p.glast = (float*)take(1536 * 4);
  p.opart = (bfr*)take((size_t)2 * NTOK * DM * 2);
  p.obr   = (bfr*)take((size_t)3 * NTOK * DM * 2);
  p.Q     = (bfr*)take((size_t)NTOK * DM * 2);
  p.Kc    = (bfr*)take((size_t)NCTX * 256 * 2);
  p.Vc    = (bfr*)take((size_t)NCTX * 256 * 2);
  p.Ks    = (bfr*)take((size_t)2 * 1280 * 256 * 2);
  p.Vs    = (bfr*)take((size_t)2 * 1280 * 256 * 2);
  p.merged= (bfr*)take((size_t)NTOK * DM * 2);
  p.R     = (float*)take((size_t)NTOK * DM * 4);
  return off <= ws_size;
}
extern "C" void kernel_launch(void* const* d_in, const int* in_sizes, int n_in, void* d_out, int out_size, void* d_ws, size_t ws_size, hipStream_t stream) {
  Params p{};
  if (n_in != 27 || out_size != 31457280) { diag_fill<<<1024, 256, 0, stream>>>((float*)d_out, (long)out_size, 3.0e6f + n_in); return; }
  if (!make_params(p, d_in, d_out, d_ws, ws_size)) { diag_fill<<<1024, 256, 0, stream>>>((float*)d_out, (long)out_size, (float)(ws_size >> 20)); return; }
  static int grid_blocks = 0;
  if (!grid_blocks) {
    (void)hipFuncSetAttribute((const void*)mega_kernel, hipFuncAttributeMaxDynamicSharedMemorySize, DYN_LDS);
    int dev = 0, cus = 0, per_cu = 0;
    (void)hipGetDevice(&dev);
    (void)hipDeviceGetAttribute(&cus, hipDeviceAttributeMultiprocessorCount, dev);
    (void)hipOccupancyMaxActiveBlocksPerMultiprocessor(&per_cu, mega_kernel, 512, DYN_LDS);
    grid_blocks = (per_cu >= 1 && cus >= 256) ? 256 : cus * per_cu;
    if (grid_blocks <= 0) { fprintf(stderr, "kernel_launch: occupancy query gave cus %d per_cu %d\n", cus, per_cu); grid_blocks = 0; return; }
  }
  (void)hipMemsetAsync(p.bar, 0, 65536, stream);
  void* args[] = {&p};
  const hipError_t e = hipLaunchCooperativeKernel((void*)mega_kernel, dim3(grid_blocks), dim3(512), args, DYN_LDS, stream);
  if (e != hipSuccess) fprintf(stderr, "cooperative launch failed: %s (grid %d)\n", hipGetErrorString(e), grid_blocks);
}
```

```cpp
#define USE_CG_SYNC 0
#include <hip/hip_runtime.h>
#include <hip/hip_bf16.h>
#include <hip/hip_cooperative_groups.h>
#include <cstdio>
#include <cstdint>
namespace cg = cooperative_groups;

typedef unsigned short bfr;
using bf16x8 = __attribute__((ext_vector_type(8))) short;
using s16x4  = __attribute__((ext_vector_type(4))) short;
using f32x4  = __attribute__((ext_vector_type(4))) float;
using f32x16 = __attribute__((ext_vector_type(16))) float;
using u32x4  = __attribute__((ext_vector_type(4))) unsigned;
using u32x2  = __attribute__((ext_vector_type(2))) unsigned;

constexpr int DM = 1024, NTOK = 6144, NCTX = 4096, DEPTH = 4;
constexpr int NIN = 11808;
constexpr int NP = 11776;
constexpr int NPAD = 12032;
constexpr int HID = 4096;
constexpr float EPS = 1e-6f;
constexpr int C_DQ = 0, C_DK = 1024, C_DV = 2048, C_DG = 3072, C_SB = 4096, C_SCG = 5120, C_SX = 6144,
              C_AQ = 7168, C_AK = 8192, C_AV = 8448, C_MG = 8704;

constexpr int REC_U = 0, REC_W = 16384, REC_QD = 32768, REC_QK = 49152, REC_KD = 57344, REC_BYTES = 73728;

struct Params {
  const float *x_prompt, *x_sample, *cache_k, *cache_v, *state_dn, *c, *c_ctx, *w_mod, *b_mod;
  const float *g_pre_mix, *g_post_mix, *g_pre_mlp, *g_post_mlp, *w_in, *w_conv_dn, *a_log, *dt_bias, *g_dn_out;
  const float *w_conv_sc, *g_q, *g_k, *w_br_dn, *w_br_sc, *w_br_att, *w_out, *w_mlp_up, *w_mlp_down;
  float *xbuf;
  float *out_ck, *out_cv, *out_state;
  bfr *wt_in, *wt_br, *wt_out, *wt_up, *wt_dn;
  float *mod;
  bfr *h;
  bfr *P;
  float *small;
  char *dnrec;
  float *glast;
  bfr *opart;
  bfr *obr;
  bfr *Q;
  bfr *Kc, *Vc;
  bfr *Ks, *Vs;
  bfr *merged;
  bfr *a3;
  float *R;
  bfr *u2;
  unsigned *bar;
};

__device__ __forceinline__ bfr f2bf(float f) { unsigned u = __float_as_uint(f); u += 0x7fffu + ((u >> 16) & 1u); return (bfr)(u >> 16); }
__device__ __forceinline__ float bf2f(bfr b) { return __uint_as_float(((unsigned)b) << 16); }
__device__ __forceinline__ unsigned pack2(float a, float b) { return (unsigned)f2bf(a) | ((unsigned)f2bf(b) << 16); }
__device__ __forceinline__ float sigmoidf_(float x) { return 1.f / (1.f + __expf(-x)); }
__device__ __forceinline__ float siluf_(float x) { return x / (1.f + __expf(-x)); }
__device__ __forceinline__ float softplusf_(float x) { return x > 20.f ? x : log1pf(__expf(x)); }

__device__ __forceinline__ int tok_modrow(int t) { return t < NCTX ? 0 : 1 + ((t - NCTX) >> 10); }
__device__ __forceinline__ int tok_L(int t) { return t < NCTX ? 256 : 1024; }
__device__ __forceinline__ int tok_pos(int t) { return t < NCTX ? (t & 255) : ((t - NCTX) & 1023); }

__host__ __device__ __forceinline__ int perm_col(int n) { return n < 4096 ? n : (n < 4128 ? NP + (n - 4096) : n - 32); }

__device__ __forceinline__ int tid_opaque() { int t = threadIdx.x; asm volatile("" : "+v"(t)); return t; }
#define NTHR 512

__device__ __forceinline__ void stage_mod(const Params& p, int bid, int nblk, char* lds) {
  float* s = (float*)lds;
  float* red = s + 3072;
  const int tid = tid_opaque();
  for (int i = tid; i < 3072; i += NTHR) { int j = i >> 10, k = i & 1023; float c = (j == 0) ? p.c_ctx[k] : p.c[(j - 1) * 1024 + k]; s[i] = siluf_(c); }
  __syncthreads();
  for (int item = bid; item < 192; item += nblk) {
    const int l = item / 48, nb = item % 48, cq = tid & 31, ks = tid >> 5;
    const float* W = p.w_mod + ((size_t)l * 1024 + ks * 64) * 6144 + nb * 128 + cq * 4;
    float a[3][4] = {};
    for (int k = 0; k < 64; ++k) {
      const float4 w = *(const float4*)(W + (size_t)k * 6144);
#pragma unroll
      for (int j = 0; j < 3; ++j) { const float sv = s[j * 1024 + ks * 64 + k]; a[j][0] += sv * w.x; a[j][1] += sv * w.y; a[j][2] += sv * w.z; a[j][3] += sv * w.w; }
    }
    __syncthreads();
#pragma unroll
    for (int j = 0; j < 3; ++j)
#pragma unroll
      for (int q = 0; q < 4; ++q) red[(ks * 3 + j) * 128 + cq * 4 + q] = a[j][q];
    __syncthreads();
    if (tid < 384) { const int j = tid >> 7, n = tid & 127; float sum = 0; for (int q = 0; q < 16; ++q) sum += red[(q * 3 + j) * 128 + n];
      p.mod[(size_t)(l * 3 + j) * 6144 + nb * 128 + n] = sum + p.b_mod[l * 6144 + nb * 128 + n]; }
  }
  __syncthreads();
}

__device__ __forceinline__ float wave_sum(float v) {
#pragma unroll
  for (int o = 32; o > 0; o >>= 1) v += __shfl_xor(v, o);
  return v;
}

__device__ __forceinline__ void stage_row(const Params& p, int l, int mode, int bid, int nblk) {
  const int tx_ = tid_opaque(), wid = tx_ >> 6, lane = tx_ & 63;
  for (int row = bid * 8 + wid; row < NTOK; row += nblk * 8) {
    const float* modr = p.mod + (size_t)(l * 3 + tok_modrow(row)) * 6144;
    const float* xin = (l == 0 && mode <= 1) ? (row < NCTX ? p.x_prompt + (size_t)row * DM : p.x_sample + (size_t)(row - NCTX) * DM) : p.xbuf + (size_t)row * DM;
    float4 x[4];
#pragma unroll
    for (int i = 0; i < 4; ++i) x[i] = *(const float4*)(xin + lane * 4 + 256 * i);
    if (mode != 0) {
      const float* rr = p.R + (size_t)row * DM;
      const float* gpost = (mode == 1 ? p.g_post_mix : p.g_post_mlp) + l * DM;
      const float* gate = modr + (mode == 1 ? 2048 : 5120);
      float4 r[4]; float ss = 0;
#pragma unroll
      for (int i = 0; i < 4; ++i) { r[i] = *(const float4*)(rr + lane * 4 + 256 * i); { const float4 r1 = *(const float4*)(rr + (size_t)NTOK * DM + lane * 4 + 256 * i); r[i].x += r1.x; r[i].y += r1.y; r[i].z += r1.z; r[i].w += r1.w; } ss += r[i].x * r[i].x + r[i].y * r[i].y + r[i].z * r[i].z + r[i].w * r[i].w; }
      ss = wave_sum(ss);
      const float nrm = rsqrtf(ss * (1.f / DM) + EPS);
#pragma unroll
      for (int i = 0; i < 4; ++i) {
        const float4 g = *(const float4*)(gpost + lane * 4 + 256 * i), gt = *(const float4*)(gate + lane * 4 + 256 * i);
        x[i].x += gt.x * (r[i].x * nrm * g.x); x[i].y += gt.y * (r[i].y * nrm * g.y); x[i].z += gt.z * (r[i].z * nrm * g.z); x[i].w += gt.w * (r[i].w * nrm * g.w);
        *(float4*)(p.xbuf + (size_t)row * DM + lane * 4 + 256 * i) = x[i];
      }
    }
    if (mode == 2 && l == DEPTH - 1) continue;
    const int ln = (mode == 2) ? l + 1 : l;
    const float* modn = p.mod + (size_t)(ln * 3 + tok_modrow(row)) * 6144;
    const float* gpre = (mode == 1 ? p.g_pre_mlp : p.g_pre_mix) + ln * DM;
    const float* sh = modn + (mode == 1 ? 3072 : 0);
    const float* sc = modn + (mode == 1 ? 4096 : 1024);
    float ss = 0;
#pragma unroll
    for (int i = 0; i < 4; ++i) ss += x[i].x * x[i].x + x[i].y * x[i].y + x[i].z * x[i].z + x[i].w * x[i].w;
    ss = wave_sum(ss);
    const float nrm = rsqrtf(ss * (1.f / DM) + EPS);
#pragma unroll
    for (int i = 0; i < 4; ++i) {
      const float4 g = *(const float4*)(gpre + lane * 4 + 256 * i), s1 = *(const float4*)(sc + lane * 4 + 256 * i), s0 = *(const float4*)(sh + lane * 4 + 256 * i);
      const float h0 = x[i].x * nrm * g.x * (1.f + s1.x) + s0.x, h1 = x[i].y * nrm * g.y * (1.f + s1.y) + s0.y;
      const float h2 = x[i].z * nrm * g.z * (1.f + s1.z) + s0.z, h3 = x[i].w * nrm * g.w * (1.f + s1.w) + s0.w;
      u32x2 o = {pack2(h0, h1), pack2(h2, h3)};
      *(u32x2*)(p.h + (size_t)row * DM + lane * 4 + 256 * i) = o;
    }
  }
}

__device__ __forceinline__ void unpack8(const u32x4 v, float* f) {
#pragma unroll
  for (int i = 0; i < 4; ++i) { f[2 * i] = __uint_as_float(v[i] << 16); f[2 * i + 1] = __uint_as_float(v[i] & 0xffff0000u); }
}
__device__ __forceinline__ u32x4 pack8(const float* f) { u32x4 v = {pack2(f[0], f[1]), pack2(f[2], f[3]), pack2(f[4], f[5]), pack2(f[6], f[7])}; return v; }

__device__ __forceinline__ void light_prep_item(const Params& p, int l, int item) {
  const int tid = tid_opaque(), t0 = item * 16;
  const bool samp = t0 >= NCTX;
  {
    const float* wsc = p.w_conv_sc + (size_t)l * 3 * DM;
    bfr* scin = p.obr + (size_t)1 * NTOK * DM;
    for (int idx = tid; idx < 16 * 128; idx += NTHR) {
      const int r = idx >> 7, g = idx & 127, t = t0 + r, pos = tok_pos(t), L = tok_L(t);
      float acc[8] = {};
#pragma unroll
      for (int k = -1; k <= 1; ++k) {
        if (pos + k < 0 || pos + k >= L) continue;
        const bfr* row = p.P + (size_t)(t + k) * NP;
        float a[8], b[8]; unpack8(*(const u32x4*)(row + C_SCG + g * 8), a); unpack8(*(const u32x4*)(row + C_SX + g * 8), b);
        const float4 w0 = *(const float4*)(wsc + (k + 1) * DM + g * 8), w1 = *(const float4*)(wsc + (k + 1) * DM + g * 8 + 4);
        acc[0] += w0.x * a[0] * b[0]; acc[1] += w0.y * a[1] * b[1]; acc[2] += w0.z * a[2] * b[2]; acc[3] += w0.w * a[3] * b[3];
        acc[4] += w1.x * a[4] * b[4]; acc[5] += w1.y * a[5] * b[5]; acc[6] += w1.z * a[6] * b[6]; acc[7] += w1.w * a[7] * b[7];
      }
      float sb[8]; unpack8(*(const u32x4*)(p.P + (size_t)t * NP + C_SB + g * 8), sb);
#pragma unroll
      for (int q = 0; q < 8; ++q) acc[q] *= sb[q];
      *(u32x4*)(scin + (size_t)t * DM + g * 8) = pack8(acc);
    }
  }
  {
    const int sub = tid & 15;
    for (int pr = tid >> 4; pr < 16 * 10; pr += NTHR / 16) {
      const int r = pr / 10, hh = pr % 10, t = t0 + r;
      const bool isq = hh < 8;
      const bfr* src = p.P + (size_t)t * NP + (isq ? C_AQ + hh * 128 : C_AK + (hh - 8) * 128) + sub * 8;
      float x[8]; unpack8(*(const u32x4*)src, x);
      float ss = 0;
#pragma unroll
      for (int q = 0; q < 8; ++q) ss += x[q] * x[q];
      ss += __shfl_xor(ss, 1); ss += __shfl_xor(ss, 2); ss += __shfl_xor(ss, 4); ss += __shfl_xor(ss, 8);
      const float nrm = rsqrtf(ss * (1.f / 128.f) + EPS);
      const float* g = (isq ? p.g_q : p.g_k) + l * 128 + sub * 8;
#pragma unroll
      for (int q = 0; q < 8; ++q) x[q] = x[q] * nrm * g[q];
      if (samp) {
        const int pos = tok_pos(t);
        const float pidx = (sub < 8) ? (float)(pos >> 6) : (float)(pos & 63);
        const int s8 = sub & 7;
        const bool lo = s8 < 4;
        float y[8];
#pragma unroll
        for (int q = 0; q < 8; ++q) {
          const float other = __shfl_xor(x[q], 4);
          const int fi = (s8 & 3) * 8 + q;
          const float freq = exp2f(-(float)fi * (13.287712379549449f / 32.f));
          const float ang = pidx * freq;
          float sn, cs; __sincosf(ang, &sn, &cs);
          y[q] = lo ? (x[q] * cs - other * sn) : (other * sn + x[q] * cs);
        }
#pragma unroll
        for (int q = 0; q < 8; ++q) x[q] = y[q];
      }
      if (isq) {
        *(u32x4*)(p.Q + (size_t)t * DM + hh * 128 + sub * 8) = pack8(x);
      } else {
        const int kvh = hh - 8;
        if (!samp) {
          *(u32x4*)(p.Kc + (size_t)t * 256 + kvh * 128 + sub * 8) = pack8(x);
          const int b = t >> 8, pos = t & 255;
          float* o = p.out_ck + ((((size_t)b * DEPTH + l) * 256 + pos) * 2 + kvh) * 128 + sub * 8;
          *(float4*)o = make_float4(x[0], x[1], x[2], x[3]); *(float4*)(o + 4) = make_float4(x[4], x[5], x[6], x[7]);
        } else {
          const int s = t - NCTX, b = s >> 10, pos = s & 1023;
          *(u32x4*)(p.Ks + ((size_t)b * 1280 + 256 + pos) * 256 + kvh * 128 + sub * 8) = pack8(x);
        }
      }
    }
  }
  for (int idx = tid; idx < 16 * 32; idx += NTHR) {
    const int r = idx >> 5, g = idx & 31, t = t0 + r;
    const u32x4 v = *(const u32x4*)(p.P + (size_t)t * NP + C_AV + g * 8);
    if (!samp) {
      *(u32x4*)(p.Vc + (size_t)t * 256 + g * 8) = v;
      float f[8]; unpack8(v, f);
      const int b = t >> 8, pos = t & 255;
      float* o = p.out_cv + (((size_t)b * DEPTH + l) * 256 + pos) * 256 + g * 8;
      *(float4*)o = make_float4(f[0], f[1], f[2], f[3]); *(float4*)(o + 4) = make_float4(f[4], f[5], f[6], f[7]);
    } else {
      const int s = t - NCTX, b = s >> 10, pos = s & 1023;
      *(u32x4*)(p.Vs + ((size_t)b * 1280 + 256 + pos) * 256 + g * 8) = v;
    }
  }
  if (samp) {
    const int cs = item - 256, b = cs >> 6, pos0 = (cs & 63) * 4;
    for (int idx = tid; idx < 2 * 4 * 32; idx += NTHR) {
      const int which = idx >> 7, r = (idx >> 5) & 3, g = idx & 31, pos = pos0 + r;
      const float* src = (which ? p.cache_v : p.cache_k) + (((size_t)b * DEPTH + l) * 256 + pos) * 256 + g * 8;
      float f[8]; *(float4*)f = *(const float4*)src; *(float4*)(f + 4) = *(const float4*)(src + 4);
      *(u32x4*)((which ? p.Vs : p.Ks) + ((size_t)b * 1280 + pos) * 256 + g * 8) = pack8(f);
    }
  }
}

__device__ __forceinline__ void dn_finalize(const Params& p, int l, int t0, int n, int h, int tid0, int nthr) {
  const int sub = tid0 & 15;
  const float* g = p.g_dn_out + l * 128 + sub * 8;
  for (int r = tid0 >> 4; r < n; r += nthr / 16) {
    const int t = t0 + r;
    float a[8], b[8], dg[8];
    unpack8(*(const u32x4*)(p.opart + (size_t)t * DM + h * 128 + sub * 8), a);
    unpack8(*(const u32x4*)(p.opart + (size_t)NTOK * DM + (size_t)t * DM + h * 128 + sub * 8), b);
    unpack8(*(const u32x4*)(p.P + (size_t)t * NP + C_DG + h * 128 + sub * 8), dg);
    float ss = 0;
#pragma unroll
    for (int q = 0; q < 8; ++q) { a[q] += b[q]; ss += a[q] * a[q]; }
    ss += __shfl_xor(ss, 1); ss += __shfl_xor(ss, 2); ss += __shfl_xor(ss, 4); ss += __shfl_xor(ss, 8);
    const float nrm = rsqrtf(ss * (1.f / 128.f) + EPS);
#pragma unroll
    for (int q = 0; q < 8; ++q) a[q] = a[q] * nrm * g[q] * siluf_(dg[q]);
    *(u32x4*)(p.obr + (size_t)t * DM + h * 128 + sub * 8) = pack8(a);
  }
}
extern __shared__ __attribute__((aligned(16))) char smem[];
constexpr int HT_BYTES = 128 * 64 * 2;

__device__ __forceinline__ int lds_byte(int r, int c) {
  int st = (r >> 4) * 2 + (c >> 5), rr = r & 15, cc = c & 31, ob = rr * 64 + cc * 2;
  return st * 1024 + (ob ^ (((ob >> 9) & 1) << 5));
}
__device__ __forceinline__ void stage_rc(int b, int& R, int& C) {
  int st = b / 1024, sb = b % 1024, swz = sb ^ (((sb >> 9) & 1) << 5);
  R = (st >> 1) * 16 + swz / 64; C = (st & 1) * 32 + (swz % 64) / 2;
}
__device__ __forceinline__ void stage_half(const bfr* G, long ld, int row0, int k0, int loff, int tx) {
#pragma unroll
  for (int i = 0; i < 2; ++i) {
    const int b = tx * 16 + i * 8192; int r, c; stage_rc(b, r, c);
    __builtin_amdgcn_global_load_lds((const unsigned*)(G + (long)(row0 + r) * ld + k0 + c), (__attribute__((address_space(3))) unsigned*)(smem + loff + b), 16, 0, 0);
  }
}

template <int NB, class AccT>
__device__ __forceinline__ void gemm_mainloop(const bfr* A, long lda, const bfr* Bt, long ldb, int K, int brow, int bcol, AccT& acc, int tx) {
  const int wid = tx >> 6, lane = tx & 63, wr = wid >> 2, wc = wid & 3, fr = lane & 15, fq = lane >> 4;
  constexpr int STG = (2 + NB) * HT_BYTES;
  const int nt = K / 64;
  auto stage = [&](int s, int kt) {
    stage_half(A, lda, brow, kt * 64, s * STG, tx);
    stage_half(A, lda, brow + 128, kt * 64, s * STG + HT_BYTES, tx);
#pragma unroll
    for (int j = 0; j < NB; ++j) stage_half(Bt, ldb, bcol + j * 128, kt * 64, s * STG + (2 + j) * HT_BYTES, tx);
  };
  stage(0, 0);
  asm volatile("s_waitcnt vmcnt(0)" ::: "memory");
  __syncthreads();
  for (int t = 0; t < nt; ++t) {
    const int s = t & 1;
    if (t + 1 < nt) stage(s ^ 1, t + 1);
    const char* base = smem + s * STG;
    bf16x8 Bf[NB][2][2];
#pragma unroll
    for (int j = 0; j < NB; ++j)
#pragma unroll
      for (int n = 0; n < 2; ++n)
#pragma unroll
        for (int k = 0; k < 2; ++k) Bf[j][n][k] = *(const bf16x8*)(base + (2 + j) * HT_BYTES + lds_byte(wc * 32 + n * 16 + fr, k * 32 + fq * 8));
#pragma unroll
    for (int ai = 0; ai < 2; ++ai) {
      bf16x8 Af[4][2];
#pragma unroll
      for (int m = 0; m < 4; ++m)
#pragma unroll
        for (int k = 0; k < 2; ++k) Af[m][k] = *(const bf16x8*)(base + ai * HT_BYTES + lds_byte(wr * 64 + m * 16 + fr, k * 32 + fq * 8));
#pragma unroll
      for (int j = 0; j < NB; ++j)
#pragma unroll
        for (int m = 0; m < 4; ++m)
#pragma unroll
          for (int n = 0; n < 2; ++n)
#pragma unroll
            for (int k = 0; k < 2; ++k) acc.a[ai][j][m][n] = __builtin_amdgcn_mfma_f32_16x16x32_bf16(Af[m][k], Bf[j][n][k], acc.a[ai][j][m][n], 0, 0, 0);
    }
    asm volatile("s_waitcnt vmcnt(0)" ::: "memory");
    __syncthreads();
  }
}
template <int NB> struct Acc { f32x4 a[2][NB][4][2]; };
template <int NB> __device__ __forceinline__ void acc_zero(Acc<NB>& acc) {
#pragma unroll
  for (int ai = 0; ai < 2; ++ai)
#pragma unroll
    for (int j = 0; j < NB; ++j)
#pragma unroll
      for (int m = 0; m < 4; ++m)
#pragma unroll
        for (int n = 0; n < 2; ++n) acc.a[ai][j][m][n] = f32x4{0.f, 0.f, 0.f, 0.f};
}
template <int NB, class F> __device__ __forceinline__ void acc_foreach(Acc<NB>& acc, int brow, int bcol, int tx, F f) {
  const int wid = tx >> 6, lane = tx & 63, wr = wid >> 2, wc = wid & 3, fr = lane & 15, fq = lane >> 4;
#pragma unroll
  for (int ai = 0; ai < 2; ++ai)
#pragma unroll
    for (int j = 0; j < NB; ++j)
#pragma unroll
      for (int m = 0; m < 4; ++m)
#pragma unroll
        for (int n = 0; n < 2; ++n)
#pragma unroll
          for (int q = 0; q < 4; ++q) f(brow + ai * 128 + wr * 64 + m * 16 + fq * 4 + q, bcol + j * 128 + wc * 32 + n * 16 + fr, acc.a[ai][j][m][n][q]);
}

template <class MapF>
__device__ __forceinline__ void convert_tile(const float* W, int N, int kt, int ntile, bfr* dst, int ldd, MapF mapf, int ncopy = 1, int cstride = 0) {
  float* tile = (float*)smem;
  const int tid = tid_opaque();
  __syncthreads();
  float4 v[8];
#pragma unroll
  for (int pass = 0; pass < 8; ++pass) {
    const int idx = tid + pass * 512, kr = idx >> 6, c4 = idx & 63, n = ntile * 256 + c4 * 4;
    v[pass] = make_float4(0.f, 0.f, 0.f, 0.f);
    if (n < N) v[pass] = *(const float4*)(W + (size_t)(kt * 64 + kr) * N + n);
  }
#pragma unroll
  for (int pass = 0; pass < 8; ++pass) {
    const int idx = tid + pass * 512, kr = idx >> 6, c4 = idx & 63;
    tile[kr * 257 + c4 * 4 + 0] = v[pass].x; tile[kr * 257 + c4 * 4 + 1] = v[pass].y; tile[kr * 257 + c4 * 4 + 2] = v[pass].z; tile[kr * 257 + c4 * 4 + 3] = v[pass].w;
  }
  __syncthreads();
#pragma unroll
  for (int rep = 0; rep < 4; ++rep) {
    const int nn = (tid >> 3) + rep * 64, kg = tid & 7, n = ntile * 256 + nn;
    if (n < N) {
      float f[8];
#pragma unroll
      for (int j = 0; j < 8; ++j) f[j] = tile[(kg * 8 + j) * 257 + nn];
      const u32x4 pk = pack8(f);
      for (int cp = 0; cp < ncopy; ++cp) *(u32x4*)(dst + (size_t)mapf(n) * ldd + cp * cstride + kt * 64 + kg * 8) = pk;
    }
  }
}
constexpr int CONV_ITEMS = 1576;
__device__ __forceinline__ void convert_item(const Params& p, int l, int it) {
  if (it < 752) { const int kt = it / 47, nt = it % 47; convert_tile(p.w_in + (size_t)l * DM * NIN, NIN, kt, nt, p.wt_in + (size_t)l * NPAD * DM, DM, [](int n) { return perm_col(n); }); }
  else if (it < 944) { const int j = it - 752, br = j >> 6, kt = (j >> 2) & 15, nt = j & 3;
    const float* W = p.w_br_dn; if (br == 1) W = p.w_br_sc; if (br == 2) W = p.w_br_att; W += (size_t)l * DM * DM;
    convert_tile(W, DM, kt, nt, p.wt_br + ((size_t)l * 3 + br) * DM * DM, DM, [](int n) { return n; }); }
  else if (it < 1008) { const int j = it - 944, kt = j >> 2, nt = j & 3; convert_tile(p.w_out + (size_t)l * DM * DM, DM, kt, nt, p.wt_out + (size_t)l * DM * 3072, 3072, [](int n) { return n; }, 3, 1024); }
  else if (it < 1264) { const int j = it - 1008, kt = j >> 4, nt = j & 15; convert_tile(p.w_mlp_up + (size_t)l * DM * HID, HID, kt, nt, p.wt_up + (size_t)l * HID * DM, DM, [](int n) { return n; }); }
  else if (it < 1520) { const int j = it - 1264, kt = j >> 2, nt = j & 3; convert_tile(p.w_mlp_down + (size_t)l * HID * DM, DM, kt, nt, p.wt_dn + (size_t)l * DM * HID, HID, [](int n) { return n; }); }
  else { const int j = it - 1520;
    bfr* d = p.wt_in + ((size_t)l * NPAD + NP + 32 + j * 4) * DM;
    *(u32x4*)(d + tid_opaque() * 8) = u32x4{0u, 0u, 0u, 0u}; }
}

__device__ __forceinline__ void gemm_in_tile(const Params& p, int l, int tile) {
  const int mt = tile % 24, nt = tile / 24, brow = mt * 256, bcol = nt * 256;
  const int tx = tid_opaque(); Acc<2> acc; acc_zero(acc);
  gemm_mainloop<2>(p.h, DM, p.wt_in + (size_t)l * NPAD * DM, DM, DM, brow, bcol, acc, tx);
  if (nt < 34) acc_foreach(acc, brow, bcol, tx, [&](int r, int c, float v) { p.P[(size_t)r * NP + c] = f2bf(v); });
  else if (nt < 46) acc_foreach(acc, brow, bcol, tx, [&](int r, int c, float v) { p.P[(size_t)r * NP + c] = f2bf(sigmoidf_(v)); });
  else acc_foreach(acc, brow, bcol, tx, [&](int r, int c, float v) { if (c < NP + 32) p.small[(size_t)r * 32 + (c - NP)] = v; });
}
__device__ __forceinline__ void gemm_up_tile(const Params& p, int l, int tile) {
  const int mt = tile % 24, nt = tile / 24, brow = mt * 256, bcol = nt * 256;
  const int tx = tid_opaque(); Acc<2> acc; acc_zero(acc);
  gemm_mainloop<2>(p.h, DM, p.wt_up + (size_t)l * HID * DM, DM, DM, brow, bcol, acc, tx);
  acc_foreach(acc, brow, bcol, tx, [&](int r, int c, float v) { const float x = fmaxf(v, 0.f); p.u2[(size_t)r * HID + c] = f2bf(x * x); });
}
__device__ __forceinline__ void gemm_out_tile(const Params& p, int l, int tile) {
  const int mt = tile % 24, nt = tile / 24, brow = mt * 256, bcol = nt * 128;
  const int tx = tid_opaque(); Acc<1> acc; acc_zero(acc);
  gemm_mainloop<1>(p.merged, DM, p.wt_out + (size_t)l * DM * DM, DM, DM, brow, bcol, acc, tx);
  acc_foreach(acc, brow, bcol, tx, [&](int r, int c, float v) { p.R[(size_t)r * DM + c] = v; });
}
__device__ __forceinline__ void gemm_down_tile(const Params& p, int l, int tile) {
  const int mt = tile % 24, nt = tile / 24, brow = mt * 256, bcol = nt * 128;
  const int tx = tid_opaque(); Acc<1> acc; acc_zero(acc);
  gemm_mainloop<1>(p.u2, HID, p.wt_dn + (size_t)l * DM * HID, HID, HID, brow, bcol, acc, tx);
  acc_foreach(acc, brow, bcol, tx, [&](int r, int c, float v) { p.R[(size_t)r * DM + c] = v; });
}
__device__ __forceinline__ void gemm_br_tile(const Params& p, int l, int tile) {
  const int mt = tile % 24, nt = tile / 24, brow = mt * 256, bcol = nt * 128;
  const int tx = tid_opaque(); Acc<1> tot; acc_zero(tot);
#pragma unroll 1
  for (int br = 0; br < 3; ++br) {
    Acc<1> acc; acc_zero(acc);
    gemm_mainloop<1>(p.obr + (size_t)br * NTOK * DM, DM, p.wt_br + ((size_t)l * 3 + br) * DM * DM, DM, DM, brow, bcol, acc, tx);
    const bfr* G = p.P + C_MG + br * DM;
    const int wid = tx >> 6, lane = tx & 63, wr = wid >> 2, wc = wid & 3, fr = lane & 15, fq = lane >> 4;
    const bfr* Gl = G + (size_t)(brow + wr * 64 + fq * 4) * NP + bcol + wc * 32 + fr;
#pragma unroll
    for (int ai = 0; ai < 2; ++ai)
#pragma unroll
      for (int m = 0; m < 4; ++m) {
        const bfr* Gm = Gl + (size_t)(ai * 128 + m * 16) * NP;
        asm volatile("" : "+v"(Gm) :: "memory");
#pragma unroll
        for (int n = 0; n < 2; ++n)
#pragma unroll
          for (int q = 0; q < 4; ++q) tot.a[ai][0][m][n][q] += bf2f(Gm[q * NP + n * 16]) * acc.a[ai][0][m][n][q];
      }
  }
  acc_foreach(tot, brow, bcol, tx, [&](int r, int c, float v) { p.merged[(size_t)r * DM + c] = f2bf(v); });
}
namespace pg8 {
#define PG8_LAS __attribute__((address_space(3)))
constexpr int BM = 256, BK = 64, HALF = 128, HTB = HALF * BK * 2, STAGE_BYTES = 8 * HTB;
__device__ __forceinline__ int perm32(int rho) { const int n = rho >> 4, i = rho & 15; return 8 * (i >> 2) + 4 * n + (i & 3); }
struct Unit { int pm, pn, z; size_t ka, kb; };
struct Gemm { const bfr* A; const bfr* Bt; int lda, ldb, K; };

template <class Epi, class Sched>
__device__ __forceinline__ void gemm_phase(const Gemm g, const Sched& S, const Epi& E) {
  PG8_LAS unsigned char* lds = (PG8_LAS unsigned char*)smem;
  const int tid = tid_opaque(), wid = __builtin_amdgcn_readfirstlane(tid >> 6), lane = tid & 63, wr = wid >> 2, wc = wid & 3, fr = lane & 15, fq = lane >> 4;
  const int K = g.K, nt = K / BK;
  unsigned voffA[2], voffB[2];
#pragma unroll
  for (int i = 0; i < 2; ++i) { int R, C; stage_rc(tid * 16 + i * 8192, R, C); const int Rb = Epi::PERM ? ((R & ~31) + perm32(R & 31)) : R;
    voffA[i] = (unsigned)(R * g.lda + C) * 2u; voffB[i] = (unsigned)(Rb * g.ldb + C) * 2u; }
  const size_t kstep = (size_t)(BK * 2);
  const size_t hstepA = (size_t)HALF * g.lda * 2, hstepB = (size_t)HALF * g.ldb * 2;
  const unsigned ldsw = (unsigned)wid * 1024u;
  const int aoff = lds_byte(wr * 64 + fr, fq * 8), boff = lds_byte(wc * 32 + fr, fq * 8);
#define PG8_SA(b, h) (((b) * 2 + (h)) * HTB)
#define PG8_SB(b, h) ((4 + (b) * 2 + (h)) * HTB)
#define PG8_STAGE(bufoff, gbase, voff) do { _Pragma("unroll") for (int _i = 0; _i < 2; ++_i) \
    __builtin_amdgcn_global_load_lds((const unsigned*)((const char*)(gbase) + (voff)[_i]), (PG8_LAS unsigned*)(lds + (bufoff) + ldsw + _i * 8192), 16, 0, 0); } while (0)
#define PG8_LDA(dst, b, h) do { _Pragma("unroll") for (int m = 0; m < 4; ++m) _Pragma("unroll") for (int k = 0; k < 2; ++k) dst[m][k] = *(const PG8_LAS bf16x8*)(lds + PG8_SA(b, h) + aoff + m * 2048 + k * 1024); } while (0)
#define PG8_LDB(dst, b, h) do { _Pragma("unroll") for (int n = 0; n < 2; ++n) _Pragma("unroll") for (int k = 0; k < 2; ++k) dst[n][k] = *(const PG8_LAS bf16x8*)(lds + PG8_SB(b, h) + boff + n * 2048 + k * 1024); } while (0)
#define PG8_MMA(ai, bj, At, Bt) do { __builtin_amdgcn_s_setprio(1); _Pragma("unroll") for (int m = 0; m < 4; ++m) _Pragma("unroll") for (int n = 0; n < 2; ++n) _Pragma("unroll") for (int k = 0; k < 2; ++k) \
    acc[ai][bj][m][n] = __builtin_amdgcn_mfma_f32_16x16x32_bf16(Bt[n][k], At[m][k], acc[ai][bj][m][n], 0, 0, 0); __builtin_amdgcn_s_setprio(0); } while (0)
#define PG8_WAIT_V(n) asm volatile("s_waitcnt vmcnt(" #n ")" ::: "memory")
#define PG8_WAIT_L(n) asm volatile("s_waitcnt lgkmcnt(" #n ")" ::: "memory")
#define PG8_BAR __builtin_amdgcn_s_barrier()
#define PG8_SCHED __builtin_amdgcn_sched_barrier(0)
  Unit cur, nxt; int ui = 0;
  __syncthreads();
  if (!S.next(0, cur)) return;
  f32x4 acc[2][2][4][2];
#pragma unroll
  for (int a = 0; a < 2; ++a)
#pragma unroll
    for (int b = 0; b < 2; ++b)
#pragma unroll
      for (int m = 0; m < 4; ++m)
#pragma unroll
        for (int n = 0; n < 2; ++n) acc[a][b][m][n] = (f32x4){0.f, 0.f, 0.f, 0.f};
  bf16x8 At[4][2], B0[2][2], B1[2][2];
  const char* cA = (const char*)(g.A + cur.ka) + (size_t)cur.pm * 2 * hstepA; const char* cB = (const char*)(g.Bt + cur.kb) + (size_t)cur.pn * 2 * hstepB;
  PG8_STAGE(PG8_SB(0, 0), cB, voffB); PG8_STAGE(PG8_SA(0, 0), cA, voffA); PG8_STAGE(PG8_SB(0, 1), cB + hstepB, voffB); PG8_STAGE(PG8_SA(0, 1), cA + hstepA, voffA);
  if (wr == 1) PG8_BAR;
  PG8_WAIT_V(4); PG8_BAR;
  PG8_STAGE(PG8_SB(1, 0), cB + kstep, voffB); PG8_STAGE(PG8_SA(1, 0), cA + kstep, voffA); PG8_STAGE(PG8_SB(1, 1), cB + hstepB + kstep, voffB);
  PG8_WAIT_V(6); PG8_BAR;
  for (;;) {
    const bool has_next = S.next(ui + 1, nxt);
    const char* nA = has_next ? (const char*)(g.A + nxt.ka) + (size_t)nxt.pm * 2 * hstepA : cA; const char* nB = has_next ? (const char*)(g.Bt + nxt.kb) + (size_t)nxt.pn * 2 * hstepB : cB;
    for (int t = 0; t < nt; t += 2) {
      const bool last = (t == nt - 2);
      const char* a1 = cA + (size_t)(t + 1) * kstep;
      const char* a2 = last ? nA : cA + (size_t)(t + 2) * kstep; const char* b2 = last ? nB : cB + (size_t)(t + 2) * kstep;
      const char* a3 = a2 + kstep; const char* b3 = b2 + kstep;
      PG8_LDB(B0, 0, 0); PG8_SCHED; PG8_LDA(At, 0, 0); PG8_STAGE(PG8_SA(1, 1), a1 + hstepA, voffA);
      PG8_WAIT_L(8); PG8_BAR; PG8_WAIT_L(0); PG8_MMA(0, 0, At, B0); PG8_BAR; PG8_SCHED;
      PG8_LDB(B1, 0, 1); PG8_STAGE(PG8_SB(0, 0), b2, voffB);
      PG8_BAR; PG8_WAIT_L(0); PG8_MMA(0, 1, At, B1); PG8_BAR;
      PG8_LDA(At, 0, 1); PG8_STAGE(PG8_SA(0, 0), a2, voffA);
      PG8_BAR; PG8_WAIT_L(0); PG8_MMA(1, 0, At, B0); PG8_BAR; PG8_SCHED;
      PG8_STAGE(PG8_SB(0, 1), b2 + hstepB, voffB);
      PG8_WAIT_V(6); PG8_BAR; PG8_MMA(1, 1, At, B1); PG8_BAR;
      PG8_LDB(B0, 1, 0); PG8_SCHED; PG8_LDA(At, 1, 0); PG8_STAGE(PG8_SA(0, 1), a2 + hstepA, voffA);
      PG8_WAIT_L(8); PG8_BAR; PG8_WAIT_L(0); PG8_MMA(0, 0, At, B0); PG8_BAR; PG8_SCHED;
      PG8_LDB(B1, 1, 1); PG8_STAGE(PG8_SB(1, 0), b3, voffB);
      PG8_BAR; PG8_WAIT_L(0); PG8_MMA(0, 1, At, B1); PG8_BAR;
      PG8_LDA(At, 1, 1); PG8_STAGE(PG8_SA(1, 0), a3, voffA);
      PG8_BAR; PG8_WAIT_L(0); PG8_MMA(1, 0, At, B0); PG8_BAR; PG8_SCHED;
      PG8_STAGE(PG8_SB(1, 1), b3 + hstepB, voffB);
      PG8_WAIT_V(6); PG8_BAR; PG8_MMA(1, 1, At, B1); PG8_BAR;
    }
    E(acc, cur, wr, wc, fr, fq);
    if (!has_next) break;
#pragma unroll
    for (int a = 0; a < 2; ++a)
#pragma unroll
      for (int b = 0; b < 2; ++b)
#pragma unroll
        for (int m = 0; m < 4; ++m)
#pragma unroll
          for (int n = 0; n < 2; ++n) acc[a][b][m][n] = (f32x4){0.f, 0.f, 0.f, 0.f};
    cur = nxt; cA = nA; cB = nB; ++ui;
  }
  PG8_WAIT_V(0);
  if (wr == 0) PG8_BAR;
  PG8_BAR;
#undef PG8_SA
#undef PG8_SB
#undef PG8_STAGE
#undef PG8_LDA
#undef PG8_LDB
#undef PG8_MMA
#undef PG8_WAIT_V
#undef PG8_WAIT_L
#undef PG8_BAR
#undef PG8_SCHED
}
__device__ __forceinline__ unsigned cvt_pk_bf16(float lo, float hi) { unsigned r; asm volatile("v_cvt_pk_bf16_f32 %0, %1, %2" : "=v"(r) : "v"(lo), "v"(hi)); return r; }
__device__ __forceinline__ u32x4 pk8(const f32x4 v0, const f32x4 v1) { u32x4 w; w.x = cvt_pk_bf16(v0[0], v0[1]); w.y = cvt_pk_bf16(v0[2], v0[3]); w.z = cvt_pk_bf16(v1[0], v1[1]); w.w = cvt_pk_bf16(v1[2], v1[3]); return w; }

struct SchedIn { int G, c; __device__ __forceinline__ bool next(int i, Unit& u) const { const int L = i * G + c; if (L >= 24 * 47) return false; u.pm = L % 24; u.pn = L / 24; u.z = 0; u.ka = 0; u.kb = 0; return true; } };
struct SchedUp { int G, c; __device__ __forceinline__ bool next(int i, Unit& u) const { const int L = i * G + c; if (L >= 24 * 16) return false; u.pm = L % 24; u.pn = L / 24; u.z = 0; u.ka = 0; u.kb = 0; return true; } };
struct SchedBr { int G, c; __device__ __forceinline__ bool next(int i, Unit& u) const { const int L = i * G + c; if (L >= 24 * 12) return false; const int r = L / 24; u.pm = L % 24; u.pn = r & 3; u.z = r >> 2;
  u.ka = (size_t)u.z * NTOK * DM; u.kb = (size_t)u.z * DM * DM; return true; } };
template <int KH> struct SchedSplit2 { int G, c; __device__ __forceinline__ bool next(int i, Unit& u) const { const int L = i * G + c; if (L >= 24 * 8) return false; const int r = L / 24; u.pm = L % 24; u.pn = r & 3; u.z = r >> 2;
  u.ka = (size_t)u.z * KH; u.kb = (size_t)u.z * KH; return true; } };

struct EpiIn { static constexpr bool PERM = true; bfr* P; float* small;
  __device__ __forceinline__ void operator()(const f32x4 (&acc)[2][2][4][2], const Unit& u, int wr, int wc, int fr, int fq) const {
    const int row0 = u.pm * BM + wr * 64 + fr, col0 = u.pn * BM + wc * 32 + 8 * fq;
    if (u.pn < 46) {
      const bool sg = u.pn >= 34;
#pragma unroll
      for (int ai = 0; ai < 2; ++ai)
#pragma unroll
        for (int m = 0; m < 4; ++m) { bfr* rowp = P + (size_t)(row0 + ai * HALF + m * 16) * NP + col0;
#pragma unroll
          for (int bj = 0; bj < 2; ++bj) { f32x4 v0 = acc[ai][bj][m][0], v1 = acc[ai][bj][m][1];
            if (sg) {
#pragma unroll
              for (int j = 0; j < 4; ++j) { v0[j] = sigmoidf_(v0[j]); v1[j] = sigmoidf_(v1[j]); } }
            *(u32x4*)(rowp + bj * HALF) = pk8(v0, v1); } }
    } else if (wc == 0) {
#pragma unroll
      for (int ai = 0; ai < 2; ++ai)
#pragma unroll
        for (int m = 0; m < 4; ++m) { float* rowp = small + (size_t)(row0 + ai * HALF + m * 16) * 32 + 8 * fq;
          *(f32x4*)rowp = acc[ai][0][m][0]; *(f32x4*)(rowp + 4) = acc[ai][0][m][1]; }
    }
  }
};
struct EpiUp { static constexpr bool PERM = true; bfr* O;
  __device__ __forceinline__ void operator()(const f32x4 (&acc)[2][2][4][2], const Unit& u, int wr, int wc, int fr, int fq) const {
    const int row0 = u.pm * BM + wr * 64 + fr, col0 = u.pn * BM + wc * 32 + 8 * fq;
#pragma unroll
    for (int ai = 0; ai < 2; ++ai)
#pragma unroll
      for (int m = 0; m < 4; ++m) { bfr* rowp = O + (size_t)(row0 + ai * HALF + m * 16) * HID + col0;
#pragma unroll
        for (int bj = 0; bj < 2; ++bj) { f32x4 v0 = acc[ai][bj][m][0], v1 = acc[ai][bj][m][1];
#pragma unroll
          for (int j = 0; j < 4; ++j) { const float a = fmaxf(v0[j], 0.f), b = fmaxf(v1[j], 0.f); v0[j] = a * a; v1[j] = b * b; }
          *(u32x4*)(rowp + bj * HALF) = pk8(v0, v1); } }
  }
};
struct EpiBr { static constexpr bool PERM = true; bfr* O; const bfr* P;
  __device__ __forceinline__ void operator()(const f32x4 (&acc)[2][2][4][2], const Unit& u, int wr, int wc, int fr, int fq) const {
    const int row0 = u.pm * BM + wr * 64 + fr, col0 = u.z * DM + u.pn * BM + wc * 32 + 8 * fq;
#pragma unroll
    for (int ai = 0; ai < 2; ++ai)
#pragma unroll
      for (int m = 0; m < 4; ++m) { const size_t row = row0 + ai * HALF + m * 16; bfr* rowp = O + row * 3072 + col0; const bfr* gp = P + row * NP + C_MG + col0;
#pragma unroll
        for (int bj = 0; bj < 2; ++bj) { f32x4 v0 = acc[ai][bj][m][0], v1 = acc[ai][bj][m][1];
          float g[8]; unpack8(*(const u32x4*)(gp + bj * HALF), g);
#pragma unroll
          for (int j = 0; j < 4; ++j) { v0[j] *= g[j]; v1[j] *= g[4 + j]; }
          *(u32x4*)(rowp + bj * HALF) = pk8(v0, v1); } }
  }
};
struct EpiF32 { static constexpr bool PERM = false; float* C;
  __device__ __forceinline__ void operator()(const f32x4 (&acc)[2][2][4][2], const Unit& u, int wr, int wc, int fr, int fq) const {
    const int row0 = u.pm * BM + wr * 64 + fr, col0 = u.pn * BM + wc * 32 + 4 * fq;
    float* Cz = C + (size_t)u.z * NTOK * DM;
#pragma unroll
    for (int ai = 0; ai < 2; ++ai)
#pragma unroll
      for (int m = 0; m < 4; ++m) { float* rowp = Cz + (size_t)(row0 + ai * HALF + m * 16) * DM + col0;
#pragma unroll
        for (int bj = 0; bj < 2; ++bj)
#pragma unroll
          for (int n = 0; n < 2; ++n) *(f32x4*)(rowp + bj * HALF + n * 16) = acc[ai][bj][m][n]; }
  }
};
}
namespace att {
constexpr int D = 128, NW = 8, QBLK = 32, KVBLK = 64;
constexpr float SCALE = 0.088388347648318440f;
constexpr float THR = 8.f;
constexpr int SDEPTH = 2;
constexpr int LDQ = 1024, LDK = 256, LDO = 1024;
constexpr size_t SHM_V = KVBLK * D * 2, SHM_K = KVBLK * D * 2, SHM_ATTN = 2 * SHM_V + 2 * SHM_K + NW * 64 * 4;
using bf16 = bfr;
using f32x8  = __attribute__((ext_vector_type(8))) float;
#define KSWZ(row, colB) ((row) * 256 + ((colB) ^ (((row) & 7) << 4)))
#define SBAR() __builtin_amdgcn_sched_barrier(0)
__device__ __forceinline__ int crow(int r, int hi) { return (r & 3) + 8 * (r >> 2) + 4 * hi; }
__device__ __forceinline__ unsigned cvtpk(float lo, float hi) {
  unsigned r; asm volatile("v_cvt_pk_bf16_f32 %0, %1, %2" : "=v"(r) : "v"(lo), "v"(hi)); return r;
}
template <typename TIn> struct Stage;
template <> struct Stage<bf16>  { using T = bf16x8;
  __device__ static __forceinline__ T ld8(const bf16* p) { return *reinterpret_cast<const bf16x8*>(p); }
  __device__ static __forceinline__ bf16x8 tobf(T x) { return x; } };
template <> struct Stage<float> { using T = f32x8;
  __device__ static __forceinline__ T ld8(const float* p) { return *reinterpret_cast<const f32x8*>(p); }
  __device__ static __forceinline__ bf16x8 tobf(T x) {
    u32x4 w = {cvtpk(x[0], x[1]), cvtpk(x[2], x[3]), cvtpk(x[4], x[5]), cvtpk(x[6], x[7])}; return *reinterpret_cast<bf16x8*>(&w); } };

__device__ __forceinline__ void partialSM(f32x16& p0, f32x16& p1, float& m_reg, float& mn, float& alpha) {
  constexpr float C = SCALE * 1.4426950408889634f;
  float pmax = p0[0]; for (int r = 1; r < 16; ++r) pmax = fmaxf(pmax, p0[r]); for (int r = 0; r < 16; ++r) pmax = fmaxf(pmax, p1[r]);
  { auto rr = __builtin_amdgcn_permlane32_swap(__float_as_uint(pmax), __float_as_uint(pmax), false, false);
    pmax = fmaxf(__uint_as_float(rr[0]), __uint_as_float(rr[1])); }
  if (__builtin_expect(__all(pmax - m_reg <= THR / SCALE), 1)) { mn = m_reg; alpha = 1.f; }
  else { mn = fmaxf(m_reg, pmax); alpha = __builtin_amdgcn_exp2f((m_reg - mn) * C); m_reg = mn; }
  float mnC = -mn * C;
  for (int r = 0; r < 16; ++r) p0[r] = fmaf(p0[r], C, mnC); for (int r = 0; r < 16; ++r) p1[r] = fmaf(p1[r], C, mnC);
  for (int r = 0; r < 16; ++r) p0[r] = __builtin_amdgcn_exp2f(p0[r]);
}
__device__ __forceinline__ void finishSM(f32x16& p0, f32x16& p1, float alpha, float& l_reg, bf16x8& pa0, bf16x8& pa1, bf16x8& pa2, bf16x8& pa3) {
  for (int r = 0; r < 16; ++r) p1[r] = __builtin_amdgcn_exp2f(p1[r]);
  float ps = 0; for (int r = 0; r < 16; ++r) ps += p0[r]; for (int r = 0; r < 16; ++r) ps += p1[r];
  { auto rr = __builtin_amdgcn_permlane32_swap(__float_as_uint(ps), __float_as_uint(ps), false, false);
    ps = __uint_as_float(rr[0]) + __uint_as_float(rr[1]); }
  l_reg = l_reg * alpha + ps;
#define PK4(P, BASE, OUT) do { unsigned a0 = cvtpk(P[BASE + 0], P[BASE + 1]), a1 = cvtpk(P[BASE + 2], P[BASE + 3]);   \
    unsigned b0 = cvtpk(P[BASE + 4], P[BASE + 5]), b1 = cvtpk(P[BASE + 6], P[BASE + 7]);                              \
    auto r0 = __builtin_amdgcn_permlane32_swap(a0, b0, false, false); auto r1 = __builtin_amdgcn_permlane32_swap(a1, b1, false, false); \
    u32x4 w = {r0[0], r1[0], r0[1], r1[1]}; OUT = *reinterpret_cast<bf16x8*>(&w); } while (0)
  PK4(p0, 0, pa0); PK4(p0, 8, pa1); PK4(p1, 0, pa2); PK4(p1, 8, pa3);
#undef PK4
}
__device__ __forceinline__ void qkt(f32x16& p0, f32x16& p1, const bf16* Ks, const bf16x8* qr, int r32, int hi) {
  p0 = f32x16{}; p1 = f32x16{};
  for (int d0 = 0; d0 < 8; ++d0) { int cb = (d0 * 16 + hi * 8) * 2;
    bf16x8 b0 = *reinterpret_cast<const bf16x8*>((const char*)Ks + KSWZ(r32, cb));
    bf16x8 b1 = *reinterpret_cast<const bf16x8*>((const char*)Ks + KSWZ(32 + r32, cb));
    p0 = __builtin_amdgcn_mfma_f32_32x32x16_bf16(b0, qr[d0], p0, 0, 0, 0);
    p1 = __builtin_amdgcn_mfma_f32_32x32x16_bf16(b1, qr[d0], p1, 0, 0, 0); }
}
__device__ __forceinline__ int v_st(int k, int c) { const int kk = (k & ~0xC) | ((k & 4) << 1) | ((k & 8) >> 1); return ((kk >> 3) * 4 + (c >> 5)) * 512 + ((kk & 7) * 32 + (c & 31)) * 2; }
__device__ __forceinline__ int v_rd_base(int lane) { return ((lane & 3) << 3) | (((lane >> 2) & 3) << 6) | (((lane >> 4) & 1) << 5) | (((lane >> 5) & 1) << 8); }
constexpr int v_rd_off(int d0, int ks, int half) { return d0 * 512 + ks * 4096 + half * 2048; }
template <int OFF> __device__ __forceinline__ s16x4 tr_read(int vb) {
  s16x4 r; asm volatile("ds_read_b64_tr_b16 %0, %1 offset:%2" : "=&v"(r) : "v"(vb), "i"(OFF) : "memory"); return r;
}
template <int D0> __device__ __forceinline__ void pv_one(f32x16& od, int vb, bf16x8 pa0, bf16x8 pa1, bf16x8 pa2, bf16x8 pa3) {
  const s16x4 l0 = tr_read<v_rd_off(D0, 0, 0)>(vb), h0 = tr_read<v_rd_off(D0, 0, 1)>(vb), l1 = tr_read<v_rd_off(D0, 1, 0)>(vb), h1 = tr_read<v_rd_off(D0, 1, 1)>(vb);
  const s16x4 l2 = tr_read<v_rd_off(D0, 2, 0)>(vb), h2 = tr_read<v_rd_off(D0, 2, 1)>(vb), l3 = tr_read<v_rd_off(D0, 3, 0)>(vb), h3 = tr_read<v_rd_off(D0, 3, 1)>(vb);
  asm volatile("s_waitcnt lgkmcnt(0)" ::: "memory"); SBAR();
#define PK(L, H) (bf16x8){L[0], L[1], L[2], L[3], H[0], H[1], H[2], H[3]}
  od = __builtin_amdgcn_mfma_f32_32x32x16_bf16(pa0, PK(l0, h0), od, 0, 0, 0);
  od = __builtin_amdgcn_mfma_f32_32x32x16_bf16(pa1, PK(l1, h1), od, 0, 0, 0);
  od = __builtin_amdgcn_mfma_f32_32x32x16_bf16(pa2, PK(l2, h2), od, 0, 0, 0);
  od = __builtin_amdgcn_mfma_f32_32x32x16_bf16(pa3, PK(l3, h3), od, 0, 0, 0);
#undef PK
}
__device__ __forceinline__ void pv_d0(f32x16* o, int vb, bf16x8 pa0, bf16x8 pa1, bf16x8 pa2, bf16x8 pa3) {
  pv_one<0>(o[0], vb, pa0, pa1, pa2, pa3); pv_one<1>(o[1], vb, pa0, pa1, pa2, pa3); pv_one<2>(o[2], vb, pa0, pa1, pa2, pa3); pv_one<3>(o[3], vb, pa0, pa1, pa2, pa3);
}

template <typename TQ>
__device__ __forceinline__ void attn_dense_body(const TQ* __restrict__ Qb, const bf16* __restrict__ Kh, const bf16* __restrict__ Vh,
                                                bfr* __restrict__ Ob, int seq, char* lds) {
  using St = Stage<bf16>; using SQ = Stage<TQ>;
  const int tid = tid_opaque(), wid = tid >> 6, lane = tid & 63, r32 = lane & 31, hi = lane >> 5;
  bf16* V_lds = (bf16*)lds; bf16* K_lds = (bf16*)(lds + 2 * SHM_V);
  float* ws = (float*)(lds + 2 * SHM_V + 2 * SHM_K) + wid * 64; float* li_l = ws; float* al_l = ws + 32;
  float m_reg = -1e30f, l_reg = 0; f32x16 o[4] = {}; bf16x8 qr[8];
  const TQ* Qw = Qb + (long)(wid * QBLK + r32) * LDQ + hi * 8;
#pragma unroll
  for (int d0 = 0; d0 < 8; ++d0) qr[d0] = SQ::tobf(SQ::ld8(Qw + d0 * 16));
  const int sr = tid >> 4, sc = (tid & 15) * 8, vst0 = v_st(sr, sc), vst1 = v_st(32 + sr, sc);
  const int vb0 = (int)(uintptr_t)V_lds + v_rd_base(lane);
  struct { typename St::T vs0, vs1, ks0, ks1; } sr_[SDEPTH];
#define SLOAD(i, k0) do { sr_[i].vs0 = St::ld8(&Vh[(long)((k0) + sr) * LDK + sc]); sr_[i].vs1 = St::ld8(&Vh[(long)((k0) + 32 + sr) * LDK + sc]); \
    sr_[i].ks0 = St::ld8(&Kh[(long)((k0) + sr) * LDK + sc]); sr_[i].ks1 = St::ld8(&Kh[(long)((k0) + 32 + sr) * LDK + sc]); } while (0)
#define SWRITE(b, i) do { *(bf16x8*)((char*)V_lds + (b) * SHM_V + vst0) = St::tobf(sr_[i].vs0);          \
    *(bf16x8*)((char*)V_lds + (b) * SHM_V + vst1) = St::tobf(sr_[i].vs1); int kc = sc * 2;               \
    *(bf16x8*)((char*)K_lds + (b) * SHM_K + KSWZ(sr, kc)) = St::tobf(sr_[i].ks0);                       \
    *(bf16x8*)((char*)K_lds + (b) * SHM_K + KSWZ(32 + sr, kc)) = St::tobf(sr_[i].ks1); } while (0)
#define SWAIT() do { if constexpr (SDEPTH == 2) asm volatile("s_waitcnt vmcnt(4)" ::: "memory"); else asm volatile("s_waitcnt vmcnt(0)" ::: "memory"); } while (0)
#define RESC(a) do { if (__any((a) < 1.f)) { if (hi == 0) al_l[r32] = (a); asm volatile("s_waitcnt lgkmcnt(0)" ::: "memory"); \
    for (int d = 0; d < 4; ++d) for (int r = 0; r < 16; ++r) o[d][r] *= al_l[crow(r, hi)]; } } while (0)
  f32x16 pA0, pA1, pB0, pB1; float mnA, mnB, alA, alB; bf16x8 pa0, pa1, pa2, pa3; const int NT = seq / KVBLK;
  constexpr int SE = 0, SO = SDEPTH - 1;
  SLOAD(SE, 0); asm volatile("s_waitcnt vmcnt(0)" ::: "memory"); SWRITE(0, SE); __syncthreads();
  qkt(pA0, pA1, K_lds, qr, r32, hi); partialSM(pA0, pA1, m_reg, mnA, alA);
  SLOAD(SO, KVBLK); if constexpr (SDEPTH == 2) { if (2 < NT) SLOAD(SE, 2 * KVBLK); }
  SWAIT(); SWRITE(1, SO); __syncthreads();
  for (int j = 1; j + 1 < NT; j += 2) {
    SBAR(); qkt(pB0, pB1, (bf16*)((char*)K_lds + SHM_K), qr, r32, hi);
    finishSM(pA0, pA1, alA, l_reg, pa0, pa1, pa2, pa3); SBAR();
    SLOAD(SO, (j + SDEPTH) * KVBLK); SBAR();
    pv_d0(o, vb0, pa0, pa1, pa2, pa3); partialSM(pB0, pB1, m_reg, mnB, alB);
    __syncthreads(); SWAIT(); SWRITE(0, SE);
    RESC(alB); __syncthreads();
    SBAR(); qkt(pA0, pA1, K_lds, qr, r32, hi);
    finishSM(pB0, pB1, alB, l_reg, pa0, pa1, pa2, pa3); SBAR();
    if (SDEPTH == 1 || j + 3 < NT) SLOAD(SE, (j + 1 + SDEPTH) * KVBLK); SBAR();
    pv_d0(o, vb0 + (int)SHM_V, pa0, pa1, pa2, pa3); partialSM(pA0, pA1, m_reg, mnA, alA);
    __syncthreads(); SWAIT(); SWRITE(1, SO);
    RESC(alA); __syncthreads();
  }
  SBAR(); qkt(pB0, pB1, (bf16*)((char*)K_lds + SHM_K), qr, r32, hi);
  finishSM(pA0, pA1, alA, l_reg, pa0, pa1, pa2, pa3); SBAR();
  pv_d0(o, vb0, pa0, pa1, pa2, pa3); partialSM(pB0, pB1, m_reg, mnB, alB);
  __syncthreads(); RESC(alB);
  finishSM(pB0, pB1, alB, l_reg, pa0, pa1, pa2, pa3); SBAR();
  pv_d0(o, vb0 + (int)SHM_V, pa0, pa1, pa2, pa3);
  if (hi == 0) li_l[r32] = l_reg; asm volatile("s_waitcnt lgkmcnt(0)" ::: "memory");
  float rli[16];
#pragma unroll
  for (int r = 0; r < 16; ++r) rli[r] = __builtin_amdgcn_rcpf(li_l[crow(r, hi)]);
  bfr* Ow = Ob + (long)(wid * QBLK) * LDO;
#pragma unroll
  for (int r = 0; r < 16; ++r) { int orow = crow(r, hi);
    for (int d0 = 0; d0 < 4; ++d0) Ow[(long)orow * LDO + d0 * 32 + r32] = f2bf(o[d0][r] * rli[r]); }
#undef SLOAD
#undef SWRITE
#undef SWAIT
#undef RESC
}

}

__device__ __forceinline__ void attn_item(const Params& p, int item) {
  __syncthreads();
  if (item < 64) {
    const int b = item >> 5, h = (item >> 2) & 7, qb = item & 3; const size_t t0 = NCTX + b * 1024 + qb * 256;
    att::attn_dense_body<bfr>(p.Q + t0 * DM + h * 128, p.Ks + (size_t)b * 1280 * 256 + (h >> 2) * 128, p.Vs + (size_t)b * 1280 * 256 + (h >> 2) * 128,
                              p.obr + (size_t)2 * NTOK * DM + t0 * DM + h * 128, 1280, smem);
  } else {
    const int j = item - 64, b = j >> 3, h = j & 7; const size_t t0 = b * 256;
    att::attn_dense_body<bfr>(p.Q + t0 * DM + h * 128, p.Kc + (size_t)b * 256 * 256 + (h >> 2) * 128, p.Vc + (size_t)b * 256 * 256 + (h >> 2) * 128,
                              p.obr + (size_t)2 * NTOK * DM + t0 * DM + h * 128, 256, smem);
  }
}
#define XB_TMO      128
#define XB_XCNT(j)  (256  + 64 * (j))
#define XB_XSUB(j)  (1280 + 64 * (j))
#define XB_XGEN(j)  (2304 + 64 * (j))
#define XB_TOP      3328
#define XB_TOPGEN   3392
#define XCD_BAR_WORDS 3456
#define XB_SPIN_CAP (1u << 20)
#define LAS __attribute__((address_space(3)))
constexpr int XB_LDS_OFF = 147456 - 16;

__device__ __forceinline__ unsigned xb_ld(unsigned* p)              { return __hip_atomic_load(p, __ATOMIC_RELAXED, __HIP_MEMORY_SCOPE_AGENT); }
__device__ __forceinline__ unsigned xb_add(unsigned* p, unsigned v) { return __hip_atomic_fetch_add(p, v, __ATOMIC_RELAXED, __HIP_MEMORY_SCOPE_AGENT); }
__device__ __forceinline__ unsigned xb_xcc_id() { return (unsigned)__builtin_amdgcn_s_getreg((3 << 11) | 20) & 0xFu; }
#define XB_SPIN(cond, bar) do { unsigned _sp = 0; while (cond) { __builtin_amdgcn_s_sleep(1); \
    if ((++_sp & 255u) == 0u) { if (xb_ld(&(bar)[XB_TMO])) break; if (_sp > XB_SPIN_CAP) { atomicAdd(&(bar)[XB_TMO], 1u); break; } } } } while (0)

__device__ __forceinline__ void xcd_barrier_post(unsigned* bar) {
  volatile LAS unsigned* st = (volatile LAS unsigned*)(smem + XB_LDS_OFF);
  if (tid_opaque() == 0) { st[0] = 0u; st[1] = 0u; (void)xb_add(&bar[XB_XCNT(xb_xcc_id())], 1u); }
  __syncthreads();
}
__device__ __forceinline__ void xcd_barrier_complete(unsigned* bar, unsigned x, unsigned& nloc, unsigned& nx) {
  const unsigned G = gridDim.x * gridDim.y * gridDim.z;
  unsigned sum, cnt, mine, sp = 0u;
  for (;;) {
    sum = 0u; cnt = 0u; mine = 0u;
#pragma unroll
    for (unsigned j = 0; j < 16; ++j) { const unsigned c = xb_ld(&bar[XB_XCNT(j)]); sum += c; cnt += (c > 0u) ? 1u : 0u; mine = (j == x) ? c : mine; }
    if (sum == G) break;
    __builtin_amdgcn_s_sleep(1);
    if ((++sp & 255u) == 0u) { if (xb_ld(&bar[XB_TMO])) break; if (sp > XB_SPIN_CAP) { atomicAdd(&bar[XB_TMO], 1u); break; } }
  }
  nloc = mine > 0u ? mine : 1u; nx = cnt > 0u ? cnt : 1u;
}
__device__ __forceinline__ void xcd_barrier(unsigned* bar) {
  asm volatile("s_waitcnt vmcnt(0)" ::: "memory");
  __syncthreads();
  if (tid_opaque() == 0) {
    volatile LAS unsigned* st = (volatile LAS unsigned*)(smem + XB_LDS_OFF);
    const unsigned x = xb_xcc_id();
    __builtin_amdgcn_s_waitcnt(0);
    unsigned nloc = st[0], nx = st[1];
    if (nloc == 0u) { xcd_barrier_complete(bar, x, nloc, nx); st[0] = nloc; st[1] = nx; }
    const unsigned old = xb_add(&bar[XB_XSUB(x)], 1u);
    const unsigned gen = old / nloc;
    if (old + 1u == (gen + 1u) * nloc) {
      __builtin_amdgcn_fence(__ATOMIC_RELEASE, "agent");
      asm volatile("s_waitcnt vmcnt(0)" ::: "memory");
      const unsigned og = xb_add(&bar[XB_TOP], 1u);
      const unsigned tg = og / nx;
      if (og + 1u == (tg + 1u) * nx) xb_add(&bar[XB_TOPGEN], 1u);
      else XB_SPIN(xb_ld(&bar[XB_TOPGEN]) == tg, bar);
      __builtin_amdgcn_fence(__ATOMIC_ACQUIRE, "agent");
      xb_add(&bar[XB_XGEN(x)], 1u);
      asm volatile("s_waitcnt vmcnt(0)" ::: "memory");
    } else {
      XB_SPIN(xb_ld(&bar[XB_XGEN(x)]) == gen, bar);
      __builtin_amdgcn_fence(__ATOMIC_ACQUIRE, "agent");
      asm volatile("s_waitcnt vmcnt(0)" ::: "memory");
    }
  }
  __syncthreads();
}
constexpr float SCALEQ = 0.08838834764831845f;
constexpr int PQH = 0, PKH = 17408, PVH = 34816, PKK = 52224, PQK = 68864, PXS = 52224, PMD = 117760, PMB = 125952, PGC = 142336, PRS = 0;
constexpr int LROW = 272;

__device__ __forceinline__ float ld_bf(const char* base, int byteoff) { return bf2f(*(const bfr*)(base + byteoff)); }

template <int B>
__device__ __forceinline__ void solve_block(int d, int e, int wid, int lane) {
  const int fr = lane & 15, hq = lane >> 4;
  char* xcol = smem + PXS + ((d * 256 + e) * 64 + 16 * B) * 2;
  float acc[16];
  { const u32x4 a = *(const u32x4*)xcol, b = *(const u32x4*)(xcol + 16); unpack8(a, acc); unpack8(b, acc + 8); }
  if (B > 0) {
    constexpr int NKS = (B + 1) / 2;
    f32x4 R[4];
#pragma unroll
    for (int ct = 0; ct < 4; ++ct) R[ct] = f32x4{0.f, 0.f, 0.f, 0.f};
#pragma unroll
    for (int ks = 0; ks < NKS; ++ks) {
      const bf16x8 a = *(const bf16x8*)(smem + PMB + ((d * 64 + 16 * B + fr) * 64 + ks * 32 + 8 * hq) * 2);
#pragma unroll
      for (int ct = 0; ct < 4; ++ct) {
        const bf16x8 b = *(const bf16x8*)(smem + PXS + ((d * 256 + (wid & 3) * 64 + ct * 16 + fr) * 64 + ks * 32 + 8 * hq) * 2);
        R[ct] = __builtin_amdgcn_mfma_f32_16x16x32_bf16(a, b, R[ct], 0, 0, 0);
      }
    }
    float* rs = (float*)(smem + PRS + wid * 4096);
#pragma unroll
    for (int ct = 0; ct < 4; ++ct)
#pragma unroll
      for (int r = 0; r < 4; ++r) rs[(4 * hq + r) * 64 + ct * 16 + fr] = R[ct][r];
    asm volatile("s_waitcnt lgkmcnt(0)" ::: "memory");
#pragma unroll
    for (int r = 0; r < 16; ++r) acc[r] -= rs[r * 64 + lane];
  }
  const float4* md = (const float4*)(smem + PMD) + ((d * 4 + B) * 16) * 4;
#pragma unroll
  for (int r2 = 0; r2 < 15; ++r2) {
#pragma unroll
    for (int q = (r2 + 1) / 4; q < 4; ++q) {
      const float4 m = md[r2 * 4 + q];
      if (4 * q + 0 > r2) acc[4 * q + 0] -= m.x * acc[r2];
      if (4 * q + 1 > r2) acc[4 * q + 1] -= m.y * acc[r2];
      if (4 * q + 2 > r2) acc[4 * q + 2] -= m.z * acc[r2];
      if (4 * q + 3 > r2) acc[4 * q + 3] -= m.w * acc[r2];
    }
  }
  *(u32x4*)xcol = pack8(acc); *(u32x4*)(xcol + 16) = pack8(acc + 8);
  asm volatile("s_waitcnt lgkmcnt(0)" ::: "memory");
}

__device__ __forceinline__ void dn_prep_item(const Params& p, int l, int c, int h) {
  const int tid = tid_opaque(), wid = tid >> 6, lane = tid & 63;
  const int t0 = c * 64;
  __syncthreads();
  {
    const int grp = tid & 15;
    const float* wc = p.w_conv_dn + (size_t)l * 3 * 3072 + h * 128 + grp * 8;
#pragma unroll 1
    for (int X = 0; X < 3; ++X) {
      float w[3][8];
#pragma unroll
      for (int k = 0; k < 3; ++k) { *(float4*)&w[k][0] = *(const float4*)(wc + k * 3072 + X * 1024); *(float4*)&w[k][4] = *(const float4*)(wc + k * 3072 + X * 1024 + 4); }
#pragma unroll 1
      for (int pass = 0; pass < 2; ++pass) {
        const int r = (tid >> 4) + pass * 32, t = t0 + r, pos = tok_pos(t), L = tok_L(t);
        float acc[8] = {};
#pragma unroll
        for (int k = -1; k <= 1; ++k) {
          if (pos + k < 0 || pos + k >= L) continue;
          float x[8]; unpack8(*(const u32x4*)(p.P + (size_t)(t + k) * NP + X * 1024 + h * 128 + grp * 8), x);
#pragma unroll
          for (int q = 0; q < 8; ++q) acc[q] += w[k + 1][q] * x[q];
        }
        float ss = 0;
#pragma unroll
        for (int q = 0; q < 8; ++q) { acc[q] = siluf_(acc[q]); ss += acc[q] * acc[q]; }
        if (X < 2) {
          ss += __shfl_xor(ss, 1); ss += __shfl_xor(ss, 2); ss += __shfl_xor(ss, 4); ss += __shfl_xor(ss, 8);
          const float nrm = rsqrtf(ss + EPS);
#pragma unroll
          for (int q = 0; q < 8; ++q) acc[q] *= nrm;
        }
        *(u32x4*)(smem + X * 17408 + r * LROW + grp * 16) = pack8(acc);
      }
    }
  }
  if (wid < 2) {
    const int d = wid, ti = d ? 63 - lane : lane, t = t0 + ti;
    const float A = __expf(p.a_log[(l * 2 + d) * 8 + h]), dtb = p.dt_bias[(l * 2 + d) * 8 + h];
    const float beta = sigmoidf_(p.small[(size_t)t * 32 + d * 8 + h]);
    float g = -A * softplusf_(p.small[(size_t)t * 32 + 16 + d * 8 + h] + dtb);
#pragma unroll
    for (int o = 1; o < 64; o <<= 1) { const float v = __shfl_up(g, o); if (lane >= o) g += v; }
    float* G = (float*)(smem + PGC);
    G[d * 64 + lane] = g; G[128 + d * 64 + lane] = beta; G[256 + d * 64 + lane] = __expf(g);
  }
  __syncthreads();
  {
    const int mat = wid >> 2, rt = wid & 3, fr = lane & 15, fq = lane >> 4;
    const char* Ab = smem + (mat ? PQH : PKH);
    f32x4 acc[4];
#pragma unroll
    for (int ct = 0; ct < 4; ++ct) acc[ct] = f32x4{0.f, 0.f, 0.f, 0.f};
#pragma unroll
    for (int ks = 0; ks < 4; ++ks) {
      const bf16x8 a = *(const bf16x8*)(Ab + (rt * 16 + fr) * LROW + (ks * 32 + fq * 8) * 2);
#pragma unroll
      for (int ct = 0; ct < 4; ++ct) {
        const bf16x8 b = *(const bf16x8*)(smem + PKH + (ct * 16 + fr) * LROW + (ks * 32 + fq * 8) * 2);
        acc[ct] = __builtin_amdgcn_mfma_f32_16x16x32_bf16(a, b, acc[ct], 0, 0, 0);
      }
    }
    float* Dst = (float*)(smem + (mat ? PQK : PKK));
#pragma unroll
    for (int ct = 0; ct < 4; ++ct)
#pragma unroll
      for (int r = 0; r < 4; ++r) Dst[(rt * 16 + fq * 4 + r) * 65 + ct * 16 + fr] = acc[ct][r];
  }
  __syncthreads();
  const int d = tid >> 8, e = tid & 255;
  const float* GC = (const float*)(smem + PGC) + d * 64;
  const float* BETA = (const float*)(smem + PGC) + 128 + d * 64;
  const float* EG = (const float*)(smem + PGC) + 256 + d * 64;
  const float* KKs = (const float*)(smem + PKK);
  const float* QKs = (const float*)(smem + PQK);
  char* rec = p.dnrec + (size_t)((c * 8 + h) * 2 + d) * REC_BYTES;
  {
    const int i = e >> 2, jq = e & 3, j0 = jq * 16, ti = d ? 63 - i : i, ib = i >> 4;
    const float bi = BETA[i], gi = GC[i];
    float mv[16];
#pragma unroll
    for (int jj = 0; jj < 16; ++jj) {
      const int j = j0 + jj, tj = d ? 63 - j : j;
      mv[jj] = (j < i) ? bi * KKs[ti * 65 + tj] * __expf(gi - GC[j]) : 0.f;
    }
    float* mdt = (float*)(smem + PMD) + ((d * 4 + ib) * 16) * 16 + (i & 15);
    if (jq == ib) {
#pragma unroll
      for (int jj = 0; jj < 16; ++jj) mdt[jj * 16] = mv[jj];
    }
    float mo[16];
#pragma unroll
    for (int jj = 0; jj < 16; ++jj) mo[jj] = (jq < ib) ? mv[jj] : 0.f;
    char* mb = smem + PMB + ((d * 64 + i) * 64 + j0) * 2;
    *(u32x4*)mb = pack8(mo); *(u32x4*)(mb + 16) = pack8(mo + 8);
#pragma unroll 1
    for (int rep = 0; rep < 2; ++rep) {
      const int f = e + rep * 256, ln = f & 63, fi = f >> 6, mt = fi >> 1, ks = fi & 1;
      const int ii = mt * 16 + (ln & 15), tii = d ? 63 - ii : ii, hq = ln >> 4;
      const float gii = GC[ii];
      float v[8];
#pragma unroll
      for (int j = 0; j < 8; ++j) {
        const int jp = ks * 32 + (j >> 2) * 16 + 4 * hq + (j & 3), tj = d ? 63 - jp : jp;
        v[j] = (jp <= ii) ? SCALEQ * QKs[tii * 65 + tj] * __expf(gii - GC[jp]) : 0.f;
      }
      *(u32x4*)(rec + REC_QK + f * 16) = pack8(v);
    }
    if (e == 0) p.glast[(c * 8 + h) * 2 + d] = EG[63];
    const float gl = GC[63];
#pragma unroll 1
    for (int rep = 0; rep < 4; ++rep) {
      const int f = e + rep * 256, ln = f & 63, fi = f >> 6, hq = ln >> 4;
      {
        const int mt = fi >> 2, ks = fi & 3, ii = mt * 16 + (ln & 15), tii = d ? 63 - ii : ii;
        const float sc = SCALEQ * EG[ii];
        const char* qrow = smem + PQH + tii * LROW + (ks * 32 + 4 * hq) * 2;
        const u32x2 lo = *(const u32x2*)qrow, hi = *(const u32x2*)(qrow + 32);
        float v[8] = {__uint_as_float(lo[0] << 16), __uint_as_float(lo[0] & 0xffff0000u), __uint_as_float(lo[1] << 16), __uint_as_float(lo[1] & 0xffff0000u),
                      __uint_as_float(hi[0] << 16), __uint_as_float(hi[0] & 0xffff0000u), __uint_as_float(hi[1] << 16), __uint_as_float(hi[1] & 0xffff0000u)};
#pragma unroll
        for (int j = 0; j < 8; ++j) v[j] *= sc;
        *(u32x4*)(rec + REC_QD + f * 16) = pack8(v);
      }
      {
        const int mt = fi >> 1, ks = fi & 1, dk = mt * 16 + (ln & 15);
        float v[8];
#pragma unroll
        for (int j = 0; j < 8; ++j) {
          const int ip = ks * 32 + (j >> 2) * 16 + 4 * hq + (j & 3), tip = d ? 63 - ip : ip;
          v[j] = ld_bf(smem + PKH, tip * LROW + dk * 2) * __expf(gl - GC[ip]);
        }
        *(u32x4*)(rec + REC_KD + f * 16) = pack8(v);
      }
    }
  }
  __syncthreads();
  {
    const int col = e & 127; const bool isw = e >= 128;
    const char* src = smem + (isw ? PKH : PVH) + col * 2;
    char* xcol = smem + PXS + ((d * 256 + e) * 64) * 2;
#pragma unroll 1
    for (int i8 = 0; i8 < 8; ++i8) {
      float v[8];
#pragma unroll
      for (int q = 0; q < 8; ++q) { const int i = i8 * 8 + q, ti = d ? 63 - i : i; v[q] = ld_bf(src, ti * LROW) * (isw ? BETA[i] * EG[i] : BETA[i]); }
      *(u32x4*)(xcol + i8 * 16) = pack8(v);
    }
  }
  __syncthreads();
  solve_block<0>(d, e, wid, lane); solve_block<1>(d, e, wid, lane); solve_block<2>(d, e, wid, lane); solve_block<3>(d, e, wid, lane);
  __syncthreads();
  {
    const char* XS = smem + PXS + d * 256 * 128;
#pragma unroll 1
    for (int rep = 0; rep < 8; ++rep) {
      const int f = e + rep * 256, ln = f & 63, fi = f >> 6, ws = fi >> 2, rt = fi & 3;
      const int i0 = rt * 16 + 4 * (ln >> 4), dv = ws * 16 + (ln & 15);
      *(u32x2*)(rec + REC_U + f * 8) = *(const u32x2*)(XS + dv * 128 + i0 * 2);
    }
#pragma unroll 1
    for (int rep = 0; rep < 4; ++rep) {
      const int f = e + rep * 256, ln = f & 63, fi = f >> 6, mt = fi >> 2, ks = fi & 3, hq = ln >> 4;
      const char* wc = XS + (128 + ks * 32 + 4 * hq) * 128 + (mt * 16 + (ln & 15)) * 2;
      unsigned q[8];
#pragma unroll
      for (int j = 0; j < 8; ++j) q[j] = *(const bfr*)(wc + ((j >> 2) * 16 + (j & 3)) * 128);
      u32x4 o = {q[0] | (q[1] << 16), q[2] | (q[3] << 16), q[4] | (q[5] << 16), q[6] | (q[7] << 16)};
      *(u32x4*)(rec + REC_W + f * 16) = o;
    }
  }
}

__device__ __forceinline__ bf16x8 pack_b(const f32x4& a, const f32x4& b) {
  u32x4 w = {pack2(a[0], a[1]), pack2(a[2], a[3]), pack2(b[0], b[1]), pack2(b[2], b[3])};
  return *reinterpret_cast<bf16x8*>(&w);
}

constexpr int SCAN_BUF = 57344;
__device__ __forceinline__ void dn_scan_item(const Params& p, int l, int s, int h, int d) {
  const int tid = tid_opaque(), wid = tid >> 6, lane = tid & 63, ws = wid, fr = lane & 15, hq = lane >> 4;
  const bool samp = s >= 16;
  const int N = samp ? 16 : 4, cb = samp ? 64 + (s - 16) * 16 : s * 4, tbase = samp ? NCTX + (s - 16) * 1024 : s * 256;
  f32x4 S[8];
  if (samp) {
    const float* s0 = p.state_dn + ((((size_t)(s - 16) * DEPTH + l) * 2 + d) * 8 + h) * 16384;
#pragma unroll
    for (int dt = 0; dt < 8; ++dt) {
      const float* q = s0 + (dt * 16 + 4 * hq) * 128 + ws * 16 + fr;
      asm volatile("" : "+v"(q) :: "memory");
#pragma unroll
      for (int r = 0; r < 4; ++r) S[dt][r] = q[r * 128];
    }
  } else {
#pragma unroll
    for (int dt = 0; dt < 8; ++dt) S[dt] = f32x4{0.f, 0.f, 0.f, 0.f};
  }
  __syncthreads();
  u32x2 U[4]; float gl;
  {
    const int c = cb + (d ? N - 1 : 0), ri = (c * 8 + h) * 2 + d;
    const char* rec = p.dnrec + (size_t)ri * REC_BYTES;
#pragma unroll
    for (int i = 0; i < 7; ++i)
      __builtin_amdgcn_global_load_lds((const unsigned*)(rec + REC_W + (i * 512 + tid) * 16), (__attribute__((address_space(3))) unsigned*)(smem + (i * 512 + tid) * 16), 16, 0, 0);
#pragma unroll
    for (int rt = 0; rt < 4; ++rt) U[rt] = *(const u32x2*)(rec + REC_U + (((ws * 4 + rt) * 64) + lane) * 8);
    gl = p.glast[ri];
  }
  asm volatile("s_waitcnt vmcnt(0)" ::: "memory");
  __syncthreads();
#pragma unroll 1
  for (int n = 0; n < N; ++n) {
    const int c = cb + (d ? N - 1 - n : n);
    const char* Lb = smem + (n & 1) * SCAN_BUF;
    u32x2 Un[4]; float gln = 0.f;
    if (n + 1 < N) {
      const int cn = cb + (d ? N - 2 - n : n + 1), rin = (cn * 8 + h) * 2 + d;
      const char* rec = p.dnrec + (size_t)rin * REC_BYTES;
#pragma unroll
      for (int i = 0; i < 7; ++i)
        __builtin_amdgcn_global_load_lds((const unsigned*)(rec + REC_W + (i * 512 + tid) * 16), (__attribute__((address_space(3))) unsigned*)(smem + ((n + 1) & 1) * SCAN_BUF + (i * 512 + tid) * 16), 16, 0, 0);
#pragma unroll
      for (int rt = 0; rt < 4; ++rt) Un[rt] = *(const u32x2*)(rec + REC_U + (((ws * 4 + rt) * 64) + lane) * 8);
      gln = p.glast[rin];
    } else {
#pragma unroll
      for (int rt = 0; rt < 4; ++rt) Un[rt] = u32x2{0u, 0u};
    }
    f32x4 P[4], O[4];
#pragma unroll
    for (int rt = 0; rt < 4; ++rt) { P[rt] = f32x4{0.f, 0.f, 0.f, 0.f}; O[rt] = f32x4{0.f, 0.f, 0.f, 0.f}; }
#pragma unroll
    for (int ks = 0; ks < 4; ++ks) {
      const bf16x8 sb = pack_b(S[2 * ks], S[2 * ks + 1]);
#pragma unroll
      for (int rt = 0; rt < 4; ++rt) {
        const bf16x8 aw = *(const bf16x8*)(Lb + ((rt * 4 + ks) * 64 + lane) * 16);
        const bf16x8 aq = *(const bf16x8*)(Lb + 16384 + ((rt * 4 + ks) * 64 + lane) * 16);
        P[rt] = __builtin_amdgcn_mfma_f32_16x16x32_bf16(aw, sb, P[rt], 0, 0, 0);
        O[rt] = __builtin_amdgcn_mfma_f32_16x16x32_bf16(aq, sb, O[rt], 0, 0, 0);
      }
    }
#pragma unroll
    for (int rt = 0; rt < 4; ++rt) {
      const u32x2 u = U[rt];
      P[rt][0] = __uint_as_float(u[0] << 16) - P[rt][0]; P[rt][1] = __uint_as_float(u[0] & 0xffff0000u) - P[rt][1];
      P[rt][2] = __uint_as_float(u[1] << 16) - P[rt][2]; P[rt][3] = __uint_as_float(u[1] & 0xffff0000u) - P[rt][3];
    }
    const bf16x8 vb0 = pack_b(P[0], P[1]), vb1 = pack_b(P[2], P[3]);
#pragma unroll
    for (int rt = 0; rt < 4; ++rt) {
      const bf16x8 a0 = *(const bf16x8*)(Lb + 32768 + ((rt * 2 + 0) * 64 + lane) * 16);
      const bf16x8 a1 = *(const bf16x8*)(Lb + 32768 + ((rt * 2 + 1) * 64 + lane) * 16);
      O[rt] = __builtin_amdgcn_mfma_f32_16x16x32_bf16(a0, vb0, O[rt], 0, 0, 0);
      O[rt] = __builtin_amdgcn_mfma_f32_16x16x32_bf16(a1, vb1, O[rt], 0, 0, 0);
    }
#pragma unroll
    for (int dt = 0; dt < 8; ++dt) {
      S[dt] *= gl;
      const bf16x8 a0 = *(const bf16x8*)(Lb + 40960 + ((dt * 2 + 0) * 64 + lane) * 16);
      const bf16x8 a1 = *(const bf16x8*)(Lb + 40960 + ((dt * 2 + 1) * 64 + lane) * 16);
      S[dt] = __builtin_amdgcn_mfma_f32_16x16x32_bf16(a0, vb0, S[dt], 0, 0, 0);
      S[dt] = __builtin_amdgcn_mfma_f32_16x16x32_bf16(a1, vb1, S[dt], 0, 0, 0);
    }
    bfr* ob = p.opart + (size_t)d * NTOK * DM + (size_t)(c * 64) * DM + h * 128 + ws * 16 + fr;
#pragma unroll
    for (int rt = 0; rt < 4; ++rt) {
      const int ip0 = rt * 16 + 4 * hq;
      bfr* q = ob + (size_t)(d ? 63 - ip0 : ip0) * DM;
      const long stp = d ? -(long)DM : (long)DM;
#pragma unroll
      for (int r = 0; r < 4; ++r) q[r * stp] = f2bf(O[rt][r]);
    }
#pragma unroll
    for (int rt = 0; rt < 4; ++rt) U[rt] = Un[rt];
    gl = gln;
    asm volatile("s_waitcnt vmcnt(0)" ::: "memory");
    __syncthreads();
  }
  if (!samp) {
    float* so = p.out_state + ((((size_t)s * DEPTH + l) * 2 + d) * 8 + h) * 16384;
#pragma unroll
    for (int dt = 0; dt < 8; ++dt) {
      float* q = so + (dt * 16 + 4 * hq) * 128 + ws * 16 + fr;
      asm volatile("" : "+v"(q) :: "memory");
#pragma unroll
      for (int r = 0; r < 4; ++r) q[r * 128] = S[dt][r];
    }
  }
  asm volatile("s_waitcnt vmcnt(0)" ::: "memory");
  __syncthreads();
  volatile __attribute__((address_space(3))) unsigned* flag = (volatile __attribute__((address_space(3))) unsigned*)(smem + XB_LDS_OFF + 8);
  if (tid == 0) {
    __builtin_amdgcn_fence(__ATOMIC_RELEASE, "agent");
    asm volatile("s_waitcnt vmcnt(0)" ::: "memory");
    const unsigned old = __hip_atomic_fetch_add(p.bar + 4096 + (l * 18 + s) * 8 + h, 1u, __ATOMIC_RELAXED, __HIP_MEMORY_SCOPE_AGENT);
    if (old == 1u) { __builtin_amdgcn_fence(__ATOMIC_ACQUIRE, "agent"); asm volatile("s_waitcnt vmcnt(0)" ::: "memory"); }
    *flag = old;
  }
  __syncthreads();
  const unsigned last = *flag;
  if (last == 1u) dn_finalize(p, l, tbase, samp ? 1024 : 256, h, tid, NTHR);
}
constexpr int DYN_LDS = 147456;
#ifndef REP
#define REP 0
#endif
#ifndef USE_CG_SYNC
#define USE_CG_SYNC 1
#endif
#if USE_CG_SYNC
#define GRID_SYNC() do { cg::this_grid().sync(); } while (0)
#else
#define GRID_SYNC() do { unsigned* bar_; { PHASE_PARAMS(pb); bar_ = pb.bar; } xcd_barrier(bar_); if (REP & 2048) xcd_barrier(bar_); } while (0)
#endif

typedef const __attribute__((address_space(4))) Params* CParamsPtr;
#define PHASE_PARAMS(p) CParamsPtr p##_c = (CParamsPtr)__builtin_amdgcn_kernarg_segment_ptr(); asm volatile("" : "+s"(p##_c)); const Params& p = *(const Params*)p##_c

template <int l> __device__ __forceinline__ void run_layer(const int bid, const int nblk) {
  { PHASE_PARAMS(p); pg8::gemm_phase(pg8::Gemm{p.h, p.wt_in + (size_t)l * NPAD * DM, DM, DM, DM}, pg8::SchedIn{nblk, bid}, pg8::EpiIn{p.P, p.small}); }
#if REP & 1
  { PHASE_PARAMS(p); pg8::gemm_phase(pg8::Gemm{p.h, p.wt_in + (size_t)l * NPAD * DM, DM, DM, DM}, pg8::SchedIn{nblk, bid}, pg8::EpiIn{p.P, p.small}); }
#endif
  GRID_SYNC();
  { PHASE_PARAMS(p); for (int it = bid; it < 768; it += nblk) dn_prep_item(p, l, it >> 3, it & 7); }
#if REP & 2
  { PHASE_PARAMS(p); for (int it = bid; it < 768; it += nblk) dn_prep_item(p, l, it >> 3, it & 7); }
#endif
  { PHASE_PARAMS(p); for (int it = bid; it < 384; it += nblk) light_prep_item(p, l, it); }
#if REP & 4096
  { PHASE_PARAMS(p); for (int it = bid; it < 384; it += nblk) light_prep_item(p, l, it); }
#endif
  GRID_SYNC();
#pragma unroll 1
  for (int rep3 = 0; rep3 < ((REP & 4) ? 2 : 1); ++rep3)
#pragma unroll 1
  for (;;) {
    volatile __attribute__((address_space(3))) unsigned* qslot = (volatile __attribute__((address_space(3))) unsigned*)(smem + XB_LDS_OFF + 12);
    __syncthreads();
    if (tid_opaque() == 0) { PHASE_PARAMS(pq); *qslot = __hip_atomic_fetch_add(pq.bar + 8192 + l * 2 + rep3, 1u, __ATOMIC_RELAXED, __HIP_MEMORY_SCOPE_AGENT); }
    __syncthreads();
    const int it = (int)*qslot;
    if (it >= 480) break;
    if (it < 64) { PHASE_PARAMS(p); attn_item(p, it); }
    else if (it < 96) { PHASE_PARAMS(p); const int j = it - 64; dn_scan_item(p, l, 16 + (j >> 4), (j >> 1) & 7, j & 1); }
    else if (it < 224) { PHASE_PARAMS(p); attn_item(p, it - 96 + 64); }
    else { PHASE_PARAMS(p); const int j = it - 224; dn_scan_item(p, l, j >> 4, (j >> 1) & 7, j & 1); }
  }
  GRID_SYNC();
  { PHASE_PARAMS(p); pg8::gemm_phase(pg8::Gemm{p.obr, p.wt_br + (size_t)l * 3 * DM * DM, DM, DM, DM}, pg8::SchedBr{nblk, bid}, pg8::EpiBr{p.a3, p.P}); }
#if REP & 8
  { PHASE_PARAMS(p); pg8::gemm_phase(pg8::Gemm{p.obr, p.wt_br + (size_t)l * 3 * DM * DM, DM, DM, DM}, pg8::SchedBr{nblk, bid}, pg8::EpiBr{p.a3, p.P}); }
#endif
  GRID_SYNC();
  { PHASE_PARAMS(p); pg8::gemm_phase(pg8::Gemm{p.a3, p.wt_out + (size_t)l * DM * 3072, 3072, 3072, 1536}, pg8::SchedSplit2<1536>{nblk, bid}, pg8::EpiF32{p.R}); }
#if REP & 16
  { PHASE_PARAMS(p); pg8::gemm_phase(pg8::Gemm{p.a3, p.wt_out + (size_t)l * DM * 3072, 3072, 3072, 1536}, pg8::SchedSplit2<1536>{nblk, bid}, pg8::EpiF32{p.R}); }
#endif
  GRID_SYNC();
  { PHASE_PARAMS(p); stage_row(p, l, 1, bid, nblk); }
  GRID_SYNC();
  { PHASE_PARAMS(p); pg8::gemm_phase(pg8::Gemm{p.h, p.wt_up + (size_t)l * HID * DM, DM, DM, DM}, pg8::SchedUp{nblk, bid}, pg8::EpiUp{p.u2}); }
#if REP & 32
  { PHASE_PARAMS(p); pg8::gemm_phase(pg8::Gemm{p.h, p.wt_up + (size_t)l * HID * DM, DM, DM, DM}, pg8::SchedUp{nblk, bid}, pg8::EpiUp{p.u2}); }
#endif
  GRID_SYNC();
  { PHASE_PARAMS(p); pg8::gemm_phase(pg8::Gemm{p.u2, p.wt_dn + (size_t)l * DM * HID, HID, HID, 2048}, pg8::SchedSplit2<2048>{nblk, bid}, pg8::EpiF32{p.R}); }
#if REP & 64
  { PHASE_PARAMS(p); pg8::gemm_phase(pg8::Gemm{p.u2, p.wt_dn + (size_t)l * DM * HID, HID, HID, 2048}, pg8::SchedSplit2<2048>{nblk, bid}, pg8::EpiF32{p.R}); }
#endif
  GRID_SYNC();
  { PHASE_PARAMS(p); stage_row(p, l, 2, bid, nblk); }
  if (l + 1 < DEPTH) GRID_SYNC();
}

__global__ __launch_bounds__(512) void mega_kernel(Params p_arg) {
#if USE_CG_SYNC
  cg::grid_group grid = cg::this_grid();
#endif
  const int bid = blockIdx.x, nblk = gridDim.x;
#if !USE_CG_SYNC
  { PHASE_PARAMS(pb); xcd_barrier_post(pb.bar); }
  cg::this_grid().sync();
#endif
  { PHASE_PARAMS(p); stage_mod(p, bid, nblk, smem); }
#if REP & 8192
  { PHASE_PARAMS(p); stage_mod(p, bid, nblk, smem); }
#endif
  { PHASE_PARAMS(p); for (int it = bid; it < CONV_ITEMS * DEPTH; it += nblk) convert_item(p, it / CONV_ITEMS, it % CONV_ITEMS); }
#if REP & 128
  { PHASE_PARAMS(p); for (int it = bid; it < CONV_ITEMS * DEPTH; it += nblk) convert_item(p, it / CONV_ITEMS, it % CONV_ITEMS); }
#endif
  GRID_SYNC();
  { PHASE_PARAMS(p); stage_row(p, 0, 0, bid, nblk); }
#if REP & 16384
  { PHASE_PARAMS(p); stage_row(p, 0, 0, bid, nblk); }
#endif
  GRID_SYNC();
  run_layer<0>(bid, nblk); run_layer<1>(bid, nblk); run_layer<2>(bid, nblk); run_layer<3>(bid, nblk);
}

__global__ void diag_fill(float* out, long n, float v) { for (long i = blockIdx.x * 256L + threadIdx.x; i < n; i += gridDim.x * 256L) out[i] = (i == 0) ? v : 0.f; }
static size_t align_up(size_t x) { return (x + 255) & ~(size_t)255; }
static bool make_params(Params& p, void* const* d_in, void* d_out, void* d_ws, size_t ws_size) {
  const float** in = (const float**)d_in;
  p.x_prompt = in[0]; p.x_sample = in[1]; p.cache_k = in[2]; p.cache_v = in[3]; p.state_dn = in[4]; p.c = in[5]; p.c_ctx = in[6];
  p.w_mod = in[7]; p.b_mod = in[8]; p.g_pre_mix = in[9]; p.g_post_mix = in[10]; p.g_pre_mlp = in[11]; p.g_post_mlp = in[12];
  p.w_in = in[13]; p.w_conv_dn = in[14]; p.a_log = in[15]; p.dt_bias = in[16]; p.g_dn_out = in[17]; p.w_conv_sc = in[18];
  p.g_q = in[19]; p.g_k = in[20]; p.w_br_dn = in[21]; p.w_br_sc = in[22]; p.w_br_att = in[23]; p.w_out = in[24];
  p.w_mlp_up = in[25]; p.w_mlp_down = in[26];
  float* out = (float*)d_out;
  p.xbuf = out; p.out_ck = out + 6291456; p.out_cv = p.out_ck + 4194304; p.out_state = p.out_cv + 4194304;
  char* w = (char*)d_ws; size_t off = 0;
  auto take = [&](size_t bytes) { char* r = w + off; off = align_up(off + bytes); return r; };
  p.bar   = (unsigned*)take(65536);
  p.wt_in = (bfr*)take((size_t)DEPTH * NPAD * DM * 2);
  p.wt_br = (bfr*)take((size_t)DEPTH * 3 * DM * DM * 2);
  p.wt_out= (bfr*)take((size_t)DEPTH * DM * 3072 * 2);
  p.wt_up = (bfr*)take((size_t)DEPTH * HID * DM * 2);
  p.wt_dn = (bfr*)take((size_t)DEPTH * DM * HID * 2);
  p.mod   = (float*)take((size_t)DEPTH * 3 * 6144 * 4);
  p.h     = (bfr*)take((size_t)NTOK * DM * 2);
  p.P     = (bfr*)take((size_t)NTOK * NP * 2);
  p.u2    = p.P;
  p.small = (float*)take((size_t)NTOK * 32 * 4);
  p.dnrec = take((size_t)1536 * REC_BYTES);
  p.glast = (float*)take(1536 * 4);
  p.opart = (bfr*)take((size_t)2 * NTOK * DM * 2);
  p.obr   = (bfr*)take((size_t)3 * NTOK * DM * 2);
  p.Q     = (bfr*)take((size_t)NTOK * DM * 2);
  p.Kc    = (bfr*)take((size_t)NCTX * 256 * 2);
  p.Vc    = (bfr*)take((size_t)NCTX * 256 * 2);
  p.Ks    = (bfr*)take((size_t)2 * 1280 * 256 * 2);
  p.Vs    = (bfr*)take((size_t)2 * 1280 * 256 * 2);
  p.merged= (bfr*)take((size_t)NTOK * DM * 2);
  p.a3    = (bfr*)take((size_t)NTOK * 3072 * 2);
  p.R     = (float*)take((size_t)2 * NTOK * DM * 4);
  return off <= ws_size;
}
extern "C" void kernel_launch(void* const* d_in, const int* in_sizes, int n_in, void* d_out, int out_size, void* d_ws, size_t ws_size, hipStream_t stream) {
  Params p{};
  if (n_in != 27 || out_size != 31457280) { diag_fill<<<1024, 256, 0, stream>>>((float*)d_out, (long)out_size, 3.0e6f + n_in); return; }
  if (!make_params(p, d_in, d_out, d_ws, ws_size)) { diag_fill<<<1024, 256, 0, stream>>>((float*)d_out, (long)out_size, (float)(ws_size >> 20)); return; }
  static int grid_blocks = 0;
  if (!grid_blocks) {
    (void)hipFuncSetAttribute((const void*)mega_kernel, hipFuncAttributeMaxDynamicSharedMemorySize, DYN_LDS);
    int dev = 0, cus = 0, per_cu = 0;
    (void)hipGetDevice(&dev);
    (void)hipDeviceGetAttribute(&cus, hipDeviceAttributeMultiprocessorCount, dev);
    (void)hipOccupancyMaxActiveBlocksPerMultiprocessor(&per_cu, mega_kernel, 512, DYN_LDS);
    grid_blocks = (per_cu >= 1 && cus >= 256) ? 256 : cus * per_cu;
    if (grid_blocks <= 0) { fprintf(stderr, "kernel_launch: occupancy query gave cus %d per_cu %d\n", cus, per_cu); grid_blocks = 0; return; }
  }
  (void)hipMemsetAsync(p.bar, 0, 65536, stream);
  void* args[] = {&p};
  const hipError_t e = hipLaunchCooperativeKernel((void*)mega_kernel, dim3(grid_blocks), dim3(512), args, DYN_LDS, stream);
  if (e != hipSuccess) fprintf(stderr, "cooperative launch failed: %s (grid %d)\n", hipGetErrorString(e), grid_blocks);
}
```

```cpp
#define USE_CG_SYNC 0
#include <hip/hip_runtime.h>
#include <hip/hip_bf16.h>
#include <hip/hip_cooperative_groups.h>
#include <cstdio>
#include <cstdint>
namespace cg = cooperative_groups;

typedef unsigned short bfr;
using bf16x8 = __attribute__((ext_vector_type(8))) short;
using s16x4  = __attribute__((ext_vector_type(4))) short;
using f32x4  = __attribute__((ext_vector_type(4))) float;
using f32x16 = __attribute__((ext_vector_type(16))) float;
using u32x4  = __attribute__((ext_vector_type(4))) unsigned;
using u32x2  = __attribute__((ext_vector_type(2))) unsigned;

extern __shared__ __attribute__((aligned(16))) char smem[];
__device__ __forceinline__ char* smem_base() { return smem; }
constexpr int DM = 1024, NTOK = 6144, NCTX = 4096, DEPTH = 4;
constexpr int NIN = 11808;
constexpr int NP = 11776;
constexpr int NPAD = 12032;
constexpr int HID = 4096;
constexpr float EPS = 1e-6f;
constexpr int C_DQ = 0, C_DK = 1024, C_DV = 2048, C_DG = 3072, C_SB = 4096, C_SCG = 5120, C_SX = 6144,
              C_AQ = 7168, C_AK = 8192, C_AV = 8448, C_MG = 8704;

constexpr int REC_U = 0, REC_W = 16384, REC_QD = 32768, REC_QK = 49152, REC_KD = 57344, REC_BYTES = 73728;

struct Params {
  const float *x_prompt, *x_sample, *cache_k, *cache_v, *state_dn, *c, *c_ctx, *w_mod, *b_mod;
  const float *g_pre_mix, *g_post_mix, *g_pre_mlp, *g_post_mlp, *w_in, *w_conv_dn, *a_log, *dt_bias, *g_dn_out;
  const float *w_conv_sc, *g_q, *g_k, *w_br_dn, *w_br_sc, *w_br_att, *w_out, *w_mlp_up, *w_mlp_down;
  float *xbuf;
  float *out_ck, *out_cv, *out_state;
  bfr *wt_in, *wt_br, *wt_out, *wt_up, *wt_dn;
  float *mod;
  bfr *h;
  bfr *P;
  float *small;
  char *dnrec;
  float *glast;
  bfr *opart;
  bfr *obr;
  bfr *Q;
  bfr *Kc, *Vc;
  bfr *Ks, *Vs;
  bfr *merged;
  bfr *a3;
  float *R;
  bfr *u2;
  unsigned *bar;
};

__device__ __forceinline__ bfr f2bf(float f) { unsigned u = __float_as_uint(f); u += 0x7fffu + ((u >> 16) & 1u); return (bfr)(u >> 16); }
__device__ __forceinline__ float bf2f(bfr b) { return __uint_as_float(((unsigned)b) << 16); }
__device__ __forceinline__ unsigned pack2(float a, float b) { return (unsigned)f2bf(a) | ((unsigned)f2bf(b) << 16); }
__device__ __forceinline__ unsigned pack2hw(float a, float b) { unsigned r; asm("v_cvt_pk_bf16_f32 %0, %1, %2" : "=v"(r) : "v"(a), "v"(b)); return r; }
__device__ __forceinline__ float sigmoidf_(float x) { return 1.f / (1.f + __expf(-x)); }
__device__ __forceinline__ float siluf_(float x) { return x * __builtin_amdgcn_rcpf(1.f + __expf(-x)); }
__device__ __forceinline__ float softplusf_(float x) { return x > 20.f ? x : log1pf(__expf(x)); }

__device__ __forceinline__ int tok_modrow(int t) { return t < NCTX ? 0 : 1 + ((t - NCTX) >> 10); }
__device__ __forceinline__ int tok_L(int t) { return t < NCTX ? 256 : 1024; }
__device__ __forceinline__ int tok_pos(int t) { return t < NCTX ? (t & 255) : ((t - NCTX) & 1023); }

__host__ __device__ __forceinline__ int perm_col(int n) { return n < 4096 ? n : (n < 4128 ? NP + (n - 4096) : n - 32); }

__device__ __forceinline__ int tid_opaque() { int t = threadIdx.x; asm volatile("" : "+v"(t)); return t; }

#ifdef DIAG_A
#ifndef DIAG_BLK
#define DIAG_BLK 0
#endif
#define TSTAMP(k) do { if (blockIdx.x == DIAG_BLK && threadIdx.x == 0) { unsigned long long* ts_ = (unsigned long long*)(smem_base() + 163840 - 256); if (ts_[(k)] == 0ull) ts_[(k)] = wall_clock64(); } } while (0)
#else
#define TSTAMP(k) do {} while (0)
#endif

#ifdef DIAG_A
#define GSTAMP(bar, k) do { if (threadIdx.x == 0) __hip_atomic_store((unsigned long long*)((bar) + 12288) + (k), (unsigned long long)wall_clock64(), __ATOMIC_RELAXED, __HIP_MEMORY_SCOPE_AGENT); } while (0)
#else
#define GSTAMP(bar, k) do {} while (0)
#endif

#ifdef DIAG_G
#define GMAX(bar, k) do { if (threadIdx.x == 0) __hip_atomic_fetch_max((unsigned long long*)((bar) + 12288) + (k), (unsigned long long)wall_clock64(), __ATOMIC_RELAXED, __HIP_MEMORY_SCOPE_AGENT); } while (0)
#else
#define GMAX(bar, k) do {} while (0)
#endif
#define NTHR 512

__device__ __forceinline__ void stage_mod(const Params& p, int bid, int nblk, char* lds) {
  float* s = (float*)lds;
  float* red = s + 3072;
  const int tid = tid_opaque();
  for (int i = tid; i < 3072; i += NTHR) { int j = i >> 10, k = i & 1023; float c = (j == 0) ? p.c_ctx[k] : p.c[(j - 1) * 1024 + k]; s[i] = siluf_(c); }
  __syncthreads();
  for (int item = bid; item < 192; item += nblk) {
    const int l = item / 48, nb = item % 48, cq = tid & 31, ks = tid >> 5;
    const float* W = p.w_mod + ((size_t)l * 1024 + ks * 64) * 6144 + nb * 128 + cq * 4;
    float a[3][4] = {};
    for (int k = 0; k < 64; ++k) {
      const float4 w = *(const float4*)(W + (size_t)k * 6144);
#pragma unroll
      for (int j = 0; j < 3; ++j) { const float sv = s[j * 1024 + ks * 64 + k]; a[j][0] += sv * w.x; a[j][1] += sv * w.y; a[j][2] += sv * w.z; a[j][3] += sv * w.w; }
    }
    __syncthreads();
#pragma unroll
    for (int j = 0; j < 3; ++j)
#pragma unroll
      for (int q = 0; q < 4; ++q) red[(ks * 3 + j) * 128 + cq * 4 + q] = a[j][q];
    __syncthreads();
    if (tid < 384) { const int j = tid >> 7, n = tid & 127; float sum = 0; for (int q = 0; q < 16; ++q) sum += red[(q * 3 + j) * 128 + n];
      p.mod[(size_t)(l * 3 + j) * 6144 + nb * 128 + n] = sum + p.b_mod[l * 6144 + nb * 128 + n]; }
  }
  __syncthreads();
}

__device__ __forceinline__ float wave_sum(float v) {
#pragma unroll
  for (int o = 32; o > 0; o >>= 1) v += __shfl_xor(v, o);
  return v;
}

template <int NR>
__device__ __forceinline__ void rows_at(const Params& p, int l, int mode, int row0, int lane) {
  float4 x[NR][4], r[NR][4];
#pragma unroll
  for (int j = 0; j < NR; ++j) {
    const int row = row0 + j;
    if (l == 0 && mode <= 1) {
      const float* xin = row < NCTX ? p.x_prompt + (size_t)row * DM : p.x_sample + (size_t)(row - NCTX) * DM;
#pragma unroll
      for (int i = 0; i < 4; ++i) x[j][i] = *(const float4*)(xin + lane * 4 + 256 * i);
    } else {
      const bfr* xin = p.merged + (size_t)row * DM;
#pragma unroll
      for (int i = 0; i < 4; ++i) { const u32x2 a = *(const u32x2*)(xin + lane * 4 + 256 * i);
        x[j][i] = make_float4(__uint_as_float(a[0] << 16), __uint_as_float(a[0] & 0xffff0000u), __uint_as_float(a[1] << 16), __uint_as_float(a[1] & 0xffff0000u)); }
    }
    if (mode != 0) {
      const bfr* rr = (const bfr*)p.R + (size_t)row * DM;
#pragma unroll
      for (int i = 0; i < 4; ++i) { const u32x2 a = *(const u32x2*)(rr + lane * 4 + 256 * i), b = *(const u32x2*)(rr + (size_t)NTOK * DM + lane * 4 + 256 * i);
        r[j][i] = make_float4(__uint_as_float(a[0] << 16) + __uint_as_float(b[0] << 16), __uint_as_float(a[0] & 0xffff0000u) + __uint_as_float(b[0] & 0xffff0000u),
                              __uint_as_float(a[1] << 16) + __uint_as_float(b[1] << 16), __uint_as_float(a[1] & 0xffff0000u) + __uint_as_float(b[1] & 0xffff0000u)); }
    }
  }
  if (mode != 0) {
    const float* gpost = (mode == 1 ? p.g_post_mix : p.g_post_mlp) + l * DM;
    float4 g[4];
#pragma unroll
    for (int i = 0; i < 4; ++i) g[i] = *(const float4*)(gpost + lane * 4 + 256 * i);
#pragma unroll
    for (int j = 0; j < NR; ++j) {
      const int row = row0 + j;
      const float* gate = p.mod + (size_t)(l * 3 + tok_modrow(row)) * 6144 + (mode == 1 ? 2048 : 5120);
      float ss = 0;
#pragma unroll
      for (int i = 0; i < 4; ++i) ss += r[j][i].x * r[j][i].x + r[j][i].y * r[j][i].y + r[j][i].z * r[j][i].z + r[j][i].w * r[j][i].w;
      ss = wave_sum(ss);
      const float nrm = rsqrtf(ss * (1.f / DM) + EPS);
#pragma unroll
      for (int i = 0; i < 4; ++i) {
        const float4 gt = *(const float4*)(gate + lane * 4 + 256 * i);
        x[j][i].x += gt.x * (r[j][i].x * nrm * g[i].x); x[j][i].y += gt.y * (r[j][i].y * nrm * g[i].y); x[j][i].z += gt.z * (r[j][i].z * nrm * g[i].z); x[j][i].w += gt.w * (r[j][i].w * nrm * g[i].w);
        if (mode == 2 && l == DEPTH - 1) *(float4*)(p.xbuf + (size_t)row * DM + lane * 4 + 256 * i) = x[j][i];
        else { u32x2 o = {pack2hw(x[j][i].x, x[j][i].y), pack2hw(x[j][i].z, x[j][i].w)}; *(u32x2*)(p.merged + (size_t)row * DM + lane * 4 + 256 * i) = o; }
      }
    }
  }
  if (mode == 2 && l == DEPTH - 1) return;
  const int ln = (mode == 2) ? l + 1 : l;
  const float* gpre = (mode == 1 ? p.g_pre_mlp : p.g_pre_mix) + ln * DM;
  float4 gp[4];
#pragma unroll
  for (int i = 0; i < 4; ++i) gp[i] = *(const float4*)(gpre + lane * 4 + 256 * i);
#pragma unroll
  for (int j = 0; j < NR; ++j) {
    const int row = row0 + j;
    const float* modn = p.mod + (size_t)(ln * 3 + tok_modrow(row)) * 6144;
    const float* sh = modn + (mode == 1 ? 3072 : 0);
    const float* sc = modn + (mode == 1 ? 4096 : 1024);
    float ss = 0;
#pragma unroll
    for (int i = 0; i < 4; ++i) ss += x[j][i].x * x[j][i].x + x[j][i].y * x[j][i].y + x[j][i].z * x[j][i].z + x[j][i].w * x[j][i].w;
    ss = wave_sum(ss);
    const float nrm = rsqrtf(ss * (1.f / DM) + EPS);
#pragma unroll
    for (int i = 0; i < 4; ++i) {
      const float4 s1 = *(const float4*)(sc + lane * 4 + 256 * i), s0 = *(const float4*)(sh + lane * 4 + 256 * i);
      const float h0 = x[j][i].x * nrm * gp[i].x * (1.f + s1.x) + s0.x, h1 = x[j][i].y * nrm * gp[i].y * (1.f + s1.y) + s0.y;
      const float h2 = x[j][i].z * nrm * gp[i].z * (1.f + s1.z) + s0.z, h3 = x[j][i].w * nrm * gp[i].w * (1.f + s1.w) + s0.w;
      u32x2 o = {pack2hw(h0, h1), pack2hw(h2, h3)};
      *(u32x2*)(p.h + (size_t)row * DM + lane * 4 + 256 * i) = o;
    }
  }
}

__device__ __forceinline__ void stage_row(const Params& p, int l, int mode, int bid, int nblk) {
  const int tx_ = tid_opaque(), wid = tx_ >> 6, lane = tx_ & 63;
  const int row0 = (bid * 8 + wid) * 3;
  if (row0 >= NTOK) return;
  rows_at<3>(p, l, mode, row0, lane);
}

__device__ __forceinline__ void unpack8(const u32x4 v, float* f) {
#pragma unroll
  for (int i = 0; i < 4; ++i) { f[2 * i] = __uint_as_float(v[i] << 16); f[2 * i + 1] = __uint_as_float(v[i] & 0xffff0000u); }
}
__device__ __forceinline__ u32x4 pack8(const float* f) { u32x4 v = {pack2(f[0], f[1]), pack2(f[2], f[3]), pack2(f[4], f[5]), pack2(f[6], f[7])}; return v; }
__device__ __forceinline__ u32x4 pack8hw(const float* f) { u32x4 v = {pack2hw(f[0], f[1]), pack2hw(f[2], f[3]), pack2hw(f[4], f[5]), pack2hw(f[6], f[7])}; return v; }

__device__ __forceinline__ void light_prep_item(const Params& p, int l, int item) {
  const int tid = tid_opaque(), t0 = item * 16;
  const bool samp = t0 >= NCTX;
  {
    const float* wsc = p.w_conv_sc + (size_t)l * 3 * DM;
    bfr* scin = p.obr + (size_t)1 * NTOK * DM;
    const int g = tid & 127, rq = tid >> 7, r0 = rq * 4, tA = t0 + r0, posA = tok_pos(tA), L = tok_L(tA);
    u32x4 cg[6], cx[6], sbv[4];
#pragma unroll
    for (int k = 0; k < 6; ++k) {
      const int pos = posA + k - 1;
      cg[k] = u32x4{0u, 0u, 0u, 0u}; cx[k] = u32x4{0u, 0u, 0u, 0u};
      if (pos >= 0 && pos < L) { const bfr* row = p.P + (size_t)(tA + k - 1) * NP; cg[k] = *(const u32x4*)(row + C_SCG + g * 8); cx[k] = *(const u32x4*)(row + C_SX + g * 8); }
    }
#pragma unroll
    for (int r = 0; r < 4; ++r) sbv[r] = *(const u32x4*)(p.P + (size_t)(tA + r) * NP + C_SB + g * 8);
    float w[3][8];
#pragma unroll
    for (int k = 0; k < 3; ++k) { *(float4*)&w[k][0] = *(const float4*)(wsc + k * DM + g * 8); *(float4*)&w[k][4] = *(const float4*)(wsc + k * DM + g * 8 + 4); }
    float prod[6][8];
#pragma unroll
    for (int k = 0; k < 6; ++k) { float a[8], b[8]; unpack8(cg[k], a); unpack8(cx[k], b);
#pragma unroll
      for (int q = 0; q < 8; ++q) prod[k][q] = a[q] * b[q]; }
#pragma unroll
    for (int r = 0; r < 4; ++r) {
      float sb[8], acc[8]; unpack8(sbv[r], sb);
#pragma unroll
      for (int q = 0; q < 8; ++q) acc[q] = sb[q] * (w[0][q] * prod[r][q] + w[1][q] * prod[r + 1][q] + w[2][q] * prod[r + 2][q]);
      *(u32x4*)(scin + (size_t)(tA + r) * DM + g * 8) = pack8hw(acc);
    }
  }
  {
    const int sub = tid & 15;
    u32x4 xin[5];
#pragma unroll
    for (int it5 = 0; it5 < 5; ++it5) {
      const int pr = (tid >> 4) + it5 * 32, r = pr / 10, hh = pr % 10, t = t0 + r;
      xin[it5] = *(const u32x4*)(p.P + (size_t)t * NP + (hh < 8 ? C_AQ + hh * 128 : C_AK + (hh - 8) * 128) + sub * 8);
    }
#pragma unroll
    for (int it5 = 0; it5 < 5; ++it5) {
      const int pr = (tid >> 4) + it5 * 32;
      const int r = pr / 10, hh = pr % 10, t = t0 + r;
      const bool isq = hh < 8;
      float x[8]; unpack8(xin[it5], x);
      float ss = 0;
#pragma unroll
      for (int q = 0; q < 8; ++q) ss += x[q] * x[q];
      ss += __shfl_xor(ss, 1); ss += __shfl_xor(ss, 2); ss += __shfl_xor(ss, 4); ss += __shfl_xor(ss, 8);
      const float nrm = rsqrtf(ss * (1.f / 128.f) + EPS);
      const float* g = (isq ? p.g_q : p.g_k) + l * 128 + sub * 8;
#pragma unroll
      for (int q = 0; q < 8; ++q) x[q] = x[q] * nrm * g[q];
      if (samp) {
        const int pos = tok_pos(t);
        const float pidx = (sub < 8) ? (float)(pos >> 6) : (float)(pos & 63);
        const int s8 = sub & 7;
        const bool lo = s8 < 4;
        float y[8];
#pragma unroll
        for (int q = 0; q < 8; ++q) {
          const float other = __shfl_xor(x[q], 4);
          const int fi = (s8 & 3) * 8 + q;
          const float freq = exp2f(-(float)fi * (13.287712379549449f / 32.f));
          const float ang = pidx * freq;
          float sn, cs; __sincosf(ang, &sn, &cs);
          y[q] = lo ? (x[q] * cs - other * sn) : (other * sn + x[q] * cs);
        }
#pragma unroll
        for (int q = 0; q < 8; ++q) x[q] = y[q];
      }
      if (isq) {
        *(u32x4*)(p.Q + (size_t)t * DM + hh * 128 + sub * 8) = pack8hw(x);
      } else {
        const int kvh = hh - 8;
        if (!samp) {
          *(u32x4*)(p.Kc + (size_t)t * 256 + kvh * 128 + sub * 8) = pack8hw(x);
          const int b = t >> 8, pos = t & 255;
          float* o = p.out_ck + ((((size_t)b * DEPTH + l) * 256 + pos) * 2 + kvh) * 128 + sub * 8;
          *(float4*)o = make_float4(x[0], x[1], x[2], x[3]); *(float4*)(o + 4) = make_float4(x[4], x[5], x[6], x[7]);
        } else {
          const int s = t - NCTX, b = s >> 10, pos = s & 1023;
          *(u32x4*)(p.Ks + ((size_t)b * 1280 + 256 + pos) * 256 + kvh * 128 + sub * 8) = pack8hw(x);
        }
      }
    }
  }
  for (int idx = tid; idx < 16 * 32; idx += NTHR) {
    const int r = idx >> 5, g = idx & 31, t = t0 + r;
    const u32x4 v = *(const u32x4*)(p.P + (size_t)t * NP + C_AV + g * 8);
    if (!samp) {
      *(u32x4*)(p.Vc + (size_t)t * 256 + g * 8) = v;
      float f[8]; unpack8(v, f);
      const int b = t >> 8, pos = t & 255;
      float* o = p.out_cv + (((size_t)b * DEPTH + l) * 256 + pos) * 256 + g * 8;
      *(float4*)o = make_float4(f[0], f[1], f[2], f[3]); *(float4*)(o + 4) = make_float4(f[4], f[5], f[6], f[7]);
    } else {
      const int s = t - NCTX, b = s >> 10, pos = s & 1023;
      *(u32x4*)(p.Vs + ((size_t)b * 1280 + 256 + pos) * 256 + g * 8) = v;
    }
  }
  if (samp) {
    const int cs = item - 256, b = cs >> 6, pos0 = (cs & 63) * 4;
    for (int idx = tid; idx < 2 * 4 * 32; idx += NTHR) {
      const int which = idx >> 7, r = (idx >> 5) & 3, g = idx & 31, pos = pos0 + r;
      const float* src = (which ? p.cache_v : p.cache_k) + (((size_t)b * DEPTH + l) * 256 + pos) * 256 + g * 8;
      float f[8]; *(float4*)f = *(const float4*)src; *(float4*)(f + 4) = *(const float4*)(src + 4);
      *(u32x4*)((which ? p.Vs : p.Ks) + ((size_t)b * 1280 + pos) * 256 + g * 8) = pack8hw(f);
    }
  }
}

__device__ __forceinline__ void dn_finalize(const Params& p, int l, int t0, int n, int h, int tid0, int nthr) {
  const int sub = tid0 & 15, rpp = nthr / 16;
  const float* g = p.g_dn_out + l * 128 + sub * 8;
  float gv[8];
#pragma unroll
  for (int q = 0; q < 8; ++q) gv[q] = g[q];
  for (int r = tid0 >> 4; r < n; r += rpp * 4) {
    u32x4 va[4], vb[4], vg[4];
#pragma unroll
    for (int u = 0; u < 4; ++u) {
      const int t = t0 + r + u * rpp;
      va[u] = *(const u32x4*)(p.opart + (size_t)t * DM + h * 128 + sub * 8);
      vb[u] = *(const u32x4*)(p.opart + (size_t)NTOK * DM + (size_t)t * DM + h * 128 + sub * 8);
      vg[u] = *(const u32x4*)(p.P + (size_t)t * NP + C_DG + h * 128 + sub * 8);
    }
#pragma unroll
    for (int u = 0; u < 4; ++u) {
      const int t = t0 + r + u * rpp;
      float a[8], b[8], dg[8];
      unpack8(va[u], a); unpack8(vb[u], b); unpack8(vg[u], dg);
      float ss = 0;
#pragma unroll
      for (int q = 0; q < 8; ++q) { a[q] += b[q]; ss += a[q] * a[q]; }
      ss += __shfl_xor(ss, 1); ss += __shfl_xor(ss, 2); ss += __shfl_xor(ss, 4); ss += __shfl_xor(ss, 8);
      const float nrm = rsqrtf(ss * (1.f / 128.f) + EPS);
#pragma unroll
      for (int q = 0; q < 8; ++q) a[q] = a[q] * nrm * gv[q] * siluf_(dg[q]);
      *(u32x4*)(p.obr + (size_t)t * DM + h * 128 + sub * 8) = pack8hw(a);
    }
  }
}
constexpr int HT_BYTES = 128 * 64 * 2;

__device__ __forceinline__ int lds_byte(int r, int c) {
  int st = (r >> 4) * 2 + (c >> 5), rr = r & 15, cc = c & 31, ob = rr * 64 + cc * 2;
  return st * 1024 + (ob ^ (((ob >> 9) & 1) << 5));
}
__device__ __forceinline__ void stage_rc(int b, int& R, int& C) {
  int st = b / 1024, sb = b % 1024, swz = sb ^ (((sb >> 9) & 1) << 5);
  R = (st >> 1) * 16 + swz / 64; C = (st & 1) * 32 + (swz % 64) / 2;
}
__device__ __forceinline__ void stage_half(const bfr* G, long ld, int row0, int k0, int loff, int tx) {
#pragma unroll
  for (int i = 0; i < 2; ++i) {
    const int b = tx * 16 + i * 8192; int r, c; stage_rc(b, r, c);
    __builtin_amdgcn_global_load_lds((const unsigned*)(G + (long)(row0 + r) * ld + k0 + c), (__attribute__((address_space(3))) unsigned*)(smem + loff + b), 16, 0, 0);
  }
}

template <int NB, class AccT>
__device__ __forceinline__ void gemm_mainloop(const bfr* A, long lda, const bfr* Bt, long ldb, int K, int brow, int bcol, AccT& acc, int tx) {
  const int wid = tx >> 6, lane = tx & 63, wr = wid >> 2, wc = wid & 3, fr = lane & 15, fq = lane >> 4;
  constexpr int STG = (2 + NB) * HT_BYTES;
  const int nt = K / 64;
  auto stage = [&](int s, int kt) {
    stage_half(A, lda, brow, kt * 64, s * STG, tx);
    stage_half(A, lda, brow + 128, kt * 64, s * STG + HT_BYTES, tx);
#pragma unroll
    for (int j = 0; j < NB; ++j) stage_half(Bt, ldb, bcol + j * 128, kt * 64, s * STG + (2 + j) * HT_BYTES, tx);
  };
  stage(0, 0);
  asm volatile("s_waitcnt vmcnt(0)" ::: "memory");
  __syncthreads();
  for (int t = 0; t < nt; ++t) {
    const int s = t & 1;
    if (t + 1 < nt) stage(s ^ 1, t + 1);
    const char* base = smem + s * STG;
    bf16x8 Bf[NB][2][2];
#pragma unroll
    for (int j = 0; j < NB; ++j)
#pragma unroll
      for (int n = 0; n < 2; ++n)
#pragma unroll
        for (int k = 0; k < 2; ++k) Bf[j][n][k] = *(const bf16x8*)(base + (2 + j) * HT_BYTES + lds_byte(wc * 32 + n * 16 + fr, k * 32 + fq * 8));
#pragma unroll
    for (int ai = 0; ai < 2; ++ai) {
      bf16x8 Af[4][2];
#pragma unroll
      for (int m = 0; m < 4; ++m)
#pragma unroll
        for (int k = 0; k < 2; ++k) Af[m][k] = *(const bf16x8*)(base + ai * HT_BYTES + lds_byte(wr * 64 + m * 16 + fr, k * 32 + fq * 8));
#pragma unroll
      for (int j = 0; j < NB; ++j)
#pragma unroll
        for (int m = 0; m < 4; ++m)
#pragma unroll
          for (int n = 0; n < 2; ++n)
#pragma unroll
            for (int k = 0; k < 2; ++k) acc.a[ai][j][m][n] = __builtin_amdgcn_mfma_f32_16x16x32_bf16(Af[m][k], Bf[j][n][k], acc.a[ai][j][m][n], 0, 0, 0);
    }
    asm volatile("s_waitcnt vmcnt(0)" ::: "memory");
    __syncthreads();
  }
}
template <int NB> struct Acc { f32x4 a[2][NB][4][2]; };
template <int NB> __device__ __forceinline__ void acc_zero(Acc<NB>& acc) {
#pragma unroll
  for (int ai = 0; ai < 2; ++ai)
#pragma unroll
    for (int j = 0; j < NB; ++j)
#pragma unroll
      for (int m = 0; m < 4; ++m)
#pragma unroll
        for (int n = 0; n < 2; ++n) acc.a[ai][j][m][n] = f32x4{0.f, 0.f, 0.f, 0.f};
}
template <int NB, class F> __device__ __forceinline__ void acc_foreach(Acc<NB>& acc, int brow, int bcol, int tx, F f) {
  const int wid = tx >> 6, lane = tx & 63, wr = wid >> 2, wc = wid & 3, fr = lane & 15, fq = lane >> 4;
#pragma unroll
  for (int ai = 0; ai < 2; ++ai)
#pragma unroll
    for (int j = 0; j < NB; ++j)
#pragma unroll
      for (int m = 0; m < 4; ++m)
#pragma unroll
        for (int n = 0; n < 2; ++n)
#pragma unroll
          for (int q = 0; q < 4; ++q) f(brow + ai * 128 + wr * 64 + m * 16 + fq * 4 + q, bcol + j * 128 + wc * 32 + n * 16 + fr, acc.a[ai][j][m][n][q]);
}

template <class MapF>
__device__ __forceinline__ void convert_tile(const float* W, int N, int kt, int ntile, bfr* dst, int ldd, MapF mapf, int ncopy = 1, int cstride = 0) {
  float* tile = (float*)smem;
  const int tid = tid_opaque();
  __syncthreads();
  float4 v[8];
#pragma unroll
  for (int pass = 0; pass < 8; ++pass) {
    const int idx = tid + pass * 512, kr = idx >> 6, c4 = idx & 63, n = ntile * 256 + c4 * 4;
    v[pass] = make_float4(0.f, 0.f, 0.f, 0.f);
    if (n < N) v[pass] = *(const float4*)(W + (size_t)(kt * 64 + kr) * N + n);
  }
#pragma unroll
  for (int pass = 0; pass < 8; ++pass) {
    const int idx = tid + pass * 512, kr = idx >> 6, c4 = idx & 63;
    tile[kr * 257 + c4 * 4 + 0] = v[pass].x; tile[kr * 257 + c4 * 4 + 1] = v[pass].y; tile[kr * 257 + c4 * 4 + 2] = v[pass].z; tile[kr * 257 + c4 * 4 + 3] = v[pass].w;
  }
  __syncthreads();
#pragma unroll
  for (int rep = 0; rep < 4; ++rep) {
    const int nn = (tid >> 3) + rep * 64, kg = tid & 7, n = ntile * 256 + nn;
    if (n < N) {
      float f[8];
#pragma unroll
      for (int j = 0; j < 8; ++j) f[j] = tile[(kg * 8 + j) * 257 + nn];
      const u32x4 pk = pack8hw(f);
      for (int cp = 0; cp < ncopy; ++cp) *(u32x4*)(dst + (size_t)mapf(n) * ldd + cp * cstride + kt * 64 + kg * 8) = pk;
    }
  }
}
constexpr int CONV_ITEMS = 1576;
__device__ __forceinline__ void convert_item(const Params& p, int l, int it) {
  if (it < 752) { const int kt = it / 47, nt = it % 47; convert_tile(p.w_in + (size_t)l * DM * NIN, NIN, kt, nt, p.wt_in + (size_t)l * NPAD * DM, DM, [](int n) { return perm_col(n); }); }
  else if (it < 944) { const int j = it - 752, br = j >> 6, kt = (j >> 2) & 15, nt = j & 3;
    const float* W = p.w_br_dn; if (br == 1) W = p.w_br_sc; if (br == 2) W = p.w_br_att; W += (size_t)l * DM * DM;
    convert_tile(W, DM, kt, nt, p.wt_br + ((size_t)l * 3 + br) * DM * DM, DM, [](int n) { return n; }); }
  else if (it < 1008) { const int j = it - 944, kt = j >> 2, nt = j & 3; convert_tile(p.w_out + (size_t)l * DM * DM, DM, kt, nt, p.wt_out + (size_t)l * DM * 3072, 3072, [](int n) { return n; }, 3, 1024); }
  else if (it < 1264) { const int j = it - 1008, kt = j >> 4, nt = j & 15; convert_tile(p.w_mlp_up + (size_t)l * DM * HID, HID, kt, nt, p.wt_up + (size_t)l * HID * DM, DM, [](int n) { return n; }); }
  else if (it < 1520) { const int j = it - 1264, kt = j >> 2, nt = j & 3; convert_tile(p.w_mlp_down + (size_t)l * HID * DM, DM, kt, nt, p.wt_dn + (size_t)l * DM * HID, HID, [](int n) { return n; }); }
  else { const int j = it - 1520;
    bfr* d = p.wt_in + ((size_t)l * NPAD + NP + 32 + j * 4) * DM;
    *(u32x4*)(d + tid_opaque() * 8) = u32x4{0u, 0u, 0u, 0u}; }
}

__device__ __forceinline__ void gemm_in_tile(const Params& p, int l, int tile) {
  const int mt = tile % 24, nt = tile / 24, brow = mt * 256, bcol = nt * 256;
  const int tx = tid_opaque(); Acc<2> acc; acc_zero(acc);
  gemm_mainloop<2>(p.h, DM, p.wt_in + (size_t)l * NPAD * DM, DM, DM, brow, bcol, acc, tx);
  if (nt < 34) acc_foreach(acc, brow, bcol, tx, [&](int r, int c, float v) { p.P[(size_t)r * NP + c] = f2bf(v); });
  else if (nt < 46) acc_foreach(acc, brow, bcol, tx, [&](int r, int c, float v) { p.P[(size_t)r * NP + c] = f2bf(sigmoidf_(v)); });
  else acc_foreach(acc, brow, bcol, tx, [&](int r, int c, float v) { if (c < NP + 32) p.small[(size_t)r * 32 + (c - NP)] = v; });
}
__device__ __forceinline__ void gemm_up_tile(const Params& p, int l, int tile) {
  const int mt = tile % 24, nt = tile / 24, brow = mt * 256, bcol = nt * 256;
  const int tx = tid_opaque(); Acc<2> acc; acc_zero(acc);
  gemm_mainloop<2>(p.h, DM, p.wt_up + (size_t)l * HID * DM, DM, DM, brow, bcol, acc, tx);
  acc_foreach(acc, brow, bcol, tx, [&](int r, int c, float v) { const float x = fmaxf(v, 0.f); p.u2[(size_t)r * HID + c] = f2bf(x * x); });
}
__device__ __forceinline__ void gemm_out_tile(const Params& p, int l, int tile) {
  const int mt = tile % 24, nt = tile / 24, brow = mt * 256, bcol = nt * 128;
  const int tx = tid_opaque(); Acc<1> acc; acc_zero(acc);
  gemm_mainloop<1>(p.merged, DM, p.wt_out + (size_t)l * DM * DM, DM, DM, brow, bcol, acc, tx);
  acc_foreach(acc, brow, bcol, tx, [&](int r, int c, float v) { p.R[(size_t)r * DM + c] = v; });
}
__device__ __forceinline__ void gemm_down_tile(const Params& p, int l, int tile) {
  const int mt = tile % 24, nt = tile / 24, brow = mt * 256, bcol = nt * 128;
  const int tx = tid_opaque(); Acc<1> acc; acc_zero(acc);
  gemm_mainloop<1>(p.u2, HID, p.wt_dn + (size_t)l * DM * HID, HID, HID, brow, bcol, acc, tx);
  acc_foreach(acc, brow, bcol, tx, [&](int r, int c, float v) { p.R[(size_t)r * DM + c] = v; });
}
__device__ __forceinline__ void gemm_br_tile(const Params& p, int l, int tile) {
  const int mt = tile % 24, nt = tile / 24, brow = mt * 256, bcol = nt * 128;
  const int tx = tid_opaque(); Acc<1> tot; acc_zero(tot);
#pragma unroll 1
  for (int br = 0; br < 3; ++br) {
    Acc<1> acc; acc_zero(acc);
    gemm_mainloop<1>(p.obr + (size_t)br * NTOK * DM, DM, p.wt_br + ((size_t)l * 3 + br) * DM * DM, DM, DM, brow, bcol, acc, tx);
    const bfr* G = p.P + C_MG + br * DM;
    const int wid = tx >> 6, lane = tx & 63, wr = wid >> 2, wc = wid & 3, fr = lane & 15, fq = lane >> 4;
    const bfr* Gl = G + (size_t)(brow + wr * 64 + fq * 4) * NP + bcol + wc * 32 + fr;
#pragma unroll
    for (int ai = 0; ai < 2; ++ai)
#pragma unroll
      for (int m = 0; m < 4; ++m) {
        const bfr* Gm = Gl + (size_t)(ai * 128 + m * 16) * NP;
        asm volatile("" : "+v"(Gm) :: "memory");
#pragma unroll
        for (int n = 0; n < 2; ++n)
#pragma unroll
          for (int q = 0; q < 4; ++q) tot.a[ai][0][m][n][q] += bf2f(Gm[q * NP + n * 16]) * acc.a[ai][0][m][n][q];
      }
  }
  acc_foreach(tot, brow, bcol, tx, [&](int r, int c, float v) { p.merged[(size_t)r * DM + c] = f2bf(v); });
}
namespace pg8 {
#define PG8_LAS __attribute__((address_space(3)))
constexpr int BM = 256, BK = 64, HALF = 128, HTB = HALF * BK * 2, STAGE_BYTES = 8 * HTB;
__device__ __forceinline__ int perm32(int rho) { const int n = rho >> 4, i = rho & 15; return 8 * (i >> 2) + 4 * n + (i & 3); }
struct Unit { int pm, pn, z; size_t ka, kb; };
struct Gemm { const bfr* A; const bfr* Bt; int lda, ldb, K; };

template <class Epi, class Sched>
__device__ __forceinline__ void gemm_phase(const Gemm g, const Sched& S, const Epi& E) {
  PG8_LAS unsigned char* lds = (PG8_LAS unsigned char*)smem;
  const int tid = tid_opaque(), wid = __builtin_amdgcn_readfirstlane(tid >> 6), lane = tid & 63, wr = wid >> 2, wc = wid & 3, fr = lane & 15, fq = lane >> 4;
  const int K = g.K, nt = K / BK;
  unsigned voffA[2], voffB[2];
#pragma unroll
  for (int i = 0; i < 2; ++i) { int R, C; stage_rc(tid * 16 + i * 8192, R, C); const int Rb = Epi::PERM ? ((R & ~31) + perm32(R & 31)) : R;
    voffA[i] = (unsigned)(R * g.lda + C) * 2u; voffB[i] = (unsigned)(Rb * g.ldb + C) * 2u; }
  const size_t kstep = (size_t)(BK * 2);
  const size_t hstepA = (size_t)HALF * g.lda * 2, hstepB = (size_t)HALF * g.ldb * 2;
  const unsigned ldsw = (unsigned)wid * 1024u;
  const int aoff = lds_byte(wr * 64 + fr, fq * 8), boff = lds_byte(wc * 32 + fr, fq * 8);
#define PG8_SA(b, h) (((b) * 2 + (h)) * HTB)
#define PG8_SB(b, h) ((4 + (b) * 2 + (h)) * HTB)
#define PG8_STAGE(bufoff, gbase, voff) do { _Pragma("unroll") for (int _i = 0; _i < 2; ++_i) \
    __builtin_amdgcn_global_load_lds((const unsigned*)((const char*)(gbase) + (voff)[_i]), (PG8_LAS unsigned*)(lds + (bufoff) + ldsw + _i * 8192), 16, 0, 0); } while (0)
#define PG8_LDA(dst, b, h) do { _Pragma("unroll") for (int m = 0; m < 4; ++m) _Pragma("unroll") for (int k = 0; k < 2; ++k) dst[m][k] = *(const PG8_LAS bf16x8*)(lds + PG8_SA(b, h) + aoff + m * 2048 + k * 1024); } while (0)
#define PG8_LDB(dst, b, h) do { _Pragma("unroll") for (int n = 0; n < 2; ++n) _Pragma("unroll") for (int k = 0; k < 2; ++k) dst[n][k] = *(const PG8_LAS bf16x8*)(lds + PG8_SB(b, h) + boff + n * 2048 + k * 1024); } while (0)
#define PG8_MMA(ai, bj, At, Bt) do { __builtin_amdgcn_s_setprio(1); _Pragma("unroll") for (int m = 0; m < 4; ++m) _Pragma("unroll") for (int n = 0; n < 2; ++n) _Pragma("unroll") for (int k = 0; k < 2; ++k) \
    acc[ai][bj][m][n] = __builtin_amdgcn_mfma_f32_16x16x32_bf16(Bt[n][k], At[m][k], acc[ai][bj][m][n], 0, 0, 0); __builtin_amdgcn_s_setprio(0); } while (0)
#define PG8_WAIT_V(n) asm volatile("s_waitcnt vmcnt(" #n ")" ::: "memory")
#define PG8_WAIT_L(n) asm volatile("s_waitcnt lgkmcnt(" #n ")" ::: "memory")
#define PG8_BAR __builtin_amdgcn_s_barrier()
#define PG8_SCHED __builtin_amdgcn_sched_barrier(0)
  Unit cur, nxt; int ui = 0;
  __syncthreads();
  if (!S.next(0, cur)) return;
  f32x4 acc[2][2][4][2];
#pragma unroll
  for (int a = 0; a < 2; ++a)
#pragma unroll
    for (int b = 0; b < 2; ++b)
#pragma unroll
      for (int m = 0; m < 4; ++m)
#pragma unroll
        for (int n = 0; n < 2; ++n) acc[a][b][m][n] = (f32x4){0.f, 0.f, 0.f, 0.f};
  bf16x8 At[4][2], B0[2][2], B1[2][2];
  const char* cA = (const char*)(g.A + cur.ka) + (size_t)cur.pm * 2 * hstepA; const char* cB = (const char*)(g.Bt + cur.kb) + (size_t)cur.pn * 2 * hstepB;
  PG8_STAGE(PG8_SB(0, 0), cB, voffB); PG8_STAGE(PG8_SA(0, 0), cA, voffA); PG8_STAGE(PG8_SB(0, 1), cB + hstepB, voffB); PG8_STAGE(PG8_SA(0, 1), cA + hstepA, voffA);
  if (wr == 1) PG8_BAR;
  PG8_WAIT_V(4); PG8_BAR;
  PG8_STAGE(PG8_SB(1, 0), cB + kstep, voffB); PG8_STAGE(PG8_SA(1, 0), cA + kstep, voffA); PG8_STAGE(PG8_SB(1, 1), cB + hstepB + kstep, voffB);
  PG8_WAIT_V(6); PG8_BAR;
  for (;;) {
    const bool has_next = S.next(ui + 1, nxt);
    const char* nA = has_next ? (const char*)(g.A + nxt.ka) + (size_t)nxt.pm * 2 * hstepA : cA; const char* nB = has_next ? (const char*)(g.Bt + nxt.kb) + (size_t)nxt.pn * 2 * hstepB : cB;
    for (int t = 0; t < nt; t += 2) {
      const bool last = (t == nt - 2);
      const char* a1 = cA + (size_t)(t + 1) * kstep;
      const char* a2 = last ? nA : cA + (size_t)(t + 2) * kstep; const char* b2 = last ? nB : cB + (size_t)(t + 2) * kstep;
      const char* a3 = a2 + kstep; const char* b3 = b2 + kstep;
      PG8_LDB(B0, 0, 0); PG8_SCHED; PG8_LDA(At, 0, 0); PG8_STAGE(PG8_SA(1, 1), a1 + hstepA, voffA);
      PG8_WAIT_L(8); PG8_BAR; PG8_WAIT_L(0); PG8_MMA(0, 0, At, B0); PG8_BAR; PG8_SCHED;
      PG8_LDB(B1, 0, 1); PG8_STAGE(PG8_SB(0, 0), b2, voffB);
      PG8_BAR; PG8_WAIT_L(0); PG8_MMA(0, 1, At, B1); PG8_BAR;
      PG8_LDA(At, 0, 1); PG8_STAGE(PG8_SA(0, 0), a2, voffA);
      PG8_BAR; PG8_WAIT_L(0); PG8_MMA(1, 0, At, B0); PG8_BAR; PG8_SCHED;
      PG8_STAGE(PG8_SB(0, 1), b2 + hstepB, voffB);
      PG8_WAIT_V(6); PG8_BAR; PG8_MMA(1, 1, At, B1); PG8_BAR;
      PG8_LDB(B0, 1, 0); PG8_SCHED; PG8_LDA(At, 1, 0); PG8_STAGE(PG8_SA(0, 1), a2 + hstepA, voffA);
      PG8_WAIT_L(8); PG8_BAR; PG8_WAIT_L(0); PG8_MMA(0, 0, At, B0); PG8_BAR; PG8_SCHED;
      PG8_LDB(B1, 1, 1); PG8_STAGE(PG8_SB(1, 0), b3, voffB);
      PG8_BAR; PG8_WAIT_L(0); PG8_MMA(0, 1, At, B1); PG8_BAR;
      PG8_LDA(At, 1, 1); PG8_STAGE(PG8_SA(1, 0), a3, voffA);
      PG8_BAR; PG8_WAIT_L(0); PG8_MMA(1, 0, At, B0); PG8_BAR; PG8_SCHED;
      PG8_STAGE(PG8_SB(1, 1), b3 + hstepB, voffB);
      PG8_WAIT_V(6); PG8_BAR; PG8_MMA(1, 1, At, B1); PG8_BAR;
    }
    E(acc, cur, wr, wc, fr, fq);
    if (!has_next) break;
#pragma unroll
    for (int a = 0; a < 2; ++a)
#pragma unroll
      for (int b = 0; b < 2; ++b)
#pragma unroll
        for (int m = 0; m < 4; ++m)
#pragma unroll
          for (int n = 0; n < 2; ++n) acc[a][b][m][n] = (f32x4){0.f, 0.f, 0.f, 0.f};
    cur = nxt; cA = nA; cB = nB; ++ui;
  }
  PG8_WAIT_V(0);
  if (wr == 0) PG8_BAR;
  PG8_BAR;
#undef PG8_SA
#undef PG8_SB
#undef PG8_STAGE
#undef PG8_LDA
#undef PG8_LDB
#undef PG8_MMA
#undef PG8_WAIT_V
#undef PG8_WAIT_L
#undef PG8_BAR
#undef PG8_SCHED
}
__device__ __forceinline__ unsigned cvt_pk_bf16(float lo, float hi) { unsigned r; asm volatile("v_cvt_pk_bf16_f32 %0, %1, %2" : "=v"(r) : "v"(lo), "v"(hi)); return r; }
__device__ __forceinline__ u32x4 pk8(const f32x4 v0, const f32x4 v1) { u32x4 w; w.x = cvt_pk_bf16(v0[0], v0[1]); w.y = cvt_pk_bf16(v0[2], v0[3]); w.z = cvt_pk_bf16(v1[0], v1[1]); w.w = cvt_pk_bf16(v1[2], v1[3]); return w; }

__device__ __forceinline__ unsigned cvt_pk_bf16_n(float lo, float hi) { unsigned r; asm volatile("s_nop 1\n\tv_cvt_pk_bf16_f32 %0, %1, %2" : "=v"(r) : "v"(lo), "v"(hi)); return r; }
__device__ __forceinline__ u32x4 pk8n(const f32x4 v0, const f32x4 v1) { u32x4 w; w.x = cvt_pk_bf16_n(v0[0], v0[1]); w.y = cvt_pk_bf16_n(v0[2], v0[3]); w.z = cvt_pk_bf16_n(v1[0], v1[1]); w.w = cvt_pk_bf16_n(v1[2], v1[3]); return w; }
__device__ __forceinline__ float sigmoid_fast(float x) { return __builtin_amdgcn_rcpf(1.f + __expf(-x)); }
struct SchedIn { int G, c; __device__ __forceinline__ bool next(int i, Unit& u) const { const int L = i * G + c; if (L >= 1024) return false; u.z = 0; u.ka = 0; u.kb = 0;
  if (L < 936) { const int j = L / 24; u.pm = L % 24; u.pn = j < 34 ? j : (j < 38 ? j + 4 : 46); }
  else { const int e = L - 936; if (e < 72) { u.pm = e % 24; u.pn = 34 + e / 24; } else { u.pm = e - 72; u.pn = 37; } }
  return true; } };
struct SchedUp { int G, c; __device__ __forceinline__ bool next(int i, Unit& u) const { const int L = i * G + c; if (L >= 24 * 16) return false; u.pm = L % 24; u.pn = L / 24; u.z = 0; u.ka = 0; u.kb = 0; return true; } };
struct SchedBr { int G, c; __device__ __forceinline__ bool next(int i, Unit& u) const { const int L = i * G + c; if (L >= 256) return false; if (L >= 192) { const int k = 32 + (L - 192); u.pm = k % 24; u.pn = k / 24; u.z = 1; u.ka = (size_t)NTOK * DM; u.kb = (size_t)DM * DM; return true; } const int r = L / 24; u.pm = L % 24; u.pn = r & 3; u.z = (r >> 2) * 2;
  u.ka = (size_t)u.z * NTOK * DM; u.kb = (size_t)u.z * DM * DM; return true; } };
struct SchedOne { Unit u0; __device__ __forceinline__ bool next(int i, Unit& u) const { if (i != 0) return false; u = u0; return true; } };
template <int KH> struct SchedSplit2 { int G, c; __device__ __forceinline__ bool next(int i, Unit& u) const { const int L = i * G + c; if (L >= 24 * 8) return false; const int r = L / 24; u.pm = L % 24; u.pn = r & 3; u.z = r >> 2;
  u.ka = (size_t)u.z * KH; u.kb = (size_t)u.z * KH; return true; } };

struct EpiIn { static constexpr bool PERM = true; bfr* P; float* small;
  __device__ __forceinline__ void operator()(const f32x4 (&acc)[2][2][4][2], const Unit& u, int wr, int wc, int fr, int fq) const {
    const int row0 = u.pm * BM + wr * 64 + fr, col0 = u.pn * BM + wc * 32 + 8 * fq;
    if (u.pn < 46) {
      const bool sg = u.pn >= 34;
#pragma unroll
      for (int ai = 0; ai < 2; ++ai)
#pragma unroll
        for (int m = 0; m < 4; ++m) { bfr* rowp = P + (size_t)(row0 + ai * HALF + m * 16) * NP + col0;
#pragma unroll
          for (int bj = 0; bj < 2; ++bj) { f32x4 v0 = acc[ai][bj][m][0], v1 = acc[ai][bj][m][1];
            if (sg) {
#pragma unroll
              for (int j = 0; j < 4; ++j) { v0[j] = sigmoid_fast(v0[j]); v1[j] = sigmoid_fast(v1[j]); }
              *(u32x4*)(rowp + bj * HALF) = pk8n(v0, v1);
            } else *(u32x4*)(rowp + bj * HALF) = pk8(v0, v1); } }
    } else if (wc == 0) {
#pragma unroll
      for (int ai = 0; ai < 2; ++ai)
#pragma unroll
        for (int m = 0; m < 4; ++m) { float* rowp = small + (size_t)(row0 + ai * HALF + m * 16) * 32 + 8 * fq;
          *(f32x4*)rowp = acc[ai][0][m][0]; *(f32x4*)(rowp + 4) = acc[ai][0][m][1]; }
    }
  }
};
struct EpiUp { static constexpr bool PERM = true; bfr* O;
  __device__ __forceinline__ void operator()(const f32x4 (&acc)[2][2][4][2], const Unit& u, int wr, int wc, int fr, int fq) const {
    const int row0 = u.pm * BM + wr * 64 + fr, col0 = u.pn * BM + wc * 32 + 8 * fq;
#pragma unroll
    for (int ai = 0; ai < 2; ++ai)
#pragma unroll
      for (int m = 0; m < 4; ++m) { bfr* rowp = O + (size_t)(row0 + ai * HALF + m * 16) * HID + col0;
#pragma unroll
        for (int bj = 0; bj < 2; ++bj) { f32x4 v0 = acc[ai][bj][m][0], v1 = acc[ai][bj][m][1];
#pragma unroll
          for (int j = 0; j < 4; ++j) { const float a = fmaxf(v0[j], 0.f), b = fmaxf(v1[j], 0.f); v0[j] = a * a; v1[j] = b * b; }
          *(u32x4*)(rowp + bj * HALF) = pk8(v0, v1); } }
  }
};
struct EpiBr { static constexpr bool PERM = true; bfr* O; const bfr* P;
  __device__ __forceinline__ void operator()(const f32x4 (&acc)[2][2][4][2], const Unit& u, int wr, int wc, int fr, int fq) const {
    const int row0 = u.pm * BM + wr * 64 + fr, col0 = u.z * DM + u.pn * BM + wc * 32 + 8 * fq;
#pragma unroll
    for (int ai = 0; ai < 2; ++ai)
#pragma unroll
      for (int m = 0; m < 4; ++m) { const size_t row = row0 + ai * HALF + m * 16; bfr* rowp = O + row * 3072 + col0; const bfr* gp = P + row * NP + C_MG + col0;
#pragma unroll
        for (int bj = 0; bj < 2; ++bj) { f32x4 v0 = acc[ai][bj][m][0], v1 = acc[ai][bj][m][1];
          float g[8]; unpack8(*(const u32x4*)(gp + bj * HALF), g);
#pragma unroll
          for (int j = 0; j < 4; ++j) { v0[j] *= g[j]; v1[j] *= g[4 + j]; }
          *(u32x4*)(rowp + bj * HALF) = pk8(v0, v1); } }
  }
};
struct EpiF32 { static constexpr bool PERM = false; float* C;
  __device__ __forceinline__ void operator()(const f32x4 (&acc)[2][2][4][2], const Unit& u, int wr, int wc, int fr, int fq) const {
    const int row0 = u.pm * BM + wr * 64 + fr, col0 = u.pn * BM + wc * 32 + 4 * fq;
    float* Cz = C + (size_t)u.z * NTOK * DM;
#pragma unroll
    for (int ai = 0; ai < 2; ++ai)
#pragma unroll
      for (int m = 0; m < 4; ++m) { float* rowp = Cz + (size_t)(row0 + ai * HALF + m * 16) * DM + col0;
#pragma unroll
        for (int bj = 0; bj < 2; ++bj)
#pragma unroll
          for (int n = 0; n < 2; ++n) *(f32x4*)(rowp + bj * HALF + n * 16) = acc[ai][bj][m][n]; }
  }
};
struct EpiPart { static constexpr bool PERM = true; bfr* C;
  __device__ __forceinline__ void operator()(const f32x4 (&acc)[2][2][4][2], const Unit& u, int wr, int wc, int fr, int fq) const {
    const int row0 = u.pm * BM + wr * 64 + fr, col0 = u.pn * BM + wc * 32 + 8 * fq;
    bfr* Cz = C + (size_t)u.z * NTOK * DM;
#pragma unroll
    for (int ai = 0; ai < 2; ++ai)
#pragma unroll
      for (int m = 0; m < 4; ++m) { bfr* rowp = Cz + (size_t)(row0 + ai * HALF + m * 16) * DM + col0;
#pragma unroll
        for (int bj = 0; bj < 2; ++bj) *(u32x4*)(rowp + bj * HALF) = pk8(acc[ai][bj][m][0], acc[ai][bj][m][1]); }
  }
};
}
namespace att {
constexpr int D = 128, NW = 8, QBLK = 32, KVBLK = 64;
constexpr float SCALE = 0.088388347648318440f;
constexpr float THR = 8.f;
constexpr int SDEPTH = 1;
constexpr int LDQ = 1024, LDK = 256, LDO = 1024;
constexpr size_t SHM_V = KVBLK * D * 2, SHM_K = KVBLK * D * 2, SHM_ATTN = 2 * SHM_V + 2 * SHM_K + NW * 64 * 4;
using bf16 = bfr;
using f32x8  = __attribute__((ext_vector_type(8))) float;
#define KSWZ(row, colB) ((row) * 256 + ((colB) ^ (((row) & 7) << 4)))
#define SBAR() __builtin_amdgcn_sched_barrier(0)
__device__ __forceinline__ int crow(int r, int hi) { return (r & 3) + 8 * (r >> 2) + 4 * hi; }
__device__ __forceinline__ unsigned cvtpk(float lo, float hi) {
  unsigned r; asm volatile("v_cvt_pk_bf16_f32 %0, %1, %2" : "=v"(r) : "v"(lo), "v"(hi)); return r;
}
template <typename TIn> struct Stage;
template <> struct Stage<bf16>  { using T = bf16x8;
  __device__ static __forceinline__ T ld8(const bf16* p) { return *reinterpret_cast<const bf16x8*>(p); }
  __device__ static __forceinline__ bf16x8 tobf(T x) { return x; } };
template <> struct Stage<float> { using T = f32x8;
  __device__ static __forceinline__ T ld8(const float* p) { return *reinterpret_cast<const f32x8*>(p); }
  __device__ static __forceinline__ bf16x8 tobf(T x) {
    u32x4 w = {cvtpk(x[0], x[1]), cvtpk(x[2], x[3]), cvtpk(x[4], x[5]), cvtpk(x[6], x[7])}; return *reinterpret_cast<bf16x8*>(&w); } };

__device__ __forceinline__ void partialSM(f32x16& p0, f32x16& p1, float& m_reg, float& mn, float& alpha) {
  constexpr float C = SCALE * 1.4426950408889634f;
  float pmax = p0[0]; for (int r = 1; r < 16; ++r) pmax = fmaxf(pmax, p0[r]); for (int r = 0; r < 16; ++r) pmax = fmaxf(pmax, p1[r]);
  { auto rr = __builtin_amdgcn_permlane32_swap(__float_as_uint(pmax), __float_as_uint(pmax), false, false);
    pmax = fmaxf(__uint_as_float(rr[0]), __uint_as_float(rr[1])); }
  if (__builtin_expect(__all(pmax - m_reg <= THR / SCALE), 1)) { mn = m_reg; alpha = 1.f; }
  else { mn = fmaxf(m_reg, pmax); alpha = __builtin_amdgcn_exp2f((m_reg - mn) * C); m_reg = mn; }
  float mnC = -mn * C;
  for (int r = 0; r < 16; ++r) p0[r] = fmaf(p0[r], C, mnC); for (int r = 0; r < 16; ++r) p1[r] = fmaf(p1[r], C, mnC);
  for (int r = 0; r < 16; ++r) p0[r] = __builtin_amdgcn_exp2f(p0[r]);
}
__device__ __forceinline__ void finishSM(f32x16& p0, f32x16& p1, float alpha, float& l_reg, bf16x8& pa0, bf16x8& pa1, bf16x8& pa2, bf16x8& pa3) {
  for (int r = 0; r < 16; ++r) p1[r] = __builtin_amdgcn_exp2f(p1[r]);
  float ps = 0; for (int r = 0; r < 16; ++r) ps += p0[r]; for (int r = 0; r < 16; ++r) ps += p1[r];
  { auto rr = __builtin_amdgcn_permlane32_swap(__float_as_uint(ps), __float_as_uint(ps), false, false);
    ps = __uint_as_float(rr[0]) + __uint_as_float(rr[1]); }
  l_reg = l_reg * alpha + ps;
#define PK4(P, BASE, OUT) do { unsigned a0 = cvtpk(P[BASE + 0], P[BASE + 1]), a1 = cvtpk(P[BASE + 2], P[BASE + 3]);   \
    unsigned b0 = cvtpk(P[BASE + 4], P[BASE + 5]), b1 = cvtpk(P[BASE + 6], P[BASE + 7]);                              \
    auto r0 = __builtin_amdgcn_permlane32_swap(a0, b0, false, false); auto r1 = __builtin_amdgcn_permlane32_swap(a1, b1, false, false); \
    u32x4 w = {r0[0], r1[0], r0[1], r1[1]}; OUT = *reinterpret_cast<bf16x8*>(&w); } while (0)
  PK4(p0, 0, pa0); PK4(p0, 8, pa1); PK4(p1, 0, pa2); PK4(p1, 8, pa3);
#undef PK4
}
__device__ __forceinline__ void qkt(f32x16& p0, f32x16& p1, const bf16* Ks, const bf16x8* qr, int r32, int hi) {
  p0 = f32x16{}; p1 = f32x16{};
  for (int d0 = 0; d0 < 8; ++d0) { int cb = (d0 * 16 + hi * 8) * 2;
    bf16x8 b0 = *reinterpret_cast<const bf16x8*>((const char*)Ks + KSWZ(r32, cb));
    bf16x8 b1 = *reinterpret_cast<const bf16x8*>((const char*)Ks + KSWZ(32 + r32, cb));
    p0 = __builtin_amdgcn_mfma_f32_32x32x16_bf16(b0, qr[d0], p0, 0, 0, 0);
    p1 = __builtin_amdgcn_mfma_f32_32x32x16_bf16(b1, qr[d0], p1, 0, 0, 0); }
}
__device__ __forceinline__ int v_st(int k, int c) { const int kk = (k & ~0xC) | ((k & 4) << 1) | ((k & 8) >> 1); return ((kk >> 3) * 4 + (c >> 5)) * 512 + ((kk & 7) * 32 + (c & 31)) * 2; }
__device__ __forceinline__ int v_rd_base(int lane) { return ((lane & 3) << 3) | (((lane >> 2) & 3) << 6) | (((lane >> 4) & 1) << 5) | (((lane >> 5) & 1) << 8); }
constexpr int v_rd_off(int d0, int ks, int half) { return d0 * 512 + ks * 4096 + half * 2048; }
template <int OFF> __device__ __forceinline__ s16x4 tr_read(int vb) {
  s16x4 r; asm volatile("ds_read_b64_tr_b16 %0, %1 offset:%2" : "=&v"(r) : "v"(vb), "i"(OFF) : "memory"); return r;
}
template <int D0> __device__ __forceinline__ void pv_one(f32x16& od, int vb, bf16x8 pa0, bf16x8 pa1, bf16x8 pa2, bf16x8 pa3) {
  const s16x4 l0 = tr_read<v_rd_off(D0, 0, 0)>(vb), h0 = tr_read<v_rd_off(D0, 0, 1)>(vb), l1 = tr_read<v_rd_off(D0, 1, 0)>(vb), h1 = tr_read<v_rd_off(D0, 1, 1)>(vb);
  const s16x4 l2 = tr_read<v_rd_off(D0, 2, 0)>(vb), h2 = tr_read<v_rd_off(D0, 2, 1)>(vb), l3 = tr_read<v_rd_off(D0, 3, 0)>(vb), h3 = tr_read<v_rd_off(D0, 3, 1)>(vb);
  asm volatile("s_waitcnt lgkmcnt(0)" ::: "memory"); SBAR();
#define PK(L, H) (bf16x8){L[0], L[1], L[2], L[3], H[0], H[1], H[2], H[3]}
  od = __builtin_amdgcn_mfma_f32_32x32x16_bf16(pa0, PK(l0, h0), od, 0, 0, 0);
  od = __builtin_amdgcn_mfma_f32_32x32x16_bf16(pa1, PK(l1, h1), od, 0, 0, 0);
  od = __builtin_amdgcn_mfma_f32_32x32x16_bf16(pa2, PK(l2, h2), od, 0, 0, 0);
  od = __builtin_amdgcn_mfma_f32_32x32x16_bf16(pa3, PK(l3, h3), od, 0, 0, 0);
#undef PK
}
__device__ __forceinline__ void pv_d0(f32x16* o, int vb, bf16x8 pa0, bf16x8 pa1, bf16x8 pa2, bf16x8 pa3) {
  pv_one<0>(o[0], vb, pa0, pa1, pa2, pa3); pv_one<1>(o[1], vb, pa0, pa1, pa2, pa3); pv_one<2>(o[2], vb, pa0, pa1, pa2, pa3); pv_one<3>(o[3], vb, pa0, pa1, pa2, pa3);
}

template <typename TQ>
__device__ __forceinline__ void attn_dense_body(const TQ* __restrict__ Qb, const bf16* __restrict__ Kh, const bf16* __restrict__ Vh,
                                                bfr* __restrict__ Ob, int seq, char* lds) {
  using St = Stage<bf16>; using SQ = Stage<TQ>;
  const int tid = tid_opaque(), wid = tid >> 6, lane = tid & 63, r32 = lane & 31, hi = lane >> 5;
  bf16* V_lds = (bf16*)lds; bf16* K_lds = (bf16*)(lds + 2 * SHM_V);
  float* ws = (float*)(lds + 2 * SHM_V + 2 * SHM_K) + wid * 64; float* li_l = ws; float* al_l = ws + 32;
  float m_reg = -1e30f, l_reg = 0; f32x16 o[4] = {}; bf16x8 qr[8];
  const TQ* Qw = Qb + (long)(wid * QBLK + r32) * LDQ + hi * 8;
#pragma unroll
  for (int d0 = 0; d0 < 8; ++d0) qr[d0] = SQ::tobf(SQ::ld8(Qw + d0 * 16));
  const int sr = tid >> 4, sc = (tid & 15) * 8, vst0 = v_st(sr, sc), vst1 = v_st(32 + sr, sc);
  const int vb0 = (int)(uintptr_t)V_lds + v_rd_base(lane);
  struct { typename St::T vs0, vs1, ks0, ks1; } sr_[SDEPTH];
#define SLOAD(i, k0) do { sr_[i].vs0 = St::ld8(&Vh[(long)((k0) + sr) * LDK + sc]); sr_[i].vs1 = St::ld8(&Vh[(long)((k0) + 32 + sr) * LDK + sc]); \
    sr_[i].ks0 = St::ld8(&Kh[(long)((k0) + sr) * LDK + sc]); sr_[i].ks1 = St::ld8(&Kh[(long)((k0) + 32 + sr) * LDK + sc]); } while (0)
#define SWRITE(b, i) do { *(bf16x8*)((char*)V_lds + (b) * SHM_V + vst0) = St::tobf(sr_[i].vs0);          \
    *(bf16x8*)((char*)V_lds + (b) * SHM_V + vst1) = St::tobf(sr_[i].vs1); int kc = sc * 2;               \
    *(bf16x8*)((char*)K_lds + (b) * SHM_K + KSWZ(sr, kc)) = St::tobf(sr_[i].ks0);                       \
    *(bf16x8*)((char*)K_lds + (b) * SHM_K + KSWZ(32 + sr, kc)) = St::tobf(sr_[i].ks1); } while (0)
#define SWAIT() do { if constexpr (SDEPTH == 2) asm volatile("s_waitcnt vmcnt(4)" ::: "memory"); else asm volatile("s_waitcnt vmcnt(0)" ::: "memory"); } while (0)
#define RESC(a) do { if (__any((a) < 1.f)) { if (hi == 0) al_l[r32] = (a); asm volatile("s_waitcnt lgkmcnt(0)" ::: "memory"); \
    for (int d = 0; d < 4; ++d) for (int r = 0; r < 16; ++r) o[d][r] *= al_l[crow(r, hi)]; } } while (0)
  f32x16 pA0, pA1, pB0, pB1; float mnA, mnB, alA, alB; bf16x8 pa0, pa1, pa2, pa3; const int NT = seq / KVBLK;
  constexpr int SE = 0, SO = SDEPTH - 1;
  SLOAD(SE, 0); asm volatile("s_waitcnt vmcnt(0)" ::: "memory"); SWRITE(0, SE); __syncthreads();
  qkt(pA0, pA1, K_lds, qr, r32, hi); partialSM(pA0, pA1, m_reg, mnA, alA);
  SLOAD(SO, KVBLK); if constexpr (SDEPTH == 2) { if (2 < NT) SLOAD(SE, 2 * KVBLK); }
  SWAIT(); SWRITE(1, SO); __syncthreads();
  for (int j = 1; j + 1 < NT; j += 2) {
    SBAR(); qkt(pB0, pB1, (bf16*)((char*)K_lds + SHM_K), qr, r32, hi);
    finishSM(pA0, pA1, alA, l_reg, pa0, pa1, pa2, pa3); SBAR();
    SLOAD(SO, (j + SDEPTH) * KVBLK); SBAR();
    pv_d0(o, vb0, pa0, pa1, pa2, pa3); partialSM(pB0, pB1, m_reg, mnB, alB);
    __syncthreads(); SWAIT(); SWRITE(0, SE);
    RESC(alB); __syncthreads();
    SBAR(); qkt(pA0, pA1, K_lds, qr, r32, hi);
    finishSM(pB0, pB1, alB, l_reg, pa0, pa1, pa2, pa3); SBAR();
    if (SDEPTH == 1 || j + 3 < NT) SLOAD(SE, (j + 1 + SDEPTH) * KVBLK); SBAR();
    pv_d0(o, vb0 + (int)SHM_V, pa0, pa1, pa2, pa3); partialSM(pA0, pA1, m_reg, mnA, alA);
    __syncthreads(); SWAIT(); SWRITE(1, SO);
    RESC(alA); __syncthreads();
  }
  SBAR(); qkt(pB0, pB1, (bf16*)((char*)K_lds + SHM_K), qr, r32, hi);
  finishSM(pA0, pA1, alA, l_reg, pa0, pa1, pa2, pa3); SBAR();
  pv_d0(o, vb0, pa0, pa1, pa2, pa3); partialSM(pB0, pB1, m_reg, mnB, alB);
  __syncthreads(); RESC(alB);
  finishSM(pB0, pB1, alB, l_reg, pa0, pa1, pa2, pa3); SBAR();
  pv_d0(o, vb0 + (int)SHM_V, pa0, pa1, pa2, pa3);
  if (hi == 0) li_l[r32] = l_reg; asm volatile("s_waitcnt lgkmcnt(0)" ::: "memory");
  float rli[16];
#pragma unroll
  for (int r = 0; r < 16; ++r) rli[r] = __builtin_amdgcn_rcpf(li_l[crow(r, hi)]);
  bfr* Ow = Ob + (long)(wid * QBLK) * LDO;
#pragma unroll
  for (int r = 0; r < 16; ++r) { int orow = crow(r, hi);
    for (int d0 = 0; d0 < 4; ++d0) Ow[(long)orow * LDO + d0 * 32 + r32] = f2bf(o[d0][r] * rli[r]); }
#undef SLOAD
#undef SWRITE
#undef SWAIT
#undef RESC
}

}

__device__ __forceinline__ void attn_item(const Params& p, int item) {
  __syncthreads();
  if (item < 64) {
    const int b = item >> 5, h = (item >> 2) & 7, qb = item & 3; const size_t t0 = NCTX + b * 1024 + qb * 256;
    att::attn_dense_body<bfr>(p.Q + t0 * DM + h * 128, p.Ks + (size_t)b * 1280 * 256 + (h >> 2) * 128, p.Vs + (size_t)b * 1280 * 256 + (h >> 2) * 128,
                              p.obr + (size_t)2 * NTOK * DM + t0 * DM + h * 128, 1280, smem);
  } else {
    const int j = item - 64, b = j >> 3, h = j & 7; const size_t t0 = b * 256;
    att::attn_dense_body<bfr>(p.Q + t0 * DM + h * 128, p.Kc + (size_t)b * 256 * 256 + (h >> 2) * 128, p.Vc + (size_t)b * 256 * 256 + (h >> 2) * 128,
                              p.obr + (size_t)2 * NTOK * DM + t0 * DM + h * 128, 256, smem);
  }
}
#define XB_TMO      128
#define XB_XCNT(j)  (256  + 64 * (j))
#define XB_XSUB(j)  (1280 + 64 * (j))
#define XB_XGEN(j)  (2304 + 64 * (j))
#define XB_TOP      3328
#define XB_TOPGEN   3392
#define XCD_BAR_WORDS 3456
#define XB_SPIN_CAP (1u << 20)
#define LAS __attribute__((address_space(3)))
constexpr int XB_LDS_OFF = 163840 - 16;

__device__ __forceinline__ unsigned xb_ld(unsigned* p)              { return __hip_atomic_load(p, __ATOMIC_RELAXED, __HIP_MEMORY_SCOPE_AGENT); }
__device__ __forceinline__ unsigned xb_add(unsigned* p, unsigned v) { return __hip_atomic_fetch_add(p, v, __ATOMIC_RELAXED, __HIP_MEMORY_SCOPE_AGENT); }
__device__ __forceinline__ unsigned xb_xcc_id() { return (unsigned)__builtin_amdgcn_s_getreg((3 << 11) | 20) & 0xFu; }
#define XB_SPIN(cond, bar) do { unsigned _sp = 0; while (cond) { __builtin_amdgcn_s_sleep(1); \
    if ((++_sp & 255u) == 0u) { if (xb_ld(&(bar)[XB_TMO])) break; if (_sp > XB_SPIN_CAP) { atomicAdd(&(bar)[XB_TMO], 1u); break; } } } } while (0)

__device__ __forceinline__ void xcd_barrier_post(unsigned* bar) {
  volatile LAS unsigned* st = (volatile LAS unsigned*)(smem + XB_LDS_OFF);
  if (tid_opaque() == 0) { st[0] = 0u; st[1] = 0u; (void)xb_add(&bar[XB_XCNT(xb_xcc_id())], 1u); }
  __syncthreads();
}
__device__ __forceinline__ void xcd_barrier_complete(unsigned* bar, unsigned x, unsigned& nloc, unsigned& nx) {
  const unsigned G = gridDim.x * gridDim.y * gridDim.z;
  unsigned sum, cnt, mine, sp = 0u;
  for (;;) {
    sum = 0u; cnt = 0u; mine = 0u;
#pragma unroll
    for (unsigned j = 0; j < 16; ++j) { const unsigned c = xb_ld(&bar[XB_XCNT(j)]); sum += c; cnt += (c > 0u) ? 1u : 0u; mine = (j == x) ? c : mine; }
    if (sum == G) break;
    __builtin_amdgcn_s_sleep(1);
    if ((++sp & 255u) == 0u) { if (xb_ld(&bar[XB_TMO])) break; if (sp > XB_SPIN_CAP) { atomicAdd(&bar[XB_TMO], 1u); break; } }
  }
  nloc = mine > 0u ? mine : 1u; nx = cnt > 0u ? cnt : 1u;
}
template <bool REL = true>
__device__ __forceinline__ void xcd_barrier(unsigned* bar) {
  asm volatile("s_waitcnt vmcnt(0)" ::: "memory");
  __syncthreads();
  if (tid_opaque() == 0) {
    volatile LAS unsigned* st = (volatile LAS unsigned*)(smem + XB_LDS_OFF);
    const unsigned x = xb_xcc_id();
    __builtin_amdgcn_s_waitcnt(0);
    unsigned nloc = st[0], nx = st[1];
    if (nloc == 0u) { xcd_barrier_complete(bar, x, nloc, nx); st[0] = nloc; st[1] = nx; }
    const unsigned old = xb_add(&bar[XB_XSUB(x)], 1u);
    const unsigned gen = old / nloc;
    if (old + 1u == (gen + 1u) * nloc) {
      if (REL) { __builtin_amdgcn_fence(__ATOMIC_RELEASE, "agent"); asm volatile("s_waitcnt vmcnt(0)" ::: "memory"); }
      const unsigned og = xb_add(&bar[XB_TOP], 1u);
      const unsigned tg = og / nx;
      if (og + 1u == (tg + 1u) * nx) xb_add(&bar[XB_TOPGEN], 1u);
      else XB_SPIN(xb_ld(&bar[XB_TOPGEN]) == tg, bar);
      xb_add(&bar[XB_XGEN(x)], 1u);
      __builtin_amdgcn_fence(__ATOMIC_ACQUIRE, "agent");
      asm volatile("s_waitcnt vmcnt(0)" ::: "memory");
    } else {
      XB_SPIN(xb_ld(&bar[XB_XGEN(x)]) == gen, bar);
      __builtin_amdgcn_fence(__ATOMIC_ACQUIRE, "agent");
      asm volatile("s_waitcnt vmcnt(0)" ::: "memory");
    }
  }
  __syncthreads();
}
constexpr float SCALEQ = 0.08838834764831845f;
constexpr int PQH = 0, PKH = 17408, PVH = 34816, PKK = 52224, PQK = 68864, PXS = 52224, PMD = 125952, PMB = 134144, PGC = 152576, PRS = 0;
constexpr int XROW = 144;
#define LDS_BARRIER() do { asm volatile("s_waitcnt lgkmcnt(0)" ::: "memory"); __builtin_amdgcn_s_barrier(); asm volatile("" ::: "memory"); } while (0)
constexpr int LROW = 272;

__device__ __forceinline__ float ld_bf(const char* base, int byteoff) { return bf2f(*(const bfr*)(base + byteoff)); }

template <int B>
__device__ __forceinline__ void solve_block(int d, int e, int wid, int lane) {
  const int fr = lane & 15, hq = lane >> 4;
  char* xcol = smem + PXS + (d * 256 + e) * XROW + 16 * B * 2;
  float acc[16];
  { const u32x4 a = *(const u32x4*)xcol, b = *(const u32x4*)(xcol + 16); unpack8(a, acc); unpack8(b, acc + 8); }
  if (B > 0) {
    constexpr int NKS = (B + 1) / 2;
    f32x4 R[4];
#pragma unroll
    for (int ct = 0; ct < 4; ++ct) R[ct] = f32x4{0.f, 0.f, 0.f, 0.f};
#pragma unroll
    for (int ks = 0; ks < NKS; ++ks) {
      const bf16x8 a = *(const bf16x8*)(smem + PMB + (d * 64 + 16 * B + fr) * XROW + (ks * 32 + 8 * hq) * 2);
#pragma unroll
      for (int ct = 0; ct < 4; ++ct) {
        const bf16x8 b = *(const bf16x8*)(smem + PXS + (d * 256 + (wid & 3) * 64 + ct * 16 + fr) * XROW + (ks * 32 + 8 * hq) * 2);
        R[ct] = __builtin_amdgcn_mfma_f32_16x16x32_bf16(a, b, R[ct], 0, 0, 0);
      }
    }
    float* rs = (float*)(smem + PRS + wid * 4352);
#pragma unroll
    for (int ct = 0; ct < 4; ++ct)
#pragma unroll
      for (int r = 0; r < 4; ++r) rs[(4 * hq + r) * 68 + ct * 16 + fr] = R[ct][r];
    asm volatile("s_waitcnt lgkmcnt(0)" ::: "memory");
#pragma unroll
    for (int r = 0; r < 16; ++r) acc[r] -= rs[r * 68 + lane];
  }
  const float4* md = (const float4*)(smem + PMD) + ((d * 4 + B) * 16) * 4;
#pragma unroll
  for (int r2 = 0; r2 < 15; ++r2) {
#pragma unroll
    for (int q = (r2 + 1) / 4; q < 4; ++q) {
      const float4 m = md[r2 * 4 + q];
      if (4 * q + 0 > r2) acc[4 * q + 0] -= m.x * acc[r2];
      if (4 * q + 1 > r2) acc[4 * q + 1] -= m.y * acc[r2];
      if (4 * q + 2 > r2) acc[4 * q + 2] -= m.z * acc[r2];
      if (4 * q + 3 > r2) acc[4 * q + 3] -= m.w * acc[r2];
    }
  }
  *(u32x4*)xcol = pack8(acc); *(u32x4*)(xcol + 16) = pack8(acc + 8);
  asm volatile("s_waitcnt lgkmcnt(0)" ::: "memory");
}

__device__ __forceinline__ void dn_prep_item(const Params& p, int l, int c, int h) {
  const int tid = tid_opaque(), wid = tid >> 6, lane = tid & 63;
  const int t0 = c * 64;
  LDS_BARRIER();
  float b_beta = 0.f, b_alpha = 0.f, b_A = 0.f, b_dtb = 0.f;
  if (wid < 2) {
    const int d = wid, ti = d ? 63 - lane : lane, t = t0 + ti;
    b_A = p.a_log[(l * 2 + d) * 8 + h]; b_dtb = p.dt_bias[(l * 2 + d) * 8 + h];
    b_beta = p.small[(size_t)t * 32 + d * 8 + h]; b_alpha = p.small[(size_t)t * 32 + 16 + d * 8 + h];
  }
  struct { u32x4 raw[3][2][3]; } R;
  {
    const int grp = tid & 15;
#pragma unroll
    for (int X = 0; X < 3; ++X)
#pragma unroll
      for (int pass = 0; pass < 2; ++pass)
#pragma unroll
        for (int k = -1; k <= 1; ++k) {
          const int r = (tid >> 4) + pass * 32, t = t0 + r, pos = tok_pos(t), L = tok_L(t);
          R.raw[X][pass][k + 1] = u32x4{0u, 0u, 0u, 0u};
          if (pos + k >= 0 && pos + k < L) R.raw[X][pass][k + 1] = *(const u32x4*)(p.P + (size_t)(t + k) * NP + X * 1024 + h * 128 + grp * 8);
        }
  }
  {
    const int grp = tid & 15;
    const float* wc = p.w_conv_dn + (size_t)l * 3 * 3072 + h * 128 + grp * 8;
#pragma unroll
    for (int X = 0; X < 3; ++X) {
      float w[3][8];
#pragma unroll
      for (int k = 0; k < 3; ++k) { *(float4*)&w[k][0] = *(const float4*)(wc + k * 3072 + X * 1024); *(float4*)&w[k][4] = *(const float4*)(wc + k * 3072 + X * 1024 + 4); }
#pragma unroll
      for (int pass = 0; pass < 2; ++pass) {
        const int r = (tid >> 4) + pass * 32;
        float acc[8] = {};
#pragma unroll
        for (int k = 0; k < 3; ++k) {
          float x[8]; unpack8(R.raw[X][pass][k], x);
#pragma unroll
          for (int q = 0; q < 8; ++q) acc[q] += w[k][q] * x[q];
        }
        float ss = 0;
#pragma unroll
        for (int q = 0; q < 8; ++q) { acc[q] = siluf_(acc[q]); ss += acc[q] * acc[q]; }
        if (X < 2) {
          ss += __shfl_xor(ss, 1); ss += __shfl_xor(ss, 2); ss += __shfl_xor(ss, 4); ss += __shfl_xor(ss, 8);
          const float nrm = rsqrtf(ss + EPS);
#pragma unroll
          for (int q = 0; q < 8; ++q) acc[q] *= nrm;
        }
        *(u32x4*)(smem + X * 17408 + r * LROW + grp * 16) = pack8hw(acc);
      }
    }
  }
  if (wid < 2) {
    const int d = wid;
    const float A = __expf(b_A);
    const float beta = sigmoidf_(b_beta);
    float g = -A * softplusf_(b_alpha + b_dtb);
#pragma unroll
    for (int o = 1; o < 64; o <<= 1) { const float v = __shfl_up(g, o); if (lane >= o) g += v; }
    float* G = (float*)(smem + PGC);
    const float eg_ = __expf(g);
    G[d * 64 + lane] = g; G[128 + d * 64 + lane] = beta; G[256 + d * 64 + lane] = eg_; G[384 + d * 64 + lane] = beta * eg_;
  }
  LDS_BARRIER();
  {
    const int mat = wid >> 2, rt = wid & 3, fr = lane & 15, fq = lane >> 4;
    const char* Ab = smem + (mat ? PQH : PKH);
    f32x4 acc[4];
#pragma unroll
    for (int ct = 0; ct < 4; ++ct) acc[ct] = f32x4{0.f, 0.f, 0.f, 0.f};
#pragma unroll
    for (int ks = 0; ks < 4; ++ks) {
      const bf16x8 a = *(const bf16x8*)(Ab + (rt * 16 + fr) * LROW + (ks * 32 + fq * 8) * 2);
#pragma unroll
      for (int ct = 0; ct < 4; ++ct) {
        const bf16x8 b = *(const bf16x8*)(smem + PKH + (ct * 16 + fr) * LROW + (ks * 32 + fq * 8) * 2);
        acc[ct] = __builtin_amdgcn_mfma_f32_16x16x32_bf16(a, b, acc[ct], 0, 0, 0);
      }
    }
    float* Dst = (float*)(smem + (mat ? PQK : PKK));
#pragma unroll
    for (int ct = 0; ct < 4; ++ct)
#pragma unroll
      for (int r = 0; r < 4; ++r) Dst[(rt * 16 + fq * 4 + r) * 65 + ct * 16 + fr] = acc[ct][r];
  }
  LDS_BARRIER();
  const int d = tid >> 8, e = tid & 255;
  const float* GC = (const float*)(smem + PGC) + d * 64;
  const float* BETA = (const float*)(smem + PGC) + 128 + d * 64;
  const float* EG = (const float*)(smem + PGC) + 256 + d * 64;
  const float* KKs = (const float*)(smem + PKK);
  const float* QKs = (const float*)(smem + PQK);
  char* rec = p.dnrec + (size_t)((c * 8 + h) * 2 + d) * REC_BYTES;
  {
    const int i = e >> 2, jq = e & 3, j0 = jq * 16, ti = d ? 63 - i : i, ib = i >> 4;
    const float bi = BETA[i], gi = GC[i];
    float mv[16];
#pragma unroll
    for (int jj = 0; jj < 16; ++jj) {
      const int j = j0 + jj, tj = d ? 63 - j : j;
      const float mraw = bi * KKs[ti * 65 + tj] * __expf(fminf(gi - GC[j], 0.f));
      mv[jj] = (j < i) ? mraw : 0.f;
    }
    float* mdt = (float*)(smem + PMD) + ((d * 4 + ib) * 16) * 16 + (i & 15);
    if (jq == ib) {
#pragma unroll
      for (int jj = 0; jj < 16; ++jj) mdt[jj * 16] = mv[jj];
    }
    float mo[16];
#pragma unroll
    for (int jj = 0; jj < 16; ++jj) mo[jj] = (jq < ib) ? mv[jj] : 0.f;
    char* mb = smem + PMB + (d * 64 + i) * XROW + j0 * 2;
    *(u32x4*)mb = pack8hw(mo); *(u32x4*)(mb + 16) = pack8hw(mo + 8);
#pragma unroll 1
    for (int rep = 0; rep < 2; ++rep) {
      const int f = e + rep * 256, ln = f & 63, fi = f >> 6, mt = fi >> 1, ks = fi & 1;
      const int ii = mt * 16 + (ln & 15), tii = d ? 63 - ii : ii, hq = ln >> 4;
      const float gii = GC[ii];
      float v[8];
#pragma unroll
      for (int j = 0; j < 8; ++j) {
        const int jp = ks * 32 + (j >> 2) * 16 + 4 * hq + (j & 3), tj = d ? 63 - jp : jp;
        const float qraw = SCALEQ * QKs[tii * 65 + tj] * __expf(fminf(gii - GC[jp], 0.f));
        v[j] = (jp <= ii) ? qraw : 0.f;
      }
      *(u32x4*)(rec + REC_QK + f * 16) = pack8hw(v);
    }
    if (e == 0) p.glast[(c * 8 + h) * 2 + d] = EG[63];
    const float gl = GC[63];
#pragma unroll 1
    for (int rep = 0; rep < 4; ++rep) {
      const int f = e + rep * 256, ln = f & 63, fi = f >> 6, hq = ln >> 4;
      {
        const int mt = fi >> 2, ks = fi & 3, ii = mt * 16 + (ln & 15), tii = d ? 63 - ii : ii;
        const float sc = SCALEQ * EG[ii];
        const char* qrow = smem + PQH + tii * LROW + (ks * 32 + 4 * hq) * 2;
        const u32x2 lo = *(const u32x2*)qrow, hi = *(const u32x2*)(qrow + 32);
        float v[8] = {__uint_as_float(lo[0] << 16), __uint_as_float(lo[0] & 0xffff0000u), __uint_as_float(lo[1] << 16), __uint_as_float(lo[1] & 0xffff0000u),
                      __uint_as_float(hi[0] << 16), __uint_as_float(hi[0] & 0xffff0000u), __uint_as_float(hi[1] << 16), __uint_as_float(hi[1] & 0xffff0000u)};
#pragma unroll
        for (int j = 0; j < 8; ++j) v[j] *= sc;
        *(u32x4*)(rec + REC_QD + f * 16) = pack8hw(v);
      }
      {
        const int mt = fi >> 1, ks = fi & 1, dk = mt * 16 + (ln & 15);
        float v[8];
#pragma unroll
        for (int j = 0; j < 8; ++j) {
          const int ip = ks * 32 + (j >> 2) * 16 + 4 * hq + (j & 3), tip = d ? 63 - ip : ip;
          v[j] = ld_bf(smem + PKH, tip * LROW + dk * 2) * __expf(gl - GC[ip]);
        }
        *(u32x4*)(rec + REC_KD + f * 16) = pack8hw(v);
      }
    }
  }
  LDS_BARRIER();
  {
    const int col = e & 127; const bool isw = e >= 128;
    const char* src = smem + (isw ? PKH : PVH) + col * 2;
    const float4* F4 = (const float4*)((const float*)(smem + PGC) + (isw ? 384 : 128) + d * 64);
    char* xcol = smem + PXS + (d * 256 + e) * XROW;
#pragma unroll
    for (int i8 = 0; i8 < 8; ++i8) {
      const float4 f0 = F4[i8 * 2], f1 = F4[i8 * 2 + 1];
      const float fs[8] = {f0.x, f0.y, f0.z, f0.w, f1.x, f1.y, f1.z, f1.w};
      float v[8];
#pragma unroll
      for (int q = 0; q < 8; ++q) { const int i = i8 * 8 + q, ti = d ? 63 - i : i; v[q] = ld_bf(src, ti * LROW) * fs[q]; }
      *(u32x4*)(xcol + i8 * 16) = pack8hw(v);
    }
  }
  LDS_BARRIER();
  solve_block<0>(d, e, wid, lane); solve_block<1>(d, e, wid, lane); solve_block<2>(d, e, wid, lane); solve_block<3>(d, e, wid, lane);
  LDS_BARRIER();
  {
    const char* XS = smem + PXS + d * 256 * XROW;
#pragma unroll 1
    for (int rep = 0; rep < 8; ++rep) {
      const int f = e + rep * 256, ln = f & 63, fi = f >> 6, ws = fi >> 2, rt = fi & 3;
      const int i0 = rt * 16 + 4 * (ln >> 4), dv = ws * 16 + (ln & 15);
      *(u32x2*)(rec + REC_U + f * 8) = *(const u32x2*)(XS + dv * XROW + i0 * 2);
    }
#pragma unroll 1
    for (int rep = 0; rep < 4; ++rep) {
      const int f = e + rep * 256, ln = f & 63, fi = f >> 6, mt = fi >> 2, ks = fi & 3, hq = ln >> 4;
      const char* wc = XS + (128 + ks * 32 + 4 * hq) * XROW + (mt * 16 + (ln & 15)) * 2;
      unsigned q[8];
#pragma unroll
      for (int j = 0; j < 8; ++j) q[j] = *(const bfr*)(wc + ((j >> 2) * 16 + (j & 3)) * XROW);
      u32x4 o = {q[0] | (q[1] << 16), q[2] | (q[3] << 16), q[4] | (q[5] << 16), q[6] | (q[7] << 16)};
      *(u32x4*)(rec + REC_W + f * 16) = o;
    }
  }
}

__device__ __forceinline__ bf16x8 pack_b(const f32x4& a, const f32x4& b) {
  u32x4 w = {pack2hw(a[0], a[1]), pack2hw(a[2], a[3]), pack2hw(b[0], b[1]), pack2hw(b[2], b[3])};
  return *reinterpret_cast<bf16x8*>(&w);
}

constexpr int SCAN_BUF = 73728;
#define SC_SCHED() __builtin_amdgcn_sched_barrier(0)
#define SC_WAITL(n) asm volatile("s_waitcnt lgkmcnt(" #n ")" ::: "memory")
__device__ __forceinline__ void dn_scan_item(const Params& p, int l, int s, int h, int d) {
  const int tid = tid_opaque(), wid = tid >> 6, lane = tid & 63, ws = wid, fr = lane & 15, hq = lane >> 4;
  const bool samp = s >= 16;
  const int N = samp ? 16 : 4, cb = samp ? 64 + (s - 16) * 16 : s * 4, tbase = samp ? NCTX + (s - 16) * 1024 : s * 256;
  const int cstep = d ? -1 : 1, c0 = cb + (d ? N - 1 : 0);
  auto recp = [&](int n) { return p.dnrec + (size_t)(((c0 + n * cstep) * 8 + h) * 2 + d) * REC_BYTES; };
  f32x4 S[8];
  if (samp) {
    const float* s0 = p.state_dn + ((((size_t)(s - 16) * DEPTH + l) * 2 + d) * 8 + h) * 16384;
#pragma unroll
    for (int dt = 0; dt < 8; ++dt) {
      const float* q = s0 + (dt * 16 + 4 * hq) * 128 + ws * 16 + fr;
      asm volatile("" : "+v"(q) :: "memory");
#pragma unroll
      for (int r = 0; r < 4; ++r) S[dt][r] = q[r * 128];
    }
  } else {
#pragma unroll
    for (int dt = 0; dt < 8; ++dt) S[dt] = f32x4{0.f, 0.f, 0.f, 0.f};
  }
  const float glv = p.glast[((c0 + (lane < N ? lane : 0) * cstep) * 8 + h) * 2 + d];
  __syncthreads();
#define SC_GLDS(rec, buf) do { _Pragma("unroll") for (int i = 0; i < 9; ++i) \
    __builtin_amdgcn_global_load_lds((const unsigned*)((rec) + (i * 512 + tid) * 16), (__attribute__((address_space(3))) unsigned*)(smem + (buf) * SCAN_BUF + (i * 512 + tid) * 16), 16, 0, 0); } while (0)
  SC_GLDS(recp(0), 0);
  SC_GLDS(recp(1), 1);
  asm volatile("s_waitcnt vmcnt(0)" ::: "memory");
  LDS_BARRIER();
#pragma unroll 1
  for (int n = 0; n < N; ++n) {
    const int c = c0 + n * cstep;
    const char* Lb = smem + (n & 1) * SCAN_BUF;
    const char* LW = Lb + REC_W + lane * 16;
    const float gl = __uint_as_float(__builtin_amdgcn_readlane(__float_as_uint(glv), n));
    f32x4 P[4], O[4];
#pragma unroll
    for (int rt = 0; rt < 4; ++rt) { P[rt] = f32x4{0.f, 0.f, 0.f, 0.f}; O[rt] = f32x4{0.f, 0.f, 0.f, 0.f}; }
    bf16x8 F[8];
#define SC_LOADWQ(ks) do { _Pragma("unroll") for (int rt = 0; rt < 4; ++rt) { F[rt] = *(const bf16x8*)(LW + ((rt * 4 + (ks)) * 64) * 16); F[4 + rt] = *(const bf16x8*)(LW + 16384 + ((rt * 4 + (ks)) * 64) * 16); } } while (0)
#define SC_MMAWQ(sb) do { _Pragma("unroll") for (int rt = 0; rt < 4; ++rt) { P[rt] = __builtin_amdgcn_mfma_f32_16x16x32_bf16(F[rt], sb, P[rt], 0, 0, 0); O[rt] = __builtin_amdgcn_mfma_f32_16x16x32_bf16(F[4 + rt], sb, O[rt], 0, 0, 0); } } while (0)
#pragma unroll
    for (int ks = 0; ks < 4; ++ks) {
      SC_LOADWQ(ks); SC_SCHED();
      const bf16x8 sb = pack_b(S[2 * ks], S[2 * ks + 1]);
      SC_WAITL(0); SC_SCHED(); SC_MMAWQ(sb); SC_SCHED();
    }
    u32x2 U[4];
#pragma unroll
    for (int rt = 0; rt < 4; ++rt) U[rt] = *(const u32x2*)(Lb + REC_U + (((ws * 4 + rt) * 64) + lane) * 8);
#pragma unroll
    for (int i = 0; i < 8; ++i) F[i] = *(const bf16x8*)(LW + 32768 + (i * 64) * 16);
    SC_SCHED(); SC_WAITL(0); SC_SCHED();
#pragma unroll
    for (int rt = 0; rt < 4; ++rt) {
      const u32x2 u = U[rt];
      P[rt][0] = __uint_as_float(u[0] << 16) - P[rt][0]; P[rt][1] = __uint_as_float(u[0] & 0xffff0000u) - P[rt][1];
      P[rt][2] = __uint_as_float(u[1] << 16) - P[rt][2]; P[rt][3] = __uint_as_float(u[1] & 0xffff0000u) - P[rt][3];
    }
    const bf16x8 vb0 = pack_b(P[0], P[1]), vb1 = pack_b(P[2], P[3]);
#pragma unroll
    for (int rt = 0; rt < 4; ++rt) {
      O[rt] = __builtin_amdgcn_mfma_f32_16x16x32_bf16(F[rt * 2 + 0], vb0, O[rt], 0, 0, 0);
      O[rt] = __builtin_amdgcn_mfma_f32_16x16x32_bf16(F[rt * 2 + 1], vb1, O[rt], 0, 0, 0);
    }
    SC_SCHED();
#pragma unroll
    for (int half = 0; half < 2; ++half) {
#pragma unroll
      for (int i = 0; i < 8; ++i) F[i] = *(const bf16x8*)(LW + 40960 + ((half * 8 + i) * 64) * 16);
      SC_SCHED(); SC_WAITL(0); SC_SCHED();
#pragma unroll
      for (int dq = 0; dq < 4; ++dq) {
        const int dt = half * 4 + dq;
        S[dt] *= gl;
        S[dt] = __builtin_amdgcn_mfma_f32_16x16x32_bf16(F[dq * 2 + 0], vb0, S[dt], 0, 0, 0);
        S[dt] = __builtin_amdgcn_mfma_f32_16x16x32_bf16(F[dq * 2 + 1], vb1, S[dt], 0, 0, 0);
      }
      SC_SCHED();
    }
    SC_SCHED();
    bfr* ob = p.opart + (size_t)d * NTOK * DM + (size_t)(c * 64) * DM + h * 128 + ws * 16 + fr;
#pragma unroll
    for (int rt = 0; rt < 4; ++rt) {
      const int ip0 = rt * 16 + 4 * hq;
      bfr* q = ob + (size_t)(d ? 63 - ip0 : ip0) * DM;
      const long stp = d ? -(long)DM : (long)DM;
#pragma unroll
      for (int r = 0; r < 4; ++r) q[r * stp] = f2bf(O[rt][r]);
    }
    asm volatile("s_waitcnt vmcnt(16)" ::: "memory");
    LDS_BARRIER();
    if (n + 2 < N) SC_GLDS(recp(n + 2), n & 1);
  }
#undef SC_GLDS
#undef SC_LOADWQ
#undef SC_MMAWQ
  if (!samp) {
    float* so = p.out_state + ((((size_t)s * DEPTH + l) * 2 + d) * 8 + h) * 16384;
#pragma unroll
    for (int dt = 0; dt < 8; ++dt) {
      float* q = so + (dt * 16 + 4 * hq) * 128 + ws * 16 + fr;
      asm volatile("" : "+v"(q) :: "memory");
#pragma unroll
      for (int r = 0; r < 4; ++r) q[r * 128] = S[dt][r];
    }
  }
  if (l == 1 && s == 16 && h == 0 && d == 0) GSTAMP(p.bar, 4);
  asm volatile("s_waitcnt vmcnt(0)" ::: "memory");
  __syncthreads();
  volatile __attribute__((address_space(3))) unsigned* flag = (volatile __attribute__((address_space(3))) unsigned*)(smem + XB_LDS_OFF + 8);
  if (tid == 0) {
    __builtin_amdgcn_fence(__ATOMIC_RELEASE, "agent");
    asm volatile("s_waitcnt vmcnt(0)" ::: "memory");
    const unsigned old = __hip_atomic_fetch_add(p.bar + 4096 + (l * 18 + s) * 8 + h, 1u, __ATOMIC_RELAXED, __HIP_MEMORY_SCOPE_AGENT);
    if (old == 1u) { __builtin_amdgcn_fence(__ATOMIC_ACQUIRE, "agent"); asm volatile("s_waitcnt vmcnt(0)" ::: "memory"); }
    *flag = old;
  }
  __syncthreads();
  const unsigned last = __builtin_amdgcn_readfirstlane(*flag);
  if (last == 1u && !samp) dn_finalize(p, l, tbase, 256, h, tid, NTHR);
}

__device__ __forceinline__ void dn_finalize_item(const Params& p, int l, int it) {
  const int tid = tid_opaque();
  const int s = 16 + (it >> 5), h = (it >> 2) & 7, qt = it & 3;
  __syncthreads();
  if (tid == 0) {
    unsigned* cnt = p.bar + 4096 + (l * 18 + s) * 8 + h; unsigned sp = 0;
    while (__hip_atomic_load(cnt, __ATOMIC_RELAXED, __HIP_MEMORY_SCOPE_AGENT) < 2u) { __builtin_amdgcn_s_sleep(2); if (++sp > (1u << 22)) { atomicAdd(&p.bar[XB_TMO], 1u); break; } }
    __builtin_amdgcn_fence(__ATOMIC_ACQUIRE, "agent");
    asm volatile("s_waitcnt vmcnt(0)" ::: "memory");
  }
  __syncthreads();
  dn_finalize(p, l, NCTX + (s - 16) * 1024 + qt * 256, 256, h, tid, NTHR);
}
constexpr int DYN_LDS = 163840;
#ifndef REP
#define REP 0
#endif
constexpr int CONV_SPLIT = 660;
#ifndef USE_CG_SYNC
#define USE_CG_SYNC 1
#endif
#if USE_CG_SYNC
#define GRID_SYNC() do { cg::this_grid().sync(); } while (0)
#define GRID_SYNC_WT() GRID_SYNC()
#else
#define GRID_SYNC() do { unsigned* bar_; { PHASE_PARAMS(pb); bar_ = pb.bar; } xcd_barrier<true>(bar_); if (REP & 2048) xcd_barrier<true>(bar_); } while (0)
#define GRID_SYNC_WT() GRID_SYNC()
#endif

typedef const __attribute__((address_space(4))) Params* CParamsPtr;
#define PHASE_PARAMS(p) CParamsPtr p##_c = (CParamsPtr)__builtin_amdgcn_kernarg_segment_ptr(); asm volatile("" : "+s"(p##_c)); const Params& p = *(const Params*)p##_c

#define PF_LINES(base_ptr, nlines) do { const int g_ = bid * 512 + tid_opaque(); unsigned d0_ = 0, d1_ = 0; \
    if (g_ < (nlines)) { const char* q_ = (const char*)(base_ptr) + (size_t)g_ * 128; asm volatile("global_load_dword %0, %1, off" : "=v"(d0_) : "v"(q_) : "memory"); } \
    if ((nlines) > 131072 && g_ + 131072 < (nlines)) { const char* q_ = (const char*)(base_ptr) + (size_t)(g_ + 131072) * 128; asm volatile("global_load_dword %0, %1, off" : "=v"(d1_) : "v"(q_) : "memory"); } \
    asm volatile("s_waitcnt vmcnt(0)" ::: "memory"); asm volatile("" :: "v"(d0_), "v"(d1_)); } while (0)
__device__ __forceinline__ void panel_rows(const Params& p, int l, int mode, int bid) {
  const int tid = tid_opaque(), wid = tid >> 6, lane = tid & 63;
  const int pm = bid % 24, q = bid / 24;
  volatile __attribute__((address_space(3))) unsigned* flag = (volatile __attribute__((address_space(3))) unsigned*)(smem + XB_LDS_OFF + 8);
  asm volatile("s_waitcnt vmcnt(0)" ::: "memory");
  __syncthreads();
  if (tid == 0) {
    unsigned* cnt = p.bar + 9216 + ((l * 2 + (mode - 1)) * 24 + pm) * 16;
    __builtin_amdgcn_fence(__ATOMIC_RELEASE, "agent");
    asm volatile("s_waitcnt vmcnt(0)" ::: "memory");
    (void)__hip_atomic_fetch_add(cnt, 1u, __ATOMIC_RELAXED, __HIP_MEMORY_SCOPE_AGENT);
    unsigned sp = 0;
    while (__hip_atomic_load(cnt, __ATOMIC_RELAXED, __HIP_MEMORY_SCOPE_AGENT) < 8u) { __builtin_amdgcn_s_sleep(1); if (++sp > (1u << 22)) { atomicAdd(&p.bar[XB_TMO], 1u); break; } }
    __builtin_amdgcn_fence(__ATOMIC_ACQUIRE, "agent");
    asm volatile("s_waitcnt vmcnt(0)" ::: "memory");
    *flag = 1u;
  }
  __syncthreads();
  rows_at<4>(p, l, mode, pm * 256 + q * 32 + wid * 4, lane);
}

template <int l> __device__ __forceinline__ void run_layer(const int bid, const int nblk) {
  if (l == 1) TSTAMP(5);
  { PHASE_PARAMS(p); pg8::gemm_phase(pg8::Gemm{p.h, p.wt_in + (size_t)l * NPAD * DM, DM, DM, DM}, pg8::SchedIn{nblk, bid}, pg8::EpiIn{p.P, p.small}); }
#if REP & 1
#if REP & 65536
  { PHASE_PARAMS(p); pg8::gemm_phase(pg8::Gemm{p.h, p.wt_in + (size_t)l * NPAD * DM, DM, DM, DM}, pg8::SchedIn{nblk, bid}, pg8::EpiIn{p.P, p.small}); }
#else
  { PHASE_PARAMS(p); pg8::gemm_phase(pg8::Gemm{p.h, p.wt_in + (size_t)l * NPAD * DM, DM, DM, DM}, pg8::SchedIn{nblk, bid}, pg8::EpiIn{p.P, p.small}); }
#endif
#endif
  GRID_SYNC_WT(); if (l == 1) TSTAMP(6);
  { PHASE_PARAMS(p); for (int it = bid; it < 768; it += nblk) dn_prep_item(p, l, it >> 3, it & 7); }
#if REP & 2
  { PHASE_PARAMS(p); for (int it = bid; it < 768; it += nblk) dn_prep_item(p, l, it >> 3, it & 7); }
#endif
  if (l == 1) TSTAMP(15);
  { PHASE_PARAMS(p); for (int it = bid; it < 384; it += nblk) light_prep_item(p, l, it); }
#if REP & 4096
  { PHASE_PARAMS(p); for (int it = bid; it < 384; it += nblk) light_prep_item(p, l, it); }
#endif
  unsigned pf_ = 0;
  { PHASE_PARAMS(p); const int gid = bid * 512 + tid_opaque(); const char* q;
    if (gid < 98304) q = (const char*)p.h + (size_t)gid * 128;
    else if (gid < 114688) q = (const char*)(p.wt_in + (size_t)l * NPAD * DM + (size_t)42 * 256 * DM) + (size_t)(gid - 98304) * 128;
    else if (gid < 118784) q = (const char*)(p.wt_in + (size_t)l * NPAD * DM + (size_t)37 * 256 * DM) + (size_t)(gid - 114688) * 128;
    else q = (const char*)(p.wt_br + (size_t)(l * 3 + 1) * DM * DM) + (size_t)((gid - 118784) & 8191) * 128;
    asm volatile("global_load_dword %0, %1, off" : "=v"(pf_) : "v"(q) : "memory"); }
  GRID_SYNC(); if (l == 1) TSTAMP(7);
  asm volatile("" :: "v"(pf_));
#define P3_PULL(slotword, limit) \
      volatile __attribute__((address_space(3))) unsigned* qslot = (volatile __attribute__((address_space(3))) unsigned*)(smem + XB_LDS_OFF + 12); \
      __syncthreads(); \
      if (tid_opaque() == 0) { PHASE_PARAMS(pq); *qslot = __hip_atomic_fetch_add(pq.bar + 8192 + l * 8 + rep3 * 4 + (slotword), 1u, __ATOMIC_RELAXED, __HIP_MEMORY_SCOPE_AGENT); } \
      __syncthreads(); \
      const int it = __builtin_amdgcn_readfirstlane((int)*qslot); \
      if (it >= (limit)) break;
#pragma unroll 1
  for (int rep3 = 0; rep3 < ((REP & 4) ? 2 : 1); ++rep3) {
    if (bid < 64) { PHASE_PARAMS(p); attn_item(p, bid); }
    else {
      if (bid >= 192)
#pragma unroll 1
      for (int rr_ = 0; rr_ < ((REP & 131072) ? 2 : 1); ++rr_) {
        const int it = bid - 192; TSTAMP(1);
        if (it >= 32) { PHASE_PARAMS(p); const int k = it - 32; pg8::Unit u; if (k < 8) { u.pm = 16 + k; u.pn = 37; } else { u.pm = (k - 8) % 24; u.pn = 42 + (k - 8) / 24; } u.z = 0; u.ka = 0; u.kb = 0;
          pg8::gemm_phase(pg8::Gemm{p.h, p.wt_in + (size_t)l * NPAD * DM, DM, DM, DM}, pg8::SchedOne{u}, pg8::EpiIn{p.P, p.small}); }
        else { PHASE_PARAMS(p); pg8::Unit u; u.pm = it % 24; u.pn = it / 24; u.z = 1; u.ka = (size_t)NTOK * DM; u.kb = (size_t)DM * DM;
          pg8::gemm_phase(pg8::Gemm{p.obr, p.wt_br + (size_t)l * 3 * DM * DM, DM, DM, DM}, pg8::SchedOne{u}, pg8::EpiBr{p.a3, p.P}); }
      }
      TSTAMP(2);
#pragma unroll 1
      for (int j = bid - 64; j < 32 + 256; j += (bid < 96 ? 1000 : 160)) {
        PHASE_PARAMS(p);
        if (j < 32) dn_scan_item(p, l, 16 + (j >> 4), (j >> 1) & 7, j & 1); else { const int jj = j - 32; dn_scan_item(p, l, jj >> 4, (jj >> 1) & 7, jj & 1); }
      }
    }
    TSTAMP(3);
#pragma unroll 1
    for (;;) { P3_PULL(2, 128) { PHASE_PARAMS(p); attn_item(p, 64 + it); } }
#pragma unroll 1
    for (;;) { P3_PULL(3, 32 + 104 - 64) const int itd = it + 64;
      if (itd >= 32) { PHASE_PARAMS(p); const int k = itd - 32; pg8::Unit u; if (k < 8) { u.pm = 16 + k; u.pn = 37; } else { u.pm = (k - 8) % 24; u.pn = 42 + (k - 8) / 24; } u.z = 0; u.ka = 0; u.kb = 0;
        pg8::gemm_phase(pg8::Gemm{p.h, p.wt_in + (size_t)l * NPAD * DM, DM, DM, DM}, pg8::SchedOne{u}, pg8::EpiIn{p.P, p.small}); }
      else { PHASE_PARAMS(p); pg8::Unit u; u.pm = itd % 24; u.pn = itd / 24; u.z = 1; u.ka = (size_t)NTOK * DM; u.kb = (size_t)DM * DM;
        pg8::gemm_phase(pg8::Gemm{p.obr, p.wt_br + (size_t)l * 3 * DM * DM, DM, DM, DM}, pg8::SchedOne{u}, pg8::EpiBr{p.a3, p.P}); }
    }
#pragma unroll 1
    for (;;) { P3_PULL(5, 64) { PHASE_PARAMS(p); dn_finalize_item(p, l, it); } }
  }
#undef P3_PULL
  { PHASE_PARAMS(p); PF_LINES(p.wt_br + (size_t)l * 3 * DM * DM, 49152); }
  GRID_SYNC(); if (l == 1) TSTAMP(8);
  { PHASE_PARAMS(p); pg8::gemm_phase(pg8::Gemm{p.obr, p.wt_br + (size_t)l * 3 * DM * DM, DM, DM, DM}, pg8::SchedBr{nblk, bid}, pg8::EpiBr{p.a3, p.P}); }
#if REP & 8
  { PHASE_PARAMS(p); pg8::gemm_phase(pg8::Gemm{p.obr, p.wt_br + (size_t)l * 3 * DM * DM, DM, DM, DM}, pg8::SchedBr{nblk, bid}, pg8::EpiBr{p.a3, p.P}); }
#endif
  { PHASE_PARAMS(p); PF_LINES(p.wt_out + (size_t)l * DM * 3072, 49152); }
  GRID_SYNC_WT(); if (l == 1) TSTAMP(9);
  { PHASE_PARAMS(p); pg8::gemm_phase(pg8::Gemm{p.a3, p.wt_out + (size_t)l * DM * 3072, 3072, 3072, 1536}, pg8::SchedSplit2<1536>{nblk, bid}, pg8::EpiPart{(bfr*)p.R}); }
  if (l + 1 < DEPTH && bid >= 192) { PHASE_PARAMS(p); for (int k = bid - 192; k < CONV_SPLIT; k += nblk - 192) convert_item(p, l + 1, k); }
#if REP & 16
  { PHASE_PARAMS(p); pg8::gemm_phase(pg8::Gemm{p.a3, p.wt_out + (size_t)l * DM * 3072, 3072, 3072, 1536}, pg8::SchedSplit2<1536>{nblk, bid}, pg8::EpiPart{(bfr*)p.R}); }
#endif
  GRID_SYNC_WT(); if (l == 1) TSTAMP(10);
  { PHASE_PARAMS(p); stage_row(p, l, 1, bid, nblk); }
  { PHASE_PARAMS(p); PF_LINES(p.wt_up + (size_t)l * HID * DM, 65536); }
  GRID_SYNC(); if (l == 1) TSTAMP(11);
  { PHASE_PARAMS(p); pg8::gemm_phase(pg8::Gemm{p.h, p.wt_up + (size_t)l * HID * DM, DM, DM, DM}, pg8::SchedUp{nblk, bid}, pg8::EpiUp{p.u2}); }
#if REP & 32
  { PHASE_PARAMS(p); pg8::gemm_phase(pg8::Gemm{p.h, p.wt_up + (size_t)l * HID * DM, DM, DM, DM}, pg8::SchedUp{nblk, bid}, pg8::EpiUp{p.u2}); }
#endif
  { PHASE_PARAMS(p); PF_LINES(p.wt_dn + (size_t)l * DM * HID, 65536); }
  GRID_SYNC_WT(); if (l == 1) TSTAMP(12);
  { PHASE_PARAMS(p); pg8::gemm_phase(pg8::Gemm{p.u2, p.wt_dn + (size_t)l * DM * HID, HID, HID, 2048}, pg8::SchedSplit2<2048>{nblk, bid}, pg8::EpiPart{(bfr*)p.R}); }
  if (l + 1 < DEPTH && bid >= 192) { PHASE_PARAMS(p); for (int k = CONV_SPLIT + bid - 192; k < CONV_ITEMS; k += nblk - 192) convert_item(p, l + 1, k); }
  GRID_SYNC_WT(); if (l == 1) TSTAMP(13);
  { PHASE_PARAMS(p); stage_row(p, l, 2, bid, nblk); }
  if (l + 1 < DEPTH) { { PHASE_PARAMS(p); PF_LINES(p.wt_in + (size_t)(l + 1) * NPAD * DM, 192512); } GRID_SYNC(); } if (l == 1) TSTAMP(14);
}

__global__ __launch_bounds__(512) void mega_kernel(Params p_arg) {
#if USE_CG_SYNC
  cg::grid_group grid = cg::this_grid();
#endif
  const int bid = blockIdx.x, nblk = gridDim.x;
#if !USE_CG_SYNC
  { PHASE_PARAMS(pb); xcd_barrier_post(pb.bar); }
  cg::this_grid().sync();
#endif
#ifdef DIAG_A
  if (threadIdx.x < 32) ((unsigned long long*)(smem + 163840 - 256))[threadIdx.x & 15] = 0ull;
  __syncthreads();
#endif
  { PHASE_PARAMS(p); stage_mod(p, bid, nblk, smem); }
#if REP & 8192
  { PHASE_PARAMS(p); stage_mod(p, bid, nblk, smem); }
#endif
  { PHASE_PARAMS(p); for (int it = bid; it < CONV_ITEMS; it += nblk) convert_item(p, 0, it); }
#if REP & 128
  { PHASE_PARAMS(p); for (int it = bid; it < CONV_ITEMS; it += nblk) convert_item(p, 0, it); }
#endif
  GRID_SYNC();
  { PHASE_PARAMS(p); stage_row(p, 0, 0, bid, nblk); }
#if REP & 16384
  { PHASE_PARAMS(p); stage_row(p, 0, 0, bid, nblk); }
#endif
  GRID_SYNC();
  run_layer<0>(bid, nblk); run_layer<1>(bid, nblk); run_layer<2>(bid, nblk); run_layer<3>(bid, nblk);
#ifdef DIAG_A
  __syncthreads();
  if (blockIdx.x == DIAG_BLK && threadIdx.x == 0) { const unsigned long long* ts_ = (const unsigned long long*)(smem + 163840 - 256); PHASE_PARAMS(pd); asm volatile("s_waitcnt vmcnt(0)" ::: "memory");
#ifdef DIAG_G
    const unsigned long long* gs_ = (const unsigned long long*)(pd.bar + 12288); const unsigned long long ta_ = __hip_atomic_load(gs_ + DIAG_A, __ATOMIC_RELAXED, __HIP_MEMORY_SCOPE_AGENT), tb_ = __hip_atomic_load(gs_ + DIAG_B, __ATOMIC_RELAXED, __HIP_MEMORY_SCOPE_AGENT);
    pd.xbuf[0] = 1000.0f * rintf(4.0f * log2f((float)(tb_ - ta_) * 10.0f));
#else
    pd.xbuf[(size_t)DIAG_BLK * 24 * 1024] = 1000.0f * rintf(4.0f * log2f((float)(ts_[DIAG_B] - ts_[DIAG_A]) * 10.0f));
#endif
  }
#endif
}

__global__ void diag_fill(float* out, long n, float v) { for (long i = blockIdx.x * 256L + threadIdx.x; i < n; i += gridDim.x * 256L) out[i] = (i == 0) ? v : 0.f; }
static size_t align_up(size_t x) { return (x + 255) & ~(size_t)255; }
static bool make_params(Params& p, void* const* d_in, void* d_out, void* d_ws, size_t ws_size) {
  const float** in = (const float**)d_in;
  p.x_prompt = in[0]; p.x_sample = in[1]; p.cache_k = in[2]; p.cache_v = in[3]; p.state_dn = in[4]; p.c = in[5]; p.c_ctx = in[6];
  p.w_mod = in[7]; p.b_mod = in[8]; p.g_pre_mix = in[9]; p.g_post_mix = in[10]; p.g_pre_mlp = in[11]; p.g_post_mlp = in[12];
  p.w_in = in[13]; p.w_conv_dn = in[14]; p.a_log = in[15]; p.dt_bias = in[16]; p.g_dn_out = in[17]; p.w_conv_sc = in[18];
  p.g_q = in[19]; p.g_k = in[20]; p.w_br_dn = in[21]; p.w_br_sc = in[22]; p.w_br_att = in[23]; p.w_out = in[24];
  p.w_mlp_up = in[25]; p.w_mlp_down = in[26];
  float* out = (float*)d_out;
  p.xbuf = out; p.out_ck = out + 6291456; p.out_cv = p.out_ck + 4194304; p.out_state = p.out_cv + 4194304;
  char* w = (char*)d_ws; size_t off = 0;
  auto take = [&](size_t bytes) { char* r = w + off; off = align_up(off + bytes); return r; };
  p.bar   = (unsigned*)take(65536);
  p.wt_in = (bfr*)take((size_t)DEPTH * NPAD * DM * 2);
  p.wt_br = (bfr*)take((size_t)DEPTH * 3 * DM * DM * 2);
  p.wt_out= (bfr*)take((size_t)DEPTH * DM * 3072 * 2);
  p.wt_up = (bfr*)take((size_t)DEPTH * HID * DM * 2);
  p.wt_dn = (bfr*)take((size_t)DEPTH * DM * HID * 2);
  p.mod   = (float*)take((size_t)DEPTH * 3 * 6144 * 4);
  p.h     = (bfr*)take((size_t)NTOK * DM * 2);
  p.P     = (bfr*)take((size_t)NTOK * NP * 2);
  p.u2    = p.P;
  p.small = (float*)take((size_t)NTOK * 32 * 4);
  p.dnrec = take((size_t)1536 * REC_BYTES);
  p.glast = (float*)take(1536 * 4);
  p.opart = (bfr*)take((size_t)2 * NTOK * DM * 2);
  p.obr   = (bfr*)take((size_t)3 * NTOK * DM * 2);
  p.Q     = (bfr*)take((size_t)NTOK * DM * 2);
  p.Kc    = (bfr*)take((size_t)NCTX * 256 * 2);
  p.Vc    = (bfr*)take((size_t)NCTX * 256 * 2);
  p.Ks    = (bfr*)take((size_t)2 * 1280 * 256 * 2);
  p.Vs    = (bfr*)take((size_t)2 * 1280 * 256 * 2);
  p.merged= (bfr*)take((size_t)NTOK * DM * 2);
  p.a3    = (bfr*)take((size_t)NTOK * 3072 * 2);
  p.R     = (float*)take((size_t)4 * NTOK * DM * 4);
  return off <= ws_size;
}
extern "C" void kernel_launch(void* const* d_in, const int* in_sizes, int n_in, void* d_out, int out_size, void* d_ws, size_t ws_size, hipStream_t stream) {
  Params p{};
  if (n_in != 27 || out_size != 31457280) { diag_fill<<<1024, 256, 0, stream>>>((float*)d_out, (long)out_size, 3.0e6f + n_in); return; }
  if (!make_params(p, d_in, d_out, d_ws, ws_size)) { diag_fill<<<1024, 256, 0, stream>>>((float*)d_out, (long)out_size, (float)(ws_size >> 20)); return; }
  static int grid_blocks = 0;
  if (!grid_blocks) {
    (void)hipFuncSetAttribute((const void*)mega_kernel, hipFuncAttributeMaxDynamicSharedMemorySize, DYN_LDS);
    int dev = 0, cus = 0, per_cu = 0;
    (void)hipGetDevice(&dev);
    (void)hipDeviceGetAttribute(&cus, hipDeviceAttributeMultiprocessorCount, dev);
    (void)hipOccupancyMaxActiveBlocksPerMultiprocessor(&per_cu, mega_kernel, 512, DYN_LDS);
    grid_blocks = (per_cu >= 1 && cus >= 256) ? 256 : cus * per_cu;
    if (grid_blocks <= 0) { fprintf(stderr, "kernel_launch: occupancy query gave cus %d per_cu %d\n", cus, per_cu); grid_blocks = 0; return; }
  }
  (void)hipMemsetAsync(p.bar, 0, 65536, stream);
  void* args[] = {&p};
  const hipError_t e = hipLaunchCooperativeKernel((void*)mega_kernel, dim3(grid_blocks), dim3(512), args, DYN_LDS, stream);
  if (e != hipSuccess) fprintf(stderr, "cooperative launch failed: %s (grid %d)\n", hipGetErrorString(e), grid_blocks);
}
```

```cpp
#define USE_CG_SYNC 0
#include <hip/hip_runtime.h>
#include <hip/hip_bf16.h>
#include <hip/hip_cooperative_groups.h>
#include <cstdio>
#include <cstdint>
namespace cg = cooperative_groups;

typedef unsigned short bfr;
using bf16x8 = __attribute__((ext_vector_type(8))) short;
using s16x4  = __attribute__((ext_vector_type(4))) short;
using f32x4  = __attribute__((ext_vector_type(4))) float;
using f32x16 = __attribute__((ext_vector_type(16))) float;
using u32x4  = __attribute__((ext_vector_type(4))) unsigned;
using u32x2  = __attribute__((ext_vector_type(2))) unsigned;

extern __shared__ __attribute__((aligned(16))) char smem[];
__device__ __forceinline__ char* smem_base() { return smem; }
constexpr int DM = 1024, NTOK = 6144, NCTX = 4096, DEPTH = 4;
constexpr int NIN = 11808;
constexpr int NP = 11776;
constexpr int NPAD = 12032;
constexpr int HID = 4096;
constexpr float EPS = 1e-6f;
constexpr int C_DQ = 0, C_DK = 1024, C_DV = 2048, C_DG = 3072, C_SB = 4096, C_SCG = 5120, C_SX = 6144,
              C_AQ = 7168, C_AK = 8192, C_AV = 8448, C_MG = 8704;

constexpr int REC_U = 0, REC_W = 16384, REC_QD = 32768, REC_QK = 49152, REC_KD = 57344, REC_BYTES = 73728;

struct Params {
  const float *x_prompt, *x_sample, *cache_k, *cache_v, *state_dn, *c, *c_ctx, *w_mod, *b_mod;
  const float *g_pre_mix, *g_post_mix, *g_pre_mlp, *g_post_mlp, *w_in, *w_conv_dn, *a_log, *dt_bias, *g_dn_out;
  const float *w_conv_sc, *g_q, *g_k, *w_br_dn, *w_br_sc, *w_br_att, *w_out, *w_mlp_up, *w_mlp_down;
  float *xbuf;
  float *out_ck, *out_cv, *out_state;
  bfr *wt_in, *wt_br, *wt_out, *wt_up, *wt_dn;
  float *mod;
  bfr *h;
  bfr *P;
  float *small;
  char *dnrec;
  float *glast;
  bfr *opart;
  bfr *obr;
  bfr *Q;
  bfr *Kc, *Vc;
  bfr *Ks, *Vs;
  bfr *merged;
  bfr *a3;
  float *R;
  bfr *u2;
  unsigned *bar;
};

__device__ __forceinline__ bfr f2bf(float f) { unsigned u = __float_as_uint(f); u += 0x7fffu + ((u >> 16) & 1u); return (bfr)(u >> 16); }
__device__ __forceinline__ float bf2f(bfr b) { return __uint_as_float(((unsigned)b) << 16); }
__device__ __forceinline__ unsigned pack2(float a, float b) { return (unsigned)f2bf(a) | ((unsigned)f2bf(b) << 16); }
__device__ __forceinline__ unsigned pack2hw(float a, float b) { unsigned r; asm("v_cvt_pk_bf16_f32 %0, %1, %2" : "=v"(r) : "v"(a), "v"(b)); return r; }
__device__ __forceinline__ float sigmoidf_(float x) { return 1.f / (1.f + __expf(-x)); }
__device__ __forceinline__ float siluf_(float x) { return x * __builtin_amdgcn_rcpf(1.f + __expf(-x)); }
__device__ __forceinline__ float softplusf_(float x) { return x > 20.f ? x : log1pf(__expf(x)); }

__device__ __forceinline__ int tok_modrow(int t) { return t < NCTX ? 0 : 1 + ((t - NCTX) >> 10); }
__device__ __forceinline__ int tok_L(int t) { return t < NCTX ? 256 : 1024; }
__device__ __forceinline__ int tok_pos(int t) { return t < NCTX ? (t & 255) : ((t - NCTX) & 1023); }

__host__ __device__ __forceinline__ int perm_col(int n) { return n < 4096 ? n : (n < 4128 ? NP + (n - 4096) : n - 32); }

__device__ __forceinline__ int tid_opaque() { int t = threadIdx.x; asm volatile("" : "+v"(t)); return t; }

#ifdef DIAG_A
#ifndef DIAG_BLK
#define DIAG_BLK 0
#endif
#define TSTAMP(k) do { if (blockIdx.x == DIAG_BLK && threadIdx.x == 0) { unsigned long long* ts_ = (unsigned long long*)(smem_base() + 163840 - 256); if (ts_[(k)] == 0ull) ts_[(k)] = wall_clock64(); } } while (0)
#else
#define TSTAMP(k) do {} while (0)
#endif

#ifdef DIAG_A
#define GSTAMP(bar, k) do { if (threadIdx.x == 0) __hip_atomic_store((unsigned long long*)((bar) + 12288) + (k), (unsigned long long)wall_clock64(), __ATOMIC_RELAXED, __HIP_MEMORY_SCOPE_AGENT); } while (0)
#else
#define GSTAMP(bar, k) do {} while (0)
#endif

#ifdef DIAG_G
#define GMAX(bar, k) do { if (threadIdx.x == 0) __hip_atomic_fetch_max((unsigned long long*)((bar) + 12288) + (k), (unsigned long long)wall_clock64(), __ATOMIC_RELAXED, __HIP_MEMORY_SCOPE_AGENT); } while (0)
#else
#define GMAX(bar, k) do {} while (0)
#endif
#define NTHR 512

__device__ __forceinline__ void stage_mod(const Params& p, int bid, int nblk, char* lds) {
  float* s = (float*)lds;
  float* red = s + 3072;
  const int tid = tid_opaque();
  for (int i = tid; i < 3072; i += NTHR) { int j = i >> 10, k = i & 1023; float c = (j == 0) ? p.c_ctx[k] : p.c[(j - 1) * 1024 + k]; s[i] = siluf_(c); }
  __syncthreads();
  for (int item = bid; item < 192; item += nblk) {
    const int l = item / 48, nb = item % 48, cq = tid & 31, ks = tid >> 5;
    const float* W = p.w_mod + ((size_t)l * 1024 + ks * 64) * 6144 + nb * 128 + cq * 4;
    float a[3][4] = {};
    for (int k = 0; k < 64; ++k) {
      const float4 w = *(const float4*)(W + (size_t)k * 6144);
#pragma unroll
      for (int j = 0; j < 3; ++j) { const float sv = s[j * 1024 + ks * 64 + k]; a[j][0] += sv * w.x; a[j][1] += sv * w.y; a[j][2] += sv * w.z; a[j][3] += sv * w.w; }
    }
    __syncthreads();
#pragma unroll
    for (int j = 0; j < 3; ++j)
#pragma unroll
      for (int q = 0; q < 4; ++q) red[(ks * 3 + j) * 128 + cq * 4 + q] = a[j][q];
    __syncthreads();
    if (tid < 384) { const int j = tid >> 7, n = tid & 127; float sum = 0; for (int q = 0; q < 16; ++q) sum += red[(q * 3 + j) * 128 + n];
      p.mod[(size_t)(l * 3 + j) * 6144 + nb * 128 + n] = sum + p.b_mod[l * 6144 + nb * 128 + n]; }
  }
  __syncthreads();
}

__device__ __forceinline__ float wave_sum(float v) {
#pragma unroll
  for (int o = 32; o > 0; o >>= 1) v += __shfl_xor(v, o);
  return v;
}

template <int NR>
__device__ __forceinline__ void rows_at(const Params& p, int l, int mode, int row0, int lane) {
  float4 x[NR][4], r[NR][4];
#pragma unroll
  for (int j = 0; j < NR; ++j) {
    const int row = row0 + j;
    if (l == 0 && mode <= 1) {
      const float* xin = row < NCTX ? p.x_prompt + (size_t)row * DM : p.x_sample + (size_t)(row - NCTX) * DM;
#pragma unroll
      for (int i = 0; i < 4; ++i) x[j][i] = *(const float4*)(xin + lane * 4 + 256 * i);
    } else {
      const bfr* xin = p.merged + (size_t)row * DM;
#pragma unroll
      for (int i = 0; i < 4; ++i) { const u32x2 a = *(const u32x2*)(xin + lane * 4 + 256 * i);
        x[j][i] = make_float4(__uint_as_float(a[0] << 16), __uint_as_float(a[0] & 0xffff0000u), __uint_as_float(a[1] << 16), __uint_as_float(a[1] & 0xffff0000u)); }
    }
    if (mode != 0) {
      const bfr* rr = (const bfr*)p.R + (size_t)row * DM;
#pragma unroll
      for (int i = 0; i < 4; ++i) { const u32x2 a = *(const u32x2*)(rr + lane * 4 + 256 * i), b = *(const u32x2*)(rr + (size_t)NTOK * DM + lane * 4 + 256 * i);
        r[j][i] = make_float4(__uint_as_float(a[0] << 16) + __uint_as_float(b[0] << 16), __uint_as_float(a[0] & 0xffff0000u) + __uint_as_float(b[0] & 0xffff0000u),
                              __uint_as_float(a[1] << 16) + __uint_as_float(b[1] << 16), __uint_as_float(a[1] & 0xffff0000u) + __uint_as_float(b[1] & 0xffff0000u)); }
    }
  }
  if (mode != 0) {
    const float* gpost = (mode == 1 ? p.g_post_mix : p.g_post_mlp) + l * DM;
    float4 g[4];
#pragma unroll
    for (int i = 0; i < 4; ++i) g[i] = *(const float4*)(gpost + lane * 4 + 256 * i);
#pragma unroll
    for (int j = 0; j < NR; ++j) {
      const int row = row0 + j;
      const float* gate = p.mod + (size_t)(l * 3 + tok_modrow(row)) * 6144 + (mode == 1 ? 2048 : 5120);
      float ss = 0;
#pragma unroll
      for (int i = 0; i < 4; ++i) ss += r[j][i].x * r[j][i].x + r[j][i].y * r[j][i].y + r[j][i].z * r[j][i].z + r[j][i].w * r[j][i].w;
      ss = wave_sum(ss);
      const float nrm = rsqrtf(ss * (1.f / DM) + EPS);
#pragma unroll
      for (int i = 0; i < 4; ++i) {
        const float4 gt = *(const float4*)(gate + lane * 4 + 256 * i);
        x[j][i].x += gt.x * (r[j][i].x * nrm * g[i].x); x[j][i].y += gt.y * (r[j][i].y * nrm * g[i].y); x[j][i].z += gt.z * (r[j][i].z * nrm * g[i].z); x[j][i].w += gt.w * (r[j][i].w * nrm * g[i].w);
        if (mode == 2 && l == DEPTH - 1) *(float4*)(p.xbuf + (size_t)row * DM + lane * 4 + 256 * i) = x[j][i];
        else { u32x2 o = {pack2hw(x[j][i].x, x[j][i].y), pack2hw(x[j][i].z, x[j][i].w)}; *(u32x2*)(p.merged + (size_t)row * DM + lane * 4 + 256 * i) = o; }
      }
    }
  }
  if (mode == 2 && l == DEPTH - 1) return;
  const int ln = (mode == 2) ? l + 1 : l;
  const float* gpre = (mode == 1 ? p.g_pre_mlp : p.g_pre_mix) + ln * DM;
  float4 gp[4];
#pragma unroll
  for (int i = 0; i < 4; ++i) gp[i] = *(const float4*)(gpre + lane * 4 + 256 * i);
#pragma unroll
  for (int j = 0; j < NR; ++j) {
    const int row = row0 + j;
    const float* modn = p.mod + (size_t)(ln * 3 + tok_modrow(row)) * 6144;
    const float* sh = modn + (mode == 1 ? 3072 : 0);
    const float* sc = modn + (mode == 1 ? 4096 : 1024);
    float ss = 0;
#pragma unroll
    for (int i = 0; i < 4; ++i) ss += x[j][i].x * x[j][i].x + x[j][i].y * x[j][i].y + x[j][i].z * x[j][i].z + x[j][i].w * x[j][i].w;
    ss = wave_sum(ss);
    const float nrm = rsqrtf(ss * (1.f / DM) + EPS);
#pragma unroll
    for (int i = 0; i < 4; ++i) {
      const float4 s1 = *(const float4*)(sc + lane * 4 + 256 * i), s0 = *(const float4*)(sh + lane * 4 + 256 * i);
      const float h0 = x[j][i].x * nrm * gp[i].x * (1.f + s1.x) + s0.x, h1 = x[j][i].y * nrm * gp[i].y * (1.f + s1.y) + s0.y;
      const float h2 = x[j][i].z * nrm * gp[i].z * (1.f + s1.z) + s0.z, h3 = x[j][i].w * nrm * gp[i].w * (1.f + s1.w) + s0.w;
      u32x2 o = {pack2hw(h0, h1), pack2hw(h2, h3)};
      *(u32x2*)(p.h + (size_t)row * DM + lane * 4 + 256 * i) = o;
    }
  }
}

__device__ __forceinline__ void stage_row(const Params& p, int l, int mode, int bid, int nblk) {
  const int tx_ = tid_opaque(), wid = tx_ >> 6, lane = tx_ & 63;
  const int row0 = (bid * 8 + wid) * 3;
  if (row0 >= NTOK) return;
  rows_at<3>(p, l, mode, row0, lane);
}

__device__ __forceinline__ void unpack8(const u32x4 v, float* f) {
#pragma unroll
  for (int i = 0; i < 4; ++i) { f[2 * i] = __uint_as_float(v[i] << 16); f[2 * i + 1] = __uint_as_float(v[i] & 0xffff0000u); }
}
__device__ __forceinline__ u32x4 pack8(const float* f) { u32x4 v = {pack2(f[0], f[1]), pack2(f[2], f[3]), pack2(f[4], f[5]), pack2(f[6], f[7])}; return v; }
__device__ __forceinline__ u32x4 pack8hw(const float* f) { u32x4 v = {pack2hw(f[0], f[1]), pack2hw(f[2], f[3]), pack2hw(f[4], f[5]), pack2hw(f[6], f[7])}; return v; }

__device__ __forceinline__ void light_prep_item(const Params& p, int l, int item) {
  const int tid = tid_opaque(), t0 = item * 16;
  const bool samp = t0 >= NCTX;
  {
    const float* wsc = p.w_conv_sc + (size_t)l * 3 * DM;
    bfr* scin = p.obr + (size_t)1 * NTOK * DM;
    const int g = tid & 127, rq = tid >> 7, r0 = rq * 4, tA = t0 + r0, posA = tok_pos(tA), L = tok_L(tA);
    u32x4 cg[6], cx[6], sbv[4];
#pragma unroll
    for (int k = 0; k < 6; ++k) {
      const int pos = posA + k - 1;
      cg[k] = u32x4{0u, 0u, 0u, 0u}; cx[k] = u32x4{0u, 0u, 0u, 0u};
      if (pos >= 0 && pos < L) { const bfr* row = p.P + (size_t)(tA + k - 1) * NP; cg[k] = *(const u32x4*)(row + C_SCG + g * 8); cx[k] = *(const u32x4*)(row + C_SX + g * 8); }
    }
#pragma unroll
    for (int r = 0; r < 4; ++r) sbv[r] = *(const u32x4*)(p.P + (size_t)(tA + r) * NP + C_SB + g * 8);
    float w[3][8];
#pragma unroll
    for (int k = 0; k < 3; ++k) { *(float4*)&w[k][0] = *(const float4*)(wsc + k * DM + g * 8); *(float4*)&w[k][4] = *(const float4*)(wsc + k * DM + g * 8 + 4); }
    float prod[6][8];
#pragma unroll
    for (int k = 0; k < 6; ++k) { float a[8], b[8]; unpack8(cg[k], a); unpack8(cx[k], b);
#pragma unroll
      for (int q = 0; q < 8; ++q) prod[k][q] = a[q] * b[q]; }
#pragma unroll
    for (int r = 0; r < 4; ++r) {
      float sb[8], acc[8]; unpack8(sbv[r], sb);
#pragma unroll
      for (int q = 0; q < 8; ++q) acc[q] = sb[q] * (w[0][q] * prod[r][q] + w[1][q] * prod[r + 1][q] + w[2][q] * prod[r + 2][q]);
      *(u32x4*)(scin + (size_t)(tA + r) * DM + g * 8) = pack8hw(acc);
    }
  }
  {
    const int sub = tid & 15;
    u32x4 xin[5];
#pragma unroll
    for (int it5 = 0; it5 < 5; ++it5) {
      const int pr = (tid >> 4) + it5 * 32, r = pr / 10, hh = pr % 10, t = t0 + r;
      xin[it5] = *(const u32x4*)(p.P + (size_t)t * NP + (hh < 8 ? C_AQ + hh * 128 : C_AK + (hh - 8) * 128) + sub * 8);
    }
#pragma unroll
    for (int it5 = 0; it5 < 5; ++it5) {
      const int pr = (tid >> 4) + it5 * 32;
      const int r = pr / 10, hh = pr % 10, t = t0 + r;
      const bool isq = hh < 8;
      float x[8]; unpack8(xin[it5], x);
      float ss = 0;
#pragma unroll
      for (int q = 0; q < 8; ++q) ss += x[q] * x[q];
      ss += __shfl_xor(ss, 1); ss += __shfl_xor(ss, 2); ss += __shfl_xor(ss, 4); ss += __shfl_xor(ss, 8);
      const float nrm = rsqrtf(ss * (1.f / 128.f) + EPS);
      const float* g = (isq ? p.g_q : p.g_k) + l * 128 + sub * 8;
#pragma unroll
      for (int q = 0; q < 8; ++q) x[q] = x[q] * nrm * g[q];
      if (samp) {
        const int pos = tok_pos(t);
        const float pidx = (sub < 8) ? (float)(pos >> 6) : (float)(pos & 63);
        const int s8 = sub & 7;
        const bool lo = s8 < 4;
        float y[8];
#pragma unroll
        for (int q = 0; q < 8; ++q) {
          const float other = __shfl_xor(x[q], 4);
          const int fi = (s8 & 3) * 8 + q;
          const float freq = exp2f(-(float)fi * (13.287712379549449f / 32.f));
          const float ang = pidx * freq;
          float sn, cs; __sincosf(ang, &sn, &cs);
          y[q] = lo ? (x[q] * cs - other * sn) : (other * sn + x[q] * cs);
        }
#pragma unroll
        for (int q = 0; q < 8; ++q) x[q] = y[q];
      }
      if (isq) {
        *(u32x4*)(p.Q + (size_t)t * DM + hh * 128 + sub * 8) = pack8hw(x);
      } else {
        const int kvh = hh - 8;
        if (!samp) {
          *(u32x4*)(p.Kc + (size_t)t * 256 + kvh * 128 + sub * 8) = pack8hw(x);
          const int b = t >> 8, pos = t & 255;
          float* o = p.out_ck + ((((size_t)b * DEPTH + l) * 256 + pos) * 2 + kvh) * 128 + sub * 8;
          *(float4*)o = make_float4(x[0], x[1], x[2], x[3]); *(float4*)(o + 4) = make_float4(x[4], x[5], x[6], x[7]);
        } else {
          const int s = t - NCTX, b = s >> 10, pos = s & 1023;
          *(u32x4*)(p.Ks + ((size_t)b * 1280 + 256 + pos) * 256 + kvh * 128 + sub * 8) = pack8hw(x);
        }
      }
    }
  }
  for (int idx = tid; idx < 16 * 32; idx += NTHR) {
    const int r = idx >> 5, g = idx & 31, t = t0 + r;
    const u32x4 v = *(const u32x4*)(p.P + (size_t)t * NP + C_AV + g * 8);
    if (!samp) {
      *(u32x4*)(p.Vc + (size_t)t * 256 + g * 8) = v;
      float f[8]; unpack8(v, f);
      const int b = t >> 8, pos = t & 255;
      float* o = p.out_cv + (((size_t)b * DEPTH + l) * 256 + pos) * 256 + g * 8;
      *(float4*)o = make_float4(f[0], f[1], f[2], f[3]); *(float4*)(o + 4) = make_float4(f[4], f[5], f[6], f[7]);
    } else {
      const int s = t - NCTX, b = s >> 10, pos = s & 1023;
      *(u32x4*)(p.Vs + ((size_t)b * 1280 + 256 + pos) * 256 + g * 8) = v;
    }
  }
  if (samp) {
    const int cs = item - 256, b = cs >> 6, pos0 = (cs & 63) * 4;
    for (int idx = tid; idx < 2 * 4 * 32; idx += NTHR) {
      const int which = idx >> 7, r = (idx >> 5) & 3, g = idx & 31, pos = pos0 + r;
      const float* src = (which ? p.cache_v : p.cache_k) + (((size_t)b * DEPTH + l) * 256 + pos) * 256 + g * 8;
      float f[8]; *(float4*)f = *(const float4*)src; *(float4*)(f + 4) = *(const float4*)(src + 4);
      *(u32x4*)((which ? p.Vs : p.Ks) + ((size_t)b * 1280 + pos) * 256 + g * 8) = pack8hw(f);
    }
  }
}

__device__ __forceinline__ void dn_finalize(const Params& p, int l, int t0, int n, int h, int tid0, int nthr) {
  const int sub = tid0 & 15, rpp = nthr / 16;
  const float* g = p.g_dn_out + l * 128 + sub * 8;
  float gv[8];
#pragma unroll
  for (int q = 0; q < 8; ++q) gv[q] = g[q];
  for (int r = tid0 >> 4; r < n; r += rpp * 4) {
    u32x4 va[4], vb[4], vg[4];
#pragma unroll
    for (int u = 0; u < 4; ++u) {
      const int t = t0 + r + u * rpp;
      va[u] = *(const u32x4*)(p.opart + (size_t)t * DM + h * 128 + sub * 8);
      vb[u] = *(const u32x4*)(p.opart + (size_t)NTOK * DM + (size_t)t * DM + h * 128 + sub * 8);
      vg[u] = *(const u32x4*)(p.P + (size_t)t * NP + C_DG + h * 128 + sub * 8);
    }
#pragma unroll
    for (int u = 0; u < 4; ++u) {
      const int t = t0 + r + u * rpp;
      float a[8], b[8], dg[8];
      unpack8(va[u], a); unpack8(vb[u], b); unpack8(vg[u], dg);
      float ss = 0;
#pragma unroll
      for (int q = 0; q < 8; ++q) { a[q] += b[q]; ss += a[q] * a[q]; }
      ss += __shfl_xor(ss, 1); ss += __shfl_xor(ss, 2); ss += __shfl_xor(ss, 4); ss += __shfl_xor(ss, 8);
      const float nrm = rsqrtf(ss * (1.f / 128.f) + EPS);
#pragma unroll
      for (int q = 0; q < 8; ++q) a[q] = a[q] * nrm * gv[q] * siluf_(dg[q]);
      *(u32x4*)(p.obr + (size_t)t * DM + h * 128 + sub * 8) = pack8hw(a);
    }
  }
}
constexpr int HT_BYTES = 128 * 64 * 2;

__device__ __forceinline__ int lds_byte(int r, int c) {
  int st = (r >> 4) * 2 + (c >> 5), rr = r & 15, cc = c & 31, ob = rr * 64 + cc * 2;
  return st * 1024 + (ob ^ (((ob >> 9) & 1) << 5));
}
__device__ __forceinline__ void stage_rc(int b, int& R, int& C) {
  int st = b / 1024, sb = b % 1024, swz = sb ^ (((sb >> 9) & 1) << 5);
  R = (st >> 1) * 16 + swz / 64; C = (st & 1) * 32 + (swz % 64) / 2;
}
__device__ __forceinline__ void stage_half(const bfr* G, long ld, int row0, int k0, int loff, int tx) {
#pragma unroll
  for (int i = 0; i < 2; ++i) {
    const int b = tx * 16 + i * 8192; int r, c; stage_rc(b, r, c);
    __builtin_amdgcn_global_load_lds((const unsigned*)(G + (long)(row0 + r) * ld + k0 + c), (__attribute__((address_space(3))) unsigned*)(smem + loff + b), 16, 0, 0);
  }
}

template <int NB, class AccT>
__device__ __forceinline__ void gemm_mainloop(const bfr* A, long lda, const bfr* Bt, long ldb, int K, int brow, int bcol, AccT& acc, int tx) {
  const int wid = tx >> 6, lane = tx & 63, wr = wid >> 2, wc = wid & 3, fr = lane & 15, fq = lane >> 4;
  constexpr int STG = (2 + NB) * HT_BYTES;
  const int nt = K / 64;
  auto stage = [&](int s, int kt) {
    stage_half(A, lda, brow, kt * 64, s * STG, tx);
    stage_half(A, lda, brow + 128, kt * 64, s * STG + HT_BYTES, tx);
#pragma unroll
    for (int j = 0; j < NB; ++j) stage_half(Bt, ldb, bcol + j * 128, kt * 64, s * STG + (2 + j) * HT_BYTES, tx);
  };
  stage(0, 0);
  asm volatile("s_waitcnt vmcnt(0)" ::: "memory");
  __syncthreads();
  for (int t = 0; t < nt; ++t) {
    const int s = t & 1;
    if (t + 1 < nt) stage(s ^ 1, t + 1);
    const char* base = smem + s * STG;
    bf16x8 Bf[NB][2][2];
#pragma unroll
    for (int j = 0; j < NB; ++j)
#pragma unroll
      for (int n = 0; n < 2; ++n)
#pragma unroll
        for (int k = 0; k < 2; ++k) Bf[j][n][k] = *(const bf16x8*)(base + (2 + j) * HT_BYTES + lds_byte(wc * 32 + n * 16 + fr, k * 32 + fq * 8));
#pragma unroll
    for (int ai = 0; ai < 2; ++ai) {
      bf16x8 Af[4][2];
#pragma unroll
      for (int m = 0; m < 4; ++m)
#pragma unroll
        for (int k = 0; k < 2; ++k) Af[m][k] = *(const bf16x8*)(base + ai * HT_BYTES + lds_byte(wr * 64 + m * 16 + fr, k * 32 + fq * 8));
#pragma unroll
      for (int j = 0; j < NB; ++j)
#pragma unroll
        for (int m = 0; m < 4; ++m)
#pragma unroll
          for (int n = 0; n < 2; ++n)
#pragma unroll
            for (int k = 0; k < 2; ++k) acc.a[ai][j][m][n] = __builtin_amdgcn_mfma_f32_16x16x32_bf16(Af[m][k], Bf[j][n][k], acc.a[ai][j][m][n], 0, 0, 0);
    }
    asm volatile("s_waitcnt vmcnt(0)" ::: "memory");
    __syncthreads();
  }
}
template <int NB> struct Acc { f32x4 a[2][NB][4][2]; };
template <int NB> __device__ __forceinline__ void acc_zero(Acc<NB>& acc) {
#pragma unroll
  for (int ai = 0; ai < 2; ++ai)
#pragma unroll
    for (int j = 0; j < NB; ++j)
#pragma unroll
      for (int m = 0; m < 4; ++m)
#pragma unroll
        for (int n = 0; n < 2; ++n) acc.a[ai][j][m][n] = f32x4{0.f, 0.f, 0.f, 0.f};
}
template <int NB, class F> __device__ __forceinline__ void acc_foreach(Acc<NB>& acc, int brow, int bcol, int tx, F f) {
  const int wid = tx >> 6, lane = tx & 63, wr = wid >> 2, wc = wid & 3, fr = lane & 15, fq = lane >> 4;
#pragma unroll
  for (int ai = 0; ai < 2; ++ai)
#pragma unroll
    for (int j = 0; j < NB; ++j)
#pragma unroll
      for (int m = 0; m < 4; ++m)
#pragma unroll
        for (int n = 0; n < 2; ++n)
#pragma unroll
          for (int q = 0; q < 4; ++q) f(brow + ai * 128 + wr * 64 + m * 16 + fq * 4 + q, bcol + j * 128 + wc * 32 + n * 16 + fr, acc.a[ai][j][m][n][q]);
}

template <class MapF>
__device__ __forceinline__ void convert_tile(const float* W, int N, int kt, int ntile, bfr* dst, int ldd, MapF mapf, int ncopy = 1, int cstride = 0) {
  float* tile = (float*)smem;
  const int tid = tid_opaque();
  __syncthreads();
  float4 v[8];
#pragma unroll
  for (int pass = 0; pass < 8; ++pass) {
    const int idx = tid + pass * 512, kr = idx >> 6, c4 = idx & 63, n = ntile * 256 + c4 * 4;
    v[pass] = make_float4(0.f, 0.f, 0.f, 0.f);
    if (n < N) v[pass] = *(const float4*)(W + (size_t)(kt * 64 + kr) * N + n);
  }
#pragma unroll
  for (int pass = 0; pass < 8; ++pass) {
    const int idx = tid + pass * 512, kr = idx >> 6, c4 = idx & 63;
    tile[kr * 257 + c4 * 4 + 0] = v[pass].x; tile[kr * 257 + c4 * 4 + 1] = v[pass].y; tile[kr * 257 + c4 * 4 + 2] = v[pass].z; tile[kr * 257 + c4 * 4 + 3] = v[pass].w;
  }
  __syncthreads();
#pragma unroll
  for (int rep = 0; rep < 4; ++rep) {
    const int nn = (tid >> 3) + rep * 64, kg = tid & 7, n = ntile * 256 + nn;
    if (n < N) {
      float f[8];
#pragma unroll
      for (int j = 0; j < 8; ++j) f[j] = tile[(kg * 8 + j) * 257 + nn];
      const u32x4 pk = pack8hw(f);
      for (int cp = 0; cp < ncopy; ++cp) *(u32x4*)(dst + (size_t)mapf(n) * ldd + cp * cstride + kt * 64 + kg * 8) = pk;
    }
  }
}
constexpr int CONV_ITEMS = 1576;
__device__ __forceinline__ void convert_item(const Params& p, int l, int it) {
  if (it < 752) { const int kt = it / 47, nt = it % 47; convert_tile(p.w_in + (size_t)l * DM * NIN, NIN, kt, nt, p.wt_in + (size_t)l * NPAD * DM, DM, [](int n) { return perm_col(n); }); }
  else if (it < 944) { const int j = it - 752, br = j >> 6, kt = (j >> 2) & 15, nt = j & 3;
    const float* W = p.w_br_dn; if (br == 1) W = p.w_br_sc; if (br == 2) W = p.w_br_att; W += (size_t)l * DM * DM;
    convert_tile(W, DM, kt, nt, p.wt_br + ((size_t)l * 3 + br) * DM * DM, DM, [](int n) { return n; }); }
  else if (it < 1008) { const int j = it - 944, kt = j >> 2, nt = j & 3; convert_tile(p.w_out + (size_t)l * DM * DM, DM, kt, nt, p.wt_out + (size_t)l * DM * 3072, 3072, [](int n) { return n; }, 3, 1024); }
  else if (it < 1264) { const int j = it - 1008, kt = j >> 4, nt = j & 15; convert_tile(p.w_mlp_up + (size_t)l * DM * HID, HID, kt, nt, p.wt_up + (size_t)l * HID * DM, DM, [](int n) { return n; }); }
  else if (it < 1520) { const int j = it - 1264, kt = j >> 2, nt = j & 3; convert_tile(p.w_mlp_down + (size_t)l * HID * DM, DM, kt, nt, p.wt_dn + (size_t)l * DM * HID, HID, [](int n) { return n; }); }
  else { const int j = it - 1520;
    bfr* d = p.wt_in + ((size_t)l * NPAD + NP + 32 + j * 4) * DM;
    *(u32x4*)(d + tid_opaque() * 8) = u32x4{0u, 0u, 0u, 0u}; }
}

__device__ __forceinline__ void gemm_in_tile(const Params& p, int l, int tile) {
  const int mt = tile % 24, nt = tile / 24, brow = mt * 256, bcol = nt * 256;
  const int tx = tid_opaque(); Acc<2> acc; acc_zero(acc);
  gemm_mainloop<2>(p.h, DM, p.wt_in + (size_t)l * NPAD * DM, DM, DM, brow, bcol, acc, tx);
  if (nt < 34) acc_foreach(acc, brow, bcol, tx, [&](int r, int c, float v) { p.P[(size_t)r * NP + c] = f2bf(v); });
  else if (nt < 46) acc_foreach(acc, brow, bcol, tx, [&](int r, int c, float v) { p.P[(size_t)r * NP + c] = f2bf(sigmoidf_(v)); });
  else acc_foreach(acc, brow, bcol, tx, [&](int r, int c, float v) { if (c < NP + 32) p.small[(size_t)r * 32 + (c - NP)] = v; });
}
__device__ __forceinline__ void gemm_up_tile(const Params& p, int l, int tile) {
  const int mt = tile % 24, nt = tile / 24, brow = mt * 256, bcol = nt * 256;
  const int tx = tid_opaque(); Acc<2> acc; acc_zero(acc);
  gemm_mainloop<2>(p.h, DM, p.wt_up + (size_t)l * HID * DM, DM, DM, brow, bcol, acc, tx);
  acc_foreach(acc, brow, bcol, tx, [&](int r, int c, float v) { const float x = fmaxf(v, 0.f); p.u2[(size_t)r * HID + c] = f2bf(x * x); });
}
__device__ __forceinline__ void gemm_out_tile(const Params& p, int l, int tile) {
  const int mt = tile % 24, nt = tile / 24, brow = mt * 256, bcol = nt * 128;
  const int tx = tid_opaque(); Acc<1> acc; acc_zero(acc);
  gemm_mainloop<1>(p.merged, DM, p.wt_out + (size_t)l * DM * DM, DM, DM, brow, bcol, acc, tx);
  acc_foreach(acc, brow, bcol, tx, [&](int r, int c, float v) { p.R[(size_t)r * DM + c] = v; });
}
__device__ __forceinline__ void gemm_down_tile(const Params& p, int l, int tile) {
  const int mt = tile % 24, nt = tile / 24, brow = mt * 256, bcol = nt * 128;
  const int tx = tid_opaque(); Acc<1> acc; acc_zero(acc);
  gemm_mainloop<1>(p.u2, HID, p.wt_dn + (size_t)l * DM * HID, HID, HID, brow, bcol, acc, tx);
  acc_foreach(acc, brow, bcol, tx, [&](int r, int c, float v) { p.R[(size_t)r * DM + c] = v; });
}
__device__ __forceinline__ void gemm_br_tile(const Params& p, int l, int tile) {
  const int mt = tile % 24, nt = tile / 24, brow = mt * 256, bcol = nt * 128;
  const int tx = tid_opaque(); Acc<1> tot; acc_zero(tot);
#pragma unroll 1
  for (int br = 0; br < 3; ++br) {
    Acc<1> acc; acc_zero(acc);
    gemm_mainloop<1>(p.obr + (size_t)br * NTOK * DM, DM, p.wt_br + ((size_t)l * 3 + br) * DM * DM, DM, DM, brow, bcol, acc, tx);
    const bfr* G = p.P + C_MG + br * DM;
    const int wid = tx >> 6, lane = tx & 63, wr = wid >> 2, wc = wid & 3, fr = lane & 15, fq = lane >> 4;
    const bfr* Gl = G + (size_t)(brow + wr * 64 + fq * 4) * NP + bcol + wc * 32 + fr;
#pragma unroll
    for (int ai = 0; ai < 2; ++ai)
#pragma unroll
      for (int m = 0; m < 4; ++m) {
        const bfr* Gm = Gl + (size_t)(ai * 128 + m * 16) * NP;
        asm volatile("" : "+v"(Gm) :: "memory");
#pragma unroll
        for (int n = 0; n < 2; ++n)
#pragma unroll
          for (int q = 0; q < 4; ++q) tot.a[ai][0][m][n][q] += bf2f(Gm[q * NP + n * 16]) * acc.a[ai][0][m][n][q];
      }
  }
  acc_foreach(tot, brow, bcol, tx, [&](int r, int c, float v) { p.merged[(size_t)r * DM + c] = f2bf(v); });
}
namespace pg8 {
#define PG8_LAS __attribute__((address_space(3)))
constexpr int BM = 256, BK = 64, HALF = 128, HTB = HALF * BK * 2, STAGE_BYTES = 8 * HTB;
__device__ __forceinline__ int perm32(int rho) { const int n = rho >> 4, i = rho & 15; return 8 * (i >> 2) + 4 * n + (i & 3); }
struct Unit { int pm, pn, z; size_t ka, kb; };
struct Gemm { const bfr* A; const bfr* Bt; int lda, ldb, K; };

template <class Epi, class Sched>
__device__ __forceinline__ void gemm_phase(const Gemm g, const Sched& S, const Epi& E) {
  PG8_LAS unsigned char* lds = (PG8_LAS unsigned char*)smem;
  const int tid = tid_opaque(), wid = __builtin_amdgcn_readfirstlane(tid >> 6), lane = tid & 63, wr = wid >> 2, wc = wid & 3, fr = lane & 15, fq = lane >> 4;
  const int K = g.K, nt = K / BK;
  unsigned voffA[2], voffB[2];
#pragma unroll
  for (int i = 0; i < 2; ++i) { int R, C; stage_rc(tid * 16 + i * 8192, R, C); const int Rb = Epi::PERM ? ((R & ~31) + perm32(R & 31)) : R;
    voffA[i] = (unsigned)(R * g.lda + C) * 2u; voffB[i] = (unsigned)(Rb * g.ldb + C) * 2u; }
  const size_t kstep = (size_t)(BK * 2);
  const size_t hstepA = (size_t)HALF * g.lda * 2, hstepB = (size_t)HALF * g.ldb * 2;
  const unsigned ldsw = (unsigned)wid * 1024u;
  const int aoff = lds_byte(wr * 64 + fr, fq * 8), boff = lds_byte(wc * 32 + fr, fq * 8);
#define PG8_SA(b, h) (((b) * 2 + (h)) * HTB)
#define PG8_SB(b, h) ((4 + (b) * 2 + (h)) * HTB)
#define PG8_STAGE(bufoff, gbase, voff) do { _Pragma("unroll") for (int _i = 0; _i < 2; ++_i) \
    __builtin_amdgcn_global_load_lds((const unsigned*)((const char*)(gbase) + (voff)[_i]), (PG8_LAS unsigned*)(lds + (bufoff) + ldsw + _i * 8192), 16, 0, 0); } while (0)
#define PG8_LDA(dst, b, h) do { _Pragma("unroll") for (int m = 0; m < 4; ++m) _Pragma("unroll") for (int k = 0; k < 2; ++k) dst[m][k] = *(const PG8_LAS bf16x8*)(lds + PG8_SA(b, h) + aoff + m * 2048 + k * 1024); } while (0)
#define PG8_LDB(dst, b, h) do { _Pragma("unroll") for (int n = 0; n < 2; ++n) _Pragma("unroll") for (int k = 0; k < 2; ++k) dst[n][k] = *(const PG8_LAS bf16x8*)(lds + PG8_SB(b, h) + boff + n * 2048 + k * 1024); } while (0)
#define PG8_MMA(ai, bj, At, Bt) do { __builtin_amdgcn_s_setprio(1); _Pragma("unroll") for (int m = 0; m < 4; ++m) _Pragma("unroll") for (int n = 0; n < 2; ++n) _Pragma("unroll") for (int k = 0; k < 2; ++k) \
    acc[ai][bj][m][n] = __builtin_amdgcn_mfma_f32_16x16x32_bf16(Bt[n][k], At[m][k], acc[ai][bj][m][n], 0, 0, 0); __builtin_amdgcn_s_setprio(0); } while (0)
#define PG8_WAIT_V(n) asm volatile("s_waitcnt vmcnt(" #n ")" ::: "memory")
#define PG8_WAIT_L(n) asm volatile("s_waitcnt lgkmcnt(" #n ")" ::: "memory")
#define PG8_BAR __builtin_amdgcn_s_barrier()
#define PG8_SCHED __builtin_amdgcn_sched_barrier(0)
  Unit cur, nxt; int ui = 0;
  __syncthreads();
  if (!S.next(0, cur)) return;
  f32x4 acc[2][2][4][2];
#pragma unroll
  for (int a = 0; a < 2; ++a)
#pragma unroll
    for (int b = 0; b < 2; ++b)
#pragma unroll
      for (int m = 0; m < 4; ++m)
#pragma unroll
        for (int n = 0; n < 2; ++n) acc[a][b][m][n] = (f32x4){0.f, 0.f, 0.f, 0.f};
  bf16x8 At[4][2], B0[2][2], B1[2][2];
  const char* cA = (const char*)(g.A + cur.ka) + (size_t)cur.pm * 2 * hstepA; const char* cB = (const char*)(g.Bt + cur.kb) + (size_t)cur.pn * 2 * hstepB;
  PG8_STAGE(PG8_SB(0, 0), cB, voffB); PG8_STAGE(PG8_SA(0, 0), cA, voffA); PG8_STAGE(PG8_SB(0, 1), cB + hstepB, voffB); PG8_STAGE(PG8_SA(0, 1), cA + hstepA, voffA);
  if (wr == 1) PG8_BAR;
  PG8_WAIT_V(4); PG8_BAR;
  PG8_STAGE(PG8_SB(1, 0), cB + kstep, voffB); PG8_STAGE(PG8_SA(1, 0), cA + kstep, voffA); PG8_STAGE(PG8_SB(1, 1), cB + hstepB + kstep, voffB);
  PG8_WAIT_V(6); PG8_BAR;
  for (;;) {
    const bool has_next = S.next(ui + 1, nxt);
    const char* nA = has_next ? (const char*)(g.A + nxt.ka) + (size_t)nxt.pm * 2 * hstepA : cA; const char* nB = has_next ? (const char*)(g.Bt + nxt.kb) + (size_t)nxt.pn * 2 * hstepB : cB;
    for (int t = 0; t < nt; t += 2) {
      const bool last = (t == nt - 2);
      const char* a1 = cA + (size_t)(t + 1) * kstep;
      const char* a2 = last ? nA : cA + (size_t)(t + 2) * kstep; const char* b2 = last ? nB : cB + (size_t)(t + 2) * kstep;
      const char* a3 = a2 + kstep; const char* b3 = b2 + kstep;
      PG8_LDB(B0, 0, 0); PG8_SCHED; PG8_LDA(At, 0, 0); PG8_STAGE(PG8_SA(1, 1), a1 + hstepA, voffA);
      PG8_WAIT_L(8); PG8_BAR; PG8_WAIT_L(0); PG8_MMA(0, 0, At, B0); PG8_BAR; PG8_SCHED;
      PG8_LDB(B1, 0, 1); PG8_STAGE(PG8_SB(0, 0), b2, voffB);
      PG8_BAR; PG8_WAIT_L(0); PG8_MMA(0, 1, At, B1); PG8_BAR;
      PG8_LDA(At, 0, 1); PG8_STAGE(PG8_SA(0, 0), a2, voffA);
      PG8_BAR; PG8_WAIT_L(0); PG8_MMA(1, 0, At, B0); PG8_BAR; PG8_SCHED;
      PG8_STAGE(PG8_SB(0, 1), b2 + hstepB, voffB);
      PG8_WAIT_V(6); PG8_BAR; PG8_MMA(1, 1, At, B1); PG8_BAR;
      PG8_LDB(B0, 1, 0); PG8_SCHED; PG8_LDA(At, 1, 0); PG8_STAGE(PG8_SA(0, 1), a2 + hstepA, voffA);
      PG8_WAIT_L(8); PG8_BAR; PG8_WAIT_L(0); PG8_MMA(0, 0, At, B0); PG8_BAR; PG8_SCHED;
      PG8_LDB(B1, 1, 1); PG8_STAGE(PG8_SB(1, 0), b3, voffB);
      PG8_BAR; PG8_WAIT_L(0); PG8_MMA(0, 1, At, B1); PG8_BAR;
      PG8_LDA(At, 1, 1); PG8_STAGE(PG8_SA(1, 0), a3, voffA);
      PG8_BAR; PG8_WAIT_L(0); PG8_MMA(1, 0, At, B0); PG8_BAR; PG8_SCHED;
      PG8_STAGE(PG8_SB(1, 1), b3 + hstepB, voffB);
      PG8_WAIT_V(6); PG8_BAR; PG8_MMA(1, 1, At, B1); PG8_BAR;
    }
    E(acc, cur, wr, wc, fr, fq);
    if (!has_next) break;
#pragma unroll
    for (int a = 0; a < 2; ++a)
#pragma unroll
      for (int b = 0; b < 2; ++b)
#pragma unroll
        for (int m = 0; m < 4; ++m)
#pragma unroll
          for (int n = 0; n < 2; ++n) acc[a][b][m][n] = (f32x4){0.f, 0.f, 0.f, 0.f};
    cur = nxt; cA = nA; cB = nB; ++ui;
  }
  PG8_WAIT_V(0);
  if (wr == 0) PG8_BAR;
  PG8_BAR;
#undef PG8_SA
#undef PG8_SB
#undef PG8_STAGE
#undef PG8_LDA
#undef PG8_LDB
#undef PG8_MMA
#undef PG8_WAIT_V
#undef PG8_WAIT_L
#undef PG8_BAR
#undef PG8_SCHED
}
__device__ __forceinline__ unsigned cvt_pk_bf16(float lo, float hi) { unsigned r; asm volatile("v_cvt_pk_bf16_f32 %0, %1, %2" : "=v"(r) : "v"(lo), "v"(hi)); return r; }
__device__ __forceinline__ u32x4 pk8(const f32x4 v0, const f32x4 v1) { u32x4 w; w.x = cvt_pk_bf16(v0[0], v0[1]); w.y = cvt_pk_bf16(v0[2], v0[3]); w.z = cvt_pk_bf16(v1[0], v1[1]); w.w = cvt_pk_bf16(v1[2], v1[3]); return w; }

__device__ __forceinline__ unsigned cvt_pk_bf16_n(float lo, float hi) { unsigned r; asm volatile("s_nop 1\n\tv_cvt_pk_bf16_f32 %0, %1, %2" : "=v"(r) : "v"(lo), "v"(hi)); return r; }
__device__ __forceinline__ u32x4 pk8n(const f32x4 v0, const f32x4 v1) { u32x4 w; w.x = cvt_pk_bf16_n(v0[0], v0[1]); w.y = cvt_pk_bf16_n(v0[2], v0[3]); w.z = cvt_pk_bf16_n(v1[0], v1[1]); w.w = cvt_pk_bf16_n(v1[2], v1[3]); return w; }
__device__ __forceinline__ float sigmoid_fast(float x) { return __builtin_amdgcn_rcpf(1.f + __expf(-x)); }
struct SchedIn { int G, c; __device__ __forceinline__ bool next(int i, Unit& u) const { const int L = i * G + c; if (L >= 1024) return false; u.z = 0; u.ka = 0; u.kb = 0;
  if (L < 936) { const int j = L / 24; u.pm = L % 24; u.pn = j < 34 ? j : (j < 38 ? j + 4 : 46); }
  else { const int e = L - 936; if (e < 72) { u.pm = e % 24; u.pn = 34 + e / 24; } else { u.pm = e - 72; u.pn = 37; } }
  return true; } };
struct SchedUp { int G, c; __device__ __forceinline__ bool next(int i, Unit& u) const { const int L = i * G + c; if (L >= 24 * 16) return false; u.pm = L % 24; u.pn = L / 24; u.z = 0; u.ka = 0; u.kb = 0; return true; } };
struct SchedBr { int G, c; __device__ __forceinline__ bool next(int i, Unit& u) const { const int L = i * G + c; if (L >= 256) return false; if (L >= 192) { const int k = 32 + (L - 192); u.pm = k % 24; u.pn = k / 24; u.z = 1; u.ka = (size_t)NTOK * DM; u.kb = (size_t)DM * DM; return true; } const int r = L / 24; u.pm = L % 24; u.pn = r & 3; u.z = (r >> 2) * 2;
  u.ka = (size_t)u.z * NTOK * DM; u.kb = (size_t)u.z * DM * DM; return true; } };
struct SchedOne { Unit u0; __device__ __forceinline__ bool next(int i, Unit& u) const { if (i != 0) return false; u = u0; return true; } };
template <int KH> struct SchedSplit2 { int G, c; __device__ __forceinline__ bool next(int i, Unit& u) const { const int L = i * G + c; if (L >= 24 * 8) return false; const int r = L / 24; u.pm = L % 24; u.pn = r & 3; u.z = r >> 2;
  u.ka = (size_t)u.z * KH; u.kb = (size_t)u.z * KH; return true; } };

struct EpiIn { static constexpr bool PERM = true; bfr* P; float* small;
  __device__ __forceinline__ void operator()(const f32x4 (&acc)[2][2][4][2], const Unit& u, int wr, int wc, int fr, int fq) const {
    const int row0 = u.pm * BM + wr * 64 + fr, col0 = u.pn * BM + wc * 32 + 8 * fq;
    if (u.pn < 46) {
      const bool sg = u.pn >= 34;
#pragma unroll
      for (int ai = 0; ai < 2; ++ai)
#pragma unroll
        for (int m = 0; m < 4; ++m) { bfr* rowp = P + (size_t)(row0 + ai * HALF + m * 16) * NP + col0;
#pragma unroll
          for (int bj = 0; bj < 2; ++bj) { f32x4 v0 = acc[ai][bj][m][0], v1 = acc[ai][bj][m][1];
            if (sg) {
#pragma unroll
              for (int j = 0; j < 4; ++j) { v0[j] = sigmoid_fast(v0[j]); v1[j] = sigmoid_fast(v1[j]); }
              *(u32x4*)(rowp + bj * HALF) = pk8n(v0, v1);
            } else *(u32x4*)(rowp + bj * HALF) = pk8(v0, v1); } }
    } else if (wc == 0) {
#pragma unroll
      for (int ai = 0; ai < 2; ++ai)
#pragma unroll
        for (int m = 0; m < 4; ++m) { float* rowp = small + (size_t)(row0 + ai * HALF + m * 16) * 32 + 8 * fq;
          *(f32x4*)rowp = acc[ai][0][m][0]; *(f32x4*)(rowp + 4) = acc[ai][0][m][1]; }
    }
  }
};
struct EpiUp { static constexpr bool PERM = true; bfr* O;
  __device__ __forceinline__ void operator()(const f32x4 (&acc)[2][2][4][2], const Unit& u, int wr, int wc, int fr, int fq) const {
    const int row0 = u.pm * BM + wr * 64 + fr, col0 = u.pn * BM + wc * 32 + 8 * fq;
#pragma unroll
    for (int ai = 0; ai < 2; ++ai)
#pragma unroll
      for (int m = 0; m < 4; ++m) { bfr* rowp = O + (size_t)(row0 + ai * HALF + m * 16) * HID + col0;
#pragma unroll
        for (int bj = 0; bj < 2; ++bj) { f32x4 v0 = acc[ai][bj][m][0], v1 = acc[ai][bj][m][1];
#pragma unroll
          for (int j = 0; j < 4; ++j) { const float a = fmaxf(v0[j], 0.f), b = fmaxf(v1[j], 0.f); v0[j] = a * a; v1[j] = b * b; }
          *(u32x4*)(rowp + bj * HALF) = pk8(v0, v1); } }
  }
};
struct EpiBr { static constexpr bool PERM = true; bfr* O; const bfr* P;
  __device__ __forceinline__ void operator()(const f32x4 (&acc)[2][2][4][2], const Unit& u, int wr, int wc, int fr, int fq) const {
    const int row0 = u.pm * BM + wr * 64 + fr, col0 = u.z * DM + u.pn * BM + wc * 32 + 8 * fq;
    u32x4 gv[2][4][2];
#pragma unroll
    for (int ai = 0; ai < 2; ++ai)
#pragma unroll
      for (int m = 0; m < 4; ++m) { const bfr* gp = P + (size_t)(row0 + ai * HALF + m * 16) * NP + C_MG + col0;
#pragma unroll
        for (int bj = 0; bj < 2; ++bj) gv[ai][m][bj] = *(const u32x4*)(gp + bj * HALF); }
#pragma unroll
    for (int ai = 0; ai < 2; ++ai)
#pragma unroll
      for (int m = 0; m < 4; ++m) { bfr* rowp = O + (size_t)(row0 + ai * HALF + m * 16) * 3072 + col0;
#pragma unroll
        for (int bj = 0; bj < 2; ++bj) { f32x4 v0 = acc[ai][bj][m][0], v1 = acc[ai][bj][m][1];
          float g[8]; unpack8(gv[ai][m][bj], g);
#pragma unroll
          for (int j = 0; j < 4; ++j) { v0[j] *= g[j]; v1[j] *= g[4 + j]; }
          *(u32x4*)(rowp + bj * HALF) = pk8(v0, v1); } }
  }
};
struct EpiF32 { static constexpr bool PERM = false; float* C;
  __device__ __forceinline__ void operator()(const f32x4 (&acc)[2][2][4][2], const Unit& u, int wr, int wc, int fr, int fq) const {
    const int row0 = u.pm * BM + wr * 64 + fr, col0 = u.pn * BM + wc * 32 + 4 * fq;
    float* Cz = C + (size_t)u.z * NTOK * DM;
#pragma unroll
    for (int ai = 0; ai < 2; ++ai)
#pragma unroll
      for (int m = 0; m < 4; ++m) { float* rowp = Cz + (size_t)(row0 + ai * HALF + m * 16) * DM + col0;
#pragma unroll
        for (int bj = 0; bj < 2; ++bj)
#pragma unroll
          for (int n = 0; n < 2; ++n) *(f32x4*)(rowp + bj * HALF + n * 16) = acc[ai][bj][m][n]; }
  }
};
struct EpiPart { static constexpr bool PERM = true; bfr* C;
  __device__ __forceinline__ void operator()(const f32x4 (&acc)[2][2][4][2], const Unit& u, int wr, int wc, int fr, int fq) const {
    const int row0 = u.pm * BM + wr * 64 + fr, col0 = u.pn * BM + wc * 32 + 8 * fq;
    bfr* Cz = C + (size_t)u.z * NTOK * DM;
#pragma unroll
    for (int ai = 0; ai < 2; ++ai)
#pragma unroll
      for (int m = 0; m < 4; ++m) { bfr* rowp = Cz + (size_t)(row0 + ai * HALF + m * 16) * DM + col0;
#pragma unroll
        for (int bj = 0; bj < 2; ++bj) *(u32x4*)(rowp + bj * HALF) = pk8(acc[ai][bj][m][0], acc[ai][bj][m][1]); }
  }
};
}
namespace att {
constexpr int D = 128, NW = 8, QBLK = 32, KVBLK = 64;
constexpr float SCALE = 0.088388347648318440f;
constexpr float THR = 8.f;
constexpr int SDEPTH = 1;
constexpr int LDQ = 1024, LDK = 256, LDO = 1024;
constexpr size_t SHM_V = KVBLK * D * 2, SHM_K = KVBLK * D * 2, SHM_ATTN = 2 * SHM_V + 2 * SHM_K + NW * 64 * 4;
using bf16 = bfr;
using f32x8  = __attribute__((ext_vector_type(8))) float;
#define KSWZ(row, colB) ((row) * 256 + ((colB) ^ (((row) & 7) << 4)))
#define SBAR() __builtin_amdgcn_sched_barrier(0)
__device__ __forceinline__ int crow(int r, int hi) { return (r & 3) + 8 * (r >> 2) + 4 * hi; }
__device__ __forceinline__ unsigned cvtpk(float lo, float hi) {
  unsigned r; asm volatile("v_cvt_pk_bf16_f32 %0, %1, %2" : "=v"(r) : "v"(lo), "v"(hi)); return r;
}
template <typename TIn> struct Stage;
template <> struct Stage<bf16>  { using T = bf16x8;
  __device__ static __forceinline__ T ld8(const bf16* p) { return *reinterpret_cast<const bf16x8*>(p); }
  __device__ static __forceinline__ bf16x8 tobf(T x) { return x; } };
template <> struct Stage<float> { using T = f32x8;
  __device__ static __forceinline__ T ld8(const float* p) { return *reinterpret_cast<const f32x8*>(p); }
  __device__ static __forceinline__ bf16x8 tobf(T x) {
    u32x4 w = {cvtpk(x[0], x[1]), cvtpk(x[2], x[3]), cvtpk(x[4], x[5]), cvtpk(x[6], x[7])}; return *reinterpret_cast<bf16x8*>(&w); } };

__device__ __forceinline__ void partialSM(f32x16& p0, f32x16& p1, float& m_reg, float& mn, float& alpha) {
  constexpr float C = SCALE * 1.4426950408889634f;
  float pmax = p0[0]; for (int r = 1; r < 16; ++r) pmax = fmaxf(pmax, p0[r]); for (int r = 0; r < 16; ++r) pmax = fmaxf(pmax, p1[r]);
  { auto rr = __builtin_amdgcn_permlane32_swap(__float_as_uint(pmax), __float_as_uint(pmax), false, false);
    pmax = fmaxf(__uint_as_float(rr[0]), __uint_as_float(rr[1])); }
  if (__builtin_expect(__all(pmax - m_reg <= THR / SCALE), 1)) { mn = m_reg; alpha = 1.f; }
  else { mn = fmaxf(m_reg, pmax); alpha = __builtin_amdgcn_exp2f((m_reg - mn) * C); m_reg = mn; }
  float mnC = -mn * C;
  for (int r = 0; r < 16; ++r) p0[r] = fmaf(p0[r], C, mnC); for (int r = 0; r < 16; ++r) p1[r] = fmaf(p1[r], C, mnC);
  for (int r = 0; r < 16; ++r) p0[r] = __builtin_amdgcn_exp2f(p0[r]);
}
__device__ __forceinline__ void finishSM(f32x16& p0, f32x16& p1, float alpha, float& l_reg, bf16x8& pa0, bf16x8& pa1, bf16x8& pa2, bf16x8& pa3) {
  for (int r = 0; r < 16; ++r) p1[r] = __builtin_amdgcn_exp2f(p1[r]);
  float ps = 0; for (int r = 0; r < 16; ++r) ps += p0[r]; for (int r = 0; r < 16; ++r) ps += p1[r];
  { auto rr = __builtin_amdgcn_permlane32_swap(__float_as_uint(ps), __float_as_uint(ps), false, false);
    ps = __uint_as_float(rr[0]) + __uint_as_float(rr[1]); }
  l_reg = l_reg * alpha + ps;
#define PK4(P, BASE, OUT) do { unsigned a0 = cvtpk(P[BASE + 0], P[BASE + 1]), a1 = cvtpk(P[BASE + 2], P[BASE + 3]);   \
    unsigned b0 = cvtpk(P[BASE + 4], P[BASE + 5]), b1 = cvtpk(P[BASE + 6], P[BASE + 7]);                              \
    auto r0 = __builtin_amdgcn_permlane32_swap(a0, b0, false, false); auto r1 = __builtin_amdgcn_permlane32_swap(a1, b1, false, false); \
    u32x4 w = {r0[0], r1[0], r0[1], r1[1]}; OUT = *reinterpret_cast<bf16x8*>(&w); } while (0)
  PK4(p0, 0, pa0); PK4(p0, 8, pa1); PK4(p1, 0, pa2); PK4(p1, 8, pa3);
#undef PK4
}
__device__ __forceinline__ void qkt(f32x16& p0, f32x16& p1, const bf16* Ks, const bf16x8* qr, int r32, int hi) {
  p0 = f32x16{}; p1 = f32x16{};
  for (int d0 = 0; d0 < 8; ++d0) { int cb = (d0 * 16 + hi * 8) * 2;
    bf16x8 b0 = *reinterpret_cast<const bf16x8*>((const char*)Ks + KSWZ(r32, cb));
    bf16x8 b1 = *reinterpret_cast<const bf16x8*>((const char*)Ks + KSWZ(32 + r32, cb));
    p0 = __builtin_amdgcn_mfma_f32_32x32x16_bf16(b0, qr[d0], p0, 0, 0, 0);
    p1 = __builtin_amdgcn_mfma_f32_32x32x16_bf16(b1, qr[d0], p1, 0, 0, 0); }
}
__device__ __forceinline__ int v_st(int k, int c) { const int kk = (k & ~0xC) | ((k & 4) << 1) | ((k & 8) >> 1); return ((kk >> 3) * 4 + (c >> 5)) * 512 + ((kk & 7) * 32 + (c & 31)) * 2; }
__device__ __forceinline__ int v_rd_base(int lane) { return ((lane & 3) << 3) | (((lane >> 2) & 3) << 6) | (((lane >> 4) & 1) << 5) | (((lane >> 5) & 1) << 8); }
constexpr int v_rd_off(int d0, int ks, int half) { return d0 * 512 + ks * 4096 + half * 2048; }
template <int OFF> __device__ __forceinline__ s16x4 tr_read(int vb) {
  s16x4 r; asm volatile("ds_read_b64_tr_b16 %0, %1 offset:%2" : "=&v"(r) : "v"(vb), "i"(OFF) : "memory"); return r;
}
template <int D0> __device__ __forceinline__ void pv_one(f32x16& od, int vb, bf16x8 pa0, bf16x8 pa1, bf16x8 pa2, bf16x8 pa3) {
  const s16x4 l0 = tr_read<v_rd_off(D0, 0, 0)>(vb), h0 = tr_read<v_rd_off(D0, 0, 1)>(vb), l1 = tr_read<v_rd_off(D0, 1, 0)>(vb), h1 = tr_read<v_rd_off(D0, 1, 1)>(vb);
  const s16x4 l2 = tr_read<v_rd_off(D0, 2, 0)>(vb), h2 = tr_read<v_rd_off(D0, 2, 1)>(vb), l3 = tr_read<v_rd_off(D0, 3, 0)>(vb), h3 = tr_read<v_rd_off(D0, 3, 1)>(vb);
  asm volatile("s_waitcnt lgkmcnt(0)" ::: "memory"); SBAR();
#define PK(L, H) (bf16x8){L[0], L[1], L[2], L[3], H[0], H[1], H[2], H[3]}
  od = __builtin_amdgcn_mfma_f32_32x32x16_bf16(pa0, PK(l0, h0), od, 0, 0, 0);
  od = __builtin_amdgcn_mfma_f32_32x32x16_bf16(pa1, PK(l1, h1), od, 0, 0, 0);
  od = __builtin_amdgcn_mfma_f32_32x32x16_bf16(pa2, PK(l2, h2), od, 0, 0, 0);
  od = __builtin_amdgcn_mfma_f32_32x32x16_bf16(pa3, PK(l3, h3), od, 0, 0, 0);
#undef PK
}
__device__ __forceinline__ void pv_d0(f32x16* o, int vb, bf16x8 pa0, bf16x8 pa1, bf16x8 pa2, bf16x8 pa3) {
  pv_one<0>(o[0], vb, pa0, pa1, pa2, pa3); pv_one<1>(o[1], vb, pa0, pa1, pa2, pa3); pv_one<2>(o[2], vb, pa0, pa1, pa2, pa3); pv_one<3>(o[3], vb, pa0, pa1, pa2, pa3);
}

template <typename TQ>
__device__ __forceinline__ void attn_dense_body(const TQ* __restrict__ Qb, const bf16* __restrict__ Kh, const bf16* __restrict__ Vh,
                                                bfr* __restrict__ Ob, int seq, char* lds) {
  using St = Stage<bf16>; using SQ = Stage<TQ>;
  const int tid = tid_opaque(), wid = tid >> 6, lane = tid & 63, r32 = lane & 31, hi = lane >> 5;
  bf16* V_lds = (bf16*)lds; bf16* K_lds = (bf16*)(lds + 2 * SHM_V);
  float* ws = (float*)(lds + 2 * SHM_V + 2 * SHM_K) + wid * 64; float* li_l = ws; float* al_l = ws + 32;
  float m_reg = -1e30f, l_reg = 0; f32x16 o[4] = {}; bf16x8 qr[8];
  const TQ* Qw = Qb + (long)(wid * QBLK + r32) * LDQ + hi * 8;
#pragma unroll
  for (int d0 = 0; d0 < 8; ++d0) qr[d0] = SQ::tobf(SQ::ld8(Qw + d0 * 16));
  const int sr = tid >> 4, sc = (tid & 15) * 8, vst0 = v_st(sr, sc), vst1 = v_st(32 + sr, sc);
  const int vb0 = (int)(uintptr_t)V_lds + v_rd_base(lane);
  struct { typename St::T vs0, vs1, ks0, ks1; } sr_[SDEPTH];
#define SLOAD(i, k0) do { sr_[i].vs0 = St::ld8(&Vh[(long)((k0) + sr) * LDK + sc]); sr_[i].vs1 = St::ld8(&Vh[(long)((k0) + 32 + sr) * LDK + sc]); \
    sr_[i].ks0 = St::ld8(&Kh[(long)((k0) + sr) * LDK + sc]); sr_[i].ks1 = St::ld8(&Kh[(long)((k0) + 32 + sr) * LDK + sc]); } while (0)
#define SWRITE(b, i) do { *(bf16x8*)((char*)V_lds + (b) * SHM_V + vst0) = St::tobf(sr_[i].vs0);          \
    *(bf16x8*)((char*)V_lds + (b) * SHM_V + vst1) = St::tobf(sr_[i].vs1); int kc = sc * 2;               \
    *(bf16x8*)((char*)K_lds + (b) * SHM_K + KSWZ(sr, kc)) = St::tobf(sr_[i].ks0);                       \
    *(bf16x8*)((char*)K_lds + (b) * SHM_K + KSWZ(32 + sr, kc)) = St::tobf(sr_[i].ks1); } while (0)
#define SWAIT() do { if constexpr (SDEPTH == 2) asm volatile("s_waitcnt vmcnt(4)" ::: "memory"); else asm volatile("s_waitcnt vmcnt(0)" ::: "memory"); } while (0)
#define RESC(a) do { if (__any((a) < 1.f)) { if (hi == 0) al_l[r32] = (a); asm volatile("s_waitcnt lgkmcnt(0)" ::: "memory"); \
    for (int d = 0; d < 4; ++d) for (int r = 0; r < 16; ++r) o[d][r] *= al_l[crow(r, hi)]; } } while (0)
  f32x16 pA0, pA1, pB0, pB1; float mnA, mnB, alA, alB; bf16x8 pa0, pa1, pa2, pa3; const int NT = seq / KVBLK;
  constexpr int SE = 0, SO = SDEPTH - 1;
  SLOAD(SE, 0); asm volatile("s_waitcnt vmcnt(0)" ::: "memory"); SWRITE(0, SE); __syncthreads();
  qkt(pA0, pA1, K_lds, qr, r32, hi); partialSM(pA0, pA1, m_reg, mnA, alA);
  SLOAD(SO, KVBLK); if constexpr (SDEPTH == 2) { if (2 < NT) SLOAD(SE, 2 * KVBLK); }
  SWAIT(); SWRITE(1, SO); __syncthreads();
  for (int j = 1; j + 1 < NT; j += 2) {
    SBAR(); qkt(pB0, pB1, (bf16*)((char*)K_lds + SHM_K), qr, r32, hi);
    finishSM(pA0, pA1, alA, l_reg, pa0, pa1, pa2, pa3); SBAR();
    SLOAD(SO, (j + SDEPTH) * KVBLK); SBAR();
    pv_d0(o, vb0, pa0, pa1, pa2, pa3); partialSM(pB0, pB1, m_reg, mnB, alB);
    __syncthreads(); SWAIT(); SWRITE(0, SE);
    RESC(alB); __syncthreads();
    SBAR(); qkt(pA0, pA1, K_lds, qr, r32, hi);
    finishSM(pB0, pB1, alB, l_reg, pa0, pa1, pa2, pa3); SBAR();
    if (SDEPTH == 1 || j + 3 < NT) SLOAD(SE, (j + 1 + SDEPTH) * KVBLK); SBAR();
    pv_d0(o, vb0 + (int)SHM_V, pa0, pa1, pa2, pa3); partialSM(pA0, pA1, m_reg, mnA, alA);
    __syncthreads(); SWAIT(); SWRITE(1, SO);
    RESC(alA); __syncthreads();
  }
  SBAR(); qkt(pB0, pB1, (bf16*)((char*)K_lds + SHM_K), qr, r32, hi);
  finishSM(pA0, pA1, alA, l_reg, pa0, pa1, pa2, pa3); SBAR();
  pv_d0(o, vb0, pa0, pa1, pa2, pa3); partialSM(pB0, pB1, m_reg, mnB, alB);
  __syncthreads(); RESC(alB);
  finishSM(pB0, pB1, alB, l_reg, pa0, pa1, pa2, pa3); SBAR();
  pv_d0(o, vb0 + (int)SHM_V, pa0, pa1, pa2, pa3);
  if (hi == 0) li_l[r32] = l_reg; asm volatile("s_waitcnt lgkmcnt(0)" ::: "memory");
  float rli[16];
#pragma unroll
  for (int r = 0; r < 16; ++r) rli[r] = __builtin_amdgcn_rcpf(li_l[crow(r, hi)]);
  bfr* Ow = Ob + (long)(wid * QBLK) * LDO;
#pragma unroll
  for (int r = 0; r < 16; ++r) { int orow = crow(r, hi);
    for (int d0 = 0; d0 < 4; ++d0) Ow[(long)orow * LDO + d0 * 32 + r32] = f2bf(o[d0][r] * rli[r]); }
#undef SLOAD
#undef SWRITE
#undef SWAIT
#undef RESC
}

}

__device__ __forceinline__ void attn_item(const Params& p, int item) {
  __syncthreads();
  if (item < 64) {
    const int b = item >> 5, h = (item >> 2) & 7, qb = item & 3; const size_t t0 = NCTX + b * 1024 + qb * 256;
    att::attn_dense_body<bfr>(p.Q + t0 * DM + h * 128, p.Ks + (size_t)b * 1280 * 256 + (h >> 2) * 128, p.Vs + (size_t)b * 1280 * 256 + (h >> 2) * 128,
                              p.obr + (size_t)2 * NTOK * DM + t0 * DM + h * 128, 1280, smem);
  } else {
    const int j = item - 64, b = j >> 3, h = j & 7; const size_t t0 = b * 256;
    att::attn_dense_body<bfr>(p.Q + t0 * DM + h * 128, p.Kc + (size_t)b * 256 * 256 + (h >> 2) * 128, p.Vc + (size_t)b * 256 * 256 + (h >> 2) * 128,
                              p.obr + (size_t)2 * NTOK * DM + t0 * DM + h * 128, 256, smem);
  }
}
#define XB_TMO      128
#define XB_XCNT(j)  (256  + 64 * (j))
#define XB_XSUB(j)  (1280 + 64 * (j))
#define XB_XGEN(j)  (2304 + 64 * (j))
#define XB_TOP      3328
#define XB_TOPGEN   3392
#define XCD_BAR_WORDS 3456
#define XB_SPIN_CAP (1u << 20)
#define LAS __attribute__((address_space(3)))
constexpr int XB_LDS_OFF = 163840 - 16;

__device__ __forceinline__ unsigned xb_ld(unsigned* p)              { return __hip_atomic_load(p, __ATOMIC_RELAXED, __HIP_MEMORY_SCOPE_AGENT); }
__device__ __forceinline__ unsigned xb_add(unsigned* p, unsigned v) { return __hip_atomic_fetch_add(p, v, __ATOMIC_RELAXED, __HIP_MEMORY_SCOPE_AGENT); }
__device__ __forceinline__ unsigned xb_xcc_id() { return (unsigned)__builtin_amdgcn_s_getreg((3 << 11) | 20) & 0xFu; }
#define XB_SPIN(cond, bar) do { unsigned _sp = 0; while (cond) { __builtin_amdgcn_s_sleep(1); \
    if ((++_sp & 255u) == 0u) { if (xb_ld(&(bar)[XB_TMO])) break; if (_sp > XB_SPIN_CAP) { atomicAdd(&(bar)[XB_TMO], 1u); break; } } } } while (0)

__device__ __forceinline__ void xcd_barrier_post(unsigned* bar) {
  volatile LAS unsigned* st = (volatile LAS unsigned*)(smem + XB_LDS_OFF);
  if (tid_opaque() == 0) { st[0] = 0u; st[1] = 0u; (void)xb_add(&bar[XB_XCNT(xb_xcc_id())], 1u); }
  __syncthreads();
}
__device__ __forceinline__ void xcd_barrier_complete(unsigned* bar, unsigned x, unsigned& nloc, unsigned& nx) {
  const unsigned G = gridDim.x * gridDim.y * gridDim.z;
  unsigned sum, cnt, mine, sp = 0u;
  for (;;) {
    sum = 0u; cnt = 0u; mine = 0u;
#pragma unroll
    for (unsigned j = 0; j < 16; ++j) { const unsigned c = xb_ld(&bar[XB_XCNT(j)]); sum += c; cnt += (c > 0u) ? 1u : 0u; mine = (j == x) ? c : mine; }
    if (sum == G) break;
    __builtin_amdgcn_s_sleep(1);
    if ((++sp & 255u) == 0u) { if (xb_ld(&bar[XB_TMO])) break; if (sp > XB_SPIN_CAP) { atomicAdd(&bar[XB_TMO], 1u); break; } }
  }
  nloc = mine > 0u ? mine : 1u; nx = cnt > 0u ? cnt : 1u;
}
template <bool REL = true>
__device__ __forceinline__ void xcd_barrier(unsigned* bar) {
  asm volatile("s_waitcnt vmcnt(0)" ::: "memory");
  __syncthreads();
  if (tid_opaque() == 0) {
    volatile LAS unsigned* st = (volatile LAS unsigned*)(smem + XB_LDS_OFF);
    const unsigned x = xb_xcc_id();
    __builtin_amdgcn_s_waitcnt(0);
    unsigned nloc = st[0], nx = st[1];
    if (nloc == 0u) { xcd_barrier_complete(bar, x, nloc, nx); st[0] = nloc; st[1] = nx; }
    const unsigned old = xb_add(&bar[XB_XSUB(x)], 1u);
    const unsigned gen = old / nloc;
    if (old + 1u == (gen + 1u) * nloc) {
      if (REL) { __builtin_amdgcn_fence(__ATOMIC_RELEASE, "agent"); asm volatile("s_waitcnt vmcnt(0)" ::: "memory"); }
      const unsigned og = xb_add(&bar[XB_TOP], 1u);
      const unsigned tg = og / nx;
      if (og + 1u == (tg + 1u) * nx) xb_add(&bar[XB_TOPGEN], 1u);
      else XB_SPIN(xb_ld(&bar[XB_TOPGEN]) == tg, bar);
      xb_add(&bar[XB_XGEN(x)], 1u);
      __builtin_amdgcn_fence(__ATOMIC_ACQUIRE, "agent");
      asm volatile("s_waitcnt vmcnt(0)" ::: "memory");
    } else {
      XB_SPIN(xb_ld(&bar[XB_XGEN(x)]) == gen, bar);
      __builtin_amdgcn_fence(__ATOMIC_ACQUIRE, "agent");
      asm volatile("s_waitcnt vmcnt(0)" ::: "memory");
    }
  }
  __syncthreads();
}
constexpr float SCALEQ = 0.08838834764831845f;
constexpr int PQH = 0, PKH = 17408, PVH = 34816, PKK = 52224, PQK = 68864, PXS = 52224, PMD = 125952, PMB = 134144, PGC = 152576, PRS = 0;
constexpr int XROW = 144;
#define LDS_BARRIER() do { asm volatile("s_waitcnt lgkmcnt(0)" ::: "memory"); __builtin_amdgcn_s_barrier(); asm volatile("" ::: "memory"); } while (0)
constexpr int LROW = 272;

__device__ __forceinline__ float ld_bf(const char* base, int byteoff) { return bf2f(*(const bfr*)(base + byteoff)); }

template <int B>
__device__ __forceinline__ void solve_block(int d, int e, int wid, int lane) {
  const int fr = lane & 15, hq = lane >> 4;
  char* xcol = smem + PXS + (d * 256 + e) * XROW + 16 * B * 2;
  float acc[16];
  { const u32x4 a = *(const u32x4*)xcol, b = *(const u32x4*)(xcol + 16); unpack8(a, acc); unpack8(b, acc + 8); }
  if (B > 0) {
    constexpr int NKS = (B + 1) / 2;
    f32x4 R[4];
#pragma unroll
    for (int ct = 0; ct < 4; ++ct) R[ct] = f32x4{0.f, 0.f, 0.f, 0.f};
#pragma unroll
    for (int ks = 0; ks < NKS; ++ks) {
      const bf16x8 a = *(const bf16x8*)(smem + PMB + (d * 64 + 16 * B + fr) * XROW + (ks * 32 + 8 * hq) * 2);
#pragma unroll
      for (int ct = 0; ct < 4; ++ct) {
        const bf16x8 b = *(const bf16x8*)(smem + PXS + (d * 256 + (wid & 3) * 64 + ct * 16 + fr) * XROW + (ks * 32 + 8 * hq) * 2);
        R[ct] = __builtin_amdgcn_mfma_f32_16x16x32_bf16(a, b, R[ct], 0, 0, 0);
      }
    }
    float* rs = (float*)(smem + PRS + wid * 4352);
#pragma unroll
    for (int ct = 0; ct < 4; ++ct)
#pragma unroll
      for (int r = 0; r < 4; ++r) rs[(4 * hq + r) * 68 + ct * 16 + fr] = R[ct][r];
    asm volatile("s_waitcnt lgkmcnt(0)" ::: "memory");
#pragma unroll
    for (int r = 0; r < 16; ++r) acc[r] -= rs[r * 68 + lane];
  }
  const float4* md = (const float4*)(smem + PMD) + ((d * 4 + B) * 16) * 4;
#pragma unroll
  for (int r2 = 0; r2 < 15; ++r2) {
#pragma unroll
    for (int q = (r2 + 1) / 4; q < 4; ++q) {
      const float4 m = md[r2 * 4 + q];
      if (4 * q + 0 > r2) acc[4 * q + 0] -= m.x * acc[r2];
      if (4 * q + 1 > r2) acc[4 * q + 1] -= m.y * acc[r2];
      if (4 * q + 2 > r2) acc[4 * q + 2] -= m.z * acc[r2];
      if (4 * q + 3 > r2) acc[4 * q + 3] -= m.w * acc[r2];
    }
  }
  *(u32x4*)xcol = pack8(acc); *(u32x4*)(xcol + 16) = pack8(acc + 8);
  asm volatile("s_waitcnt lgkmcnt(0)" ::: "memory");
}

__device__ __forceinline__ void dn_prep_item(const Params& p, int l, int c, int h) {
  const int tid = tid_opaque(), wid = tid >> 6, lane = tid & 63;
  const int t0 = c * 64;
  LDS_BARRIER();
  float b_beta = 0.f, b_alpha = 0.f, b_A = 0.f, b_dtb = 0.f;
  if (wid < 2) {
    const int d = wid, ti = d ? 63 - lane : lane, t = t0 + ti;
    b_A = p.a_log[(l * 2 + d) * 8 + h]; b_dtb = p.dt_bias[(l * 2 + d) * 8 + h];
    b_beta = p.small[(size_t)t * 32 + d * 8 + h]; b_alpha = p.small[(size_t)t * 32 + 16 + d * 8 + h];
  }
  struct { u32x4 raw[3][2][3]; } R;
  {
    const int grp = tid & 15;
#pragma unroll
    for (int X = 0; X < 3; ++X)
#pragma unroll
      for (int pass = 0; pass < 2; ++pass)
#pragma unroll
        for (int k = -1; k <= 1; ++k) {
          const int r = (tid >> 4) + pass * 32, t = t0 + r, pos = tok_pos(t), L = tok_L(t);
          R.raw[X][pass][k + 1] = u32x4{0u, 0u, 0u, 0u};
          if (pos + k >= 0 && pos + k < L) R.raw[X][pass][k + 1] = *(const u32x4*)(p.P + (size_t)(t + k) * NP + X * 1024 + h * 128 + grp * 8);
        }
  }
  {
    const int grp = tid & 15;
    const float* wc = p.w_conv_dn + (size_t)l * 3 * 3072 + h * 128 + grp * 8;
#pragma unroll
    for (int X = 0; X < 3; ++X) {
      float w[3][8];
#pragma unroll
      for (int k = 0; k < 3; ++k) { *(float4*)&w[k][0] = *(const float4*)(wc + k * 3072 + X * 1024); *(float4*)&w[k][4] = *(const float4*)(wc + k * 3072 + X * 1024 + 4); }
#pragma unroll
      for (int pass = 0; pass < 2; ++pass) {
        const int r = (tid >> 4) + pass * 32;
        float acc[8] = {};
#pragma unroll
        for (int k = 0; k < 3; ++k) {
          float x[8]; unpack8(R.raw[X][pass][k], x);
#pragma unroll
          for (int q = 0; q < 8; ++q) acc[q] += w[k][q] * x[q];
        }
        float ss = 0;
#pragma unroll
        for (int q = 0; q < 8; ++q) { acc[q] = siluf_(acc[q]); ss += acc[q] * acc[q]; }
        if (X < 2) {
          ss += __shfl_xor(ss, 1); ss += __shfl_xor(ss, 2); ss += __shfl_xor(ss, 4); ss += __shfl_xor(ss, 8);
          const float nrm = rsqrtf(ss + EPS);
#pragma unroll
          for (int q = 0; q < 8; ++q) acc[q] *= nrm;
        }
        *(u32x4*)(smem + X * 17408 + r * LROW + grp * 16) = pack8hw(acc);
      }
    }
  }
  if (wid < 2) {
    const int d = wid;
    const float A = __expf(b_A);
    const float beta = sigmoidf_(b_beta);
    float g = -A * softplusf_(b_alpha + b_dtb);
#pragma unroll
    for (int o = 1; o < 64; o <<= 1) { const float v = __shfl_up(g, o); if (lane >= o) g += v; }
    float* G = (float*)(smem + PGC);
    const float eg_ = __expf(g);
    G[d * 64 + lane] = g; G[128 + d * 64 + lane] = beta; G[256 + d * 64 + lane] = eg_; G[384 + d * 64 + lane] = beta * eg_;
  }
  LDS_BARRIER();
  {
    const int mat = wid >> 2, rt = wid & 3, fr = lane & 15, fq = lane >> 4;
    const char* Ab = smem + (mat ? PQH : PKH);
    f32x4 acc[4];
#pragma unroll
    for (int ct = 0; ct < 4; ++ct) acc[ct] = f32x4{0.f, 0.f, 0.f, 0.f};
#pragma unroll
    for (int ks = 0; ks < 4; ++ks) {
      const bf16x8 a = *(const bf16x8*)(Ab + (rt * 16 + fr) * LROW + (ks * 32 + fq * 8) * 2);
#pragma unroll
      for (int ct = 0; ct < 4; ++ct) {
        const bf16x8 b = *(const bf16x8*)(smem + PKH + (ct * 16 + fr) * LROW + (ks * 32 + fq * 8) * 2);
        acc[ct] = __builtin_amdgcn_mfma_f32_16x16x32_bf16(a, b, acc[ct], 0, 0, 0);
      }
    }
    float* Dst = (float*)(smem + (mat ? PQK : PKK));
#pragma unroll
    for (int ct = 0; ct < 4; ++ct)
#pragma unroll
      for (int r = 0; r < 4; ++r) Dst[(rt * 16 + fq * 4 + r) * 65 + ct * 16 + fr] = acc[ct][r];
  }
  LDS_BARRIER();
  const int d = tid >> 8, e = tid & 255;
  const float* GC = (const float*)(smem + PGC) + d * 64;
  const float* BETA = (const float*)(smem + PGC) + 128 + d * 64;
  const float* EG = (const float*)(smem + PGC) + 256 + d * 64;
  const float* KKs = (const float*)(smem + PKK);
  const float* QKs = (const float*)(smem + PQK);
  char* rec = p.dnrec + (size_t)((c * 8 + h) * 2 + d) * REC_BYTES;
  {
    const int i = e >> 2, jq = e & 3, j0 = jq * 16, ti = d ? 63 - i : i, ib = i >> 4;
    const float bi = BETA[i], gi = GC[i];
    float mv[16];
#pragma unroll
    for (int jj = 0; jj < 16; ++jj) {
      const int j = j0 + jj, tj = d ? 63 - j : j;
      const float mraw = bi * KKs[ti * 65 + tj] * __expf(fminf(gi - GC[j], 0.f));
      mv[jj] = (j < i) ? mraw : 0.f;
    }
    float* mdt = (float*)(smem + PMD) + ((d * 4 + ib) * 16) * 16 + (i & 15);
    if (jq == ib) {
#pragma unroll
      for (int jj = 0; jj < 16; ++jj) mdt[jj * 16] = mv[jj];
    }
    float mo[16];
#pragma unroll
    for (int jj = 0; jj < 16; ++jj) mo[jj] = (jq < ib) ? mv[jj] : 0.f;
    char* mb = smem + PMB + (d * 64 + i) * XROW + j0 * 2;
    *(u32x4*)mb = pack8hw(mo); *(u32x4*)(mb + 16) = pack8hw(mo + 8);
#pragma unroll 1
    for (int rep = 0; rep < 2; ++rep) {
      const int f = e + rep * 256, ln = f & 63, fi = f >> 6, mt = fi >> 1, ks = fi & 1;
      const int ii = mt * 16 + (ln & 15), tii = d ? 63 - ii : ii, hq = ln >> 4;
      const float gii = GC[ii];
      float v[8];
#pragma unroll
      for (int j = 0; j < 8; ++j) {
        const int jp = ks * 32 + (j >> 2) * 16 + 4 * hq + (j & 3), tj = d ? 63 - jp : jp;
        const float qraw = SCALEQ * QKs[tii * 65 + tj] * __expf(fminf(gii - GC[jp], 0.f));
        v[j] = (jp <= ii) ? qraw : 0.f;
      }
      *(u32x4*)(rec + REC_QK + f * 16) = pack8hw(v);
    }
    if (e == 0) p.glast[(c * 8 + h) * 2 + d] = EG[63];
    const float gl = GC[63];
#pragma unroll 1
    for (int rep = 0; rep < 4; ++rep) {
      const int f = e + rep * 256, ln = f & 63, fi = f >> 6, hq = ln >> 4;
      {
        const int mt = fi >> 2, ks = fi & 3, ii = mt * 16 + (ln & 15), tii = d ? 63 - ii : ii;
        const float sc = SCALEQ * EG[ii];
        const char* qrow = smem + PQH + tii * LROW + (ks * 32 + 4 * hq) * 2;
        const u32x2 lo = *(const u32x2*)qrow, hi = *(const u32x2*)(qrow + 32);
        float v[8] = {__uint_as_float(lo[0] << 16), __uint_as_float(lo[0] & 0xffff0000u), __uint_as_float(lo[1] << 16), __uint_as_float(lo[1] & 0xffff0000u),
                      __uint_as_float(hi[0] << 16), __uint_as_float(hi[0] & 0xffff0000u), __uint_as_float(hi[1] << 16), __uint_as_float(hi[1] & 0xffff0000u)};
#pragma unroll
        for (int j = 0; j < 8; ++j) v[j] *= sc;
        *(u32x4*)(rec + REC_QD + f * 16) = pack8hw(v);
      }
      {
        const int mt = fi >> 1, ks = fi & 1, dk = mt * 16 + (ln & 15);
        float v[8];
#pragma unroll
        for (int j = 0; j < 8; ++j) {
          const int ip = ks * 32 + (j >> 2) * 16 + 4 * hq + (j & 3), tip = d ? 63 - ip : ip;
          v[j] = ld_bf(smem + PKH, tip * LROW + dk * 2) * __expf(gl - GC[ip]);
        }
        *(u32x4*)(rec + REC_KD + f * 16) = pack8hw(v);
      }
    }
  }
  LDS_BARRIER();
  {
    const int col = e & 127; const bool isw = e >= 128;
    const char* src = smem + (isw ? PKH : PVH) + col * 2;
    const float4* F4 = (const float4*)((const float*)(smem + PGC) + (isw ? 384 : 128) + d * 64);
    char* xcol = smem + PXS + (d * 256 + e) * XROW;
#pragma unroll
    for (int i8 = 0; i8 < 8; ++i8) {
      const float4 f0 = F4[i8 * 2], f1 = F4[i8 * 2 + 1];
      const float fs[8] = {f0.x, f0.y, f0.z, f0.w, f1.x, f1.y, f1.z, f1.w};
      float v[8];
#pragma unroll
      for (int q = 0; q < 8; ++q) { const int i = i8 * 8 + q, ti = d ? 63 - i : i; v[q] = ld_bf(src, ti * LROW) * fs[q]; }
      *(u32x4*)(xcol + i8 * 16) = pack8hw(v);
    }
  }
  LDS_BARRIER();
  solve_block<0>(d, e, wid, lane); solve_block<1>(d, e, wid, lane); solve_block<2>(d, e, wid, lane); solve_block<3>(d, e, wid, lane);
  LDS_BARRIER();
  {
    const char* XS = smem + PXS + d * 256 * XROW;
#pragma unroll 1
    for (int rep = 0; rep < 8; ++rep) {
      const int f = e + rep * 256, ln = f & 63, fi = f >> 6, ws = fi >> 2, rt = fi & 3;
      const int i0 = rt * 16 + 4 * (ln >> 4), dv = ws * 16 + (ln & 15);
      *(u32x2*)(rec + REC_U + f * 8) = *(const u32x2*)(XS + dv * XROW + i0 * 2);
    }
#pragma unroll 1
    for (int rep = 0; rep < 4; ++rep) {
      const int f = e + rep * 256, ln = f & 63, fi = f >> 6, mt = fi >> 2, ks = fi & 3, hq = ln >> 4;
      const char* wc = XS + (128 + ks * 32 + 4 * hq) * XROW + (mt * 16 + (ln & 15)) * 2;
      unsigned q[8];
#pragma unroll
      for (int j = 0; j < 8; ++j) q[j] = *(const bfr*)(wc + ((j >> 2) * 16 + (j & 3)) * XROW);
      u32x4 o = {q[0] | (q[1] << 16), q[2] | (q[3] << 16), q[4] | (q[5] << 16), q[6] | (q[7] << 16)};
      *(u32x4*)(rec + REC_W + f * 16) = o;
    }
  }
}

__device__ __forceinline__ bf16x8 pack_b(const f32x4& a, const f32x4& b) {
  u32x4 w = {pack2hw(a[0], a[1]), pack2hw(a[2], a[3]), pack2hw(b[0], b[1]), pack2hw(b[2], b[3])};
  return *reinterpret_cast<bf16x8*>(&w);
}

constexpr int SCAN_BUF = 73728;
#define SC_SCHED() __builtin_amdgcn_sched_barrier(0)
#define SC_WAITL(n) asm volatile("s_waitcnt lgkmcnt(" #n ")" ::: "memory")
__device__ __forceinline__ void dn_scan_item(const Params& p, int l, int s, int h, int d) {
  const int tid = tid_opaque(), wid = tid >> 6, lane = tid & 63, ws = wid, fr = lane & 15, hq = lane >> 4;
  const bool samp = s >= 16;
  const int N = samp ? 16 : 4, cb = samp ? 64 + (s - 16) * 16 : s * 4, tbase = samp ? NCTX + (s - 16) * 1024 : s * 256;
  const int cstep = d ? -1 : 1, c0 = cb + (d ? N - 1 : 0);
  auto recp = [&](int n) { return p.dnrec + (size_t)(((c0 + n * cstep) * 8 + h) * 2 + d) * REC_BYTES; };
  f32x4 S[8];
  if (samp) {
    const float* s0 = p.state_dn + ((((size_t)(s - 16) * DEPTH + l) * 2 + d) * 8 + h) * 16384;
#pragma unroll
    for (int dt = 0; dt < 8; ++dt) {
      const float* q = s0 + (dt * 16 + 4 * hq) * 128 + ws * 16 + fr;
      asm volatile("" : "+v"(q) :: "memory");
#pragma unroll
      for (int r = 0; r < 4; ++r) S[dt][r] = q[r * 128];
    }
  } else {
#pragma unroll
    for (int dt = 0; dt < 8; ++dt) S[dt] = f32x4{0.f, 0.f, 0.f, 0.f};
  }
  const float glv = p.glast[((c0 + (lane < N ? lane : 0) * cstep) * 8 + h) * 2 + d];
  __syncthreads();
#define SC_GLDS(rec, buf) do { _Pragma("unroll") for (int i = 0; i < 9; ++i) \
    __builtin_amdgcn_global_load_lds((const unsigned*)((rec) + (i * 512 + tid) * 16), (__attribute__((address_space(3))) unsigned*)(smem + (buf) * SCAN_BUF + (i * 512 + tid) * 16), 16, 0, 0); } while (0)
  SC_GLDS(recp(0), 0);
  SC_GLDS(recp(1), 1);
  asm volatile("s_waitcnt vmcnt(0)" ::: "memory");
  LDS_BARRIER();
#pragma unroll 1
  for (int n = 0; n < N; ++n) {
    const int c = c0 + n * cstep;
    const char* Lb = smem + (n & 1) * SCAN_BUF;
    const char* LW = Lb + REC_W + lane * 16;
    const float gl = __uint_as_float(__builtin_amdgcn_readlane(__float_as_uint(glv), n));
    f32x4 P[4], O[4];
#pragma unroll
    for (int rt = 0; rt < 4; ++rt) { P[rt] = f32x4{0.f, 0.f, 0.f, 0.f}; O[rt] = f32x4{0.f, 0.f, 0.f, 0.f}; }
    bf16x8 F[8];
#define SC_LOADWQ(ks) do { _Pragma("unroll") for (int rt = 0; rt < 4; ++rt) { F[rt] = *(const bf16x8*)(LW + ((rt * 4 + (ks)) * 64) * 16); F[4 + rt] = *(const bf16x8*)(LW + 16384 + ((rt * 4 + (ks)) * 64) * 16); } } while (0)
#define SC_MMAWQ(sb) do { _Pragma("unroll") for (int rt = 0; rt < 4; ++rt) { P[rt] = __builtin_amdgcn_mfma_f32_16x16x32_bf16(F[rt], sb, P[rt], 0, 0, 0); O[rt] = __builtin_amdgcn_mfma_f32_16x16x32_bf16(F[4 + rt], sb, O[rt], 0, 0, 0); } } while (0)
#pragma unroll
    for (int ks = 0; ks < 4; ++ks) {
      SC_LOADWQ(ks); SC_SCHED();
      const bf16x8 sb = pack_b(S[2 * ks], S[2 * ks + 1]);
      SC_WAITL(0); SC_SCHED(); SC_MMAWQ(sb); SC_SCHED();
    }
    u32x2 U[4];
#pragma unroll
    for (int rt = 0; rt < 4; ++rt) U[rt] = *(const u32x2*)(Lb + REC_U + (((ws * 4 + rt) * 64) + lane) * 8);
#pragma unroll
    for (int i = 0; i < 8; ++i) F[i] = *(const bf16x8*)(LW + 32768 + (i * 64) * 16);
    SC_SCHED(); SC_WAITL(0); SC_SCHED();
#pragma unroll
    for (int rt = 0; rt < 4; ++rt) {
      const u32x2 u = U[rt];
      P[rt][0] = __uint_as_float(u[0] << 16) - P[rt][0]; P[rt][1] = __uint_as_float(u[0] & 0xffff0000u) - P[rt][1];
      P[rt][2] = __uint_as_float(u[1] << 16) - P[rt][2]; P[rt][3] = __uint_as_float(u[1] & 0xffff0000u) - P[rt][3];
    }
    const bf16x8 vb0 = pack_b(P[0], P[1]), vb1 = pack_b(P[2], P[3]);
#pragma unroll
    for (int rt = 0; rt < 4; ++rt) {
      O[rt] = __builtin_amdgcn_mfma_f32_16x16x32_bf16(F[rt * 2 + 0], vb0, O[rt], 0, 0, 0);
      O[rt] = __builtin_amdgcn_mfma_f32_16x16x32_bf16(F[rt * 2 + 1], vb1, O[rt], 0, 0, 0);
    }
    SC_SCHED();
#pragma unroll
    for (int half = 0; half < 2; ++half) {
#pragma unroll
      for (int i = 0; i < 8; ++i) F[i] = *(const bf16x8*)(LW + 40960 + ((half * 8 + i) * 64) * 16);
      SC_SCHED(); SC_WAITL(0); SC_SCHED();
#pragma unroll
      for (int dq = 0; dq < 4; ++dq) {
        const int dt = half * 4 + dq;
        S[dt] *= gl;
        S[dt] = __builtin_amdgcn_mfma_f32_16x16x32_bf16(F[dq * 2 + 0], vb0, S[dt], 0, 0, 0);
        S[dt] = __builtin_amdgcn_mfma_f32_16x16x32_bf16(F[dq * 2 + 1], vb1, S[dt], 0, 0, 0);
      }
      SC_SCHED();
    }
    SC_SCHED();
    bfr* ob = p.opart + (size_t)d * NTOK * DM + (size_t)(c * 64) * DM + h * 128 + ws * 16 + fr;
#pragma unroll
    for (int rt = 0; rt < 4; ++rt) {
      const int ip0 = rt * 16 + 4 * hq;
      bfr* q = ob + (size_t)(d ? 63 - ip0 : ip0) * DM;
      const long stp = d ? -(long)DM : (long)DM;
#pragma unroll
      for (int r = 0; r < 4; ++r) q[r * stp] = f2bf(O[rt][r]);
    }
    asm volatile("s_waitcnt vmcnt(16)" ::: "memory");
    LDS_BARRIER();
    if (n + 2 < N) SC_GLDS(recp(n + 2), n & 1);
  }
#undef SC_GLDS
#undef SC_LOADWQ
#undef SC_MMAWQ
  if (!samp) {
    float* so = p.out_state + ((((size_t)s * DEPTH + l) * 2 + d) * 8 + h) * 16384;
#pragma unroll
    for (int dt = 0; dt < 8; ++dt) {
      float* q = so + (dt * 16 + 4 * hq) * 128 + ws * 16 + fr;
      asm volatile("" : "+v"(q) :: "memory");
#pragma unroll
      for (int r = 0; r < 4; ++r) q[r * 128] = S[dt][r];
    }
  }
  if (l == 1 && s == 16 && h == 0 && d == 0) GSTAMP(p.bar, 4);
  asm volatile("s_waitcnt vmcnt(0)" ::: "memory");
  __syncthreads();
  volatile __attribute__((address_space(3))) unsigned* flag = (volatile __attribute__((address_space(3))) unsigned*)(smem + XB_LDS_OFF + 8);
  if (tid == 0) {
    __builtin_amdgcn_fence(__ATOMIC_RELEASE, "agent");
    asm volatile("s_waitcnt vmcnt(0)" ::: "memory");
    const unsigned old = __hip_atomic_fetch_add(p.bar + 4096 + (l * 18 + s) * 8 + h, 1u, __ATOMIC_RELAXED, __HIP_MEMORY_SCOPE_AGENT);
    if (old == 1u) { __builtin_amdgcn_fence(__ATOMIC_ACQUIRE, "agent"); asm volatile("s_waitcnt vmcnt(0)" ::: "memory"); }
    *flag = old;
  }
  __syncthreads();
  const unsigned last = __builtin_amdgcn_readfirstlane(*flag);
  if (last == 1u && !samp) dn_finalize(p, l, tbase, 256, h, tid, NTHR);
}

__device__ __forceinline__ void dn_finalize_item(const Params& p, int l, int it) {
  const int tid = tid_opaque();
  const int s = 16 + (it >> 5), h = (it >> 2) & 7, qt = it & 3;
  __syncthreads();
  if (tid == 0) {
    unsigned* cnt = p.bar + 4096 + (l * 18 + s) * 8 + h; unsigned sp = 0;
    while (__hip_atomic_load(cnt, __ATOMIC_RELAXED, __HIP_MEMORY_SCOPE_AGENT) < 2u) { __builtin_amdgcn_s_sleep(2); if (++sp > (1u << 22)) { atomicAdd(&p.bar[XB_TMO], 1u); break; } }
    __builtin_amdgcn_fence(__ATOMIC_ACQUIRE, "agent");
    asm volatile("s_waitcnt vmcnt(0)" ::: "memory");
  }
  __syncthreads();
  dn_finalize(p, l, NCTX + (s - 16) * 1024 + qt * 256, 256, h, tid, NTHR);
}
constexpr int DYN_LDS = 163840;
#ifndef REP
#define REP 0
#endif
constexpr int CONV_SPLIT = 660;
#ifndef USE_CG_SYNC
#define USE_CG_SYNC 1
#endif
#if USE_CG_SYNC
#define GRID_SYNC() do { cg::this_grid().sync(); } while (0)
#define GRID_SYNC_WT() GRID_SYNC()
#else
#define GRID_SYNC() do { unsigned* bar_; { PHASE_PARAMS(pb); bar_ = pb.bar; } xcd_barrier<true>(bar_); if (REP & 2048) xcd_barrier<true>(bar_); } while (0)
#define GRID_SYNC_WT() GRID_SYNC()
#endif

typedef const __attribute__((address_space(4))) Params* CParamsPtr;
#define PHASE_PARAMS(p) CParamsPtr p##_c = (CParamsPtr)__builtin_amdgcn_kernarg_segment_ptr(); asm volatile("" : "+s"(p##_c)); const Params& p = *(const Params*)p##_c

#define PF_LINES(base_ptr, nlines) do { const int g_ = bid * 512 + tid_opaque(); unsigned d0_ = 0, d1_ = 0; \
    if (g_ < (nlines)) { const char* q_ = (const char*)(base_ptr) + (size_t)g_ * 128; asm volatile("global_load_dword %0, %1, off" : "=v"(d0_) : "v"(q_) : "memory"); } \
    if ((nlines) > 131072 && g_ + 131072 < (nlines)) { const char* q_ = (const char*)(base_ptr) + (size_t)(g_ + 131072) * 128; asm volatile("global_load_dword %0, %1, off" : "=v"(d1_) : "v"(q_) : "memory"); } \
    asm volatile("s_waitcnt vmcnt(0)" ::: "memory"); asm volatile("" :: "v"(d0_), "v"(d1_)); } while (0)
__device__ __forceinline__ void panel_rows(const Params& p, int l, int mode, int bid) {
  const int tid = tid_opaque(), wid = tid >> 6, lane = tid & 63;
  const int pm = bid % 24, q = bid / 24;
  volatile __attribute__((address_space(3))) unsigned* flag = (volatile __attribute__((address_space(3))) unsigned*)(smem + XB_LDS_OFF + 8);
  asm volatile("s_waitcnt vmcnt(0)" ::: "memory");
  __syncthreads();
  if (tid == 0) {
    unsigned* cnt = p.bar + 9216 + ((l * 2 + (mode - 1)) * 24 + pm) * 16;
    __builtin_amdgcn_fence(__ATOMIC_RELEASE, "agent");
    asm volatile("s_waitcnt vmcnt(0)" ::: "memory");
    (void)__hip_atomic_fetch_add(cnt, 1u, __ATOMIC_RELAXED, __HIP_MEMORY_SCOPE_AGENT);
    unsigned sp = 0;
    while (__hip_atomic_load(cnt, __ATOMIC_RELAXED, __HIP_MEMORY_SCOPE_AGENT) < 8u) { __builtin_amdgcn_s_sleep(1); if (++sp > (1u << 22)) { atomicAdd(&p.bar[XB_TMO], 1u); break; } }
    __builtin_amdgcn_fence(__ATOMIC_ACQUIRE, "agent");
    asm volatile("s_waitcnt vmcnt(0)" ::: "memory");
    *flag = 1u;
  }
  __syncthreads();
  rows_at<4>(p, l, mode, pm * 256 + q * 32 + wid * 4, lane);
}

template <int l> __device__ __forceinline__ void run_layer(const int bid, const int nblk) {
  if (l == 1) TSTAMP(5);
  { PHASE_PARAMS(p); pg8::gemm_phase(pg8::Gemm{p.h, p.wt_in + (size_t)l * NPAD * DM, DM, DM, DM}, pg8::SchedIn{nblk, bid}, pg8::EpiIn{p.P, p.small}); }
#if REP & 1
#if REP & 65536
  { PHASE_PARAMS(p); pg8::gemm_phase(pg8::Gemm{p.h, p.wt_in + (size_t)l * NPAD * DM, DM, DM, DM}, pg8::SchedIn{nblk, bid}, pg8::EpiIn{p.P, p.small}); }
#else
  { PHASE_PARAMS(p); pg8::gemm_phase(pg8::Gemm{p.h, p.wt_in + (size_t)l * NPAD * DM, DM, DM, DM}, pg8::SchedIn{nblk, bid}, pg8::EpiIn{p.P, p.small}); }
#endif
#endif
  GRID_SYNC_WT(); if (l == 1) TSTAMP(6);
  { PHASE_PARAMS(p); for (int it = bid; it < 768; it += nblk) dn_prep_item(p, l, it >> 3, it & 7); }
#if REP & 2
  { PHASE_PARAMS(p); for (int it = bid; it < 768; it += nblk) dn_prep_item(p, l, it >> 3, it & 7); }
#endif
  if (l == 1) TSTAMP(15);
  { PHASE_PARAMS(p); for (int it = bid; it < 384; it += nblk) light_prep_item(p, l, it); }
#if REP & 4096
  { PHASE_PARAMS(p); for (int it = bid; it < 384; it += nblk) light_prep_item(p, l, it); }
#endif
  unsigned pf_ = 0;
  { PHASE_PARAMS(p); const int gid = bid * 512 + tid_opaque(); const char* q;
    if (gid < 98304) q = (const char*)p.h + (size_t)gid * 128;
    else if (gid < 114688) q = (const char*)(p.wt_in + (size_t)l * NPAD * DM + (size_t)42 * 256 * DM) + (size_t)(gid - 98304) * 128;
    else if (gid < 118784) q = (const char*)(p.wt_in + (size_t)l * NPAD * DM + (size_t)37 * 256 * DM) + (size_t)(gid - 114688) * 128;
    else q = (const char*)(p.wt_br + (size_t)(l * 3 + 1) * DM * DM) + (size_t)((gid - 118784) & 8191) * 128;
    asm volatile("global_load_dword %0, %1, off" : "=v"(pf_) : "v"(q) : "memory"); }
  GRID_SYNC(); if (l == 1) TSTAMP(7);
  asm volatile("" :: "v"(pf_));
#define P3_PULL(slotword, limit) \
      volatile __attribute__((address_space(3))) unsigned* qslot = (volatile __attribute__((address_space(3))) unsigned*)(smem + XB_LDS_OFF + 12); \
      __syncthreads(); \
      if (tid_opaque() == 0) { PHASE_PARAMS(pq); *qslot = __hip_atomic_fetch_add(pq.bar + 8192 + l * 8 + rep3 * 4 + (slotword), 1u, __ATOMIC_RELAXED, __HIP_MEMORY_SCOPE_AGENT); } \
      __syncthreads(); \
      const int it = __builtin_amdgcn_readfirstlane((int)*qslot); \
      if (it >= (limit)) break;
#pragma unroll 1
  for (int rep3 = 0; rep3 < ((REP & 4) ? 2 : 1); ++rep3) {
    if (bid < 64) { PHASE_PARAMS(p); attn_item(p, bid); }
    else {
      if (bid >= 192)
#pragma unroll 1
      for (int rr_ = 0; rr_ < ((REP & 131072) ? 2 : 1); ++rr_) {
        const int it = bid - 192; TSTAMP(1);
        if (it >= 32) { PHASE_PARAMS(p); const int k = it - 32; pg8::Unit u; if (k < 8) { u.pm = 16 + k; u.pn = 37; } else { u.pm = (k - 8) % 24; u.pn = 42 + (k - 8) / 24; } u.z = 0; u.ka = 0; u.kb = 0;
          pg8::gemm_phase(pg8::Gemm{p.h, p.wt_in + (size_t)l * NPAD * DM, DM, DM, DM}, pg8::SchedOne{u}, pg8::EpiIn{p.P, p.small}); }
        else { PHASE_PARAMS(p); pg8::Unit u; u.pm = it % 24; u.pn = it / 24; u.z = 1; u.ka = (size_t)NTOK * DM; u.kb = (size_t)DM * DM;
          pg8::gemm_phase(pg8::Gemm{p.obr, p.wt_br + (size_t)l * 3 * DM * DM, DM, DM, DM}, pg8::SchedOne{u}, pg8::EpiBr{p.a3, p.P}); }
      }
      TSTAMP(2);
#pragma unroll 1
      for (int j = bid - 64; j < 32 + 256; j += (bid < 96 ? 1000 : 160)) {
        PHASE_PARAMS(p);
        if (j < 32) dn_scan_item(p, l, 16 + (j >> 4), (j >> 1) & 7, j & 1); else { const int jj = j - 32; dn_scan_item(p, l, jj >> 4, (jj >> 1) & 7, jj & 1); }
      }
    }
    TSTAMP(3);
#pragma unroll 1
    for (;;) { P3_PULL(2, 128) { PHASE_PARAMS(p); attn_item(p, 64 + it); } }
#pragma unroll 1
    for (;;) { P3_PULL(3, 32 + 104 - 64) const int itd = it + 64;
      if (itd >= 32) { PHASE_PARAMS(p); const int k = itd - 32; pg8::Unit u; if (k < 8) { u.pm = 16 + k; u.pn = 37; } else { u.pm = (k - 8) % 24; u.pn = 42 + (k - 8) / 24; } u.z = 0; u.ka = 0; u.kb = 0;
        pg8::gemm_phase(pg8::Gemm{p.h, p.wt_in + (size_t)l * NPAD * DM, DM, DM, DM}, pg8::SchedOne{u}, pg8::EpiIn{p.P, p.small}); }
      else { PHASE_PARAMS(p); pg8::Unit u; u.pm = itd % 24; u.pn = itd / 24; u.z = 1; u.ka = (size_t)NTOK * DM; u.kb = (size_t)DM * DM;
        pg8::gemm_phase(pg8::Gemm{p.obr, p.wt_br + (size_t)l * 3 * DM * DM, DM, DM, DM}, pg8::SchedOne{u}, pg8::EpiBr{p.a3, p.P}); }
    }
#pragma unroll 1
    for (;;) { P3_PULL(5, 64) { PHASE_PARAMS(p); dn_finalize_item(p, l, it); } }
  }
#undef P3_PULL
  GRID_SYNC(); if (l == 1) TSTAMP(8);
  { PHASE_PARAMS(p); pg8::gemm_phase(pg8::Gemm{p.obr, p.wt_br + (size_t)l * 3 * DM * DM, DM, DM, DM}, pg8::SchedBr{nblk, bid}, pg8::EpiBr{p.a3, p.P}); }
#if REP & 8
  { PHASE_PARAMS(p); pg8::gemm_phase(pg8::Gemm{p.obr, p.wt_br + (size_t)l * 3 * DM * DM, DM, DM, DM}, pg8::SchedBr{nblk, bid}, pg8::EpiBr{p.a3, p.P}); }
#endif
  GRID_SYNC_WT(); if (l == 1) TSTAMP(9);
  { PHASE_PARAMS(p); pg8::gemm_phase(pg8::Gemm{p.a3, p.wt_out + (size_t)l * DM * 3072, 3072, 3072, 1536}, pg8::SchedSplit2<1536>{nblk, bid}, pg8::EpiPart{(bfr*)p.R}); }
  if (l + 1 < DEPTH && bid >= 192) { PHASE_PARAMS(p); for (int k = bid - 192; k < CONV_SPLIT; k += nblk - 192) convert_item(p, l + 1, k); }
#if REP & 16
  { PHASE_PARAMS(p); pg8::gemm_phase(pg8::Gemm{p.a3, p.wt_out + (size_t)l * DM * 3072, 3072, 3072, 1536}, pg8::SchedSplit2<1536>{nblk, bid}, pg8::EpiPart{(bfr*)p.R}); }
#endif
  GRID_SYNC_WT(); if (l == 1) TSTAMP(10);
  { PHASE_PARAMS(p); stage_row(p, l, 1, bid, nblk); }
  GRID_SYNC(); if (l == 1) TSTAMP(11);
  { PHASE_PARAMS(p); pg8::gemm_phase(pg8::Gemm{p.h, p.wt_up + (size_t)l * HID * DM, DM, DM, DM}, pg8::SchedUp{nblk, bid}, pg8::EpiUp{p.u2}); }
#if REP & 32
  { PHASE_PARAMS(p); pg8::gemm_phase(pg8::Gemm{p.h, p.wt_up + (size_t)l * HID * DM, DM, DM, DM}, pg8::SchedUp{nblk, bid}, pg8::EpiUp{p.u2}); }
#endif
  GRID_SYNC_WT(); if (l == 1) TSTAMP(12);
  { PHASE_PARAMS(p); pg8::gemm_phase(pg8::Gemm{p.u2, p.wt_dn + (size_t)l * DM * HID, HID, HID, 2048}, pg8::SchedSplit2<2048>{nblk, bid}, pg8::EpiPart{(bfr*)p.R}); }
  if (l + 1 < DEPTH && bid >= 192) { PHASE_PARAMS(p); for (int k = CONV_SPLIT + bid - 192; k < CONV_ITEMS; k += nblk - 192) convert_item(p, l + 1, k); }
  GRID_SYNC_WT(); if (l == 1) TSTAMP(13);
  { PHASE_PARAMS(p); stage_row(p, l, 2, bid, nblk); }
  if (l + 1 < DEPTH) GRID_SYNC(); if (l == 1) TSTAMP(14);
}

__global__ __launch_bounds__(512) void mega_kernel(Params p_arg) {
#if USE_CG_SYNC
  cg::grid_group grid = cg::this_grid();
#endif
  const int bid = blockIdx.x, nblk = gridDim.x;
#if !USE_CG_SYNC
  { PHASE_PARAMS(pb); xcd_barrier_post(pb.bar); }
  cg::this_grid().sync();
#endif
#ifdef DIAG_A
  if (threadIdx.x < 32) ((unsigned long long*)(smem + 163840 - 256))[threadIdx.x & 15] = 0ull;
  __syncthreads();
#endif
  { PHASE_PARAMS(p); stage_mod(p, bid, nblk, smem); }
#if REP & 8192
  { PHASE_PARAMS(p); stage_mod(p, bid, nblk, smem); }
#endif
  { PHASE_PARAMS(p); for (int it = bid; it < CONV_ITEMS; it += nblk) convert_item(p, 0, it); }
#if REP & 128
  { PHASE_PARAMS(p); for (int it = bid; it < CONV_ITEMS; it += nblk) convert_item(p, 0, it); }
#endif
  GRID_SYNC();
  { PHASE_PARAMS(p); stage_row(p, 0, 0, bid, nblk); }
#if REP & 16384
  { PHASE_PARAMS(p); stage_row(p, 0, 0, bid, nblk); }
#endif
  GRID_SYNC();
  run_layer<0>(bid, nblk); run_layer<1>(bid, nblk); run_layer<2>(bid, nblk); run_layer<3>(bid, nblk);
#ifdef DIAG_A
  __syncthreads();
  if (blockIdx.x == DIAG_BLK && threadIdx.x == 0) { const unsigned long long* ts_ = (const unsigned long long*)(smem + 163840 - 256); PHASE_PARAMS(pd); asm volatile("s_waitcnt vmcnt(0)" ::: "memory");
#ifdef DIAG_G
    const unsigned long long* gs_ = (const unsigned long long*)(pd.bar + 12288); const unsigned long long ta_ = __hip_atomic_load(gs_ + DIAG_A, __ATOMIC_RELAXED, __HIP_MEMORY_SCOPE_AGENT), tb_ = __hip_atomic_load(gs_ + DIAG_B, __ATOMIC_RELAXED, __HIP_MEMORY_SCOPE_AGENT);
    pd.xbuf[0] = 1000.0f * rintf(4.0f * log2f((float)(tb_ - ta_) * 10.0f));
#else
    pd.xbuf[(size_t)DIAG_BLK * 24 * 1024] = 1000.0f * rintf(4.0f * log2f((float)(ts_[DIAG_B] - ts_[DIAG_A]) * 10.0f));
#endif
  }
#endif
}

__global__ void diag_fill(float* out, long n, float v) { for (long i = blockIdx.x * 256L + threadIdx.x; i < n; i += gridDim.x * 256L) out[i] = (i == 0) ? v : 0.f; }
static size_t align_up(size_t x) { return (x + 255) & ~(size_t)255; }
static bool make_params(Params& p, void* const* d_in, void* d_out, void* d_ws, size_t ws_size) {
  const float** in = (const float**)d_in;
  p.x_prompt = in[0]; p.x_sample = in[1]; p.cache_k = in[2]; p.cache_v = in[3]; p.state_dn = in[4]; p.c = in[5]; p.c_ctx = in[6];
  p.w_mod = in[7]; p.b_mod = in[8]; p.g_pre_mix = in[9]; p.g_post_mix = in[10]; p.g_pre_mlp = in[11]; p.g_post_mlp = in[12];
  p.w_in = in[13]; p.w_conv_dn = in[14]; p.a_log = in[15]; p.dt_bias = in[16]; p.g_dn_out = in[17]; p.w_conv_sc = in[18];
  p.g_q = in[19]; p.g_k = in[20]; p.w_br_dn = in[21]; p.w_br_sc = in[22]; p.w_br_att = in[23]; p.w_out = in[24];
  p.w_mlp_up = in[25]; p.w_mlp_down = in[26];
  float* out = (float*)d_out;
  p.xbuf = out; p.out_ck = out + 6291456; p.out_cv = p.out_ck + 4194304; p.out_state = p.out_cv + 4194304;
  char* w = (char*)d_ws; size_t off = 0;
  auto take = [&](size_t bytes) { char* r = w + off; off = align_up(off + bytes); return r; };
  p.bar   = (unsigned*)take(65536);
  p.wt_in = (bfr*)take((size_t)DEPTH * NPAD * DM * 2);
  p.wt_br = (bfr*)take((size_t)DEPTH * 3 * DM * DM * 2);
  p.wt_out= (bfr*)take((size_t)DEPTH * DM * 3072 * 2);
  p.wt_up = (bfr*)take((size_t)DEPTH * HID * DM * 2);
  p.wt_dn = (bfr*)take((size_t)DEPTH * DM * HID * 2);
  p.mod   = (float*)take((size_t)DEPTH * 3 * 6144 * 4);
  p.h     = (bfr*)take((size_t)NTOK * DM * 2);
  p.P     = (bfr*)take((size_t)NTOK * NP * 2);
  p.u2    = p.P;
  p.small = (float*)take((size_t)NTOK * 32 * 4);
  p.dnrec = take((size_t)1536 * REC_BYTES);
  p.glast = (float*)take(1536 * 4);
  p.opart = (bfr*)take((size_t)2 * NTOK * DM * 2);
  p.obr   = (bfr*)take((size_t)3 * NTOK * DM * 2);
  p.Q     = (bfr*)take((size_t)NTOK * DM * 2);
  p.Kc    = (bfr*)take((size_t)NCTX * 256 * 2);
  p.Vc    = (bfr*)take((size_t)NCTX * 256 * 2);
  p.Ks    = (bfr*)take((size_t)2 * 1280 * 256 * 2);
  p.Vs    = (bfr*)take((size_t)2 * 1280 * 256 * 2);
  p.merged= (bfr*)take((size_t)NTOK * DM * 2);
  p.a3    = (bfr*)take((size_t)NTOK * 3072 * 2);
  p.R     = (float*)take((size_t)4 * NTOK * DM * 4);
  return off <= ws_size;
}
extern "C" void kernel_launch(void* const* d_in, const int* in_sizes, int n_in, void* d_out, int out_size, void* d_ws, size_t ws_size, hipStream_t stream) {
  Params p{};
  if (n_in != 27 || out_size != 31457280) { diag_fill<<<1024, 256, 0, stream>>>((float*)d_out, (long)out_size, 3.0e6f + n_in); return; }
  if (!make_params(p, d_in, d_out, d_ws, ws_size)) { diag_fill<<<1024, 256, 0, stream>>>((float*)d_out, (long)out_size, (float)(ws_size >> 20)); return; }
  static int grid_blocks = 0;
  if (!grid_blocks) {
    (void)hipFuncSetAttribute((const void*)mega_kernel, hipFuncAttributeMaxDynamicSharedMemorySize, DYN_LDS);
    int dev = 0, cus = 0, per_cu = 0;
    (void)hipGetDevice(&dev);
    (void)hipDeviceGetAttribute(&cus, hipDeviceAttributeMultiprocessorCount, dev);
    (void)hipOccupancyMaxActiveBlocksPerMultiprocessor(&per_cu, mega_kernel, 512, DYN_LDS);
    grid_blocks = (per_cu >= 1 && cus >= 256) ? 256 : cus * per_cu;
    if (grid_blocks <= 0) { fprintf(stderr, "kernel_launch: occupancy query gave cus %d per_cu %d\n", cus, per_cu); grid_blocks = 0; return; }
  }
  (void)hipMemsetAsync(p.bar, 0, 65536, stream);
  void* args[] = {&p};
  const hipError_t e = hipLaunchCooperativeKernel((void*)mega_kernel, dim3(grid_blocks), dim3(512), args, DYN_LDS, stream);
  if (e != hipSuccess) fprintf(stderr, "cooperative launch failed: %s (grid %d)\n", hipGetErrorString(e), grid_blocks);
}
```

```cpp
#define USE_CG_SYNC 0
#include <hip/hip_runtime.h>
#include <hip/hip_bf16.h>
#include <hip/hip_cooperative_groups.h>
#include <cstdio>
#include <cstdint>
namespace cg = cooperative_groups;

typedef unsigned short bfr;
using bf16x8 = __attribute__((ext_vector_type(8))) short;
using s16x4  = __attribute__((ext_vector_type(4))) short;
using f32x4  = __attribute__((ext_vector_type(4))) float;
using f32x16 = __attribute__((ext_vector_type(16))) float;
using u32x4  = __attribute__((ext_vector_type(4))) unsigned;
using u32x2  = __attribute__((ext_vector_type(2))) unsigned;

extern __shared__ __attribute__((aligned(16))) char smem[];
__device__ __forceinline__ char* smem_base() { return smem; }
constexpr int DM = 1024, NTOK = 6144, NCTX = 4096, DEPTH = 4;
constexpr int NIN = 11808;
constexpr int NP = 11776;
constexpr int NPAD = 12032;
constexpr int HID = 4096;
constexpr float EPS = 1e-6f;
constexpr int C_DQ = 0, C_DK = 1024, C_DV = 2048, C_DG = 3072, C_SB = 4096, C_SCG = 5120, C_SX = 6144,
              C_AQ = 7168, C_AK = 8192, C_AV = 8448, C_MG = 8704;

constexpr int REC_U = 0, REC_W = 16384, REC_QD = 32768, REC_QK = 49152, REC_KD = 57344, REC_BYTES = 73728;

struct Params {
  const float *x_prompt, *x_sample, *cache_k, *cache_v, *state_dn, *c, *c_ctx, *w_mod, *b_mod;
  const float *g_pre_mix, *g_post_mix, *g_pre_mlp, *g_post_mlp, *w_in, *w_conv_dn, *a_log, *dt_bias, *g_dn_out;
  const float *w_conv_sc, *g_q, *g_k, *w_br_dn, *w_br_sc, *w_br_att, *w_out, *w_mlp_up, *w_mlp_down;
  float *xbuf;
  float *out_ck, *out_cv, *out_state;
  bfr *wt_in, *wt_br, *wt_out, *wt_up, *wt_dn;
  float *mod;
  bfr *h;
  bfr *P;
  float *small;
  char *dnrec;
  float *glast;
  bfr *opart;
  bfr *obr;
  bfr *Q;
  bfr *Kc, *Vc;
  bfr *Ks, *Vs;
  bfr *merged;
  bfr *a3;
  float *R;
  bfr *u2;
  unsigned *bar;
};

__device__ __forceinline__ bfr f2bf(float f) { unsigned u = __float_as_uint(f); u += 0x7fffu + ((u >> 16) & 1u); return (bfr)(u >> 16); }
__device__ __forceinline__ float bf2f(bfr b) { return __uint_as_float(((unsigned)b) << 16); }
__device__ __forceinline__ unsigned pack2(float a, float b) { return (unsigned)f2bf(a) | ((unsigned)f2bf(b) << 16); }
__device__ __forceinline__ unsigned pack2hw(float a, float b) { unsigned r; asm("v_cvt_pk_bf16_f32 %0, %1, %2" : "=v"(r) : "v"(a), "v"(b)); return r; }
__device__ __forceinline__ float sigmoidf_(float x) { return 1.f / (1.f + __expf(-x)); }
__device__ __forceinline__ float siluf_(float x) { return x * __builtin_amdgcn_rcpf(1.f + __expf(-x)); }
__device__ __forceinline__ float softplusf_(float x) { return x > 20.f ? x : log1pf(__expf(x)); }

__device__ __forceinline__ int tok_modrow(int t) { return t < NCTX ? 0 : 1 + ((t - NCTX) >> 10); }
__device__ __forceinline__ int tok_L(int t) { return t < NCTX ? 256 : 1024; }
__device__ __forceinline__ int tok_pos(int t) { return t < NCTX ? (t & 255) : ((t - NCTX) & 1023); }

__host__ __device__ __forceinline__ int perm_col(int n) { return n < 4096 ? n : (n < 4128 ? NP + (n - 4096) : n - 32); }

__device__ __forceinline__ int tid_opaque() { int t = threadIdx.x; asm volatile("" : "+v"(t)); return t; }

#ifdef DIAG_A
#ifndef DIAG_BLK
#define DIAG_BLK 0
#endif
#define TSTAMP(k) do { if (blockIdx.x == DIAG_BLK && threadIdx.x == 0) { unsigned long long* ts_ = (unsigned long long*)(smem_base() + 163840 - 256); if (ts_[(k)] == 0ull) ts_[(k)] = wall_clock64(); } } while (0)
#else
#define TSTAMP(k) do {} while (0)
#endif

#ifdef DIAG_A
#define GSTAMP(bar, k) do { if (threadIdx.x == 0) __hip_atomic_store((unsigned long long*)((bar) + 12288) + (k), (unsigned long long)wall_clock64(), __ATOMIC_RELAXED, __HIP_MEMORY_SCOPE_AGENT); } while (0)
#else
#define GSTAMP(bar, k) do {} while (0)
#endif

#ifdef DIAG_G
#define GMAX(bar, k) do { if (threadIdx.x == 0) __hip_atomic_fetch_max((unsigned long long*)((bar) + 12288) + (k), (unsigned long long)wall_clock64(), __ATOMIC_RELAXED, __HIP_MEMORY_SCOPE_AGENT); } while (0)
#else
#define GMAX(bar, k) do {} while (0)
#endif
#define NTHR 512

__device__ __forceinline__ void stage_mod(const Params& p, int bid, int nblk, char* lds) {
  float* s = (float*)lds;
  float* red = s + 3072;
  const int tid = tid_opaque();
  for (int i = tid; i < 3072; i += NTHR) { int j = i >> 10, k = i & 1023; float c = (j == 0) ? p.c_ctx[k] : p.c[(j - 1) * 1024 + k]; s[i] = siluf_(c); }
  __syncthreads();
  for (int item = bid; item < 192; item += nblk) {
    const int l = item / 48, nb = item % 48, cq = tid & 31, ks = tid >> 5;
    const float* W = p.w_mod + ((size_t)l * 1024 + ks * 64) * 6144 + nb * 128 + cq * 4;
    float a[3][4] = {};
    for (int k = 0; k < 64; ++k) {
      const float4 w = *(const float4*)(W + (size_t)k * 6144);
#pragma unroll
      for (int j = 0; j < 3; ++j) { const float sv = s[j * 1024 + ks * 64 + k]; a[j][0] += sv * w.x; a[j][1] += sv * w.y; a[j][2] += sv * w.z; a[j][3] += sv * w.w; }
    }
    __syncthreads();
#pragma unroll
    for (int j = 0; j < 3; ++j)
#pragma unroll
      for (int q = 0; q < 4; ++q) red[(ks * 3 + j) * 128 + cq * 4 + q] = a[j][q];
    __syncthreads();
    if (tid < 384) { const int j = tid >> 7, n = tid & 127; float sum = 0; for (int q = 0; q < 16; ++q) sum += red[(q * 3 + j) * 128 + n];
      p.mod[(size_t)(l * 3 + j) * 6144 + nb * 128 + n] = sum + p.b_mod[l * 6144 + nb * 128 + n]; }
  }
  __syncthreads();
}

__device__ __forceinline__ float wave_sum(float v) {
#pragma unroll
  for (int o = 32; o > 0; o >>= 1) v += __shfl_xor(v, o);
  return v;
}

template <int NR>
__device__ __forceinline__ void rows_at(const Params& p, int l, int mode, int row0, int lane) {
  float4 x[NR][4], r[NR][4];
#pragma unroll
  for (int j = 0; j < NR; ++j) {
    const int row = row0 + j;
    if (l == 0 && mode <= 1) {
      const float* xin = row < NCTX ? p.x_prompt + (size_t)row * DM : p.x_sample + (size_t)(row - NCTX) * DM;
#pragma unroll
      for (int i = 0; i < 4; ++i) x[j][i] = *(const float4*)(xin + lane * 4 + 256 * i);
    } else {
      const bfr* xin = p.merged + (size_t)row * DM;
#pragma unroll
      for (int i = 0; i < 4; ++i) { const u32x2 a = *(const u32x2*)(xin + lane * 4 + 256 * i);
        x[j][i] = make_float4(__uint_as_float(a[0] << 16), __uint_as_float(a[0] & 0xffff0000u), __uint_as_float(a[1] << 16), __uint_as_float(a[1] & 0xffff0000u)); }
    }
    if (mode != 0) {
      const bfr* rr = (const bfr*)p.R + (size_t)row * DM;
#pragma unroll
      for (int i = 0; i < 4; ++i) { const u32x2 a = *(const u32x2*)(rr + lane * 4 + 256 * i), b = *(const u32x2*)(rr + (size_t)NTOK * DM + lane * 4 + 256 * i);
        r[j][i] = make_float4(__uint_as_float(a[0] << 16) + __uint_as_float(b[0] << 16), __uint_as_float(a[0] & 0xffff0000u) + __uint_as_float(b[0] & 0xffff0000u),
                              __uint_as_float(a[1] << 16) + __uint_as_float(b[1] << 16), __uint_as_float(a[1] & 0xffff0000u) + __uint_as_float(b[1] & 0xffff0000u)); }
    }
  }
  if (mode != 0) {
    const float* gpost = (mode == 1 ? p.g_post_mix : p.g_post_mlp) + l * DM;
    float4 g[4];
#pragma unroll
    for (int i = 0; i < 4; ++i) g[i] = *(const float4*)(gpost + lane * 4 + 256 * i);
#pragma unroll
    for (int j = 0; j < NR; ++j) {
      const int row = row0 + j;
      const float* gate = p.mod + (size_t)(l * 3 + tok_modrow(row)) * 6144 + (mode == 1 ? 2048 : 5120);
      float ss = 0;
#pragma unroll
      for (int i = 0; i < 4; ++i) ss += r[j][i].x * r[j][i].x + r[j][i].y * r[j][i].y + r[j][i].z * r[j][i].z + r[j][i].w * r[j][i].w;
      ss = wave_sum(ss);
      const float nrm = rsqrtf(ss * (1.f / DM) + EPS);
#pragma unroll
      for (int i = 0; i < 4; ++i) {
        const float4 gt = *(const float4*)(gate + lane * 4 + 256 * i);
        x[j][i].x += gt.x * (r[j][i].x * nrm * g[i].x); x[j][i].y += gt.y * (r[j][i].y * nrm * g[i].y); x[j][i].z += gt.z * (r[j][i].z * nrm * g[i].z); x[j][i].w += gt.w * (r[j][i].w * nrm * g[i].w);
        if (mode == 2 && l == DEPTH - 1) *(float4*)(p.xbuf + (size_t)row * DM + lane * 4 + 256 * i) = x[j][i];
        else { u32x2 o = {pack2hw(x[j][i].x, x[j][i].y), pack2hw(x[j][i].z, x[j][i].w)}; *(u32x2*)(p.merged + (size_t)row * DM + lane * 4 + 256 * i) = o; }
      }
    }
  }
  if (mode == 2 && l == DEPTH - 1) return;
  const int ln = (mode == 2) ? l + 1 : l;
  const float* gpre = (mode == 1 ? p.g_pre_mlp : p.g_pre_mix) + ln * DM;
  float4 gp[4];
#pragma unroll
  for (int i = 0; i < 4; ++i) gp[i] = *(const float4*)(gpre + lane * 4 + 256 * i);
#pragma unroll
  for (int j = 0; j < NR; ++j) {
    const int row = row0 + j;
    const float* modn = p.mod + (size_t)(ln * 3 + tok_modrow(row)) * 6144;
    const float* sh = modn + (mode == 1 ? 3072 : 0);
    const float* sc = modn + (mode == 1 ? 4096 : 1024);
    float ss = 0;
#pragma unroll
    for (int i = 0; i < 4; ++i) ss += x[j][i].x * x[j][i].x + x[j][i].y * x[j][i].y + x[j][i].z * x[j][i].z + x[j][i].w * x[j][i].w;
    ss = wave_sum(ss);
    const float nrm = rsqrtf(ss * (1.f / DM) + EPS);
#pragma unroll
    for (int i = 0; i < 4; ++i) {
      const float4 s1 = *(const float4*)(sc + lane * 4 + 256 * i), s0 = *(const float4*)(sh + lane * 4 + 256 * i);
      const float h0 = x[j][i].x * nrm * gp[i].x * (1.f + s1.x) + s0.x, h1 = x[j][i].y * nrm * gp[i].y * (1.f + s1.y) + s0.y;
      const float h2 = x[j][i].z * nrm * gp[i].z * (1.f + s1.z) + s0.z, h3 = x[j][i].w * nrm * gp[i].w * (1.f + s1.w) + s0.w;
      u32x2 o = {pack2hw(h0, h1), pack2hw(h2, h3)};
      *(u32x2*)(p.h + (size_t)row * DM + lane * 4 + 256 * i) = o;
    }
  }
}

__device__ __forceinline__ void stage_row(const Params& p, int l, int mode, int bid, int nblk) {
  const int tx_ = tid_opaque(), wid = tx_ >> 6, lane = tx_ & 63;
  const int row0 = (bid * 8 + wid) * 3;
  if (row0 >= NTOK) return;
  rows_at<3>(p, l, mode, row0, lane);
}

__device__ __forceinline__ void unpack8(const u32x4 v, float* f) {
#pragma unroll
  for (int i = 0; i < 4; ++i) { f[2 * i] = __uint_as_float(v[i] << 16); f[2 * i + 1] = __uint_as_float(v[i] & 0xffff0000u); }
}
__device__ __forceinline__ u32x4 pack8(const float* f) { u32x4 v = {pack2(f[0], f[1]), pack2(f[2], f[3]), pack2(f[4], f[5]), pack2(f[6], f[7])}; return v; }
__device__ __forceinline__ u32x4 pack8hw(const float* f) { u32x4 v = {pack2hw(f[0], f[1]), pack2hw(f[2], f[3]), pack2hw(f[4], f[5]), pack2hw(f[6], f[7])}; return v; }

__device__ __forceinline__ void light_prep_item(const Params& p, int l, int item) {
  const int tid = tid_opaque(), t0 = item * 16;
  const bool samp = t0 >= NCTX;
  {
    const float* wsc = p.w_conv_sc + (size_t)l * 3 * DM;
    bfr* scin = p.obr + (size_t)1 * NTOK * DM;
    const int g = tid & 127, rq = tid >> 7, r0 = rq * 4, tA = t0 + r0, posA = tok_pos(tA), L = tok_L(tA);
    u32x4 cg[6], cx[6], sbv[4];
#pragma unroll
    for (int k = 0; k < 6; ++k) {
      const int pos = posA + k - 1;
      cg[k] = u32x4{0u, 0u, 0u, 0u}; cx[k] = u32x4{0u, 0u, 0u, 0u};
      if (pos >= 0 && pos < L) { const bfr* row = p.P + (size_t)(tA + k - 1) * NP; cg[k] = *(const u32x4*)(row + C_SCG + g * 8); cx[k] = *(const u32x4*)(row + C_SX + g * 8); }
    }
#pragma unroll
    for (int r = 0; r < 4; ++r) sbv[r] = *(const u32x4*)(p.P + (size_t)(tA + r) * NP + C_SB + g * 8);
    float w[3][8];
#pragma unroll
    for (int k = 0; k < 3; ++k) { *(float4*)&w[k][0] = *(const float4*)(wsc + k * DM + g * 8); *(float4*)&w[k][4] = *(const float4*)(wsc + k * DM + g * 8 + 4); }
    float prod[6][8];
#pragma unroll
    for (int k = 0; k < 6; ++k) { float a[8], b[8]; unpack8(cg[k], a); unpack8(cx[k], b);
#pragma unroll
      for (int q = 0; q < 8; ++q) prod[k][q] = a[q] * b[q]; }
#pragma unroll
    for (int r = 0; r < 4; ++r) {
      float sb[8], acc[8]; unpack8(sbv[r], sb);
#pragma unroll
      for (int q = 0; q < 8; ++q) acc[q] = sb[q] * (w[0][q] * prod[r][q] + w[1][q] * prod[r + 1][q] + w[2][q] * prod[r + 2][q]);
      *(u32x4*)(scin + (size_t)(tA + r) * DM + g * 8) = pack8hw(acc);
    }
  }
  {
    const int sub = tid & 15;
    u32x4 xin[5];
#pragma unroll
    for (int it5 = 0; it5 < 5; ++it5) {
      const int pr = (tid >> 4) + it5 * 32, r = pr / 10, hh = pr % 10, t = t0 + r;
      xin[it5] = *(const u32x4*)(p.P + (size_t)t * NP + (hh < 8 ? C_AQ + hh * 128 : C_AK + (hh - 8) * 128) + sub * 8);
    }
#pragma unroll
    for (int it5 = 0; it5 < 5; ++it5) {
      const int pr = (tid >> 4) + it5 * 32;
      const int r = pr / 10, hh = pr % 10, t = t0 + r;
      const bool isq = hh < 8;
      float x[8]; unpack8(xin[it5], x);
      float ss = 0;
#pragma unroll
      for (int q = 0; q < 8; ++q) ss += x[q] * x[q];
      ss += __shfl_xor(ss, 1); ss += __shfl_xor(ss, 2); ss += __shfl_xor(ss, 4); ss += __shfl_xor(ss, 8);
      const float nrm = rsqrtf(ss * (1.f / 128.f) + EPS);
      const float* g = (isq ? p.g_q : p.g_k) + l * 128 + sub * 8;
#pragma unroll
      for (int q = 0; q < 8; ++q) x[q] = x[q] * nrm * g[q];
      if (samp) {
        const int pos = tok_pos(t);
        const float pidx = (sub < 8) ? (float)(pos >> 6) : (float)(pos & 63);
        const int s8 = sub & 7;
        const bool lo = s8 < 4;
        float y[8];
#pragma unroll
        for (int q = 0; q < 8; ++q) {
          const float other = __shfl_xor(x[q], 4);
          const int fi = (s8 & 3) * 8 + q;
          const float freq = exp2f(-(float)fi * (13.287712379549449f / 32.f));
          const float ang = pidx * freq;
          float sn, cs; __sincosf(ang, &sn, &cs);
          y[q] = lo ? (x[q] * cs - other * sn) : (other * sn + x[q] * cs);
        }
#pragma unroll
        for (int q = 0; q < 8; ++q) x[q] = y[q];
      }
      if (isq) {
        *(u32x4*)(p.Q + (size_t)t * DM + hh * 128 + sub * 8) = pack8hw(x);
      } else {
        const int kvh = hh - 8;
        if (!samp) {
          *(u32x4*)(p.Kc + (size_t)t * 256 + kvh * 128 + sub * 8) = pack8hw(x);
          const int b = t >> 8, pos = t & 255;
          float* o = p.out_ck + ((((size_t)b * DEPTH + l) * 256 + pos) * 2 + kvh) * 128 + sub * 8;
          *(float4*)o = make_float4(x[0], x[1], x[2], x[3]); *(float4*)(o + 4) = make_float4(x[4], x[5], x[6], x[7]);
        } else {
          const int s = t - NCTX, b = s >> 10, pos = s & 1023;
          *(u32x4*)(p.Ks + ((size_t)b * 1280 + 256 + pos) * 256 + kvh * 128 + sub * 8) = pack8hw(x);
        }
      }
    }
  }
  for (int idx = tid; idx < 16 * 32; idx += NTHR) {
    const int r = idx >> 5, g = idx & 31, t = t0 + r;
    const u32x4 v = *(const u32x4*)(p.P + (size_t)t * NP + C_AV + g * 8);
    if (!samp) {
      *(u32x4*)(p.Vc + (size_t)t * 256 + g * 8) = v;
      float f[8]; unpack8(v, f);
      const int b = t >> 8, pos = t & 255;
      float* o = p.out_cv + (((size_t)b * DEPTH + l) * 256 + pos) * 256 + g * 8;
      *(float4*)o = make_float4(f[0], f[1], f[2], f[3]); *(float4*)(o + 4) = make_float4(f[4], f[5], f[6], f[7]);
    } else {
      const int s = t - NCTX, b = s >> 10, pos = s & 1023;
      *(u32x4*)(p.Vs + ((size_t)b * 1280 + 256 + pos) * 256 + g * 8) = v;
    }
  }
  if (samp) {
    const int cs = item - 256, b = cs >> 6, pos0 = (cs & 63) * 4;
    for (int idx = tid; idx < 2 * 4 * 32; idx += NTHR) {
      const int which = idx >> 7, r = (idx >> 5) & 3, g = idx & 31, pos = pos0 + r;
      const float* src = (which ? p.cache_v : p.cache_k) + (((size_t)b * DEPTH + l) * 256 + pos) * 256 + g * 8;
      float f[8]; *(float4*)f = *(const float4*)src; *(float4*)(f + 4) = *(const float4*)(src + 4);
      *(u32x4*)((which ? p.Vs : p.Ks) + ((size_t)b * 1280 + pos) * 256 + g * 8) = pack8hw(f);
    }
  }
}

__device__ __forceinline__ void dn_finalize(const Params& p, int l, int t0, int n, int h, int tid0, int nthr) {
  const int sub = tid0 & 15, rpp = nthr / 16;
  const float* g = p.g_dn_out + l * 128 + sub * 8;
  float gv[8];
#pragma unroll
  for (int q = 0; q < 8; ++q) gv[q] = g[q];
  for (int r = tid0 >> 4; r < n; r += rpp * 4) {
    u32x4 va[4], vb[4], vg[4];
#pragma unroll
    for (int u = 0; u < 4; ++u) {
      const int t = t0 + r + u * rpp;
      va[u] = *(const u32x4*)(p.opart + (size_t)t * DM + h * 128 + sub * 8);
      vb[u] = *(const u32x4*)(p.opart + (size_t)NTOK * DM + (size_t)t * DM + h * 128 + sub * 8);
      vg[u] = *(const u32x4*)(p.P + (size_t)t * NP + C_DG + h * 128 + sub * 8);
    }
#pragma unroll
    for (int u = 0; u < 4; ++u) {
      const int t = t0 + r + u * rpp;
      float a[8], b[8], dg[8];
      unpack8(va[u], a); unpack8(vb[u], b); unpack8(vg[u], dg);
      float ss = 0;
#pragma unroll
      for (int q = 0; q < 8; ++q) { a[q] += b[q]; ss += a[q] * a[q]; }
      ss += __shfl_xor(ss, 1); ss += __shfl_xor(ss, 2); ss += __shfl_xor(ss, 4); ss += __shfl_xor(ss, 8);
      const float nrm = rsqrtf(ss * (1.f / 128.f) + EPS);
#pragma unroll
      for (int q = 0; q < 8; ++q) a[q] = a[q] * nrm * gv[q] * siluf_(dg[q]);
      *(u32x4*)(p.obr + (size_t)t * DM + h * 128 + sub * 8) = pack8hw(a);
    }
  }
}
constexpr int HT_BYTES = 128 * 64 * 2;

__device__ __forceinline__ int lds_byte(int r, int c) {
  int st = (r >> 4) * 2 + (c >> 5), rr = r & 15, cc = c & 31, ob = rr * 64 + cc * 2;
  return st * 1024 + (ob ^ (((ob >> 9) & 1) << 5));
}
__device__ __forceinline__ void stage_rc(int b, int& R, int& C) {
  int st = b / 1024, sb = b % 1024, swz = sb ^ (((sb >> 9) & 1) << 5);
  R = (st >> 1) * 16 + swz / 64; C = (st & 1) * 32 + (swz % 64) / 2;
}
__device__ __forceinline__ void stage_half(const bfr* G, long ld, int row0, int k0, int loff, int tx) {
#pragma unroll
  for (int i = 0; i < 2; ++i) {
    const int b = tx * 16 + i * 8192; int r, c; stage_rc(b, r, c);
    __builtin_amdgcn_global_load_lds((const unsigned*)(G + (long)(row0 + r) * ld + k0 + c), (__attribute__((address_space(3))) unsigned*)(smem + loff + b), 16, 0, 0);
  }
}

template <int NB, class AccT>
__device__ __forceinline__ void gemm_mainloop(const bfr* A, long lda, const bfr* Bt, long ldb, int K, int brow, int bcol, AccT& acc, int tx) {
  const int wid = tx >> 6, lane = tx & 63, wr = wid >> 2, wc = wid & 3, fr = lane & 15, fq = lane >> 4;
  constexpr int STG = (2 + NB) * HT_BYTES;
  const int nt = K / 64;
  auto stage = [&](int s, int kt) {
    stage_half(A, lda, brow, kt * 64, s * STG, tx);
    stage_half(A, lda, brow + 128, kt * 64, s * STG + HT_BYTES, tx);
#pragma unroll
    for (int j = 0; j < NB; ++j) stage_half(Bt, ldb, bcol + j * 128, kt * 64, s * STG + (2 + j) * HT_BYTES, tx);
  };
  stage(0, 0);
  asm volatile("s_waitcnt vmcnt(0)" ::: "memory");
  __syncthreads();
  for (int t = 0; t < nt; ++t) {
    const int s = t & 1;
    if (t + 1 < nt) stage(s ^ 1, t + 1);
    const char* base = smem + s * STG;
    bf16x8 Bf[NB][2][2];
#pragma unroll
    for (int j = 0; j < NB; ++j)
#pragma unroll
      for (int n = 0; n < 2; ++n)
#pragma unroll
        for (int k = 0; k < 2; ++k) Bf[j][n][k] = *(const bf16x8*)(base + (2 + j) * HT_BYTES + lds_byte(wc * 32 + n * 16 + fr, k * 32 + fq * 8));
#pragma unroll
    for (int ai = 0; ai < 2; ++ai) {
      bf16x8 Af[4][2];
#pragma unroll
      for (int m = 0; m < 4; ++m)
#pragma unroll
        for (int k = 0; k < 2; ++k) Af[m][k] = *(const bf16x8*)(base + ai * HT_BYTES + lds_byte(wr * 64 + m * 16 + fr, k * 32 + fq * 8));
#pragma unroll
      for (int j = 0; j < NB; ++j)
#pragma unroll
        for (int m = 0; m < 4; ++m)
#pragma unroll
          for (int n = 0; n < 2; ++n)
#pragma unroll
            for (int k = 0; k < 2; ++k) acc.a[ai][j][m][n] = __builtin_amdgcn_mfma_f32_16x16x32_bf16(Af[m][k], Bf[j][n][k], acc.a[ai][j][m][n], 0, 0, 0);
    }
    asm volatile("s_waitcnt vmcnt(0)" ::: "memory");
    __syncthreads();
  }
}
template <int NB> struct Acc { f32x4 a[2][NB][4][2]; };
template <int NB> __device__ __forceinline__ void acc_zero(Acc<NB>& acc) {
#pragma unroll
  for (int ai = 0; ai < 2; ++ai)
#pragma unroll
    for (int j = 0; j < NB; ++j)
#pragma unroll
      for (int m = 0; m < 4; ++m)
#pragma unroll
        for (int n = 0; n < 2; ++n) acc.a[ai][j][m][n] = f32x4{0.f, 0.f, 0.f, 0.f};
}
template <int NB, class F> __device__ __forceinline__ void acc_foreach(Acc<NB>& acc, int brow, int bcol, int tx, F f) {
  const int wid = tx >> 6, lane = tx & 63, wr = wid >> 2, wc = wid & 3, fr = lane & 15, fq = lane >> 4;
#pragma unroll
  for (int ai = 0; ai < 2; ++ai)
#pragma unroll
    for (int j = 0; j < NB; ++j)
#pragma unroll
      for (int m = 0; m < 4; ++m)
#pragma unroll
        for (int n = 0; n < 2; ++n)
#pragma unroll
          for (int q = 0; q < 4; ++q) f(brow + ai * 128 + wr * 64 + m * 16 + fq * 4 + q, bcol + j * 128 + wc * 32 + n * 16 + fr, acc.a[ai][j][m][n][q]);
}

template <class MapF>
__device__ __forceinline__ void convert_tile(const float* W, int N, int kt, int ntile, bfr* dst, int ldd, MapF mapf, int ncopy = 1, int cstride = 0) {
  float* tile = (float*)smem;
  const int tid = tid_opaque();
  __syncthreads();
  float4 v[8];
#pragma unroll
  for (int pass = 0; pass < 8; ++pass) {
    const int idx = tid + pass * 512, kr = idx >> 6, c4 = idx & 63, n = ntile * 256 + c4 * 4;
    v[pass] = make_float4(0.f, 0.f, 0.f, 0.f);
    if (n < N) v[pass] = *(const float4*)(W + (size_t)(kt * 64 + kr) * N + n);
  }
#pragma unroll
  for (int pass = 0; pass < 8; ++pass) {
    const int idx = tid + pass * 512, kr = idx >> 6, c4 = idx & 63;
    tile[kr * 257 + c4 * 4 + 0] = v[pass].x; tile[kr * 257 + c4 * 4 + 1] = v[pass].y; tile[kr * 257 + c4 * 4 + 2] = v[pass].z; tile[kr * 257 + c4 * 4 + 3] = v[pass].w;
  }
  __syncthreads();
#pragma unroll
  for (int rep = 0; rep < 4; ++rep) {
    const int nn = (tid >> 3) + rep * 64, kg = tid & 7, n = ntile * 256 + nn;
    if (n < N) {
      float f[8];
#pragma unroll
      for (int j = 0; j < 8; ++j) f[j] = tile[(kg * 8 + j) * 257 + nn];
      const u32x4 pk = pack8hw(f);
      for (int cp = 0; cp < ncopy; ++cp) *(u32x4*)(dst + (size_t)mapf(n) * ldd + cp * cstride + kt * 64 + kg * 8) = pk;
    }
  }
}
constexpr int CONV_ITEMS = 1576;
__device__ __forceinline__ void convert_item(const Params& p, int l, int it) {
  if (it < 752) { const int kt = it / 47, nt = it % 47; convert_tile(p.w_in + (size_t)l * DM * NIN, NIN, kt, nt, p.wt_in + (size_t)l * NPAD * DM, DM, [](int n) { return perm_col(n); }); }
  else if (it < 944) { const int j = it - 752, br = j >> 6, kt = (j >> 2) & 15, nt = j & 3;
    const float* W = p.w_br_dn; if (br == 1) W = p.w_br_sc; if (br == 2) W = p.w_br_att; W += (size_t)l * DM * DM;
    convert_tile(W, DM, kt, nt, p.wt_br + ((size_t)l * 3 + br) * DM * DM, DM, [](int n) { return n; }); }
  else if (it < 1008) { const int j = it - 944, kt = j >> 2, nt = j & 3; convert_tile(p.w_out + (size_t)l * DM * DM, DM, kt, nt, p.wt_out + (size_t)l * DM * 3072, 3072, [](int n) { return n; }, 3, 1024); }
  else if (it < 1264) { const int j = it - 1008, kt = j >> 4, nt = j & 15; convert_tile(p.w_mlp_up + (size_t)l * DM * HID, HID, kt, nt, p.wt_up + (size_t)l * HID * DM, DM, [](int n) { return n; }); }
  else if (it < 1520) { const int j = it - 1264, kt = j >> 2, nt = j & 3; convert_tile(p.w_mlp_down + (size_t)l * HID * DM, DM, kt, nt, p.wt_dn + (size_t)l * DM * HID, HID, [](int n) { return n; }); }
  else { const int j = it - 1520;
    bfr* d = p.wt_in + ((size_t)l * NPAD + NP + 32 + j * 4) * DM;
    *(u32x4*)(d + tid_opaque() * 8) = u32x4{0u, 0u, 0u, 0u}; }
}

__device__ __forceinline__ void gemm_in_tile(const Params& p, int l, int tile) {
  const int mt = tile % 24, nt = tile / 24, brow = mt * 256, bcol = nt * 256;
  const int tx = tid_opaque(); Acc<2> acc; acc_zero(acc);
  gemm_mainloop<2>(p.h, DM, p.wt_in + (size_t)l * NPAD * DM, DM, DM, brow, bcol, acc, tx);
  if (nt < 34) acc_foreach(acc, brow, bcol, tx, [&](int r, int c, float v) { p.P[(size_t)r * NP + c] = f2bf(v); });
  else if (nt < 46) acc_foreach(acc, brow, bcol, tx, [&](int r, int c, float v) { p.P[(size_t)r * NP + c] = f2bf(sigmoidf_(v)); });
  else acc_foreach(acc, brow, bcol, tx, [&](int r, int c, float v) { if (c < NP + 32) p.small[(size_t)r * 32 + (c - NP)] = v; });
}
__device__ __forceinline__ void gemm_up_tile(const Params& p, int l, int tile) {
  const int mt = tile % 24, nt = tile / 24, brow = mt * 256, bcol = nt * 256;
  const int tx = tid_opaque(); Acc<2> acc; acc_zero(acc);
  gemm_mainloop<2>(p.h, DM, p.wt_up + (size_t)l * HID * DM, DM, DM, brow, bcol, acc, tx);
  acc_foreach(acc, brow, bcol, tx, [&](int r, int c, float v) { const float x = fmaxf(v, 0.f); p.u2[(size_t)r * HID + c] = f2bf(x * x); });
}
__device__ __forceinline__ void gemm_out_tile(const Params& p, int l, int tile) {
  const int mt = tile % 24, nt = tile / 24, brow = mt * 256, bcol = nt * 128;
  const int tx = tid_opaque(); Acc<1> acc; acc_zero(acc);
  gemm_mainloop<1>(p.merged, DM, p.wt_out + (size_t)l * DM * DM, DM, DM, brow, bcol, acc, tx);
  acc_foreach(acc, brow, bcol, tx, [&](int r, int c, float v) { p.R[(size_t)r * DM + c] = v; });
}
__device__ __forceinline__ void gemm_down_tile(const Params& p, int l, int tile) {
  const int mt = tile % 24, nt = tile / 24, brow = mt * 256, bcol = nt * 128;
  const int tx = tid_opaque(); Acc<1> acc; acc_zero(acc);
  gemm_mainloop<1>(p.u2, HID, p.wt_dn + (size_t)l * DM * HID, HID, HID, brow, bcol, acc, tx);
  acc_foreach(acc, brow, bcol, tx, [&](int r, int c, float v) { p.R[(size_t)r * DM + c] = v; });
}
__device__ __forceinline__ void gemm_br_tile(const Params& p, int l, int tile) {
  const int mt = tile % 24, nt = tile / 24, brow = mt * 256, bcol = nt * 128;
  const int tx = tid_opaque(); Acc<1> tot; acc_zero(tot);
#pragma unroll 1
  for (int br = 0; br < 3; ++br) {
    Acc<1> acc; acc_zero(acc);
    gemm_mainloop<1>(p.obr + (size_t)br * NTOK * DM, DM, p.wt_br + ((size_t)l * 3 + br) * DM * DM, DM, DM, brow, bcol, acc, tx);
    const bfr* G = p.P + C_MG + br * DM;
    const int wid = tx >> 6, lane = tx & 63, wr = wid >> 2, wc = wid & 3, fr = lane & 15, fq = lane >> 4;
    const bfr* Gl = G + (size_t)(brow + wr * 64 + fq * 4) * NP + bcol + wc * 32 + fr;
#pragma unroll
    for (int ai = 0; ai < 2; ++ai)
#pragma unroll
      for (int m = 0; m < 4; ++m) {
        const bfr* Gm = Gl + (size_t)(ai * 128 + m * 16) * NP;
        asm volatile("" : "+v"(Gm) :: "memory");
#pragma unroll
        for (int n = 0; n < 2; ++n)
#pragma unroll
          for (int q = 0; q < 4; ++q) tot.a[ai][0][m][n][q] += bf2f(Gm[q * NP + n * 16]) * acc.a[ai][0][m][n][q];
      }
  }
  acc_foreach(tot, brow, bcol, tx, [&](int r, int c, float v) { p.merged[(size_t)r * DM + c] = f2bf(v); });
}
namespace pg8 {
#define PG8_LAS __attribute__((address_space(3)))
constexpr int BM = 256, BK = 64, HALF = 128, HTB = HALF * BK * 2, STAGE_BYTES = 8 * HTB;
__device__ __forceinline__ int perm32(int rho) { const int n = rho >> 4, i = rho & 15; return 8 * (i >> 2) + 4 * n + (i & 3); }
struct Unit { int pm, pn, z; size_t ka, kb; };
struct Gemm { const bfr* A; const bfr* Bt; int lda, ldb, K; };

template <class Epi, class Sched>
__device__ __forceinline__ void gemm_phase(const Gemm g, const Sched& S, const Epi& E) {
  PG8_LAS unsigned char* lds = (PG8_LAS unsigned char*)smem;
  const int tid = tid_opaque(), wid = __builtin_amdgcn_readfirstlane(tid >> 6), lane = tid & 63, wr = wid >> 2, wc = wid & 3, fr = lane & 15, fq = lane >> 4;
  const int K = g.K, nt = K / BK;
  unsigned voffA[2], voffB[2];
#pragma unroll
  for (int i = 0; i < 2; ++i) { int R, C; stage_rc(tid * 16 + i * 8192, R, C); const int Rb = Epi::PERM ? ((R & ~31) + perm32(R & 31)) : R;
    voffA[i] = (unsigned)(R * g.lda + C) * 2u; voffB[i] = (unsigned)(Rb * g.ldb + C) * 2u; }
  const size_t kstep = (size_t)(BK * 2);
  const size_t hstepA = (size_t)HALF * g.lda * 2, hstepB = (size_t)HALF * g.ldb * 2;
  const unsigned ldsw = (unsigned)wid * 1024u;
  const int aoff = lds_byte(wr * 64 + fr, fq * 8), boff = lds_byte(wc * 32 + fr, fq * 8);
#define PG8_SA(b, h) (((b) * 2 + (h)) * HTB)
#define PG8_SB(b, h) ((4 + (b) * 2 + (h)) * HTB)
#define PG8_STAGE(bufoff, gbase, voff) do { _Pragma("unroll") for (int _i = 0; _i < 2; ++_i) \
    __builtin_amdgcn_global_load_lds((const unsigned*)((const char*)(gbase) + (voff)[_i]), (PG8_LAS unsigned*)(lds + (bufoff) + ldsw + _i * 8192), 16, 0, 0); } while (0)
#define PG8_LDA(dst, b, h) do { _Pragma("unroll") for (int m = 0; m < 4; ++m) _Pragma("unroll") for (int k = 0; k < 2; ++k) dst[m][k] = *(const PG8_LAS bf16x8*)(lds + PG8_SA(b, h) + aoff + m * 2048 + k * 1024); } while (0)
#define PG8_LDB(dst, b, h) do { _Pragma("unroll") for (int n = 0; n < 2; ++n) _Pragma("unroll") for (int k = 0; k < 2; ++k) dst[n][k] = *(const PG8_LAS bf16x8*)(lds + PG8_SB(b, h) + boff + n * 2048 + k * 1024); } while (0)
#define PG8_MMA(ai, bj, At, Bt) do { __builtin_amdgcn_s_setprio(1); _Pragma("unroll") for (int m = 0; m < 4; ++m) _Pragma("unroll") for (int n = 0; n < 2; ++n) _Pragma("unroll") for (int k = 0; k < 2; ++k) \
    acc[ai][bj][m][n] = __builtin_amdgcn_mfma_f32_16x16x32_bf16(Bt[n][k], At[m][k], acc[ai][bj][m][n], 0, 0, 0); __builtin_amdgcn_s_setprio(0); } while (0)
#define PG8_WAIT_V(n) asm volatile("s_waitcnt vmcnt(" #n ")" ::: "memory")
#define PG8_WAIT_L(n) asm volatile("s_waitcnt lgkmcnt(" #n ")" ::: "memory")
#define PG8_BAR __builtin_amdgcn_s_barrier()
#define PG8_SCHED __builtin_amdgcn_sched_barrier(0)
  Unit cur, nxt; int ui = 0;
  __syncthreads();
  if (!S.next(0, cur)) return;
  f32x4 acc[2][2][4][2];
#pragma unroll
  for (int a = 0; a < 2; ++a)
#pragma unroll
    for (int b = 0; b < 2; ++b)
#pragma unroll
      for (int m = 0; m < 4; ++m)
#pragma unroll
        for (int n = 0; n < 2; ++n) acc[a][b][m][n] = (f32x4){0.f, 0.f, 0.f, 0.f};
  bf16x8 At[4][2], B0[2][2], B1[2][2];
  const char* cA = (const char*)(g.A + cur.ka) + (size_t)cur.pm * 2 * hstepA; const char* cB = (const char*)(g.Bt + cur.kb) + (size_t)cur.pn * 2 * hstepB;
  PG8_STAGE(PG8_SB(0, 0), cB, voffB); PG8_STAGE(PG8_SA(0, 0), cA, voffA); PG8_STAGE(PG8_SB(0, 1), cB + hstepB, voffB); PG8_STAGE(PG8_SA(0, 1), cA + hstepA, voffA);
  if (wr == 1) PG8_BAR;
  PG8_WAIT_V(4); PG8_BAR;
  PG8_STAGE(PG8_SB(1, 0), cB + kstep, voffB); PG8_STAGE(PG8_SA(1, 0), cA + kstep, voffA); PG8_STAGE(PG8_SB(1, 1), cB + hstepB + kstep, voffB);
  PG8_WAIT_V(6); PG8_BAR;
  for (;;) {
    const bool has_next = S.next(ui + 1, nxt);
    const char* nA = has_next ? (const char*)(g.A + nxt.ka) + (size_t)nxt.pm * 2 * hstepA : cA; const char* nB = has_next ? (const char*)(g.Bt + nxt.kb) + (size_t)nxt.pn * 2 * hstepB : cB;
    for (int t = 0; t < nt; t += 2) {
      const bool last = (t == nt - 2);
      const char* a1 = cA + (size_t)(t + 1) * kstep;
      const char* a2 = last ? nA : cA + (size_t)(t + 2) * kstep; const char* b2 = last ? nB : cB + (size_t)(t + 2) * kstep;
      const char* a3 = a2 + kstep; const char* b3 = b2 + kstep;
      PG8_LDB(B0, 0, 0); PG8_SCHED; PG8_LDA(At, 0, 0); PG8_STAGE(PG8_SA(1, 1), a1 + hstepA, voffA);
      PG8_WAIT_L(8); PG8_BAR; PG8_WAIT_L(0); PG8_MMA(0, 0, At, B0); PG8_BAR; PG8_SCHED;
      PG8_LDB(B1, 0, 1); PG8_STAGE(PG8_SB(0, 0), b2, voffB);
      PG8_BAR; PG8_WAIT_L(0); PG8_MMA(0, 1, At, B1); PG8_BAR;
      PG8_LDA(At, 0, 1); PG8_STAGE(PG8_SA(0, 0), a2, voffA);
      PG8_BAR; PG8_WAIT_L(0); PG8_MMA(1, 0, At, B0); PG8_BAR; PG8_SCHED;
      PG8_STAGE(PG8_SB(0, 1), b2 + hstepB, voffB);
      PG8_WAIT_V(6); PG8_BAR; PG8_MMA(1, 1, At, B1); PG8_BAR;
      PG8_LDB(B0, 1, 0); PG8_SCHED; PG8_LDA(At, 1, 0); PG8_STAGE(PG8_SA(0, 1), a2 + hstepA, voffA);
      PG8_WAIT_L(8); PG8_BAR; PG8_WAIT_L(0); PG8_MMA(0, 0, At, B0); PG8_BAR; PG8_SCHED;
      PG8_LDB(B1, 1, 1); PG8_STAGE(PG8_SB(1, 0), b3, voffB);
      PG8_BAR; PG8_WAIT_L(0); PG8_MMA(0, 1, At, B1); PG8_BAR;
      PG8_LDA(At, 1, 1); PG8_STAGE(PG8_SA(1, 0), a3, voffA);
      PG8_BAR; PG8_WAIT_L(0); PG8_MMA(1, 0, At, B0); PG8_BAR; PG8_SCHED;
      PG8_STAGE(PG8_SB(1, 1), b3 + hstepB, voffB);
      PG8_WAIT_V(6); PG8_BAR; PG8_MMA(1, 1, At, B1); PG8_BAR;
    }
    E(acc, cur, wr, wc, fr, fq);
    if (!has_next) break;
#pragma unroll
    for (int a = 0; a < 2; ++a)
#pragma unroll
      for (int b = 0; b < 2; ++b)
#pragma unroll
        for (int m = 0; m < 4; ++m)
#pragma unroll
          for (int n = 0; n < 2; ++n) acc[a][b][m][n] = (f32x4){0.f, 0.f, 0.f, 0.f};
    cur = nxt; cA = nA; cB = nB; ++ui;
  }
  PG8_WAIT_V(0);
  if (wr == 0) PG8_BAR;
  PG8_BAR;
#undef PG8_SA
#undef PG8_SB
#undef PG8_STAGE
#undef PG8_LDA
#undef PG8_LDB
#undef PG8_MMA
#undef PG8_WAIT_V
#undef PG8_WAIT_L
#undef PG8_BAR
#undef PG8_SCHED
}
__device__ __forceinline__ unsigned cvt_pk_bf16(float lo, float hi) { unsigned r; asm volatile("v_cvt_pk_bf16_f32 %0, %1, %2" : "=v"(r) : "v"(lo), "v"(hi)); return r; }
__device__ __forceinline__ u32x4 pk8(const f32x4 v0, const f32x4 v1) { u32x4 w; w.x = cvt_pk_bf16(v0[0], v0[1]); w.y = cvt_pk_bf16(v0[2], v0[3]); w.z = cvt_pk_bf16(v1[0], v1[1]); w.w = cvt_pk_bf16(v1[2], v1[3]); return w; }

__device__ __forceinline__ unsigned cvt_pk_bf16_n(float lo, float hi) { unsigned r; asm volatile("s_nop 1\n\tv_cvt_pk_bf16_f32 %0, %1, %2" : "=v"(r) : "v"(lo), "v"(hi)); return r; }
__device__ __forceinline__ u32x4 pk8n(const f32x4 v0, const f32x4 v1) { u32x4 w; w.x = cvt_pk_bf16_n(v0[0], v0[1]); w.y = cvt_pk_bf16_n(v0[2], v0[3]); w.z = cvt_pk_bf16_n(v1[0], v1[1]); w.w = cvt_pk_bf16_n(v1[2], v1[3]); return w; }
__device__ __forceinline__ float sigmoid_fast(float x) { return __builtin_amdgcn_rcpf(1.f + __expf(-x)); }
struct SchedIn { int G, c; __device__ __forceinline__ bool next(int i, Unit& u) const { const int L = i * G + c; if (L >= 1024) return false; u.z = 0; u.ka = 0; u.kb = 0;
  if (L < 936) { const int j = L / 24; u.pm = L % 24; u.pn = j < 34 ? j : (j < 38 ? j + 4 : 46); }
  else { const int e = L - 936; if (e < 72) { u.pm = e % 24; u.pn = 34 + e / 24; } else { u.pm = e - 72; u.pn = 37; } }
  return true; } };
struct SchedUp { int G, c; __device__ __forceinline__ bool next(int i, Unit& u) const { const int L = i * G + c; if (L >= 24 * 16) return false; u.pm = L % 24; u.pn = L / 24; u.z = 0; u.ka = 0; u.kb = 0; return true; } };
struct SchedBr { int G, c; __device__ __forceinline__ bool next(int i, Unit& u) const { const int L = i * G + c; if (L >= 256) return false; if (L >= 192) { const int k = 32 + (L - 192); u.pm = k % 24; u.pn = k / 24; u.z = 1; u.ka = (size_t)NTOK * DM; u.kb = (size_t)DM * DM; return true; } const int r = L / 24; u.pm = L % 24; u.pn = r & 3; u.z = (r >> 2) * 2;
  u.ka = (size_t)u.z * NTOK * DM; u.kb = (size_t)u.z * DM * DM; return true; } };
struct SchedOne { Unit u0; __device__ __forceinline__ bool next(int i, Unit& u) const { if (i != 0) return false; u = u0; return true; } };
template <int KH> struct SchedSplit2 { int G, c; __device__ __forceinline__ bool next(int i, Unit& u) const { const int L = i * G + c; if (L >= 24 * 8) return false; const int r = L / 24; u.pm = L % 24; u.pn = r & 3; u.z = r >> 2;
  u.ka = (size_t)u.z * KH; u.kb = (size_t)u.z * KH; return true; } };

struct EpiIn { static constexpr bool PERM = true; bfr* P; float* small;
  __device__ __forceinline__ void operator()(const f32x4 (&acc)[2][2][4][2], const Unit& u, int wr, int wc, int fr, int fq) const {
    const int row0 = u.pm * BM + wr * 64 + fr, col0 = u.pn * BM + wc * 32 + 8 * fq;
    if (u.pn < 46) {
      const bool sg = u.pn >= 34;
#pragma unroll
      for (int ai = 0; ai < 2; ++ai)
#pragma unroll
        for (int m = 0; m < 4; ++m) { bfr* rowp = P + (size_t)(row0 + ai * HALF + m * 16) * NP + col0;
#pragma unroll
          for (int bj = 0; bj < 2; ++bj) { f32x4 v0 = acc[ai][bj][m][0], v1 = acc[ai][bj][m][1];
            if (sg) {
#pragma unroll
              for (int j = 0; j < 4; ++j) { v0[j] = sigmoid_fast(v0[j]); v1[j] = sigmoid_fast(v1[j]); }
              *(u32x4*)(rowp + bj * HALF) = pk8n(v0, v1);
            } else *(u32x4*)(rowp + bj * HALF) = pk8(v0, v1); } }
    } else if (wc == 0) {
#pragma unroll
      for (int ai = 0; ai < 2; ++ai)
#pragma unroll
        for (int m = 0; m < 4; ++m) { float* rowp = small + (size_t)(row0 + ai * HALF + m * 16) * 32 + 8 * fq;
          *(f32x4*)rowp = acc[ai][0][m][0]; *(f32x4*)(rowp + 4) = acc[ai][0][m][1]; }
    }
  }
};
struct EpiUp { static constexpr bool PERM = true; bfr* O;
  __device__ __forceinline__ void operator()(const f32x4 (&acc)[2][2][4][2], const Unit& u, int wr, int wc, int fr, int fq) const {
    const int row0 = u.pm * BM + wr * 64 + fr, col0 = u.pn * BM + wc * 32 + 8 * fq;
#pragma unroll
    for (int ai = 0; ai < 2; ++ai)
#pragma unroll
      for (int m = 0; m < 4; ++m) { bfr* rowp = O + (size_t)(row0 + ai * HALF + m * 16) * HID + col0;
#pragma unroll
        for (int bj = 0; bj < 2; ++bj) { f32x4 v0 = acc[ai][bj][m][0], v1 = acc[ai][bj][m][1];
#pragma unroll
          for (int j = 0; j < 4; ++j) { const float a = fmaxf(v0[j], 0.f), b = fmaxf(v1[j], 0.f); v0[j] = a * a; v1[j] = b * b; }
          *(u32x4*)(rowp + bj * HALF) = pk8(v0, v1); } }
  }
};
struct EpiBr { static constexpr bool PERM = true; bfr* O; const bfr* P;
  __device__ __forceinline__ void operator()(const f32x4 (&acc)[2][2][4][2], const Unit& u, int wr, int wc, int fr, int fq) const {
    const int row0 = u.pm * BM + wr * 64 + fr, col0 = u.z * DM + u.pn * BM + wc * 32 + 8 * fq;
    u32x4 gv[2][4][2];
#pragma unroll
    for (int ai = 0; ai < 2; ++ai)
#pragma unroll
      for (int m = 0; m < 4; ++m) { const bfr* gp = P + (size_t)(row0 + ai * HALF + m * 16) * NP + C_MG + col0;
#pragma unroll
        for (int bj = 0; bj < 2; ++bj) gv[ai][m][bj] = *(const u32x4*)(gp + bj * HALF); }
#pragma unroll
    for (int ai = 0; ai < 2; ++ai)
#pragma unroll
      for (int m = 0; m < 4; ++m) { bfr* rowp = O + (size_t)(row0 + ai * HALF + m * 16) * 3072 + col0;
#pragma unroll
        for (int bj = 0; bj < 2; ++bj) { f32x4 v0 = acc[ai][bj][m][0], v1 = acc[ai][bj][m][1];
          float g[8]; unpack8(gv[ai][m][bj], g);
#pragma unroll
          for (int j = 0; j < 4; ++j) { v0[j] *= g[j]; v1[j] *= g[4 + j]; }
          *(u32x4*)(rowp + bj * HALF) = pk8(v0, v1); } }
  }
};
struct EpiF32 { static constexpr bool PERM = false; float* C;
  __device__ __forceinline__ void operator()(const f32x4 (&acc)[2][2][4][2], const Unit& u, int wr, int wc, int fr, int fq) const {
    const int row0 = u.pm * BM + wr * 64 + fr, col0 = u.pn * BM + wc * 32 + 4 * fq;
    float* Cz = C + (size_t)u.z * NTOK * DM;
#pragma unroll
    for (int ai = 0; ai < 2; ++ai)
#pragma unroll
      for (int m = 0; m < 4; ++m) { float* rowp = Cz + (size_t)(row0 + ai * HALF + m * 16) * DM + col0;
#pragma unroll
        for (int bj = 0; bj < 2; ++bj)
#pragma unroll
          for (int n = 0; n < 2; ++n) *(f32x4*)(rowp + bj * HALF + n * 16) = acc[ai][bj][m][n]; }
  }
};
struct EpiPart { static constexpr bool PERM = true; bfr* C;
  __device__ __forceinline__ void operator()(const f32x4 (&acc)[2][2][4][2], const Unit& u, int wr, int wc, int fr, int fq) const {
    const int row0 = u.pm * BM + wr * 64 + fr, col0 = u.pn * BM + wc * 32 + 8 * fq;
    bfr* Cz = C + (size_t)u.z * NTOK * DM;
#pragma unroll
    for (int ai = 0; ai < 2; ++ai)
#pragma unroll
      for (int m = 0; m < 4; ++m) { bfr* rowp = Cz + (size_t)(row0 + ai * HALF + m * 16) * DM + col0;
#pragma unroll
        for (int bj = 0; bj < 2; ++bj) *(u32x4*)(rowp + bj * HALF) = pk8(acc[ai][bj][m][0], acc[ai][bj][m][1]); }
  }
};
}
namespace att {
constexpr int D = 128, NW = 8, QBLK = 32, KVBLK = 64;
constexpr float SCALE = 0.088388347648318440f;
constexpr float THR = 8.f;
constexpr int SDEPTH = 1;
constexpr int LDQ = 1024, LDK = 256, LDO = 1024;
constexpr size_t SHM_V = KVBLK * D * 2, SHM_K = KVBLK * D * 2, SHM_ATTN = 2 * SHM_V + 2 * SHM_K + NW * 64 * 4;
using bf16 = bfr;
using f32x8  = __attribute__((ext_vector_type(8))) float;
#define KSWZ(row, colB) ((row) * 256 + ((colB) ^ (((row) & 7) << 4)))
#define SBAR() __builtin_amdgcn_sched_barrier(0)
__device__ __forceinline__ int crow(int r, int hi) { return (r & 3) + 8 * (r >> 2) + 4 * hi; }
__device__ __forceinline__ unsigned cvtpk(float lo, float hi) {
  unsigned r; asm volatile("v_cvt_pk_bf16_f32 %0, %1, %2" : "=v"(r) : "v"(lo), "v"(hi)); return r;
}
template <typename TIn> struct Stage;
template <> struct Stage<bf16>  { using T = bf16x8;
  __device__ static __forceinline__ T ld8(const bf16* p) { return *reinterpret_cast<const bf16x8*>(p); }
  __device__ static __forceinline__ bf16x8 tobf(T x) { return x; } };
template <> struct Stage<float> { using T = f32x8;
  __device__ static __forceinline__ T ld8(const float* p) { return *reinterpret_cast<const f32x8*>(p); }
  __device__ static __forceinline__ bf16x8 tobf(T x) {
    u32x4 w = {cvtpk(x[0], x[1]), cvtpk(x[2], x[3]), cvtpk(x[4], x[5]), cvtpk(x[6], x[7])}; return *reinterpret_cast<bf16x8*>(&w); } };

__device__ __forceinline__ void partialSM(f32x16& p0, f32x16& p1, float& m_reg, float& mn, float& alpha) {
  constexpr float C = SCALE * 1.4426950408889634f;
  float pmax = p0[0]; for (int r = 1; r < 16; ++r) pmax = fmaxf(pmax, p0[r]); for (int r = 0; r < 16; ++r) pmax = fmaxf(pmax, p1[r]);
  { auto rr = __builtin_amdgcn_permlane32_swap(__float_as_uint(pmax), __float_as_uint(pmax), false, false);
    pmax = fmaxf(__uint_as_float(rr[0]), __uint_as_float(rr[1])); }
  if (__builtin_expect(__all(pmax - m_reg <= THR / SCALE), 1)) { mn = m_reg; alpha = 1.f; }
  else { mn = fmaxf(m_reg, pmax); alpha = __builtin_amdgcn_exp2f((m_reg - mn) * C); m_reg = mn; }
  float mnC = -mn * C;
  for (int r = 0; r < 16; ++r) p0[r] = fmaf(p0[r], C, mnC); for (int r = 0; r < 16; ++r) p1[r] = fmaf(p1[r], C, mnC);
  for (int r = 0; r < 16; ++r) p0[r] = __builtin_amdgcn_exp2f(p0[r]);
}
__device__ __forceinline__ void finishSM(f32x16& p0, f32x16& p1, float alpha, float& l_reg, bf16x8& pa0, bf16x8& pa1, bf16x8& pa2, bf16x8& pa3) {
  for (int r = 0; r < 16; ++r) p1[r] = __builtin_amdgcn_exp2f(p1[r]);
  float ps = 0; for (int r = 0; r < 16; ++r) ps += p0[r]; for (int r = 0; r < 16; ++r) ps += p1[r];
  { auto rr = __builtin_amdgcn_permlane32_swap(__float_as_uint(ps), __float_as_uint(ps), false, false);
    ps = __uint_as_float(rr[0]) + __uint_as_float(rr[1]); }
  l_reg = l_reg * alpha + ps;
#define PK4(P, BASE, OUT) do { unsigned a0 = cvtpk(P[BASE + 0], P[BASE + 1]), a1 = cvtpk(P[BASE + 2], P[BASE + 3]);   \
    unsigned b0 = cvtpk(P[BASE + 4], P[BASE + 5]), b1 = cvtpk(P[BASE + 6], P[BASE + 7]);                              \
    auto r0 = __builtin_amdgcn_permlane32_swap(a0, b0, false, false); auto r1 = __builtin_amdgcn_permlane32_swap(a1, b1, false, false); \
    u32x4 w = {r0[0], r1[0], r0[1], r1[1]}; OUT = *reinterpret_cast<bf16x8*>(&w); } while (0)
  PK4(p0, 0, pa0); PK4(p0, 8, pa1); PK4(p1, 0, pa2); PK4(p1, 8, pa3);
#undef PK4
}
__device__ __forceinline__ void qkt(f32x16& p0, f32x16& p1, const bf16* Ks, const bf16x8* qr, int r32, int hi) {
  p0 = f32x16{}; p1 = f32x16{};
  for (int d0 = 0; d0 < 8; ++d0) { int cb = (d0 * 16 + hi * 8) * 2;
    bf16x8 b0 = *reinterpret_cast<const bf16x8*>((const char*)Ks + KSWZ(r32, cb));
    bf16x8 b1 = *reinterpret_cast<const bf16x8*>((const char*)Ks + KSWZ(32 + r32, cb));
    p0 = __builtin_amdgcn_mfma_f32_32x32x16_bf16(b0, qr[d0], p0, 0, 0, 0);
    p1 = __builtin_amdgcn_mfma_f32_32x32x16_bf16(b1, qr[d0], p1, 0, 0, 0); }
}
__device__ __forceinline__ int v_st(int k, int c) { const int kk = (k & ~0xC) | ((k & 4) << 1) | ((k & 8) >> 1); return ((kk >> 3) * 4 + (c >> 5)) * 512 + ((kk & 7) * 32 + (c & 31)) * 2; }
__device__ __forceinline__ int v_rd_base(int lane) { return ((lane & 3) << 3) | (((lane >> 2) & 3) << 6) | (((lane >> 4) & 1) << 5) | (((lane >> 5) & 1) << 8); }
constexpr int v_rd_off(int d0, int ks, int half) { return d0 * 512 + ks * 4096 + half * 2048; }
template <int OFF> __device__ __forceinline__ s16x4 tr_read(int vb) {
  s16x4 r; asm volatile("ds_read_b64_tr_b16 %0, %1 offset:%2" : "=&v"(r) : "v"(vb), "i"(OFF) : "memory"); return r;
}
template <int D0> __device__ __forceinline__ void pv_one(f32x16& od, int vb, bf16x8 pa0, bf16x8 pa1, bf16x8 pa2, bf16x8 pa3) {
  const s16x4 l0 = tr_read<v_rd_off(D0, 0, 0)>(vb), h0 = tr_read<v_rd_off(D0, 0, 1)>(vb), l1 = tr_read<v_rd_off(D0, 1, 0)>(vb), h1 = tr_read<v_rd_off(D0, 1, 1)>(vb);
  const s16x4 l2 = tr_read<v_rd_off(D0, 2, 0)>(vb), h2 = tr_read<v_rd_off(D0, 2, 1)>(vb), l3 = tr_read<v_rd_off(D0, 3, 0)>(vb), h3 = tr_read<v_rd_off(D0, 3, 1)>(vb);
  asm volatile("s_waitcnt lgkmcnt(0)" ::: "memory"); SBAR();
#define PK(L, H) (bf16x8){L[0], L[1], L[2], L[3], H[0], H[1], H[2], H[3]}
  od = __builtin_amdgcn_mfma_f32_32x32x16_bf16(pa0, PK(l0, h0), od, 0, 0, 0);
  od = __builtin_amdgcn_mfma_f32_32x32x16_bf16(pa1, PK(l1, h1), od, 0, 0, 0);
  od = __builtin_amdgcn_mfma_f32_32x32x16_bf16(pa2, PK(l2, h2), od, 0, 0, 0);
  od = __builtin_amdgcn_mfma_f32_32x32x16_bf16(pa3, PK(l3, h3), od, 0, 0, 0);
#undef PK
}
__device__ __forceinline__ void pv_d0(f32x16* o, int vb, bf16x8 pa0, bf16x8 pa1, bf16x8 pa2, bf16x8 pa3) {
  pv_one<0>(o[0], vb, pa0, pa1, pa2, pa3); pv_one<1>(o[1], vb, pa0, pa1, pa2, pa3); pv_one<2>(o[2], vb, pa0, pa1, pa2, pa3); pv_one<3>(o[3], vb, pa0, pa1, pa2, pa3);
}

template <typename TQ>
__device__ __forceinline__ void attn_dense_body(const TQ* __restrict__ Qb, const bf16* __restrict__ Kh, const bf16* __restrict__ Vh,
                                                bfr* __restrict__ Ob, int seq, char* lds) {
  using St = Stage<bf16>; using SQ = Stage<TQ>;
  const int tid = tid_opaque(), wid = tid >> 6, lane = tid & 63, r32 = lane & 31, hi = lane >> 5;
  bf16* V_lds = (bf16*)lds; bf16* K_lds = (bf16*)(lds + 2 * SHM_V);
  float* ws = (float*)(lds + 2 * SHM_V + 2 * SHM_K) + wid * 64; float* li_l = ws; float* al_l = ws + 32;
  float m_reg = -1e30f, l_reg = 0; f32x16 o[4] = {}; bf16x8 qr[8];
  const TQ* Qw = Qb + (long)(wid * QBLK + r32) * LDQ + hi * 8;
#pragma unroll
  for (int d0 = 0; d0 < 8; ++d0) qr[d0] = SQ::tobf(SQ::ld8(Qw + d0 * 16));
  const int sr = tid >> 4, sc = (tid & 15) * 8, vst0 = v_st(sr, sc), vst1 = v_st(32 + sr, sc);
  const int vb0 = (int)(uintptr_t)V_lds + v_rd_base(lane);
  struct { typename St::T vs0, vs1, ks0, ks1; } sr_[SDEPTH];
#define SLOAD(i, k0) do { sr_[i].vs0 = St::ld8(&Vh[(long)((k0) + sr) * LDK + sc]); sr_[i].vs1 = St::ld8(&Vh[(long)((k0) + 32 + sr) * LDK + sc]); \
    sr_[i].ks0 = St::ld8(&Kh[(long)((k0) + sr) * LDK + sc]); sr_[i].ks1 = St::ld8(&Kh[(long)((k0) + 32 + sr) * LDK + sc]); } while (0)
#define SWRITE(b, i) do { *(bf16x8*)((char*)V_lds + (b) * SHM_V + vst0) = St::tobf(sr_[i].vs0);          \
    *(bf16x8*)((char*)V_lds + (b) * SHM_V + vst1) = St::tobf(sr_[i].vs1); int kc = sc * 2;               \
    *(bf16x8*)((char*)K_lds + (b) * SHM_K + KSWZ(sr, kc)) = St::tobf(sr_[i].ks0);                       \
    *(bf16x8*)((char*)K_lds + (b) * SHM_K + KSWZ(32 + sr, kc)) = St::tobf(sr_[i].ks1); } while (0)
#define SWAIT() do { if constexpr (SDEPTH == 2) asm volatile("s_waitcnt vmcnt(4)" ::: "memory"); else asm volatile("s_waitcnt vmcnt(0)" ::: "memory"); } while (0)
#define RESC(a) do { if (__any((a) < 1.f)) { if (hi == 0) al_l[r32] = (a); asm volatile("s_waitcnt lgkmcnt(0)" ::: "memory"); \
    for (int d = 0; d < 4; ++d) for (int r = 0; r < 16; ++r) o[d][r] *= al_l[crow(r, hi)]; } } while (0)
  f32x16 pA0, pA1, pB0, pB1; float mnA, mnB, alA, alB; bf16x8 pa0, pa1, pa2, pa3; const int NT = seq / KVBLK;
  constexpr int SE = 0, SO = SDEPTH - 1;
  SLOAD(SE, 0); asm volatile("s_waitcnt vmcnt(0)" ::: "memory"); SWRITE(0, SE); __syncthreads();
  qkt(pA0, pA1, K_lds, qr, r32, hi); partialSM(pA0, pA1, m_reg, mnA, alA);
  SLOAD(SO, KVBLK); if constexpr (SDEPTH == 2) { if (2 < NT) SLOAD(SE, 2 * KVBLK); }
  SWAIT(); SWRITE(1, SO); __syncthreads();
  for (int j = 1; j + 1 < NT; j += 2) {
    SBAR(); qkt(pB0, pB1, (bf16*)((char*)K_lds + SHM_K), qr, r32, hi);
    finishSM(pA0, pA1, alA, l_reg, pa0, pa1, pa2, pa3); SBAR();
    SLOAD(SO, (j + SDEPTH) * KVBLK); SBAR();
    pv_d0(o, vb0, pa0, pa1, pa2, pa3); partialSM(pB0, pB1, m_reg, mnB, alB);
    __syncthreads(); SWAIT(); SWRITE(0, SE);
    RESC(alB); __syncthreads();
    SBAR(); qkt(pA0, pA1, K_lds, qr, r32, hi);
    finishSM(pB0, pB1, alB, l_reg, pa0, pa1, pa2, pa3); SBAR();
    if (SDEPTH == 1 || j + 3 < NT) SLOAD(SE, (j + 1 + SDEPTH) * KVBLK); SBAR();
    pv_d0(o, vb0 + (int)SHM_V, pa0, pa1, pa2, pa3); partialSM(pA0, pA1, m_reg, mnA, alA);
    __syncthreads(); SWAIT(); SWRITE(1, SO);
    RESC(alA); __syncthreads();
  }
  SBAR(); qkt(pB0, pB1, (bf16*)((char*)K_lds + SHM_K), qr, r32, hi);
  finishSM(pA0, pA1, alA, l_reg, pa0, pa1, pa2, pa3); SBAR();
  pv_d0(o, vb0, pa0, pa1, pa2, pa3); partialSM(pB0, pB1, m_reg, mnB, alB);
  __syncthreads(); RESC(alB);
  finishSM(pB0, pB1, alB, l_reg, pa0, pa1, pa2, pa3); SBAR();
  pv_d0(o, vb0 + (int)SHM_V, pa0, pa1, pa2, pa3);
  if (hi == 0) li_l[r32] = l_reg; asm volatile("s_waitcnt lgkmcnt(0)" ::: "memory");
  float rli[16];
#pragma unroll
  for (int r = 0; r < 16; ++r) rli[r] = __builtin_amdgcn_rcpf(li_l[crow(r, hi)]);
  bfr* Ow = Ob + (long)(wid * QBLK) * LDO;
#pragma unroll
  for (int r = 0; r < 16; ++r) { int orow = crow(r, hi);
    for (int d0 = 0; d0 < 4; ++d0) Ow[(long)orow * LDO + d0 * 32 + r32] = f2bf(o[d0][r] * rli[r]); }
#undef SLOAD
#undef SWRITE
#undef SWAIT
#undef RESC
}

}

__device__ __forceinline__ void attn_item(const Params& p, int item) {
  __syncthreads();
  if (item < 64) {
    const int b = item >> 5, h = (item >> 2) & 7, qb = item & 3; const size_t t0 = NCTX + b * 1024 + qb * 256;
    att::attn_dense_body<bfr>(p.Q + t0 * DM + h * 128, p.Ks + (size_t)b * 1280 * 256 + (h >> 2) * 128, p.Vs + (size_t)b * 1280 * 256 + (h >> 2) * 128,
                              p.obr + (size_t)2 * NTOK * DM + t0 * DM + h * 128, 1280, smem);
  } else {
    const int j = item - 64, b = j >> 3, h = j & 7; const size_t t0 = b * 256;
    att::attn_dense_body<bfr>(p.Q + t0 * DM + h * 128, p.Kc + (size_t)b * 256 * 256 + (h >> 2) * 128, p.Vc + (size_t)b * 256 * 256 + (h >> 2) * 128,
                              p.obr + (size_t)2 * NTOK * DM + t0 * DM + h * 128, 256, smem);
  }
}
#define XB_TMO      128
#define XB_XCNT(j)  (256  + 64 * (j))
#define XB_XSUB(j)  (1280 + 64 * (j))
#define XB_XGEN(j)  (2304 + 64 * (j))
#define XB_TOP      3328
#define XB_TOPGEN   3392
#define XCD_BAR_WORDS 3456
#define XB_SPIN_CAP (1u << 20)
#define LAS __attribute__((address_space(3)))
constexpr int XB_LDS_OFF = 163840 - 16;

__device__ __forceinline__ unsigned xb_ld(unsigned* p)              { return __hip_atomic_load(p, __ATOMIC_RELAXED, __HIP_MEMORY_SCOPE_AGENT); }
__device__ __forceinline__ unsigned xb_add(unsigned* p, unsigned v) { return __hip_atomic_fetch_add(p, v, __ATOMIC_RELAXED, __HIP_MEMORY_SCOPE_AGENT); }
__device__ __forceinline__ unsigned xb_xcc_id() { return (unsigned)__builtin_amdgcn_s_getreg((3 << 11) | 20) & 0xFu; }
#define XB_SPIN(cond, bar) do { unsigned _sp = 0; while (cond) { __builtin_amdgcn_s_sleep(1); \
    if ((++_sp & 255u) == 0u) { if (xb_ld(&(bar)[XB_TMO])) break; if (_sp > XB_SPIN_CAP) { atomicAdd(&(bar)[XB_TMO], 1u); break; } } } } while (0)

__device__ __forceinline__ void xcd_barrier_post(unsigned* bar) {
  volatile LAS unsigned* st = (volatile LAS unsigned*)(smem + XB_LDS_OFF);
  if (tid_opaque() == 0) { st[0] = 0u; st[1] = 0u; (void)xb_add(&bar[XB_XCNT(xb_xcc_id())], 1u); }
  __syncthreads();
}
__device__ __forceinline__ void xcd_barrier_complete(unsigned* bar, unsigned x, unsigned& nloc, unsigned& nx) {
  const unsigned G = gridDim.x * gridDim.y * gridDim.z;
  unsigned sum, cnt, mine, sp = 0u;
  for (;;) {
    sum = 0u; cnt = 0u; mine = 0u;
#pragma unroll
    for (unsigned j = 0; j < 16; ++j) { const unsigned c = xb_ld(&bar[XB_XCNT(j)]); sum += c; cnt += (c > 0u) ? 1u : 0u; mine = (j == x) ? c : mine; }
    if (sum == G) break;
    __builtin_amdgcn_s_sleep(1);
    if ((++sp & 255u) == 0u) { if (xb_ld(&bar[XB_TMO])) break; if (sp > XB_SPIN_CAP) { atomicAdd(&bar[XB_TMO], 1u); break; } }
  }
  nloc = mine > 0u ? mine : 1u; nx = cnt > 0u ? cnt : 1u;
}
template <bool REL = true>
__device__ __forceinline__ void xcd_barrier(unsigned* bar) {
  asm volatile("s_waitcnt vmcnt(0)" ::: "memory");
  __syncthreads();
  if (tid_opaque() == 0) {
    volatile LAS unsigned* st = (volatile LAS unsigned*)(smem + XB_LDS_OFF);
    const unsigned x = xb_xcc_id();
    __builtin_amdgcn_s_waitcnt(0);
    unsigned nloc = st[0], nx = st[1];
    if (nloc == 0u) { xcd_barrier_complete(bar, x, nloc, nx); st[0] = nloc; st[1] = nx; }
    const unsigned old = xb_add(&bar[XB_XSUB(x)], 1u);
    const unsigned gen = old / nloc;
    if (old + 1u == (gen + 1u) * nloc) {
      if (REL) { __builtin_amdgcn_fence(__ATOMIC_RELEASE, "agent"); asm volatile("s_waitcnt vmcnt(0)" ::: "memory"); }
      const unsigned og = xb_add(&bar[XB_TOP], 1u);
      const unsigned tg = og / nx;
      if (og + 1u == (tg + 1u) * nx) xb_add(&bar[XB_TOPGEN], 1u);
      else XB_SPIN(xb_ld(&bar[XB_TOPGEN]) == tg, bar);
      xb_add(&bar[XB_XGEN(x)], 1u);
      __builtin_amdgcn_fence(__ATOMIC_ACQUIRE, "agent");
      asm volatile("s_waitcnt vmcnt(0)" ::: "memory");
    } else {
      XB_SPIN(xb_ld(&bar[XB_XGEN(x)]) == gen, bar);
      __builtin_amdgcn_fence(__ATOMIC_ACQUIRE, "agent");
      asm volatile("s_waitcnt vmcnt(0)" ::: "memory");
    }
  }
  __syncthreads();
}
constexpr float SCALEQ = 0.08838834764831845f;
constexpr int PQH = 0, PKH = 17408, PVH = 34816, PKK = 52224, PQK = 68864, PXS = 52224, PMD = 125952, PMB = 134144, PGC = 152576, PRS = 0;
constexpr int XROW = 144;
#define LDS_BARRIER() do { asm volatile("s_waitcnt lgkmcnt(0)" ::: "memory"); __builtin_amdgcn_s_barrier(); asm volatile("" ::: "memory"); } while (0)
constexpr int LROW = 272;

__device__ __forceinline__ float ld_bf(const char* base, int byteoff) { return bf2f(*(const bfr*)(base + byteoff)); }

template <int B>
__device__ __forceinline__ void solve_block(int d, int e, int wid, int lane) {
  const int fr = lane & 15, hq = lane >> 4;
  char* xcol = smem + PXS + (d * 256 + e) * XROW + 16 * B * 2;
  float acc[16];
  { const u32x4 a = *(const u32x4*)xcol, b = *(const u32x4*)(xcol + 16); unpack8(a, acc); unpack8(b, acc + 8); }
  if (B > 0) {
    constexpr int NKS = (B + 1) / 2;
    f32x4 R[4];
#pragma unroll
    for (int ct = 0; ct < 4; ++ct) R[ct] = f32x4{0.f, 0.f, 0.f, 0.f};
#pragma unroll
    for (int ks = 0; ks < NKS; ++ks) {
      const bf16x8 a = *(const bf16x8*)(smem + PMB + (d * 64 + 16 * B + fr) * XROW + (ks * 32 + 8 * hq) * 2);
#pragma unroll
      for (int ct = 0; ct < 4; ++ct) {
        const bf16x8 b = *(const bf16x8*)(smem + PXS + (d * 256 + (wid & 3) * 64 + ct * 16 + fr) * XROW + (ks * 32 + 8 * hq) * 2);
        R[ct] = __builtin_amdgcn_mfma_f32_16x16x32_bf16(a, b, R[ct], 0, 0, 0);
      }
    }
    float* rs = (float*)(smem + PRS + wid * 4352);
#pragma unroll
    for (int ct = 0; ct < 4; ++ct)
#pragma unroll
      for (int r = 0; r < 4; ++r) rs[(4 * hq + r) * 68 + ct * 16 + fr] = R[ct][r];
    asm volatile("s_waitcnt lgkmcnt(0)" ::: "memory");
#pragma unroll
    for (int r = 0; r < 16; ++r) acc[r] -= rs[r * 68 + lane];
  }
  const float4* md = (const float4*)(smem + PMD) + ((d * 4 + B) * 16) * 4;
#pragma unroll
  for (int r2 = 0; r2 < 15; ++r2) {
#pragma unroll
    for (int q = (r2 + 1) / 4; q < 4; ++q) {
      const float4 m = md[r2 * 4 + q];
      if (4 * q + 0 > r2) acc[4 * q + 0] -= m.x * acc[r2];
      if (4 * q + 1 > r2) acc[4 * q + 1] -= m.y * acc[r2];
      if (4 * q + 2 > r2) acc[4 * q + 2] -= m.z * acc[r2];
      if (4 * q + 3 > r2) acc[4 * q + 3] -= m.w * acc[r2];
    }
  }
  *(u32x4*)xcol = pack8(acc); *(u32x4*)(xcol + 16) = pack8(acc + 8);
  asm volatile("s_waitcnt lgkmcnt(0)" ::: "memory");
}

__device__ __forceinline__ void dn_prep_item(const Params& p, int l, int c, int h) {
  const int tid = tid_opaque(), wid = tid >> 6, lane = tid & 63;
  const int t0 = c * 64;
  LDS_BARRIER();
  float b_beta = 0.f, b_alpha = 0.f, b_A = 0.f, b_dtb = 0.f;
  if (wid < 2) {
    const int d = wid, ti = d ? 63 - lane : lane, t = t0 + ti;
    b_A = p.a_log[(l * 2 + d) * 8 + h]; b_dtb = p.dt_bias[(l * 2 + d) * 8 + h];
    b_beta = p.small[(size_t)t * 32 + d * 8 + h]; b_alpha = p.small[(size_t)t * 32 + 16 + d * 8 + h];
  }
  struct { u32x4 raw[3][2][3]; } R;
  {
    const int grp = tid & 15;
#pragma unroll
    for (int X = 0; X < 3; ++X)
#pragma unroll
      for (int pass = 0; pass < 2; ++pass)
#pragma unroll
        for (int k = -1; k <= 1; ++k) {
          const int r = (tid >> 4) + pass * 32, t = t0 + r, pos = tok_pos(t), L = tok_L(t);
          R.raw[X][pass][k + 1] = u32x4{0u, 0u, 0u, 0u};
          if (pos + k >= 0 && pos + k < L) R.raw[X][pass][k + 1] = *(const u32x4*)(p.P + (size_t)(t + k) * NP + X * 1024 + h * 128 + grp * 8);
        }
  }
  {
    const int grp = tid & 15;
    const float* wc = p.w_conv_dn + (size_t)l * 3 * 3072 + h * 128 + grp * 8;
#pragma unroll
    for (int X = 0; X < 3; ++X) {
      float w[3][8];
#pragma unroll
      for (int k = 0; k < 3; ++k) { *(float4*)&w[k][0] = *(const float4*)(wc + k * 3072 + X * 1024); *(float4*)&w[k][4] = *(const float4*)(wc + k * 3072 + X * 1024 + 4); }
#pragma unroll
      for (int pass = 0; pass < 2; ++pass) {
        const int r = (tid >> 4) + pass * 32;
        float acc[8] = {};
#pragma unroll
        for (int k = 0; k < 3; ++k) {
          float x[8]; unpack8(R.raw[X][pass][k], x);
#pragma unroll
          for (int q = 0; q < 8; ++q) acc[q] += w[k][q] * x[q];
        }
        float ss = 0;
#pragma unroll
        for (int q = 0; q < 8; ++q) { acc[q] = siluf_(acc[q]); ss += acc[q] * acc[q]; }
        if (X < 2) {
          ss += __shfl_xor(ss, 1); ss += __shfl_xor(ss, 2); ss += __shfl_xor(ss, 4); ss += __shfl_xor(ss, 8);
          const float nrm = rsqrtf(ss + EPS);
#pragma unroll
          for (int q = 0; q < 8; ++q) acc[q] *= nrm;
        }
        *(u32x4*)(smem + X * 17408 + r * LROW + grp * 16) = pack8hw(acc);
      }
    }
  }
  if (wid < 2) {
    const int d = wid;
    const float A = __expf(b_A);
    const float beta = sigmoidf_(b_beta);
    float g = -A * softplusf_(b_alpha + b_dtb);
#pragma unroll
    for (int o = 1; o < 64; o <<= 1) { const float v = __shfl_up(g, o); if (lane >= o) g += v; }
    float* G = (float*)(smem + PGC);
    const float eg_ = __expf(g);
    G[d * 64 + lane] = g; G[128 + d * 64 + lane] = beta; G[256 + d * 64 + lane] = eg_; G[384 + d * 64 + lane] = beta * eg_;
  }
  LDS_BARRIER();
  {
    const int mat = wid >> 2, rt = wid & 3, fr = lane & 15, fq = lane >> 4;
    const char* Ab = smem + (mat ? PQH : PKH);
    f32x4 acc[4];
#pragma unroll
    for (int ct = 0; ct < 4; ++ct) acc[ct] = f32x4{0.f, 0.f, 0.f, 0.f};
#pragma unroll
    for (int ks = 0; ks < 4; ++ks) {
      const bf16x8 a = *(const bf16x8*)(Ab + (rt * 16 + fr) * LROW + (ks * 32 + fq * 8) * 2);
#pragma unroll
      for (int ct = 0; ct < 4; ++ct) {
        const bf16x8 b = *(const bf16x8*)(smem + PKH + (ct * 16 + fr) * LROW + (ks * 32 + fq * 8) * 2);
        acc[ct] = __builtin_amdgcn_mfma_f32_16x16x32_bf16(a, b, acc[ct], 0, 0, 0);
      }
    }
    float* Dst = (float*)(smem + (mat ? PQK : PKK));
#pragma unroll
    for (int ct = 0; ct < 4; ++ct)
#pragma unroll
      for (int r = 0; r < 4; ++r) Dst[(rt * 16 + fq * 4 + r) * 65 + ct * 16 + fr] = acc[ct][r];
  }
  LDS_BARRIER();
  const int d = tid >> 8, e = tid & 255;
  const float* GC = (const float*)(smem + PGC) + d * 64;
  const float* BETA = (const float*)(smem + PGC) + 128 + d * 64;
  const float* EG = (const float*)(smem + PGC) + 256 + d * 64;
  const float* KKs = (const float*)(smem + PKK);
  const float* QKs = (const float*)(smem + PQK);
  char* rec = p.dnrec + (size_t)((c * 8 + h) * 2 + d) * REC_BYTES;
  {
    const int i = e >> 2, jq = e & 3, j0 = jq * 16, ti = d ? 63 - i : i, ib = i >> 4;
    const float bi = BETA[i], gi = GC[i];
    float mv[16];
#pragma unroll
    for (int jj = 0; jj < 16; ++jj) {
      const int j = j0 + jj, tj = d ? 63 - j : j;
      const float mraw = bi * KKs[ti * 65 + tj] * __expf(fminf(gi - GC[j], 0.f));
      mv[jj] = (j < i) ? mraw : 0.f;
    }
    float* mdt = (float*)(smem + PMD) + ((d * 4 + ib) * 16) * 16 + (i & 15);
    if (jq == ib) {
#pragma unroll
      for (int jj = 0; jj < 16; ++jj) mdt[jj * 16] = mv[jj];
    }
    float mo[16];
#pragma unroll
    for (int jj = 0; jj < 16; ++jj) mo[jj] = (jq < ib) ? mv[jj] : 0.f;
    char* mb = smem + PMB + (d * 64 + i) * XROW + j0 * 2;
    *(u32x4*)mb = pack8hw(mo); *(u32x4*)(mb + 16) = pack8hw(mo + 8);
#pragma unroll 1
    for (int rep = 0; rep < 2; ++rep) {
      const int f = e + rep * 256, ln = f & 63, fi = f >> 6, mt = fi >> 1, ks = fi & 1;
      const int ii = mt * 16 + (ln & 15), tii = d ? 63 - ii : ii, hq = ln >> 4;
      const float gii = GC[ii];
      float v[8];
#pragma unroll
      for (int j = 0; j < 8; ++j) {
        const int jp = ks * 32 + (j >> 2) * 16 + 4 * hq + (j & 3), tj = d ? 63 - jp : jp;
        const float qraw = SCALEQ * QKs[tii * 65 + tj] * __expf(fminf(gii - GC[jp], 0.f));
        v[j] = (jp <= ii) ? qraw : 0.f;
      }
      *(u32x4*)(rec + REC_QK + f * 16) = pack8hw(v);
    }
    if (e == 0) p.glast[(c * 8 + h) * 2 + d] = EG[63];
    const float gl = GC[63];
#pragma unroll 1
    for (int rep = 0; rep < 4; ++rep) {
      const int f = e + rep * 256, ln = f & 63, fi = f >> 6, hq = ln >> 4;
      {
        const int mt = fi >> 2, ks = fi & 3, ii = mt * 16 + (ln & 15), tii = d ? 63 - ii : ii;
        const float sc = SCALEQ * EG[ii];
        const char* qrow = smem + PQH + tii * LROW + (ks * 32 + 4 * hq) * 2;
        const u32x2 lo = *(const u32x2*)qrow, hi = *(const u32x2*)(qrow + 32);
        float v[8] = {__uint_as_float(lo[0] << 16), __uint_as_float(lo[0] & 0xffff0000u), __uint_as_float(lo[1] << 16), __uint_as_float(lo[1] & 0xffff0000u),
                      __uint_as_float(hi[0] << 16), __uint_as_float(hi[0] & 0xffff0000u), __uint_as_float(hi[1] << 16), __uint_as_float(hi[1] & 0xffff0000u)};
#pragma unroll
        for (int j = 0; j < 8; ++j) v[j] *= sc;
        *(u32x4*)(rec + REC_QD + f * 16) = pack8hw(v);
      }
      {
        const int mt = fi >> 1, ks = fi & 1, dk = mt * 16 + (ln & 15);
        float v[8];
#pragma unroll
        for (int j = 0; j < 8; ++j) {
          const int ip = ks * 32 + (j >> 2) * 16 + 4 * hq + (j & 3), tip = d ? 63 - ip : ip;
          v[j] = ld_bf(smem + PKH, tip * LROW + dk * 2) * __expf(gl - GC[ip]);
        }
        *(u32x4*)(rec + REC_KD + f * 16) = pack8hw(v);
      }
    }
  }
  LDS_BARRIER();
  {
    const int col = e & 127; const bool isw = e >= 128;
    const char* src = smem + (isw ? PKH : PVH) + col * 2;
    const float4* F4 = (const float4*)((const float*)(smem + PGC) + (isw ? 384 : 128) + d * 64);
    char* xcol = smem + PXS + (d * 256 + e) * XROW;
#pragma unroll
    for (int i8 = 0; i8 < 8; ++i8) {
      const float4 f0 = F4[i8 * 2], f1 = F4[i8 * 2 + 1];
      const float fs[8] = {f0.x, f0.y, f0.z, f0.w, f1.x, f1.y, f1.z, f1.w};
      float v[8];
#pragma unroll
      for (int q = 0; q < 8; ++q) { const int i = i8 * 8 + q, ti = d ? 63 - i : i; v[q] = ld_bf(src, ti * LROW) * fs[q]; }
      *(u32x4*)(xcol + i8 * 16) = pack8hw(v);
    }
  }
  LDS_BARRIER();
  solve_block<0>(d, e, wid, lane); solve_block<1>(d, e, wid, lane); solve_block<2>(d, e, wid, lane); solve_block<3>(d, e, wid, lane);
  LDS_BARRIER();
  {
    const char* XS = smem + PXS + d * 256 * XROW;
#pragma unroll 1
    for (int rep = 0; rep < 8; ++rep) {
      const int f = e + rep * 256, ln = f & 63, fi = f >> 6, ws = fi >> 2, rt = fi & 3;
      const int i0 = rt * 16 + 4 * (ln >> 4), dv = ws * 16 + (ln & 15);
      *(u32x2*)(rec + REC_U + f * 8) = *(const u32x2*)(XS + dv * XROW + i0 * 2);
    }
#pragma unroll 1
    for (int rep = 0; rep < 4; ++rep) {
      const int f = e + rep * 256, ln = f & 63, fi = f >> 6, mt = fi >> 2, ks = fi & 3, hq = ln >> 4;
      const char* wc = XS + (128 + ks * 32 + 4 * hq) * XROW + (mt * 16 + (ln & 15)) * 2;
      unsigned q[8];
#pragma unroll
      for (int j = 0; j < 8; ++j) q[j] = *(const bfr*)(wc + ((j >> 2) * 16 + (j & 3)) * XROW);
      u32x4 o = {q[0] | (q[1] << 16), q[2] | (q[3] << 16), q[4] | (q[5] << 16), q[6] | (q[7] << 16)};
      *(u32x4*)(rec + REC_W + f * 16) = o;
    }
  }
}

__device__ __forceinline__ bf16x8 pack_b(const f32x4& a, const f32x4& b) {
  u32x4 w = {pack2hw(a[0], a[1]), pack2hw(a[2], a[3]), pack2hw(b[0], b[1]), pack2hw(b[2], b[3])};
  return *reinterpret_cast<bf16x8*>(&w);
}

constexpr int SCAN_BUF = 73728;
#define SC_SCHED() __builtin_amdgcn_sched_barrier(0)
#define SC_WAITL(n) asm volatile("s_waitcnt lgkmcnt(" #n ")" ::: "memory")
__device__ __forceinline__ void dn_scan_item(const Params& p, int l, int s, int h, int d) {
  const int tid = tid_opaque(), wid = tid >> 6, lane = tid & 63, ws = wid, fr = lane & 15, hq = lane >> 4;
  const bool samp = s >= 16;
  const int N = samp ? 16 : 4, cb = samp ? 64 + (s - 16) * 16 : s * 4, tbase = samp ? NCTX + (s - 16) * 1024 : s * 256;
  const int cstep = d ? -1 : 1, c0 = cb + (d ? N - 1 : 0);
  auto recp = [&](int n) { return p.dnrec + (size_t)(((c0 + n * cstep) * 8 + h) * 2 + d) * REC_BYTES; };
  f32x4 S[8];
  if (samp) {
    const float* s0 = p.state_dn + ((((size_t)(s - 16) * DEPTH + l) * 2 + d) * 8 + h) * 16384;
#pragma unroll
    for (int dt = 0; dt < 8; ++dt) {
      const float* q = s0 + (dt * 16 + 4 * hq) * 128 + ws * 16 + fr;
      asm volatile("" : "+v"(q) :: "memory");
#pragma unroll
      for (int r = 0; r < 4; ++r) S[dt][r] = q[r * 128];
    }
  } else {
#pragma unroll
    for (int dt = 0; dt < 8; ++dt) S[dt] = f32x4{0.f, 0.f, 0.f, 0.f};
  }
  const float glv = p.glast[((c0 + (lane < N ? lane : 0) * cstep) * 8 + h) * 2 + d];
  __syncthreads();
#define SC_GLDS(rec, buf) do { _Pragma("unroll") for (int i = 0; i < 9; ++i) \
    __builtin_amdgcn_global_load_lds((const unsigned*)((rec) + (i * 512 + tid) * 16), (__attribute__((address_space(3))) unsigned*)(smem + (buf) * SCAN_BUF + (i * 512 + tid) * 16), 16, 0, 0); } while (0)
  SC_GLDS(recp(0), 0);
  SC_GLDS(recp(1), 1);
  asm volatile("s_waitcnt vmcnt(0)" ::: "memory");
  LDS_BARRIER();
#pragma unroll 1
  for (int n = 0; n < N; ++n) {
    const int c = c0 + n * cstep;
    const char* Lb = smem + (n & 1) * SCAN_BUF;
    const char* LW = Lb + REC_W + lane * 16;
    const float gl = __uint_as_float(__builtin_amdgcn_readlane(__float_as_uint(glv), n));
    f32x4 P[4], O[4];
#pragma unroll
    for (int rt = 0; rt < 4; ++rt) { P[rt] = f32x4{0.f, 0.f, 0.f, 0.f}; O[rt] = f32x4{0.f, 0.f, 0.f, 0.f}; }
    bf16x8 F[8];
#define SC_LOADWQ(ks) do { _Pragma("unroll") for (int rt = 0; rt < 4; ++rt) { F[rt] = *(const bf16x8*)(LW + ((rt * 4 + (ks)) * 64) * 16); F[4 + rt] = *(const bf16x8*)(LW + 16384 + ((rt * 4 + (ks)) * 64) * 16); } } while (0)
#define SC_MMAWQ(sb) do { _Pragma("unroll") for (int rt = 0; rt < 4; ++rt) { P[rt] = __builtin_amdgcn_mfma_f32_16x16x32_bf16(F[rt], sb, P[rt], 0, 0, 0); O[rt] = __builtin_amdgcn_mfma_f32_16x16x32_bf16(F[4 + rt], sb, O[rt], 0, 0, 0); } } while (0)
#pragma unroll
    for (int ks = 0; ks < 4; ++ks) {
      SC_LOADWQ(ks); SC_SCHED();
      const bf16x8 sb = pack_b(S[2 * ks], S[2 * ks + 1]);
      SC_WAITL(0); SC_SCHED(); SC_MMAWQ(sb); SC_SCHED();
    }
    u32x2 U[4];
#pragma unroll
    for (int rt = 0; rt < 4; ++rt) U[rt] = *(const u32x2*)(Lb + REC_U + (((ws * 4 + rt) * 64) + lane) * 8);
#pragma unroll
    for (int i = 0; i < 8; ++i) F[i] = *(const bf16x8*)(LW + 32768 + (i * 64) * 16);
    SC_SCHED(); SC_WAITL(0); SC_SCHED();
#pragma unroll
    for (int rt = 0; rt < 4; ++rt) {
      const u32x2 u = U[rt];
      P[rt][0] = __uint_as_float(u[0] << 16) - P[rt][0]; P[rt][1] = __uint_as_float(u[0] & 0xffff0000u) - P[rt][1];
      P[rt][2] = __uint_as_float(u[1] << 16) - P[rt][2]; P[rt][3] = __uint_as_float(u[1] & 0xffff0000u) - P[rt][3];
    }
    const bf16x8 vb0 = pack_b(P[0], P[1]), vb1 = pack_b(P[2], P[3]);
#pragma unroll
    for (int rt = 0; rt < 4; ++rt) {
      O[rt] = __builtin_amdgcn_mfma_f32_16x16x32_bf16(F[rt * 2 + 0], vb0, O[rt], 0, 0, 0);
      O[rt] = __builtin_amdgcn_mfma_f32_16x16x32_bf16(F[rt * 2 + 1], vb1, O[rt], 0, 0, 0);
    }
    SC_SCHED();
#pragma unroll
    for (int half = 0; half < 2; ++half) {
#pragma unroll
      for (int i = 0; i < 8; ++i) F[i] = *(const bf16x8*)(LW + 40960 + ((half * 8 + i) * 64) * 16);
      SC_SCHED(); SC_WAITL(0); SC_SCHED();
#pragma unroll
      for (int dq = 0; dq < 4; ++dq) {
        const int dt = half * 4 + dq;
        S[dt] *= gl;
        S[dt] = __builtin_amdgcn_mfma_f32_16x16x32_bf16(F[dq * 2 + 0], vb0, S[dt], 0, 0, 0);
        S[dt] = __builtin_amdgcn_mfma_f32_16x16x32_bf16(F[dq * 2 + 1], vb1, S[dt], 0, 0, 0);
      }
      SC_SCHED();
    }
    SC_SCHED();
    bfr* ob = p.opart + (size_t)d * NTOK * DM + (size_t)(c * 64) * DM + h * 128 + ws * 16 + fr;
#pragma unroll
    for (int rt = 0; rt < 4; ++rt) {
      const int ip0 = rt * 16 + 4 * hq;
      bfr* q = ob + (size_t)(d ? 63 - ip0 : ip0) * DM;
      const long stp = d ? -(long)DM : (long)DM;
#pragma unroll
      for (int r = 0; r < 4; ++r) q[r * stp] = f2bf(O[rt][r]);
    }
    asm volatile("s_waitcnt vmcnt(16)" ::: "memory");
    LDS_BARRIER();
    if (n + 2 < N) SC_GLDS(recp(n + 2), n & 1);
  }
#undef SC_GLDS
#undef SC_LOADWQ
#undef SC_MMAWQ
  if (!samp) {
    float* so = p.out_state + ((((size_t)s * DEPTH + l) * 2 + d) * 8 + h) * 16384;
#pragma unroll
    for (int dt = 0; dt < 8; ++dt) {
      float* q = so + (dt * 16 + 4 * hq) * 128 + ws * 16 + fr;
      asm volatile("" : "+v"(q) :: "memory");
#pragma unroll
      for (int r = 0; r < 4; ++r) q[r * 128] = S[dt][r];
    }
  }
  if (l == 1 && s == 16 && h == 0 && d == 0) GSTAMP(p.bar, 4);
  asm volatile("s_waitcnt vmcnt(0)" ::: "memory");
  __syncthreads();
  volatile __attribute__((address_space(3))) unsigned* flag = (volatile __attribute__((address_space(3))) unsigned*)(smem + XB_LDS_OFF + 8);
  if (tid == 0) {
    __builtin_amdgcn_fence(__ATOMIC_RELEASE, "agent");
    asm volatile("s_waitcnt vmcnt(0)" ::: "memory");
    const unsigned old = __hip_atomic_fetch_add(p.bar + 4096 + (l * 18 + s) * 8 + h, 1u, __ATOMIC_RELAXED, __HIP_MEMORY_SCOPE_AGENT);
    if (old == 1u) { __builtin_amdgcn_fence(__ATOMIC_ACQUIRE, "agent"); asm volatile("s_waitcnt vmcnt(0)" ::: "memory"); }
    *flag = old;
  }
  __syncthreads();
  const unsigned last = __builtin_amdgcn_readfirstlane(*flag);
  if (last == 1u && !samp) dn_finalize(p, l, tbase, 256, h, tid, NTHR);
}

__device__ __forceinline__ void dn_finalize_item(const Params& p, int l, int it) {
  const int tid = tid_opaque();
  const int s = 16 + (it >> 5), h = (it >> 2) & 7, qt = it & 3;
  __syncthreads();
  if (tid == 0) {
    unsigned* cnt = p.bar + 4096 + (l * 18 + s) * 8 + h; unsigned sp = 0;
    while (__hip_atomic_load(cnt, __ATOMIC_RELAXED, __HIP_MEMORY_SCOPE_AGENT) < 2u) { __builtin_amdgcn_s_sleep(2); if (++sp > (1u << 22)) { atomicAdd(&p.bar[XB_TMO], 1u); break; } }
    __builtin_amdgcn_fence(__ATOMIC_ACQUIRE, "agent");
    asm volatile("s_waitcnt vmcnt(0)" ::: "memory");
  }
  __syncthreads();
  dn_finalize(p, l, NCTX + (s - 16) * 1024 + qt * 256, 256, h, tid, NTHR);
}
constexpr int DYN_LDS = 163840;
#ifndef REP
#define REP 0
#endif
constexpr int CONV_SPLIT = 660;
#ifndef USE_CG_SYNC
#define USE_CG_SYNC 1
#endif
#if USE_CG_SYNC
#define GRID_SYNC() do { cg::this_grid().sync(); } while (0)
#define GRID_SYNC_WT() GRID_SYNC()
#else
#define GRID_SYNC() do { unsigned* bar_; { PHASE_PARAMS(pb); bar_ = pb.bar; } xcd_barrier<true>(bar_); if (REP & 2048) xcd_barrier<true>(bar_); } while (0)
#define GRID_SYNC_WT() GRID_SYNC()
#endif

typedef const __attribute__((address_space(4))) Params* CParamsPtr;
#define PHASE_PARAMS(p) CParamsPtr p##_c = (CParamsPtr)__builtin_amdgcn_kernarg_segment_ptr(); asm volatile("" : "+s"(p##_c)); const Params& p = *(const Params*)p##_c

#define PF_LINES(base_ptr, nlines) do { const int g_ = bid * 512 + tid_opaque(); unsigned d0_ = 0, d1_ = 0; \
    if (g_ < (nlines)) { const char* q_ = (const char*)(base_ptr) + (size_t)g_ * 128; asm volatile("global_load_dword %0, %1, off" : "=v"(d0_) : "v"(q_) : "memory"); } \
    if ((nlines) > 131072 && g_ + 131072 < (nlines)) { const char* q_ = (const char*)(base_ptr) + (size_t)(g_ + 131072) * 128; asm volatile("global_load_dword %0, %1, off" : "=v"(d1_) : "v"(q_) : "memory"); } \
    asm volatile("s_waitcnt vmcnt(0)" ::: "memory"); asm volatile("" :: "v"(d0_), "v"(d1_)); } while (0)
__device__ __forceinline__ void panel_rows(const Params& p, int l, int mode, int bid) {
  const int tid = tid_opaque(), wid = tid >> 6, lane = tid & 63;
  const int pm = bid % 24, q = bid / 24;
  volatile __attribute__((address_space(3))) unsigned* flag = (volatile __attribute__((address_space(3))) unsigned*)(smem + XB_LDS_OFF + 8);
  asm volatile("s_waitcnt vmcnt(0)" ::: "memory");
  __syncthreads();
  if (tid == 0) {
    unsigned* cnt = p.bar + 9216 + ((l * 2 + (mode - 1)) * 24 + pm) * 16;
    __builtin_amdgcn_fence(__ATOMIC_RELEASE, "agent");
    asm volatile("s_waitcnt vmcnt(0)" ::: "memory");
    (void)__hip_atomic_fetch_add(cnt, 1u, __ATOMIC_RELAXED, __HIP_MEMORY_SCOPE_AGENT);
    unsigned sp = 0;
    while (__hip_atomic_load(cnt, __ATOMIC_RELAXED, __HIP_MEMORY_SCOPE_AGENT) < 8u) { __builtin_amdgcn_s_sleep(1); if (++sp > (1u << 22)) { atomicAdd(&p.bar[XB_TMO], 1u); break; } }
    __builtin_amdgcn_fence(__ATOMIC_ACQUIRE, "agent");
    asm volatile("s_waitcnt vmcnt(0)" ::: "memory");
    *flag = 1u;
  }
  __syncthreads();
  rows_at<4>(p, l, mode, pm * 256 + q * 32 + wid * 4, lane);
}

template <int l> __device__ __forceinline__ void run_layer(const int bid, const int nblk) {
  if (l == 1) TSTAMP(5);
  { PHASE_PARAMS(p); pg8::gemm_phase(pg8::Gemm{p.h, p.wt_in + (size_t)l * NPAD * DM, DM, DM, DM}, pg8::SchedIn{nblk, bid}, pg8::EpiIn{p.P, p.small}); }
#if REP & 1
#if REP & 65536
  { PHASE_PARAMS(p); pg8::gemm_phase(pg8::Gemm{p.h, p.wt_in + (size_t)l * NPAD * DM, DM, DM, DM}, pg8::SchedIn{nblk, bid}, pg8::EpiIn{p.P, p.small}); }
#else
  { PHASE_PARAMS(p); pg8::gemm_phase(pg8::Gemm{p.h, p.wt_in + (size_t)l * NPAD * DM, DM, DM, DM}, pg8::SchedIn{nblk, bid}, pg8::EpiIn{p.P, p.small}); }
#endif
#endif
  GRID_SYNC_WT(); if (l == 1) TSTAMP(6);
  { PHASE_PARAMS(p); for (int it = bid; it < 768; it += nblk) dn_prep_item(p, l, it >> 3, it & 7); }
#if REP & 2
  { PHASE_PARAMS(p); for (int it = bid; it < 768; it += nblk) dn_prep_item(p, l, it >> 3, it & 7); }
#endif
  if (l == 1) TSTAMP(15);
  { PHASE_PARAMS(p); for (int it = bid; it < 384; it += nblk) light_prep_item(p, l, it); }
#if REP & 4096
  { PHASE_PARAMS(p); for (int it = bid; it < 384; it += nblk) light_prep_item(p, l, it); }
#endif
  unsigned pf_ = 0;
  { PHASE_PARAMS(p); const int gid = bid * 512 + tid_opaque(); const char* q;
    if (gid < 98304) q = (const char*)p.h + (size_t)gid * 128;
    else if (gid < 114688) q = (const char*)(p.wt_in + (size_t)l * NPAD * DM + (size_t)42 * 256 * DM) + (size_t)(gid - 98304) * 128;
    else if (gid < 118784) q = (const char*)(p.wt_in + (size_t)l * NPAD * DM + (size_t)37 * 256 * DM) + (size_t)(gid - 114688) * 128;
    else q = (const char*)(p.wt_br + (size_t)(l * 3 + 1) * DM * DM) + (size_t)((gid - 118784) & 8191) * 128;
    asm volatile("global_load_dword %0, %1, off" : "=v"(pf_) : "v"(q) : "memory"); }
  GRID_SYNC(); if (l == 1) TSTAMP(7);
  asm volatile("" :: "v"(pf_));
#define P3_PULL(slotword, limit) \
      volatile __attribute__((address_space(3))) unsigned* qslot = (volatile __attribute__((address_space(3))) unsigned*)(smem + XB_LDS_OFF + 12); \
      __syncthreads(); \
      if (tid_opaque() == 0) { PHASE_PARAMS(pq); *qslot = __hip_atomic_fetch_add(pq.bar + 8192 + l * 8 + rep3 * 4 + (slotword), 1u, __ATOMIC_RELAXED, __HIP_MEMORY_SCOPE_AGENT); } \
      __syncthreads(); \
      const int it = __builtin_amdgcn_readfirstlane((int)*qslot); \
      if (it >= (limit)) break;
#pragma unroll 1
  for (int rep3 = 0; rep3 < ((REP & 4) ? 2 : 1); ++rep3) {
    if (bid < 64) { PHASE_PARAMS(p); attn_item(p, bid); }
    else {
      if (bid >= 192)
#pragma unroll 1
      for (int rr_ = 0; rr_ < ((REP & 131072) ? 2 : 1); ++rr_) {
        const int it = bid - 192; TSTAMP(1);
        if (it >= 32) { PHASE_PARAMS(p); const int k = it - 32; pg8::Unit u; if (k < 8) { u.pm = 16 + k; u.pn = 37; } else { u.pm = (k - 8) % 24; u.pn = 42 + (k - 8) / 24; } u.z = 0; u.ka = 0; u.kb = 0;
          pg8::gemm_phase(pg8::Gemm{p.h, p.wt_in + (size_t)l * NPAD * DM, DM, DM, DM}, pg8::SchedOne{u}, pg8::EpiIn{p.P, p.small}); }
        else { PHASE_PARAMS(p); pg8::Unit u; u.pm = it % 24; u.pn = it / 24; u.z = 1; u.ka = (size_t)NTOK * DM; u.kb = (size_t)DM * DM;
          pg8::gemm_phase(pg8::Gemm{p.obr, p.wt_br + (size_t)l * 3 * DM * DM, DM, DM, DM}, pg8::SchedOne{u}, pg8::EpiBr{p.a3, p.P}); }
      }
      TSTAMP(2);
#pragma unroll 1
      for (int j = bid - 64; j < 32 + 256; j += (bid < 96 ? 1000 : 160)) {
        PHASE_PARAMS(p);
        if (j < 32) dn_scan_item(p, l, 16 + (j >> 4), (j >> 1) & 7, j & 1); else { const int jj = j - 32; dn_scan_item(p, l, jj >> 4, (jj >> 1) & 7, jj & 1); }
      }
    }
    TSTAMP(3);
#define P3_TICKET(var) do { volatile __attribute__((address_space(3))) unsigned* qslot = (volatile __attribute__((address_space(3))) unsigned*)(smem + XB_LDS_OFF + 12); \
      __syncthreads(); \
      if (tid_opaque() == 0) { PHASE_PARAMS(pq); *qslot = __hip_atomic_fetch_add(pq.bar + 8192 + l * 8 + rep3 * 4 + 2, 1u, __ATOMIC_RELAXED, __HIP_MEMORY_SCOPE_AGENT); } \
      __syncthreads(); \
      var = __builtin_amdgcn_readfirstlane((int)*qslot); } while (0)
    int tk; P3_TICKET(tk);
#pragma unroll 1
    while (tk < 128) { { PHASE_PARAMS(p); attn_item(p, 64 + tk); } P3_TICKET(tk); }
#pragma unroll 1
    while (tk < 200) { const int itd = tk - 128 + 64;
      if (itd >= 32) { PHASE_PARAMS(p); const int k = itd - 32; pg8::Unit u; if (k < 8) { u.pm = 16 + k; u.pn = 37; } else { u.pm = (k - 8) % 24; u.pn = 42 + (k - 8) / 24; } u.z = 0; u.ka = 0; u.kb = 0;
        pg8::gemm_phase(pg8::Gemm{p.h, p.wt_in + (size_t)l * NPAD * DM, DM, DM, DM}, pg8::SchedOne{u}, pg8::EpiIn{p.P, p.small}); }
      else { PHASE_PARAMS(p); pg8::Unit u; u.pm = itd % 24; u.pn = itd / 24; u.z = 1; u.ka = (size_t)NTOK * DM; u.kb = (size_t)DM * DM;
        pg8::gemm_phase(pg8::Gemm{p.obr, p.wt_br + (size_t)l * 3 * DM * DM, DM, DM, DM}, pg8::SchedOne{u}, pg8::EpiBr{p.a3, p.P}); }
      P3_TICKET(tk);
    }
#pragma unroll 1
    while (tk < 264) { { PHASE_PARAMS(p); dn_finalize_item(p, l, tk - 200); } P3_TICKET(tk); }
#undef P3_TICKET
  }
#undef P3_PULL
  GRID_SYNC(); if (l == 1) TSTAMP(8);
  { PHASE_PARAMS(p); pg8::gemm_phase(pg8::Gemm{p.obr, p.wt_br + (size_t)l * 3 * DM * DM, DM, DM, DM}, pg8::SchedBr{nblk, bid}, pg8::EpiBr{p.a3, p.P}); }
#if REP & 8
  { PHASE_PARAMS(p); pg8::gemm_phase(pg8::Gemm{p.obr, p.wt_br + (size_t)l * 3 * DM * DM, DM, DM, DM}, pg8::SchedBr{nblk, bid}, pg8::EpiBr{p.a3, p.P}); }
#endif
  GRID_SYNC_WT(); if (l == 1) TSTAMP(9);
  { PHASE_PARAMS(p); pg8::gemm_phase(pg8::Gemm{p.a3, p.wt_out + (size_t)l * DM * 3072, 3072, 3072, 1536}, pg8::SchedSplit2<1536>{nblk, bid}, pg8::EpiPart{(bfr*)p.R}); }
  if (l + 1 < DEPTH && bid >= 192) { PHASE_PARAMS(p); for (int k = bid - 192; k < CONV_SPLIT; k += nblk - 192) convert_item(p, l + 1, k); }
#if REP & 16
  { PHASE_PARAMS(p); pg8::gemm_phase(pg8::Gemm{p.a3, p.wt_out + (size_t)l * DM * 3072, 3072, 3072, 1536}, pg8::SchedSplit2<1536>{nblk, bid}, pg8::EpiPart{(bfr*)p.R}); }
#endif
  GRID_SYNC_WT(); if (l == 1) TSTAMP(10);
  { PHASE_PARAMS(p); stage_row(p, l, 1, bid, nblk); }
  GRID_SYNC(); if (l == 1) TSTAMP(11);
  { PHASE_PARAMS(p); pg8::gemm_phase(pg8::Gemm{p.h, p.wt_up + (size_t)l * HID * DM, DM, DM, DM}, pg8::SchedUp{nblk, bid}, pg8::EpiUp{p.u2}); }
#if REP & 32
  { PHASE_PARAMS(p); pg8::gemm_phase(pg8::Gemm{p.h, p.wt_up + (size_t)l * HID * DM, DM, DM, DM}, pg8::SchedUp{nblk, bid}, pg8::EpiUp{p.u2}); }
#endif
  GRID_SYNC_WT(); if (l == 1) TSTAMP(12);
  { PHASE_PARAMS(p); pg8::gemm_phase(pg8::Gemm{p.u2, p.wt_dn + (size_t)l * DM * HID, HID, HID, 2048}, pg8::SchedSplit2<2048>{nblk, bid}, pg8::EpiPart{(bfr*)p.R}); }
  if (l + 1 < DEPTH && bid >= 192) { PHASE_PARAMS(p); for (int k = CONV_SPLIT + bid - 192; k < CONV_ITEMS; k += nblk - 192) convert_item(p, l + 1, k); }
  GRID_SYNC_WT(); if (l == 1) TSTAMP(13);
  { PHASE_PARAMS(p); stage_row(p, l, 2, bid, nblk); }
  if (l + 1 < DEPTH) GRID_SYNC(); if (l == 1) TSTAMP(14);
}

__global__ __launch_bounds__(512) void mega_kernel(Params p_arg) {
#if USE_CG_SYNC
  cg::grid_group grid = cg::this_grid();
#endif
  const int bid = blockIdx.x, nblk = gridDim.x;
#if !USE_CG_SYNC
  { PHASE_PARAMS(pb); xcd_barrier_post(pb.bar); }
  cg::this_grid().sync();
#endif
#ifdef DIAG_A
  if (threadIdx.x < 32) ((unsigned long long*)(smem + 163840 - 256))[threadIdx.x & 15] = 0ull;
  __syncthreads();
#endif
  { PHASE_PARAMS(p); stage_mod(p, bid, nblk, smem); }
#if REP & 8192
  { PHASE_PARAMS(p); stage_mod(p, bid, nblk, smem); }
#endif
  { PHASE_PARAMS(p); for (int it = bid; it < CONV_ITEMS; it += nblk) convert_item(p, 0, it); }
#if REP & 128
  { PHASE_PARAMS(p); for (int it = bid; it < CONV_ITEMS; it += nblk) convert_item(p, 0, it); }
#endif
  GRID_SYNC();
  { PHASE_PARAMS(p); stage_row(p, 0, 0, bid, nblk); }
#if REP & 16384
  { PHASE_PARAMS(p); stage_row(p, 0, 0, bid, nblk); }
#endif
  GRID_SYNC();
  run_layer<0>(bid, nblk); run_layer<1>(bid, nblk); run_layer<2>(bid, nblk); run_layer<3>(bid, nblk);
#ifdef DIAG_A
  __syncthreads();
  if (blockIdx.x == DIAG_BLK && threadIdx.x == 0) { const unsigned long long* ts_ = (const unsigned long long*)(smem + 163840 - 256); PHASE_PARAMS(pd); asm volatile("s_waitcnt vmcnt(0)" ::: "memory");
#ifdef DIAG_G
    const unsigned long long* gs_ = (const unsigned long long*)(pd.bar + 12288); const unsigned long long ta_ = __hip_atomic_load(gs_ + DIAG_A, __ATOMIC_RELAXED, __HIP_MEMORY_SCOPE_AGENT), tb_ = __hip_atomic_load(gs_ + DIAG_B, __ATOMIC_RELAXED, __HIP_MEMORY_SCOPE_AGENT);
    pd.xbuf[0] = 1000.0f * rintf(4.0f * log2f((float)(tb_ - ta_) * 10.0f));
#else
    pd.xbuf[(size_t)DIAG_BLK * 24 * 1024] = 1000.0f * rintf(4.0f * log2f((float)(ts_[DIAG_B] - ts_[DIAG_A]) * 10.0f));
#endif
  }
#endif
}

__global__ void diag_fill(float* out, long n, float v) { for (long i = blockIdx.x * 256L + threadIdx.x; i < n; i += gridDim.x * 256L) out[i] = (i == 0) ? v : 0.f; }
static size_t align_up(size_t x) { return (x + 255) & ~(size_t)255; }
static bool make_params(Params& p, void* const* d_in, void* d_out, void* d_ws, size_t ws_size) {
  const float** in = (const float**)d_in;
  p.x_prompt = in[0]; p.x_sample = in[1]; p.cache_k = in[2]; p.cache_v = in[3]; p.state_dn = in[4]; p.c = in[5]; p.c_ctx = in[6];
  p.w_mod = in[7]; p.b_mod = in[8]; p.g_pre_mix = in[9]; p.g_post_mix = in[10]; p.g_pre_mlp = in[11]; p.g_post_mlp = in[12];
  p.w_in = in[13]; p.w_conv_dn = in[14]; p.a_log = in[15]; p.dt_bias = in[16]; p.g_dn_out = in[17]; p.w_conv_sc = in[18];
  p.g_q = in[19]; p.g_k = in[20]; p.w_br_dn = in[21]; p.w_br_sc = in[22]; p.w_br_att = in[23]; p.w_out = in[24];
  p.w_mlp_up = in[25]; p.w_mlp_down = in[26];
  float* out = (float*)d_out;
  p.xbuf = out; p.out_ck = out + 6291456; p.out_cv = p.out_ck + 4194304; p.out_state = p.out_cv + 4194304;
  char* w = (char*)d_ws; size_t off = 0;
  auto take = [&](size_t bytes) { char* r = w + off; off = align_up(off + bytes); return r; };
  p.bar   = (unsigned*)take(65536);
  p.wt_in = (bfr*)take((size_t)DEPTH * NPAD * DM * 2);
  p.wt_br = (bfr*)take((size_t)DEPTH * 3 * DM * DM * 2);
  p.wt_out= (bfr*)take((size_t)DEPTH * DM * 3072 * 2);
  p.wt_up = (bfr*)take((size_t)DEPTH * HID * DM * 2);
  p.wt_dn = (bfr*)take((size_t)DEPTH * DM * HID * 2);
  p.mod   = (float*)take((size_t)DEPTH * 3 * 6144 * 4);
  p.h     = (bfr*)take((size_t)NTOK * DM * 2);
  p.P     = (bfr*)take((size_t)NTOK * NP * 2);
  p.u2    = p.P;
  p.small = (float*)take((size_t)NTOK * 32 * 4);
  p.dnrec = take((size_t)1536 * REC_BYTES);
  p.glast = (float*)take(1536 * 4);
  p.opart = (bfr*)take((size_t)2 * NTOK * DM * 2);
  p.obr   = (bfr*)take((size_t)3 * NTOK * DM * 2);
  p.Q     = (bfr*)take((size_t)NTOK * DM * 2);
  p.Kc    = (bfr*)take((size_t)NCTX * 256 * 2);
  p.Vc    = (bfr*)take((size_t)NCTX * 256 * 2);
  p.Ks    = (bfr*)take((size_t)2 * 1280 * 256 * 2);
  p.Vs    = (bfr*)take((size_t)2 * 1280 * 256 * 2);
  p.merged= (bfr*)take((size_t)NTOK * DM * 2);
  p.a3    = (bfr*)take((size_t)NTOK * 3072 * 2);
  p.R     = (float*)take((size_t)4 * NTOK * DM * 4);
  return off <= ws_size;
}
extern "C" void kernel_launch(void* const* d_in, const int* in_sizes, int n_in, void* d_out, int out_size, void* d_ws, size_t ws_size, hipStream_t stream) {
  Params p{};
  if (n_in != 27 || out_size != 31457280) { diag_fill<<<1024, 256, 0, stream>>>((float*)d_out, (long)out_size, 3.0e6f + n_in); return; }
  if (!make_params(p, d_in, d_out, d_ws, ws_size)) { diag_fill<<<1024, 256, 0, stream>>>((float*)d_out, (long)out_size, (float)(ws_size >> 20)); return; }
  static int grid_blocks = 0;
  if (!grid_blocks) {
    (void)hipFuncSetAttribute((const void*)mega_kernel, hipFuncAttributeMaxDynamicSharedMemorySize, DYN_LDS);
    int dev = 0, cus = 0, per_cu = 0;
    (void)hipGetDevice(&dev);
    (void)hipDeviceGetAttribute(&cus, hipDeviceAttributeMultiprocessorCount, dev);
    (void)hipOccupancyMaxActiveBlocksPerMultiprocessor(&per_cu, mega_kernel, 512, DYN_LDS);
    grid_blocks = (per_cu >= 1 && cus >= 256) ? 256 : cus * per_cu;
    if (grid_blocks <= 0) { fprintf(stderr, "kernel_launch: occupancy query gave cus %d per_cu %d\n", cus, per_cu); grid_blocks = 0; return; }
  }
  (void)hipMemsetAsync(p.bar, 0, 65536, stream);
  void* args[] = {&p};
  const hipError_t e = hipLaunchCooperativeKernel((void*)mega_kernel, dim3(grid_blocks), dim3(512), args, DYN_LDS, stream);
  if (e != hipSuccess) fprintf(stderr, "cooperative launch failed: %s (grid %d)\n", hipGetErrorString(e), grid_blocks);
}
```

```cpp
#define USE_CG_SYNC 0
#include <hip/hip_runtime.h>
#include <hip/hip_bf16.h>
#include <hip/hip_cooperative_groups.h>
#include <cstdio>
#include <cstdint>
namespace cg = cooperative_groups;

typedef unsigned short bfr;
using bf16x8 = __attribute__((ext_vector_type(8))) short;
using s16x4  = __attribute__((ext_vector_type(4))) short;
using f32x4  = __attribute__((ext_vector_type(4))) float;
using f32x16 = __attribute__((ext_vector_type(16))) float;
using u32x4  = __attribute__((ext_vector_type(4))) unsigned;
using u32x2  = __attribute__((ext_vector_type(2))) unsigned;

extern __shared__ __attribute__((aligned(16))) char smem[];
__device__ __forceinline__ char* smem_base() { return smem; }
constexpr int DM = 1024, NTOK = 6144, NCTX = 4096, DEPTH = 4;
constexpr int NIN = 11808;
constexpr int NP = 11776;
constexpr int NPAD = 12032;
constexpr int HID = 4096;
constexpr float EPS = 1e-6f;
constexpr int C_DQ = 0, C_DK = 1024, C_DV = 2048, C_DG = 3072, C_SB = 4096, C_SCG = 5120, C_SX = 6144,
              C_AQ = 7168, C_AK = 8192, C_AV = 8448, C_MG = 8704;

constexpr int REC_U = 0, REC_W = 16384, REC_QD = 32768, REC_QK = 49152, REC_KD = 57344, REC_BYTES = 73728;

struct Params {
  const float *x_prompt, *x_sample, *cache_k, *cache_v, *state_dn, *c, *c_ctx, *w_mod, *b_mod;
  const float *g_pre_mix, *g_post_mix, *g_pre_mlp, *g_post_mlp, *w_in, *w_conv_dn, *a_log, *dt_bias, *g_dn_out;
  const float *w_conv_sc, *g_q, *g_k, *w_br_dn, *w_br_sc, *w_br_att, *w_out, *w_mlp_up, *w_mlp_down;
  float *xbuf;
  float *out_ck, *out_cv, *out_state;
  bfr *wt_in, *wt_br, *wt_out, *wt_up, *wt_dn;
  float *mod;
  bfr *h;
  bfr *P;
  float *small;
  char *dnrec;
  float *glast;
  bfr *opart;
  bfr *obr;
  bfr *Q;
  bfr *Kc, *Vc;
  bfr *Ks, *Vs;
  bfr *merged;
  bfr *a3;
  float *R;
  bfr *u2;
  unsigned *bar;
};

__device__ __forceinline__ bfr f2bf(float f) { unsigned u = __float_as_uint(f); u += 0x7fffu + ((u >> 16) & 1u); return (bfr)(u >> 16); }
__device__ __forceinline__ float bf2f(bfr b) { return __uint_as_float(((unsigned)b) << 16); }
__device__ __forceinline__ unsigned pack2(float a, float b) { return (unsigned)f2bf(a) | ((unsigned)f2bf(b) << 16); }
__device__ __forceinline__ unsigned pack2hw(float a, float b) { unsigned r; asm("v_cvt_pk_bf16_f32 %0, %1, %2" : "=v"(r) : "v"(a), "v"(b)); return r; }
__device__ __forceinline__ float sigmoidf_(float x) { return 1.f / (1.f + __expf(-x)); }
__device__ __forceinline__ float siluf_(float x) { return x * __builtin_amdgcn_rcpf(1.f + __expf(-x)); }
__device__ __forceinline__ float softplusf_(float x) { return x > 20.f ? x : log1pf(__expf(x)); }

__device__ __forceinline__ int tok_modrow(int t) { return t < NCTX ? 0 : 1 + ((t - NCTX) >> 10); }
__device__ __forceinline__ int tok_L(int t) { return t < NCTX ? 256 : 1024; }
__device__ __forceinline__ int tok_pos(int t) { return t < NCTX ? (t & 255) : ((t - NCTX) & 1023); }

__host__ __device__ __forceinline__ int perm_col(int n) { return n < 4096 ? n : (n < 4128 ? NP + (n - 4096) : n - 32); }

__device__ __forceinline__ int tid_opaque() { int t = threadIdx.x; asm volatile("" : "+v"(t)); return t; }

#ifdef DIAG_A
#ifndef DIAG_BLK
#define DIAG_BLK 0
#endif
#define TSTAMP(k) do { if (blockIdx.x == DIAG_BLK && threadIdx.x == 0) { unsigned long long* ts_ = (unsigned long long*)(smem_base() + 163840 - 256); if (ts_[(k)] == 0ull) ts_[(k)] = wall_clock64(); } } while (0)
#else
#define TSTAMP(k) do {} while (0)
#endif

#ifdef DIAG_A
#define GSTAMP(bar, k) do { if (threadIdx.x == 0) __hip_atomic_store((unsigned long long*)((bar) + 12288) + (k), (unsigned long long)wall_clock64(), __ATOMIC_RELAXED, __HIP_MEMORY_SCOPE_AGENT); } while (0)
#else
#define GSTAMP(bar, k) do {} while (0)
#endif

#ifdef DIAG_G
#define GMAX(bar, k) do { if (threadIdx.x == 0) __hip_atomic_fetch_max((unsigned long long*)((bar) + 12288) + (k), (unsigned long long)wall_clock64(), __ATOMIC_RELAXED, __HIP_MEMORY_SCOPE_AGENT); } while (0)
#else
#define GMAX(bar, k) do {} while (0)
#endif
#define NTHR 512

__device__ __forceinline__ void stage_mod(const Params& p, int bid, int nblk, char* lds) {
  float* s = (float*)lds;
  float* red = s + 3072;
  const int tid = tid_opaque();
  for (int i = tid; i < 3072; i += NTHR) { int j = i >> 10, k = i & 1023; float c = (j == 0) ? p.c_ctx[k] : p.c[(j - 1) * 1024 + k]; s[i] = siluf_(c); }
  __syncthreads();
  for (int item = bid; item < 192; item += nblk) {
    const int l = item / 48, nb = item % 48, cq = tid & 31, ks = tid >> 5;
    const float* W = p.w_mod + ((size_t)l * 1024 + ks * 64) * 6144 + nb * 128 + cq * 4;
    float a[3][4] = {};
    for (int k = 0; k < 64; ++k) {
      const float4 w = *(const float4*)(W + (size_t)k * 6144);
#pragma unroll
      for (int j = 0; j < 3; ++j) { const float sv = s[j * 1024 + ks * 64 + k]; a[j][0] += sv * w.x; a[j][1] += sv * w.y; a[j][2] += sv * w.z; a[j][3] += sv * w.w; }
    }
    __syncthreads();
#pragma unroll
    for (int j = 0; j < 3; ++j)
#pragma unroll
      for (int q = 0; q < 4; ++q) red[(ks * 3 + j) * 128 + cq * 4 + q] = a[j][q];
    __syncthreads();
    if (tid < 384) { const int j = tid >> 7, n = tid & 127; float sum = 0; for (int q = 0; q < 16; ++q) sum += red[(q * 3 + j) * 128 + n];
      p.mod[(size_t)(l * 3 + j) * 6144 + nb * 128 + n] = sum + p.b_mod[l * 6144 + nb * 128 + n]; }
  }
  __syncthreads();
}

__device__ __forceinline__ float wave_sum(float v) {
#pragma unroll
  for (int o = 32; o > 0; o >>= 1) v += __shfl_xor(v, o);
  return v;
}

template <int NR>
__device__ __forceinline__ void rows_at(const Params& p, int l, int mode, int row0, int lane) {
  float4 x[NR][4], r[NR][4];
#pragma unroll
  for (int j = 0; j < NR; ++j) {
    const int row = row0 + j;
    if (l == 0 && mode <= 1) {
      const float* xin = row < NCTX ? p.x_prompt + (size_t)row * DM : p.x_sample + (size_t)(row - NCTX) * DM;
#pragma unroll
      for (int i = 0; i < 4; ++i) x[j][i] = *(const float4*)(xin + lane * 4 + 256 * i);
    } else {
      const bfr* xin = p.merged + (size_t)row * DM;
#pragma unroll
      for (int i = 0; i < 4; ++i) { const u32x2 a = *(const u32x2*)(xin + lane * 4 + 256 * i);
        x[j][i] = make_float4(__uint_as_float(a[0] << 16), __uint_as_float(a[0] & 0xffff0000u), __uint_as_float(a[1] << 16), __uint_as_float(a[1] & 0xffff0000u)); }
    }
    if (mode != 0) {
      const bfr* rr = (const bfr*)p.R + (size_t)row * DM;
#pragma unroll
      for (int i = 0; i < 4; ++i) { const u32x2 a = *(const u32x2*)(rr + lane * 4 + 256 * i), b = *(const u32x2*)(rr + (size_t)NTOK * DM + lane * 4 + 256 * i);
        r[j][i] = make_float4(__uint_as_float(a[0] << 16) + __uint_as_float(b[0] << 16), __uint_as_float(a[0] & 0xffff0000u) + __uint_as_float(b[0] & 0xffff0000u),
                              __uint_as_float(a[1] << 16) + __uint_as_float(b[1] << 16), __uint_as_float(a[1] & 0xffff0000u) + __uint_as_float(b[1] & 0xffff0000u)); }
    }
  }
  if (mode != 0) {
    const float* gpost = (mode == 1 ? p.g_post_mix : p.g_post_mlp) + l * DM;
    float4 g[4];
#pragma unroll
    for (int i = 0; i < 4; ++i) g[i] = *(const float4*)(gpost + lane * 4 + 256 * i);
#pragma unroll
    for (int j = 0; j < NR; ++j) {
      const int row = row0 + j;
      const float* gate = p.mod + (size_t)(l * 3 + tok_modrow(row)) * 6144 + (mode == 1 ? 2048 : 5120);
      float ss = 0;
#pragma unroll
      for (int i = 0; i < 4; ++i) ss += r[j][i].x * r[j][i].x + r[j][i].y * r[j][i].y + r[j][i].z * r[j][i].z + r[j][i].w * r[j][i].w;
      ss = wave_sum(ss);
      const float nrm = rsqrtf(ss * (1.f / DM) + EPS);
#pragma unroll
      for (int i = 0; i < 4; ++i) {
        const float4 gt = *(const float4*)(gate + lane * 4 + 256 * i);
        x[j][i].x += gt.x * (r[j][i].x * nrm * g[i].x); x[j][i].y += gt.y * (r[j][i].y * nrm * g[i].y); x[j][i].z += gt.z * (r[j][i].z * nrm * g[i].z); x[j][i].w += gt.w * (r[j][i].w * nrm * g[i].w);
        if (mode == 2 && l == DEPTH - 1) *(float4*)(p.xbuf + (size_t)row * DM + lane * 4 + 256 * i) = x[j][i];
        else { u32x2 o = {pack2hw(x[j][i].x, x[j][i].y), pack2hw(x[j][i].z, x[j][i].w)}; *(u32x2*)(p.merged + (size_t)row * DM + lane * 4 + 256 * i) = o; }
      }
    }
  }
  if (mode == 2 && l == DEPTH - 1) return;
  const int ln = (mode == 2) ? l + 1 : l;
  const float* gpre = (mode == 1 ? p.g_pre_mlp : p.g_pre_mix) + ln * DM;
  float4 gp[4];
#pragma unroll
  for (int i = 0; i < 4; ++i) gp[i] = *(const float4*)(gpre + lane * 4 + 256 * i);
#pragma unroll
  for (int j = 0; j < NR; ++j) {
    const int row = row0 + j;
    const float* modn = p.mod + (size_t)(ln * 3 + tok_modrow(row)) * 6144;
    const float* sh = modn + (mode == 1 ? 3072 : 0);
    const float* sc = modn + (mode == 1 ? 4096 : 1024);
    float ss = 0;
#pragma unroll
    for (int i = 0; i < 4; ++i) ss += x[j][i].x * x[j][i].x + x[j][i].y * x[j][i].y + x[j][i].z * x[j][i].z + x[j][i].w * x[j][i].w;
    ss = wave_sum(ss);
    const float nrm = rsqrtf(ss * (1.f / DM) + EPS);
#pragma unroll
    for (int i = 0; i < 4; ++i) {
      const float4 s1 = *(const float4*)(sc + lane * 4 + 256 * i), s0 = *(const float4*)(sh + lane * 4 + 256 * i);
      const float h0 = x[j][i].x * nrm * gp[i].x * (1.f + s1.x) + s0.x, h1 = x[j][i].y * nrm * gp[i].y * (1.f + s1.y) + s0.y;
      const float h2 = x[j][i].z * nrm * gp[i].z * (1.f + s1.z) + s0.z, h3 = x[j][i].w * nrm * gp[i].w * (1.f + s1.w) + s0.w;
      u32x2 o = {pack2hw(h0, h1), pack2hw(h2, h3)};
      *(u32x2*)(p.h + (size_t)row * DM + lane * 4 + 256 * i) = o;
    }
  }
}

__device__ __forceinline__ void stage_row(const Params& p, int l, int mode, int bid, int nblk) {
  const int tx_ = tid_opaque(), wid = tx_ >> 6, lane = tx_ & 63;
  const int row0 = (bid * 8 + wid) * 3;
  if (row0 >= NTOK) return;
  rows_at<3>(p, l, mode, row0, lane);
}

__device__ __forceinline__ void unpack8(const u32x4 v, float* f) {
#pragma unroll
  for (int i = 0; i < 4; ++i) { f[2 * i] = __uint_as_float(v[i] << 16); f[2 * i + 1] = __uint_as_float(v[i] & 0xffff0000u); }
}
__device__ __forceinline__ u32x4 pack8(const float* f) { u32x4 v = {pack2(f[0], f[1]), pack2(f[2], f[3]), pack2(f[4], f[5]), pack2(f[6], f[7])}; return v; }
__device__ __forceinline__ u32x4 pack8hw(const float* f) { u32x4 v = {pack2hw(f[0], f[1]), pack2hw(f[2], f[3]), pack2hw(f[4], f[5]), pack2hw(f[6], f[7])}; return v; }

__device__ __forceinline__ void light_prep_item(const Params& p, int l, int item) {
  const int tid = tid_opaque(), t0 = item * 16;
  const bool samp = t0 >= NCTX;
  {
    const float* wsc = p.w_conv_sc + (size_t)l * 3 * DM;
    bfr* scin = p.obr + (size_t)1 * NTOK * DM;
    const int g = tid & 127, rq = tid >> 7, r0 = rq * 4, tA = t0 + r0, posA = tok_pos(tA), L = tok_L(tA);
    u32x4 cg[6], cx[6], sbv[4];
#pragma unroll
    for (int k = 0; k < 6; ++k) {
      const int pos = posA + k - 1;
      cg[k] = u32x4{0u, 0u, 0u, 0u}; cx[k] = u32x4{0u, 0u, 0u, 0u};
      if (pos >= 0 && pos < L) { const bfr* row = p.P + (size_t)(tA + k - 1) * NP; cg[k] = *(const u32x4*)(row + C_SCG + g * 8); cx[k] = *(const u32x4*)(row + C_SX + g * 8); }
    }
#pragma unroll
    for (int r = 0; r < 4; ++r) sbv[r] = *(const u32x4*)(p.P + (size_t)(tA + r) * NP + C_SB + g * 8);
    float w[3][8];
#pragma unroll
    for (int k = 0; k < 3; ++k) { *(float4*)&w[k][0] = *(const float4*)(wsc + k * DM + g * 8); *(float4*)&w[k][4] = *(const float4*)(wsc + k * DM + g * 8 + 4); }
    float prod[6][8];
#pragma unroll
    for (int k = 0; k < 6; ++k) { float a[8], b[8]; unpack8(cg[k], a); unpack8(cx[k], b);
#pragma unroll
      for (int q = 0; q < 8; ++q) prod[k][q] = a[q] * b[q]; }
#pragma unroll
    for (int r = 0; r < 4; ++r) {
      float sb[8], acc[8]; unpack8(sbv[r], sb);
#pragma unroll
      for (int q = 0; q < 8; ++q) acc[q] = sb[q] * (w[0][q] * prod[r][q] + w[1][q] * prod[r + 1][q] + w[2][q] * prod[r + 2][q]);
      *(u32x4*)(scin + (size_t)(tA + r) * DM + g * 8) = pack8hw(acc);
    }
  }
  {
    const int sub = tid & 15;
    u32x4 xin[5];
#pragma unroll
    for (int it5 = 0; it5 < 5; ++it5) {
      const int pr = (tid >> 4) + it5 * 32, r = pr / 10, hh = pr % 10, t = t0 + r;
      xin[it5] = *(const u32x4*)(p.P + (size_t)t * NP + (hh < 8 ? C_AQ + hh * 128 : C_AK + (hh - 8) * 128) + sub * 8);
    }
#pragma unroll
    for (int it5 = 0; it5 < 5; ++it5) {
      const int pr = (tid >> 4) + it5 * 32;
      const int r = pr / 10, hh = pr % 10, t = t0 + r;
      const bool isq = hh < 8;
      float x[8]; unpack8(xin[it5], x);
      float ss = 0;
#pragma unroll
      for (int q = 0; q < 8; ++q) ss += x[q] * x[q];
      ss += __shfl_xor(ss, 1); ss += __shfl_xor(ss, 2); ss += __shfl_xor(ss, 4); ss += __shfl_xor(ss, 8);
      const float nrm = rsqrtf(ss * (1.f / 128.f) + EPS);
      const float* g = (isq ? p.g_q : p.g_k) + l * 128 + sub * 8;
#pragma unroll
      for (int q = 0; q < 8; ++q) x[q] = x[q] * nrm * g[q];
      if (samp) {
        const int pos = tok_pos(t);
        const float pidx = (sub < 8) ? (float)(pos >> 6) : (float)(pos & 63);
        const int s8 = sub & 7;
        const bool lo = s8 < 4;
        float y[8];
#pragma unroll
        for (int q = 0; q < 8; ++q) {
          const float other = __shfl_xor(x[q], 4);
          const int fi = (s8 & 3) * 8 + q;
          const float freq = exp2f(-(float)fi * (13.287712379549449f / 32.f));
          const float ang = pidx * freq;
          float sn, cs; __sincosf(ang, &sn, &cs);
          y[q] = lo ? (x[q] * cs - other * sn) : (other * sn + x[q] * cs);
        }
#pragma unroll
        for (int q = 0; q < 8; ++q) x[q] = y[q];
      }
      if (isq) {
        *(u32x4*)(p.Q + (size_t)t * DM + hh * 128 + sub * 8) = pack8hw(x);
      } else {
        const int kvh = hh - 8;
        if (!samp) {
          *(u32x4*)(p.Kc + (size_t)t * 256 + kvh * 128 + sub * 8) = pack8hw(x);
          const int b = t >> 8, pos = t & 255;
          float* o = p.out_ck + ((((size_t)b * DEPTH + l) * 256 + pos) * 2 + kvh) * 128 + sub * 8;
          *(float4*)o = make_float4(x[0], x[1], x[2], x[3]); *(float4*)(o + 4) = make_float4(x[4], x[5], x[6], x[7]);
        } else {
          const int s = t - NCTX, b = s >> 10, pos = s & 1023;
          *(u32x4*)(p.Ks + ((size_t)b * 1280 + 256 + pos) * 256 + kvh * 128 + sub * 8) = pack8hw(x);
        }
      }
    }
  }
  for (int idx = tid; idx < 16 * 32; idx += NTHR) {
    const int r = idx >> 5, g = idx & 31, t = t0 + r;
    const u32x4 v = *(const u32x4*)(p.P + (size_t)t * NP + C_AV + g * 8);
    if (!samp) {
      *(u32x4*)(p.Vc + (size_t)t * 256 + g * 8) = v;
      float f[8]; unpack8(v, f);
      const int b = t >> 8, pos = t & 255;
      float* o = p.out_cv + (((size_t)b * DEPTH + l) * 256 + pos) * 256 + g * 8;
      *(float4*)o = make_float4(f[0], f[1], f[2], f[3]); *(float4*)(o + 4) = make_float4(f[4], f[5], f[6], f[7]);
    } else {
      const int s = t - NCTX, b = s >> 10, pos = s & 1023;
      *(u32x4*)(p.Vs + ((size_t)b * 1280 + 256 + pos) * 256 + g * 8) = v;
    }
  }
  if (samp) {
    const int cs = item - 256, b = cs >> 6, pos0 = (cs & 63) * 4;
    for (int idx = tid; idx < 2 * 4 * 32; idx += NTHR) {
      const int which = idx >> 7, r = (idx >> 5) & 3, g = idx & 31, pos = pos0 + r;
      const float* src = (which ? p.cache_v : p.cache_k) + (((size_t)b * DEPTH + l) * 256 + pos) * 256 + g * 8;
      float f[8]; *(float4*)f = *(const float4*)src; *(float4*)(f + 4) = *(const float4*)(src + 4);
      *(u32x4*)((which ? p.Vs : p.Ks) + ((size_t)b * 1280 + pos) * 256 + g * 8) = pack8hw(f);
    }
  }
}

__device__ __forceinline__ void dn_finalize(const Params& p, int l, int t0, int n, int h, int tid0, int nthr) {
  const int sub = tid0 & 15, rpp = nthr / 16;
  const float* g = p.g_dn_out + l * 128 + sub * 8;
  float gv[8];
#pragma unroll
  for (int q = 0; q < 8; ++q) gv[q] = g[q];
  for (int r = tid0 >> 4; r < n; r += rpp * 4) {
    u32x4 va[4], vb[4], vg[4];
#pragma unroll
    for (int u = 0; u < 4; ++u) {
      const int t = t0 + r + u * rpp;
      va[u] = *(const u32x4*)(p.opart + (size_t)t * DM + h * 128 + sub * 8);
      vb[u] = *(const u32x4*)(p.opart + (size_t)NTOK * DM + (size_t)t * DM + h * 128 + sub * 8);
      vg[u] = *(const u32x4*)(p.P + (size_t)t * NP + C_DG + h * 128 + sub * 8);
    }
#pragma unroll
    for (int u = 0; u < 4; ++u) {
      const int t = t0 + r + u * rpp;
      float a[8], b[8], dg[8];
      unpack8(va[u], a); unpack8(vb[u], b); unpack8(vg[u], dg);
      float ss = 0;
#pragma unroll
      for (int q = 0; q < 8; ++q) { a[q] += b[q]; ss += a[q] * a[q]; }
      ss += __shfl_xor(ss, 1); ss += __shfl_xor(ss, 2); ss += __shfl_xor(ss, 4); ss += __shfl_xor(ss, 8);
      const float nrm = rsqrtf(ss * (1.f / 128.f) + EPS);
#pragma unroll
      for (int q = 0; q < 8; ++q) a[q] = a[q] * nrm * gv[q] * siluf_(dg[q]);
      *(u32x4*)(p.obr + (size_t)t * DM + h * 128 + sub * 8) = pack8hw(a);
    }
  }
}
constexpr int HT_BYTES = 128 * 64 * 2;

__device__ __forceinline__ int lds_byte(int r, int c) {
  int st = (r >> 4) * 2 + (c >> 5), rr = r & 15, cc = c & 31, ob = rr * 64 + cc * 2;
  return st * 1024 + (ob ^ (((ob >> 9) & 1) << 5));
}
__device__ __forceinline__ void stage_rc(int b, int& R, int& C) {
  int st = b / 1024, sb = b % 1024, swz = sb ^ (((sb >> 9) & 1) << 5);
  R = (st >> 1) * 16 + swz / 64; C = (st & 1) * 32 + (swz % 64) / 2;
}
__device__ __forceinline__ void stage_half(const bfr* G, long ld, int row0, int k0, int loff, int tx) {
#pragma unroll
  for (int i = 0; i < 2; ++i) {
    const int b = tx * 16 + i * 8192; int r, c; stage_rc(b, r, c);
    __builtin_amdgcn_global_load_lds((const unsigned*)(G + (long)(row0 + r) * ld + k0 + c), (__attribute__((address_space(3))) unsigned*)(smem + loff + b), 16, 0, 0);
  }
}

template <int NB, class AccT>
__device__ __forceinline__ void gemm_mainloop(const bfr* A, long lda, const bfr* Bt, long ldb, int K, int brow, int bcol, AccT& acc, int tx) {
  const int wid = tx >> 6, lane = tx & 63, wr = wid >> 2, wc = wid & 3, fr = lane & 15, fq = lane >> 4;
  constexpr int STG = (2 + NB) * HT_BYTES;
  const int nt = K / 64;
  auto stage = [&](int s, int kt) {
    stage_half(A, lda, brow, kt * 64, s * STG, tx);
    stage_half(A, lda, brow + 128, kt * 64, s * STG + HT_BYTES, tx);
#pragma unroll
    for (int j = 0; j < NB; ++j) stage_half(Bt, ldb, bcol + j * 128, kt * 64, s * STG + (2 + j) * HT_BYTES, tx);
  };
  stage(0, 0);
  asm volatile("s_waitcnt vmcnt(0)" ::: "memory");
  __syncthreads();
  for (int t = 0; t < nt; ++t) {
    const int s = t & 1;
    if (t + 1 < nt) stage(s ^ 1, t + 1);
    const char* base = smem + s * STG;
    bf16x8 Bf[NB][2][2];
#pragma unroll
    for (int j = 0; j < NB; ++j)
#pragma unroll
      for (int n = 0; n < 2; ++n)
#pragma unroll
        for (int k = 0; k < 2; ++k) Bf[j][n][k] = *(const bf16x8*)(base + (2 + j) * HT_BYTES + lds_byte(wc * 32 + n * 16 + fr, k * 32 + fq * 8));
#pragma unroll
    for (int ai = 0; ai < 2; ++ai) {
      bf16x8 Af[4][2];
#pragma unroll
      for (int m = 0; m < 4; ++m)
#pragma unroll
        for (int k = 0; k < 2; ++k) Af[m][k] = *(const bf16x8*)(base + ai * HT_BYTES + lds_byte(wr * 64 + m * 16 + fr, k * 32 + fq * 8));
#pragma unroll
      for (int j = 0; j < NB; ++j)
#pragma unroll
        for (int m = 0; m < 4; ++m)
#pragma unroll
          for (int n = 0; n < 2; ++n)
#pragma unroll
            for (int k = 0; k < 2; ++k) acc.a[ai][j][m][n] = __builtin_amdgcn_mfma_f32_16x16x32_bf16(Af[m][k], Bf[j][n][k], acc.a[ai][j][m][n], 0, 0, 0);
    }
    asm volatile("s_waitcnt vmcnt(0)" ::: "memory");
    __syncthreads();
  }
}
template <int NB> struct Acc { f32x4 a[2][NB][4][2]; };
template <int NB> __device__ __forceinline__ void acc_zero(Acc<NB>& acc) {
#pragma unroll
  for (int ai = 0; ai < 2; ++ai)
#pragma unroll
    for (int j = 0; j < NB; ++j)
#pragma unroll
      for (int m = 0; m < 4; ++m)
#pragma unroll
        for (int n = 0; n < 2; ++n) acc.a[ai][j][m][n] = f32x4{0.f, 0.f, 0.f, 0.f};
}
template <int NB, class F> __device__ __forceinline__ void acc_foreach(Acc<NB>& acc, int brow, int bcol, int tx, F f) {
  const int wid = tx >> 6, lane = tx & 63, wr = wid >> 2, wc = wid & 3, fr = lane & 15, fq = lane >> 4;
#pragma unroll
  for (int ai = 0; ai < 2; ++ai)
#pragma unroll
    for (int j = 0; j < NB; ++j)
#pragma unroll
      for (int m = 0; m < 4; ++m)
#pragma unroll
        for (int n = 0; n < 2; ++n)
#pragma unroll
          for (int q = 0; q < 4; ++q) f(brow + ai * 128 + wr * 64 + m * 16 + fq * 4 + q, bcol + j * 128 + wc * 32 + n * 16 + fr, acc.a[ai][j][m][n][q]);
}

template <class MapF>
__device__ __forceinline__ void convert_tile(const float* W, int N, int kt, int ntile, bfr* dst, int ldd, MapF mapf, int ncopy = 1, int cstride = 0) {
  float* tile = (float*)smem;
  const int tid = tid_opaque();
  __syncthreads();
  float4 v[8];
#pragma unroll
  for (int pass = 0; pass < 8; ++pass) {
    const int idx = tid + pass * 512, kr = idx >> 6, c4 = idx & 63, n = ntile * 256 + c4 * 4;
    v[pass] = make_float4(0.f, 0.f, 0.f, 0.f);
    if (n < N) v[pass] = *(const float4*)(W + (size_t)(kt * 64 + kr) * N + n);
  }
#pragma unroll
  for (int pass = 0; pass < 8; ++pass) {
    const int idx = tid + pass * 512, kr = idx >> 6, c4 = idx & 63;
    tile[kr * 257 + c4 * 4 + 0] = v[pass].x; tile[kr * 257 + c4 * 4 + 1] = v[pass].y; tile[kr * 257 + c4 * 4 + 2] = v[pass].z; tile[kr * 257 + c4 * 4 + 3] = v[pass].w;
  }
  __syncthreads();
#pragma unroll
  for (int rep = 0; rep < 4; ++rep) {
    const int nn = (tid >> 3) + rep * 64, kg = tid & 7, n = ntile * 256 + nn;
    if (n < N) {
      float f[8];
#pragma unroll
      for (int j = 0; j < 8; ++j) f[j] = tile[(kg * 8 + j) * 257 + nn];
      const u32x4 pk = pack8hw(f);
      for (int cp = 0; cp < ncopy; ++cp) *(u32x4*)(dst + (size_t)mapf(n) * ldd + cp * cstride + kt * 64 + kg * 8) = pk;
    }
  }
}
constexpr int CONV_ITEMS = 1576;
__device__ __forceinline__ void convert_item(const Params& p, int l, int it) {
  if (it < 752) { const int kt = it / 47, nt = it % 47; convert_tile(p.w_in + (size_t)l * DM * NIN, NIN, kt, nt, p.wt_in + (size_t)l * NPAD * DM, DM, [](int n) { return perm_col(n); }); }
  else if (it < 944) { const int j = it - 752, br = j >> 6, kt = (j >> 2) & 15, nt = j & 3;
    const float* W = p.w_br_dn; if (br == 1) W = p.w_br_sc; if (br == 2) W = p.w_br_att; W += (size_t)l * DM * DM;
    convert_tile(W, DM, kt, nt, p.wt_br + ((size_t)l * 3 + br) * DM * DM, DM, [](int n) { return n; }); }
  else if (it < 1008) { const int j = it - 944, kt = j >> 2, nt = j & 3; convert_tile(p.w_out + (size_t)l * DM * DM, DM, kt, nt, p.wt_out + (size_t)l * DM * 3072, 3072, [](int n) { return n; }, 3, 1024); }
  else if (it < 1264) { const int j = it - 1008, kt = j >> 4, nt = j & 15; convert_tile(p.w_mlp_up + (size_t)l * DM * HID, HID, kt, nt, p.wt_up + (size_t)l * HID * DM, DM, [](int n) { return n; }); }
  else if (it < 1520) { const int j = it - 1264, kt = j >> 2, nt = j & 3; convert_tile(p.w_mlp_down + (size_t)l * HID * DM, DM, kt, nt, p.wt_dn + (size_t)l * DM * HID, HID, [](int n) { return n; }); }
  else { const int j = it - 1520;
    bfr* d = p.wt_in + ((size_t)l * NPAD + NP + 32 + j * 4) * DM;
    *(u32x4*)(d + tid_opaque() * 8) = u32x4{0u, 0u, 0u, 0u}; }
}

__device__ __forceinline__ void gemm_in_tile(const Params& p, int l, int tile) {
  const int mt = tile % 24, nt = tile / 24, brow = mt * 256, bcol = nt * 256;
  const int tx = tid_opaque(); Acc<2> acc; acc_zero(acc);
  gemm_mainloop<2>(p.h, DM, p.wt_in + (size_t)l * NPAD * DM, DM, DM, brow, bcol, acc, tx);
  if (nt < 34) acc_foreach(acc, brow, bcol, tx, [&](int r, int c, float v) { p.P[(size_t)r * NP + c] = f2bf(v); });
  else if (nt < 46) acc_foreach(acc, brow, bcol, tx, [&](int r, int c, float v) { p.P[(size_t)r * NP + c] = f2bf(sigmoidf_(v)); });
  else acc_foreach(acc, brow, bcol, tx, [&](int r, int c, float v) { if (c < NP + 32) p.small[(size_t)r * 32 + (c - NP)] = v; });
}
__device__ __forceinline__ void gemm_up_tile(const Params& p, int l, int tile) {
  const int mt = tile % 24, nt = tile / 24, brow = mt * 256, bcol = nt * 256;
  const int tx = tid_opaque(); Acc<2> acc; acc_zero(acc);
  gemm_mainloop<2>(p.h, DM, p.wt_up + (size_t)l * HID * DM, DM, DM, brow, bcol, acc, tx);
  acc_foreach(acc, brow, bcol, tx, [&](int r, int c, float v) { const float x = fmaxf(v, 0.f); p.u2[(size_t)r * HID + c] = f2bf(x * x); });
}
__device__ __forceinline__ void gemm_out_tile(const Params& p, int l, int tile) {
  const int mt = tile % 24, nt = tile / 24, brow = mt * 256, bcol = nt * 128;
  const int tx = tid_opaque(); Acc<1> acc; acc_zero(acc);
  gemm_mainloop<1>(p.merged, DM, p.wt_out + (size_t)l * DM * DM, DM, DM, brow, bcol, acc, tx);
  acc_foreach(acc, brow, bcol, tx, [&](int r, int c, float v) { p.R[(size_t)r * DM + c] = v; });
}
__device__ __forceinline__ void gemm_down_tile(const Params& p, int l, int tile) {
  const int mt = tile % 24, nt = tile / 24, brow = mt * 256, bcol = nt * 128;
  const int tx = tid_opaque(); Acc<1> acc; acc_zero(acc);
  gemm_mainloop<1>(p.u2, HID, p.wt_dn + (size_t)l * DM * HID, HID, HID, brow, bcol, acc, tx);
  acc_foreach(acc, brow, bcol, tx, [&](int r, int c, float v) { p.R[(size_t)r * DM + c] = v; });
}
__device__ __forceinline__ void gemm_br_tile(const Params& p, int l, int tile) {
  const int mt = tile % 24, nt = tile / 24, brow = mt * 256, bcol = nt * 128;
  const int tx = tid_opaque(); Acc<1> tot; acc_zero(tot);
#pragma unroll 1
  for (int br = 0; br < 3; ++br) {
    Acc<1> acc; acc_zero(acc);
    gemm_mainloop<1>(p.obr + (size_t)br * NTOK * DM, DM, p.wt_br + ((size_t)l * 3 + br) * DM * DM, DM, DM, brow, bcol, acc, tx);
    const bfr* G = p.P + C_MG + br * DM;
    const int wid = tx >> 6, lane = tx & 63, wr = wid >> 2, wc = wid & 3, fr = lane & 15, fq = lane >> 4;
    const bfr* Gl = G + (size_t)(brow + wr * 64 + fq * 4) * NP + bcol + wc * 32 + fr;
#pragma unroll
    for (int ai = 0; ai < 2; ++ai)
#pragma unroll
      for (int m = 0; m < 4; ++m) {
        const bfr* Gm = Gl + (size_t)(ai * 128 + m * 16) * NP;
        asm volatile("" : "+v"(Gm) :: "memory");
#pragma unroll
        for (int n = 0; n < 2; ++n)
#pragma unroll
          for (int q = 0; q < 4; ++q) tot.a[ai][0][m][n][q] += bf2f(Gm[q * NP + n * 16]) * acc.a[ai][0][m][n][q];
      }
  }
  acc_foreach(tot, brow, bcol, tx, [&](int r, int c, float v) { p.merged[(size_t)r * DM + c] = f2bf(v); });
}
namespace pg8 {
#define PG8_LAS __attribute__((address_space(3)))
constexpr int BM = 256, BK = 64, HALF = 128, HTB = HALF * BK * 2, STAGE_BYTES = 8 * HTB;
__device__ __forceinline__ int perm32(int rho) { const int n = rho >> 4, i = rho & 15; return 8 * (i >> 2) + 4 * n + (i & 3); }
struct Unit { int pm, pn, z; size_t ka, kb; };
struct Gemm { const bfr* A; const bfr* Bt; int lda, ldb, K; };

template <class Epi, class Sched>
__device__ __forceinline__ void gemm_phase(const Gemm g, const Sched& S, const Epi& E) {
  PG8_LAS unsigned char* lds = (PG8_LAS unsigned char*)smem;
  const int tid = tid_opaque(), wid = __builtin_amdgcn_readfirstlane(tid >> 6), lane = tid & 63, wr = wid >> 2, wc = wid & 3, fr = lane & 15, fq = lane >> 4;
  const int K = g.K, nt = K / BK;
  unsigned voffA[2], voffB[2];
#pragma unroll
  for (int i = 0; i < 2; ++i) { int R, C; stage_rc(tid * 16 + i * 8192, R, C); const int Rb = Epi::PERM ? ((R & ~31) + perm32(R & 31)) : R;
    voffA[i] = (unsigned)(R * g.lda + C) * 2u; voffB[i] = (unsigned)(Rb * g.ldb + C) * 2u; }
  const size_t kstep = (size_t)(BK * 2);
  const size_t hstepA = (size_t)HALF * g.lda * 2, hstepB = (size_t)HALF * g.ldb * 2;
  const unsigned ldsw = (unsigned)wid * 1024u;
  const int aoff = lds_byte(wr * 64 + fr, fq * 8), boff = lds_byte(wc * 32 + fr, fq * 8);
#define PG8_SA(b, h) (((b) * 2 + (h)) * HTB)
#define PG8_SB(b, h) ((4 + (b) * 2 + (h)) * HTB)
#define PG8_STAGE(bufoff, gbase, voff) do { _Pragma("unroll") for (int _i = 0; _i < 2; ++_i) \
    __builtin_amdgcn_global_load_lds((const unsigned*)((const char*)(gbase) + (voff)[_i]), (PG8_LAS unsigned*)(lds + (bufoff) + ldsw + _i * 8192), 16, 0, 0); } while (0)
#define PG8_LDA(dst, b, h) do { _Pragma("unroll") for (int m = 0; m < 4; ++m) _Pragma("unroll") for (int k = 0; k < 2; ++k) dst[m][k] = *(const PG8_LAS bf16x8*)(lds + PG8_SA(b, h) + aoff + m * 2048 + k * 1024); } while (0)
#define PG8_LDB(dst, b, h) do { _Pragma("unroll") for (int n = 0; n < 2; ++n) _Pragma("unroll") for (int k = 0; k < 2; ++k) dst[n][k] = *(const PG8_LAS bf16x8*)(lds + PG8_SB(b, h) + boff + n * 2048 + k * 1024); } while (0)
#define PG8_MMA(ai, bj, At, Bt) do { __builtin_amdgcn_s_setprio(1); _Pragma("unroll") for (int m = 0; m < 4; ++m) _Pragma("unroll") for (int n = 0; n < 2; ++n) _Pragma("unroll") for (int k = 0; k < 2; ++k) \
    acc[ai][bj][m][n] = __builtin_amdgcn_mfma_f32_16x16x32_bf16(Bt[n][k], At[m][k], acc[ai][bj][m][n], 0, 0, 0); __builtin_amdgcn_s_setprio(0); } while (0)
#define PG8_WAIT_V(n) asm volatile("s_waitcnt vmcnt(" #n ")" ::: "memory")
#define PG8_WAIT_L(n) asm volatile("s_waitcnt lgkmcnt(" #n ")" ::: "memory")
#define PG8_BAR __builtin_amdgcn_s_barrier()
#define PG8_SCHED __builtin_amdgcn_sched_barrier(0)
  Unit cur, nxt; int ui = 0;
  __syncthreads();
  if (!S.next(0, cur)) return;
  f32x4 acc[2][2][4][2];
#pragma unroll
  for (int a = 0; a < 2; ++a)
#pragma unroll
    for (int b = 0; b < 2; ++b)
#pragma unroll
      for (int m = 0; m < 4; ++m)
#pragma unroll
        for (int n = 0; n < 2; ++n) acc[a][b][m][n] = (f32x4){0.f, 0.f, 0.f, 0.f};
  bf16x8 At[4][2], B0[2][2], B1[2][2];
  const char* cA = (const char*)(g.A + cur.ka) + (size_t)cur.pm * 2 * hstepA; const char* cB = (const char*)(g.Bt + cur.kb) + (size_t)cur.pn * 2 * hstepB;
  PG8_STAGE(PG8_SB(0, 0), cB, voffB); PG8_STAGE(PG8_SA(0, 0), cA, voffA); PG8_STAGE(PG8_SB(0, 1), cB + hstepB, voffB); PG8_STAGE(PG8_SA(0, 1), cA + hstepA, voffA);
  if (wr == 1) PG8_BAR;
  PG8_WAIT_V(4); PG8_BAR;
  PG8_STAGE(PG8_SB(1, 0), cB + kstep, voffB); PG8_STAGE(PG8_SA(1, 0), cA + kstep, voffA); PG8_STAGE(PG8_SB(1, 1), cB + hstepB + kstep, voffB);
  PG8_WAIT_V(6); PG8_BAR;
  for (;;) {
    const bool has_next = S.next(ui + 1, nxt);
    const char* nA = has_next ? (const char*)(g.A + nxt.ka) + (size_t)nxt.pm * 2 * hstepA : cA; const char* nB = has_next ? (const char*)(g.Bt + nxt.kb) + (size_t)nxt.pn * 2 * hstepB : cB;
    for (int t = 0; t < nt; t += 2) {
      const bool last = (t == nt - 2);
      const char* a1 = cA + (size_t)(t + 1) * kstep;
      const char* a2 = last ? nA : cA + (size_t)(t + 2) * kstep; const char* b2 = last ? nB : cB + (size_t)(t + 2) * kstep;
      const char* a3 = a2 + kstep; const char* b3 = b2 + kstep;
      PG8_LDB(B0, 0, 0); PG8_SCHED; PG8_LDA(At, 0, 0); PG8_STAGE(PG8_SA(1, 1), a1 + hstepA, voffA);
      PG8_WAIT_L(8); PG8_BAR; PG8_WAIT_L(0); PG8_MMA(0, 0, At, B0); PG8_BAR; PG8_SCHED;
      PG8_LDB(B1, 0, 1); PG8_STAGE(PG8_SB(0, 0), b2, voffB);
      PG8_BAR; PG8_WAIT_L(0); PG8_MMA(0, 1, At, B1); PG8_BAR;
      PG8_LDA(At, 0, 1); PG8_STAGE(PG8_SA(0, 0), a2, voffA);
      PG8_BAR; PG8_WAIT_L(0); PG8_MMA(1, 0, At, B0); PG8_BAR; PG8_SCHED;
      PG8_STAGE(PG8_SB(0, 1), b2 + hstepB, voffB);
      PG8_WAIT_V(6); PG8_BAR; PG8_MMA(1, 1, At, B1); PG8_BAR;
      PG8_LDB(B0, 1, 0); PG8_SCHED; PG8_LDA(At, 1, 0); PG8_STAGE(PG8_SA(0, 1), a2 + hstepA, voffA);
      PG8_WAIT_L(8); PG8_BAR; PG8_WAIT_L(0); PG8_MMA(0, 0, At, B0); PG8_BAR; PG8_SCHED;
      PG8_LDB(B1, 1, 1); PG8_STAGE(PG8_SB(1, 0), b3, voffB);
      PG8_BAR; PG8_WAIT_L(0); PG8_MMA(0, 1, At, B1); PG8_BAR;
      PG8_LDA(At, 1, 1); PG8_STAGE(PG8_SA(1, 0), a3, voffA);
      PG8_BAR; PG8_WAIT_L(0); PG8_MMA(1, 0, At, B0); PG8_BAR; PG8_SCHED;
      PG8_STAGE(PG8_SB(1, 1), b3 + hstepB, voffB);
      PG8_WAIT_V(6); PG8_BAR; PG8_MMA(1, 1, At, B1); PG8_BAR;
    }
    E(acc, cur, wr, wc, fr, fq);
    if (!has_next) break;
#pragma unroll
    for (int a = 0; a < 2; ++a)
#pragma unroll
      for (int b = 0; b < 2; ++b)
#pragma unroll
        for (int m = 0; m < 4; ++m)
#pragma unroll
          for (int n = 0; n < 2; ++n) acc[a][b][m][n] = (f32x4){0.f, 0.f, 0.f, 0.f};
    cur = nxt; cA = nA; cB = nB; ++ui;
  }
  PG8_WAIT_V(0);
  if (wr == 0) PG8_BAR;
  PG8_BAR;
#undef PG8_SA
#undef PG8_SB
#undef PG8_STAGE
#undef PG8_LDA
#undef PG8_LDB
#undef PG8_MMA
#undef PG8_WAIT_V
#undef PG8_WAIT_L
#undef PG8_BAR
#undef PG8_SCHED
}
__device__ __forceinline__ unsigned cvt_pk_bf16(float lo, float hi) { unsigned r; asm volatile("v_cvt_pk_bf16_f32 %0, %1, %2" : "=v"(r) : "v"(lo), "v"(hi)); return r; }
__device__ __forceinline__ u32x4 pk8(const f32x4 v0, const f32x4 v1) { u32x4 w; w.x = cvt_pk_bf16(v0[0], v0[1]); w.y = cvt_pk_bf16(v0[2], v0[3]); w.z = cvt_pk_bf16(v1[0], v1[1]); w.w = cvt_pk_bf16(v1[2], v1[3]); return w; }

__device__ __forceinline__ unsigned cvt_pk_bf16_n(float lo, float hi) { unsigned r; asm volatile("s_nop 1\n\tv_cvt_pk_bf16_f32 %0, %1, %2" : "=v"(r) : "v"(lo), "v"(hi)); return r; }
__device__ __forceinline__ u32x4 pk8n(const f32x4 v0, const f32x4 v1) { u32x4 w; w.x = cvt_pk_bf16_n(v0[0], v0[1]); w.y = cvt_pk_bf16_n(v0[2], v0[3]); w.z = cvt_pk_bf16_n(v1[0], v1[1]); w.w = cvt_pk_bf16_n(v1[2], v1[3]); return w; }
__device__ __forceinline__ float sigmoid_fast(float x) { return __builtin_amdgcn_rcpf(1.f + __expf(-x)); }
struct SchedIn { int G, c; __device__ __forceinline__ bool next(int i, Unit& u) const { const int L = i * G + c; if (L >= 1024) return false; u.z = 0; u.ka = 0; u.kb = 0;
  if (L < 936) { const int j = L / 24; u.pm = L % 24; u.pn = j < 34 ? j : (j < 38 ? j + 4 : 46); }
  else { const int e = L - 936; if (e < 72) { u.pm = e % 24; u.pn = 34 + e / 24; } else { u.pm = e - 72; u.pn = 37; } }
  return true; } };
struct SchedUp { int G, c; __device__ __forceinline__ bool next(int i, Unit& u) const { const int L = i * G + c; if (L >= 24 * 16) return false; u.pm = L % 24; u.pn = L / 24; u.z = 0; u.ka = 0; u.kb = 0; return true; } };
struct SchedBr { int G, c; __device__ __forceinline__ bool next(int i, Unit& u) const { const int L = i * G + c; if (L >= 256) return false; if (L >= 192) { const int k = 32 + (L - 192); u.pm = k % 24; u.pn = k / 24; u.z = 1; u.ka = (size_t)NTOK * DM; u.kb = (size_t)DM * DM; return true; } const int r = L / 24; u.pm = L % 24; u.pn = r & 3; u.z = (r >> 2) * 2;
  u.ka = (size_t)u.z * NTOK * DM; u.kb = (size_t)u.z * DM * DM; return true; } };
struct SchedOne { Unit u0; __device__ __forceinline__ bool next(int i, Unit& u) const { if (i != 0) return false; u = u0; return true; } };
template <int KH> struct SchedSplit2 { int G, c; __device__ __forceinline__ bool next(int i, Unit& u) const { const int L = i * G + c; if (L >= 24 * 8) return false; const int r = L / 24; u.pm = L % 24; u.pn = r & 3; u.z = r >> 2;
  u.ka = (size_t)u.z * KH; u.kb = (size_t)u.z * KH; return true; } };

struct EpiIn { static constexpr bool PERM = true; bfr* P; float* small;
  __device__ __forceinline__ void operator()(const f32x4 (&acc)[2][2][4][2], const Unit& u, int wr, int wc, int fr, int fq) const {
    const int row0 = u.pm * BM + wr * 64 + fr, col0 = u.pn * BM + wc * 32 + 8 * fq;
    if (u.pn < 46) {
      const bool sg = u.pn >= 34;
#pragma unroll
      for (int ai = 0; ai < 2; ++ai)
#pragma unroll
        for (int m = 0; m < 4; ++m) { bfr* rowp = P + (size_t)(row0 + ai * HALF + m * 16) * NP + col0;
#pragma unroll
          for (int bj = 0; bj < 2; ++bj) { f32x4 v0 = acc[ai][bj][m][0], v1 = acc[ai][bj][m][1];
            if (sg) {
#pragma unroll
              for (int j = 0; j < 4; ++j) { v0[j] = sigmoid_fast(v0[j]); v1[j] = sigmoid_fast(v1[j]); }
              *(u32x4*)(rowp + bj * HALF) = pk8n(v0, v1);
            } else *(u32x4*)(rowp + bj * HALF) = pk8(v0, v1); } }
    } else if (wc == 0) {
#pragma unroll
      for (int ai = 0; ai < 2; ++ai)
#pragma unroll
        for (int m = 0; m < 4; ++m) { float* rowp = small + (size_t)(row0 + ai * HALF + m * 16) * 32 + 8 * fq;
          *(f32x4*)rowp = acc[ai][0][m][0]; *(f32x4*)(rowp + 4) = acc[ai][0][m][1]; }
    }
  }
};
struct EpiUp { static constexpr bool PERM = true; bfr* O;
  __device__ __forceinline__ void operator()(const f32x4 (&acc)[2][2][4][2], const Unit& u, int wr, int wc, int fr, int fq) const {
    const int row0 = u.pm * BM + wr * 64 + fr, col0 = u.pn * BM + wc * 32 + 8 * fq;
#pragma unroll
    for (int ai = 0; ai < 2; ++ai)
#pragma unroll
      for (int m = 0; m < 4; ++m) { bfr* rowp = O + (size_t)(row0 + ai * HALF + m * 16) * HID + col0;
#pragma unroll
        for (int bj = 0; bj < 2; ++bj) { f32x4 v0 = acc[ai][bj][m][0], v1 = acc[ai][bj][m][1];
#pragma unroll
          for (int j = 0; j < 4; ++j) { const float a = fmaxf(v0[j], 0.f), b = fmaxf(v1[j], 0.f); v0[j] = a * a; v1[j] = b * b; }
          *(u32x4*)(rowp + bj * HALF) = pk8(v0, v1); } }
  }
};
struct EpiBr { static constexpr bool PERM = true; bfr* O; const bfr* P;
  __device__ __forceinline__ void operator()(const f32x4 (&acc)[2][2][4][2], const Unit& u, int wr, int wc, int fr, int fq) const {
    const int row0 = u.pm * BM + wr * 64 + fr, col0 = u.z * DM + u.pn * BM + wc * 32 + 8 * fq;
    u32x4 gv[2][4][2];
#pragma unroll
    for (int ai = 0; ai < 2; ++ai)
#pragma unroll
      for (int m = 0; m < 4; ++m) { const bfr* gp = P + (size_t)(row0 + ai * HALF + m * 16) * NP + C_MG + col0;
#pragma unroll
        for (int bj = 0; bj < 2; ++bj) gv[ai][m][bj] = *(const u32x4*)(gp + bj * HALF); }
#pragma unroll
    for (int ai = 0; ai < 2; ++ai)
#pragma unroll
      for (int m = 0; m < 4; ++m) { bfr* rowp = O + (size_t)(row0 + ai * HALF + m * 16) * 3072 + col0;
#pragma unroll
        for (int bj = 0; bj < 2; ++bj) { f32x4 v0 = acc[ai][bj][m][0], v1 = acc[ai][bj][m][1];
          float g[8]; unpack8(gv[ai][m][bj], g);
#pragma unroll
          for (int j = 0; j < 4; ++j) { v0[j] *= g[j]; v1[j] *= g[4 + j]; }
          *(u32x4*)(rowp + bj * HALF) = pk8(v0, v1); } }
  }
};
struct EpiF32 { static constexpr bool PERM = false; float* C;
  __device__ __forceinline__ void operator()(const f32x4 (&acc)[2][2][4][2], const Unit& u, int wr, int wc, int fr, int fq) const {
    const int row0 = u.pm * BM + wr * 64 + fr, col0 = u.pn * BM + wc * 32 + 4 * fq;
    float* Cz = C + (size_t)u.z * NTOK * DM;
#pragma unroll
    for (int ai = 0; ai < 2; ++ai)
#pragma unroll
      for (int m = 0; m < 4; ++m) { float* rowp = Cz + (size_t)(row0 + ai * HALF + m * 16) * DM + col0;
#pragma unroll
        for (int bj = 0; bj < 2; ++bj)
#pragma unroll
          for (int n = 0; n < 2; ++n) *(f32x4*)(rowp + bj * HALF + n * 16) = acc[ai][bj][m][n]; }
  }
};
struct EpiPart { static constexpr bool PERM = true; bfr* C;
  __device__ __forceinline__ void operator()(const f32x4 (&acc)[2][2][4][2], const Unit& u, int wr, int wc, int fr, int fq) const {
    const int row0 = u.pm * BM + wr * 64 + fr, col0 = u.pn * BM + wc * 32 + 8 * fq;
    bfr* Cz = C + (size_t)u.z * NTOK * DM;
#pragma unroll
    for (int ai = 0; ai < 2; ++ai)
#pragma unroll
      for (int m = 0; m < 4; ++m) { bfr* rowp = Cz + (size_t)(row0 + ai * HALF + m * 16) * DM + col0;
#pragma unroll
        for (int bj = 0; bj < 2; ++bj) *(u32x4*)(rowp + bj * HALF) = pk8(acc[ai][bj][m][0], acc[ai][bj][m][1]); }
  }
};
}
namespace att {
constexpr int D = 128, NW = 8, QBLK = 32, KVBLK = 64;
constexpr float SCALE = 0.088388347648318440f;
constexpr float THR = 8.f;
constexpr int SDEPTH = 1;
constexpr int LDQ = 1024, LDK = 256, LDO = 1024;
constexpr size_t SHM_V = KVBLK * D * 2, SHM_K = KVBLK * D * 2, SHM_ATTN = 2 * SHM_V + 2 * SHM_K + NW * 64 * 4;
using bf16 = bfr;
using f32x8  = __attribute__((ext_vector_type(8))) float;
#define KSWZ(row, colB) ((row) * 256 + ((colB) ^ (((row) & 7) << 4)))
#define SBAR() __builtin_amdgcn_sched_barrier(0)
__device__ __forceinline__ int crow(int r, int hi) { return (r & 3) + 8 * (r >> 2) + 4 * hi; }
__device__ __forceinline__ unsigned cvtpk(float lo, float hi) {
  unsigned r; asm volatile("v_cvt_pk_bf16_f32 %0, %1, %2" : "=v"(r) : "v"(lo), "v"(hi)); return r;
}
template <typename TIn> struct Stage;
template <> struct Stage<bf16>  { using T = bf16x8;
  __device__ static __forceinline__ T ld8(const bf16* p) { return *reinterpret_cast<const bf16x8*>(p); }
  __device__ static __forceinline__ bf16x8 tobf(T x) { return x; } };
template <> struct Stage<float> { using T = f32x8;
  __device__ static __forceinline__ T ld8(const float* p) { return *reinterpret_cast<const f32x8*>(p); }
  __device__ static __forceinline__ bf16x8 tobf(T x) {
    u32x4 w = {cvtpk(x[0], x[1]), cvtpk(x[2], x[3]), cvtpk(x[4], x[5]), cvtpk(x[6], x[7])}; return *reinterpret_cast<bf16x8*>(&w); } };

__device__ __forceinline__ void partialSM(f32x16& p0, f32x16& p1, float& m_reg, float& mn, float& alpha) {
  constexpr float C = SCALE * 1.4426950408889634f;
  float pmax = p0[0]; for (int r = 1; r < 16; ++r) pmax = fmaxf(pmax, p0[r]); for (int r = 0; r < 16; ++r) pmax = fmaxf(pmax, p1[r]);
  { auto rr = __builtin_amdgcn_permlane32_swap(__float_as_uint(pmax), __float_as_uint(pmax), false, false);
    pmax = fmaxf(__uint_as_float(rr[0]), __uint_as_float(rr[1])); }
  if (__builtin_expect(__all(pmax - m_reg <= THR / SCALE), 1)) { mn = m_reg; alpha = 1.f; }
  else { mn = fmaxf(m_reg, pmax); alpha = __builtin_amdgcn_exp2f((m_reg - mn) * C); m_reg = mn; }
  float mnC = -mn * C;
  for (int r = 0; r < 16; ++r) p0[r] = fmaf(p0[r], C, mnC); for (int r = 0; r < 16; ++r) p1[r] = fmaf(p1[r], C, mnC);
  for (int r = 0; r < 16; ++r) p0[r] = __builtin_amdgcn_exp2f(p0[r]);
}
__device__ __forceinline__ void finishSM(f32x16& p0, f32x16& p1, float alpha, float& l_reg, bf16x8& pa0, bf16x8& pa1, bf16x8& pa2, bf16x8& pa3) {
  for (int r = 0; r < 16; ++r) p1[r] = __builtin_amdgcn_exp2f(p1[r]);
  float ps = 0; for (int r = 0; r < 16; ++r) ps += p0[r]; for (int r = 0; r < 16; ++r) ps += p1[r];
  { auto rr = __builtin_amdgcn_permlane32_swap(__float_as_uint(ps), __float_as_uint(ps), false, false);
    ps = __uint_as_float(rr[0]) + __uint_as_float(rr[1]); }
  l_reg = l_reg * alpha + ps;
#define PK4(P, BASE, OUT) do { unsigned a0 = cvtpk(P[BASE + 0], P[BASE + 1]), a1 = cvtpk(P[BASE + 2], P[BASE + 3]);   \
    unsigned b0 = cvtpk(P[BASE + 4], P[BASE + 5]), b1 = cvtpk(P[BASE + 6], P[BASE + 7]);                              \
    auto r0 = __builtin_amdgcn_permlane32_swap(a0, b0, false, false); auto r1 = __builtin_amdgcn_permlane32_swap(a1, b1, false, false); \
    u32x4 w = {r0[0], r1[0], r0[1], r1[1]}; OUT = *reinterpret_cast<bf16x8*>(&w); } while (0)
  PK4(p0, 0, pa0); PK4(p0, 8, pa1); PK4(p1, 0, pa2); PK4(p1, 8, pa3);
#undef PK4
}
__device__ __forceinline__ void qkt(f32x16& p0, f32x16& p1, const bf16* Ks, const bf16x8* qr, int r32, int hi) {
  p0 = f32x16{}; p1 = f32x16{};
  for (int d0 = 0; d0 < 8; ++d0) { int cb = (d0 * 16 + hi * 8) * 2;
    bf16x8 b0 = *reinterpret_cast<const bf16x8*>((const char*)Ks + KSWZ(r32, cb));
    bf16x8 b1 = *reinterpret_cast<const bf16x8*>((const char*)Ks + KSWZ(32 + r32, cb));
    p0 = __builtin_amdgcn_mfma_f32_32x32x16_bf16(b0, qr[d0], p0, 0, 0, 0);
    p1 = __builtin_amdgcn_mfma_f32_32x32x16_bf16(b1, qr[d0], p1, 0, 0, 0); }
}
__device__ __forceinline__ int v_st(int k, int c) { const int kk = (k & ~0xC) | ((k & 4) << 1) | ((k & 8) >> 1); return ((kk >> 3) * 4 + (c >> 5)) * 512 + ((kk & 7) * 32 + (c & 31)) * 2; }
__device__ __forceinline__ int v_rd_base(int lane) { return ((lane & 3) << 3) | (((lane >> 2) & 3) << 6) | (((lane >> 4) & 1) << 5) | (((lane >> 5) & 1) << 8); }
constexpr int v_rd_off(int d0, int ks, int half) { return d0 * 512 + ks * 4096 + half * 2048; }
template <int OFF> __device__ __forceinline__ s16x4 tr_read(int vb) {
  s16x4 r; asm volatile("ds_read_b64_tr_b16 %0, %1 offset:%2" : "=&v"(r) : "v"(vb), "i"(OFF) : "memory"); return r;
}
template <int D0> __device__ __forceinline__ void pv_one(f32x16& od, int vb, bf16x8 pa0, bf16x8 pa1, bf16x8 pa2, bf16x8 pa3) {
  const s16x4 l0 = tr_read<v_rd_off(D0, 0, 0)>(vb), h0 = tr_read<v_rd_off(D0, 0, 1)>(vb), l1 = tr_read<v_rd_off(D0, 1, 0)>(vb), h1 = tr_read<v_rd_off(D0, 1, 1)>(vb);
  const s16x4 l2 = tr_read<v_rd_off(D0, 2, 0)>(vb), h2 = tr_read<v_rd_off(D0, 2, 1)>(vb), l3 = tr_read<v_rd_off(D0, 3, 0)>(vb), h3 = tr_read<v_rd_off(D0, 3, 1)>(vb);
  asm volatile("s_waitcnt lgkmcnt(0)" ::: "memory"); SBAR();
#define PK(L, H) (bf16x8){L[0], L[1], L[2], L[3], H[0], H[1], H[2], H[3]}
  od = __builtin_amdgcn_mfma_f32_32x32x16_bf16(pa0, PK(l0, h0), od, 0, 0, 0);
  od = __builtin_amdgcn_mfma_f32_32x32x16_bf16(pa1, PK(l1, h1), od, 0, 0, 0);
  od = __builtin_amdgcn_mfma_f32_32x32x16_bf16(pa2, PK(l2, h2), od, 0, 0, 0);
  od = __builtin_amdgcn_mfma_f32_32x32x16_bf16(pa3, PK(l3, h3), od, 0, 0, 0);
#undef PK
}
__device__ __forceinline__ void pv_d0(f32x16* o, int vb, bf16x8 pa0, bf16x8 pa1, bf16x8 pa2, bf16x8 pa3) {
  pv_one<0>(o[0], vb, pa0, pa1, pa2, pa3); pv_one<1>(o[1], vb, pa0, pa1, pa2, pa3); pv_one<2>(o[2], vb, pa0, pa1, pa2, pa3); pv_one<3>(o[3], vb, pa0, pa1, pa2, pa3);
}

template <typename TQ>
__device__ __forceinline__ void attn_dense_body(const TQ* __restrict__ Qb, const bf16* __restrict__ Kh, const bf16* __restrict__ Vh,
                                                bfr* __restrict__ Ob, int seq, char* lds) {
  using St = Stage<bf16>; using SQ = Stage<TQ>;
  const int tid = tid_opaque(), wid = tid >> 6, lane = tid & 63, r32 = lane & 31, hi = lane >> 5;
  bf16* V_lds = (bf16*)lds; bf16* K_lds = (bf16*)(lds + 2 * SHM_V);
  float* ws = (float*)(lds + 2 * SHM_V + 2 * SHM_K) + wid * 64; float* li_l = ws; float* al_l = ws + 32;
  float m_reg = -1e30f, l_reg = 0; f32x16 o[4] = {}; bf16x8 qr[8];
  const TQ* Qw = Qb + (long)(wid * QBLK + r32) * LDQ + hi * 8;
#pragma unroll
  for (int d0 = 0; d0 < 8; ++d0) qr[d0] = SQ::tobf(SQ::ld8(Qw + d0 * 16));
  const int sr = tid >> 4, sc = (tid & 15) * 8, vst0 = v_st(sr, sc), vst1 = v_st(32 + sr, sc);
  const int vb0 = (int)(uintptr_t)V_lds + v_rd_base(lane);
  struct { typename St::T vs0, vs1, ks0, ks1; } sr_[SDEPTH];
#define SLOAD(i, k0) do { sr_[i].vs0 = St::ld8(&Vh[(long)((k0) + sr) * LDK + sc]); sr_[i].vs1 = St::ld8(&Vh[(long)((k0) + 32 + sr) * LDK + sc]); \
    sr_[i].ks0 = St::ld8(&Kh[(long)((k0) + sr) * LDK + sc]); sr_[i].ks1 = St::ld8(&Kh[(long)((k0) + 32 + sr) * LDK + sc]); } while (0)
#define SWRITE(b, i) do { *(bf16x8*)((char*)V_lds + (b) * SHM_V + vst0) = St::tobf(sr_[i].vs0);          \
    *(bf16x8*)((char*)V_lds + (b) * SHM_V + vst1) = St::tobf(sr_[i].vs1); int kc = sc * 2;               \
    *(bf16x8*)((char*)K_lds + (b) * SHM_K + KSWZ(sr, kc)) = St::tobf(sr_[i].ks0);                       \
    *(bf16x8*)((char*)K_lds + (b) * SHM_K + KSWZ(32 + sr, kc)) = St::tobf(sr_[i].ks1); } while (0)
#define SWAIT() do { if constexpr (SDEPTH == 2) asm volatile("s_waitcnt vmcnt(4)" ::: "memory"); else asm volatile("s_waitcnt vmcnt(0)" ::: "memory"); } while (0)
#define RESC(a) do { if (__any((a) < 1.f)) { if (hi == 0) al_l[r32] = (a); asm volatile("s_waitcnt lgkmcnt(0)" ::: "memory"); \
    for (int d = 0; d < 4; ++d) for (int r = 0; r < 16; ++r) o[d][r] *= al_l[crow(r, hi)]; } } while (0)
  f32x16 pA0, pA1, pB0, pB1; float mnA, mnB, alA, alB; bf16x8 pa0, pa1, pa2, pa3; const int NT = seq / KVBLK;
  constexpr int SE = 0, SO = SDEPTH - 1;
  SLOAD(SE, 0); asm volatile("s_waitcnt vmcnt(0)" ::: "memory"); SWRITE(0, SE); __syncthreads();
  qkt(pA0, pA1, K_lds, qr, r32, hi); partialSM(pA0, pA1, m_reg, mnA, alA);
  SLOAD(SO, KVBLK); if constexpr (SDEPTH == 2) { if (2 < NT) SLOAD(SE, 2 * KVBLK); }
  SWAIT(); SWRITE(1, SO); __syncthreads();
  for (int j = 1; j + 1 < NT; j += 2) {
    SBAR(); qkt(pB0, pB1, (bf16*)((char*)K_lds + SHM_K), qr, r32, hi);
    finishSM(pA0, pA1, alA, l_reg, pa0, pa1, pa2, pa3); SBAR();
    SLOAD(SO, (j + SDEPTH) * KVBLK); SBAR();
    pv_d0(o, vb0, pa0, pa1, pa2, pa3); partialSM(pB0, pB1, m_reg, mnB, alB);
    __syncthreads(); SWAIT(); SWRITE(0, SE);
    RESC(alB); __syncthreads();
    SBAR(); qkt(pA0, pA1, K_lds, qr, r32, hi);
    finishSM(pB0, pB1, alB, l_reg, pa0, pa1, pa2, pa3); SBAR();
    if (SDEPTH == 1 || j + 3 < NT) SLOAD(SE, (j + 1 + SDEPTH) * KVBLK); SBAR();
    pv_d0(o, vb0 + (int)SHM_V, pa0, pa1, pa2, pa3); partialSM(pA0, pA1, m_reg, mnA, alA);
    __syncthreads(); SWAIT(); SWRITE(1, SO);
    RESC(alA); __syncthreads();
  }
  SBAR(); qkt(pB0, pB1, (bf16*)((char*)K_lds + SHM_K), qr, r32, hi);
  finishSM(pA0, pA1, alA, l_reg, pa0, pa1, pa2, pa3); SBAR();
  pv_d0(o, vb0, pa0, pa1, pa2, pa3); partialSM(pB0, pB1, m_reg, mnB, alB);
  __syncthreads(); RESC(alB);
  finishSM(pB0, pB1, alB, l_reg, pa0, pa1, pa2, pa3); SBAR();
  pv_d0(o, vb0 + (int)SHM_V, pa0, pa1, pa2, pa3);
  if (hi == 0) li_l[r32] = l_reg; asm volatile("s_waitcnt lgkmcnt(0)" ::: "memory");
  float rli[16];
#pragma unroll
  for (int r = 0; r < 16; ++r) rli[r] = __builtin_amdgcn_rcpf(li_l[crow(r, hi)]);
  bfr* Ow = Ob + (long)(wid * QBLK) * LDO;
#pragma unroll
  for (int r = 0; r < 16; ++r) { int orow = crow(r, hi);
    for (int d0 = 0; d0 < 4; ++d0) Ow[(long)orow * LDO + d0 * 32 + r32] = f2bf(o[d0][r] * rli[r]); }
#undef SLOAD
#undef SWRITE
#undef SWAIT
#undef RESC
}

}

__device__ __forceinline__ void attn_item(const Params& p, int item) {
  __syncthreads();
  if (item < 64) {
    const int b = item >> 5, h = (item >> 2) & 7, qb = item & 3; const size_t t0 = NCTX + b * 1024 + qb * 256;
    att::attn_dense_body<bfr>(p.Q + t0 * DM + h * 128, p.Ks + (size_t)b * 1280 * 256 + (h >> 2) * 128, p.Vs + (size_t)b * 1280 * 256 + (h >> 2) * 128,
                              p.obr + (size_t)2 * NTOK * DM + t0 * DM + h * 128, 1280, smem);
  } else {
    const int j = item - 64, b = j >> 3, h = j & 7; const size_t t0 = b * 256;
    att::attn_dense_body<bfr>(p.Q + t0 * DM + h * 128, p.Kc + (size_t)b * 256 * 256 + (h >> 2) * 128, p.Vc + (size_t)b * 256 * 256 + (h >> 2) * 128,
                              p.obr + (size_t)2 * NTOK * DM + t0 * DM + h * 128, 256, smem);
  }
}
#define XB_TMO      128
#define XB_XCNT(j)  (256  + 64 * (j))
#define XB_XSUB(j)  (1280 + 64 * (j))
#define XB_XGEN(j)  (2304 + 64 * (j))
#define XB_TOP      3328
#define XB_TOPGEN   3392
#define XCD_BAR_WORDS 3456
#define XB_SPIN_CAP (1u << 20)
#define LAS __attribute__((address_space(3)))
constexpr int XB_LDS_OFF = 163840 - 16;

__device__ __forceinline__ unsigned xb_ld(unsigned* p)              { return __hip_atomic_load(p, __ATOMIC_RELAXED, __HIP_MEMORY_SCOPE_AGENT); }
__device__ __forceinline__ unsigned xb_add(unsigned* p, unsigned v) { return __hip_atomic_fetch_add(p, v, __ATOMIC_RELAXED, __HIP_MEMORY_SCOPE_AGENT); }
__device__ __forceinline__ unsigned xb_xcc_id() { return (unsigned)__builtin_amdgcn_s_getreg((3 << 11) | 20) & 0xFu; }
#define XB_SPIN(cond, bar) do { unsigned _sp = 0; while (cond) { __builtin_amdgcn_s_sleep(1); \
    if ((++_sp & 255u) == 0u) { if (xb_ld(&(bar)[XB_TMO])) break; if (_sp > XB_SPIN_CAP) { atomicAdd(&(bar)[XB_TMO], 1u); break; } } } } while (0)

__device__ __forceinline__ void xcd_barrier_post(unsigned* bar) {
  volatile LAS unsigned* st = (volatile LAS unsigned*)(smem + XB_LDS_OFF);
  if (tid_opaque() == 0) { st[0] = 0u; st[1] = 0u; (void)xb_add(&bar[XB_XCNT(xb_xcc_id())], 1u); }
  __syncthreads();
}
__device__ __forceinline__ void xcd_barrier_complete(unsigned* bar, unsigned x, unsigned& nloc, unsigned& nx) {
  const unsigned G = gridDim.x * gridDim.y * gridDim.z;
  unsigned sum, cnt, mine, sp = 0u;
  for (;;) {
    sum = 0u; cnt = 0u; mine = 0u;
#pragma unroll
    for (unsigned j = 0; j < 16; ++j) { const unsigned c = xb_ld(&bar[XB_XCNT(j)]); sum += c; cnt += (c > 0u) ? 1u : 0u; mine = (j == x) ? c : mine; }
    if (sum == G) break;
    __builtin_amdgcn_s_sleep(1);
    if ((++sp & 255u) == 0u) { if (xb_ld(&bar[XB_TMO])) break; if (sp > XB_SPIN_CAP) { atomicAdd(&bar[XB_TMO], 1u); break; } }
  }
  nloc = mine > 0u ? mine : 1u; nx = cnt > 0u ? cnt : 1u;
}
template <bool REL = true>
__device__ __forceinline__ void xcd_barrier(unsigned* bar) {
  asm volatile("s_waitcnt vmcnt(0)" ::: "memory");
  __syncthreads();
  if (tid_opaque() == 0) {
    volatile LAS unsigned* st = (volatile LAS unsigned*)(smem + XB_LDS_OFF);
    const unsigned x = xb_xcc_id();
    __builtin_amdgcn_s_waitcnt(0);
    unsigned nloc = st[0], nx = st[1];
    if (nloc == 0u) { xcd_barrier_complete(bar, x, nloc, nx); st[0] = nloc; st[1] = nx; }
    const unsigned old = xb_add(&bar[XB_XSUB(x)], 1u);
    const unsigned gen = old / nloc;
    if (old + 1u == (gen + 1u) * nloc) {
      if (REL) { __builtin_amdgcn_fence(__ATOMIC_RELEASE, "agent"); asm volatile("s_waitcnt vmcnt(0)" ::: "memory"); }
      const unsigned og = xb_add(&bar[XB_TOP], 1u);
      const unsigned tg = og / nx;
      if (og + 1u == (tg + 1u) * nx) xb_add(&bar[XB_TOPGEN], 1u);
      else XB_SPIN(xb_ld(&bar[XB_TOPGEN]) == tg, bar);
      xb_add(&bar[XB_XGEN(x)], 1u);
      __builtin_amdgcn_fence(__ATOMIC_ACQUIRE, "agent");
      asm volatile("s_waitcnt vmcnt(0)" ::: "memory");
    } else {
      XB_SPIN(xb_ld(&bar[XB_XGEN(x)]) == gen, bar);
      __builtin_amdgcn_fence(__ATOMIC_ACQUIRE, "agent");
      asm volatile("s_waitcnt vmcnt(0)" ::: "memory");
    }
  }
  __syncthreads();
}
constexpr float SCALEQ = 0.08838834764831845f;
constexpr int PQH = 0, PKH = 17408, PVH = 34816, PKK = 52224, PQK = 68864, PXS = 52224, PMD = 125952, PMB = 134144, PGC = 152576, PRS = 0;
constexpr int XROW = 144;
#define LDS_BARRIER() do { asm volatile("s_waitcnt lgkmcnt(0)" ::: "memory"); __builtin_amdgcn_s_barrier(); asm volatile("" ::: "memory"); } while (0)
constexpr int LROW = 272;

__device__ __forceinline__ float ld_bf(const char* base, int byteoff) { return bf2f(*(const bfr*)(base + byteoff)); }

template <int B>
__device__ __forceinline__ void solve_block(int d, int e, int wid, int lane) {
  const int fr = lane & 15, hq = lane >> 4;
  char* xcol = smem + PXS + (d * 256 + e) * XROW + 16 * B * 2;
  float acc[16];
  { const u32x4 a = *(const u32x4*)xcol, b = *(const u32x4*)(xcol + 16); unpack8(a, acc); unpack8(b, acc + 8); }
  if (B > 0) {
    constexpr int NKS = (B + 1) / 2;
    f32x4 R[4];
#pragma unroll
    for (int ct = 0; ct < 4; ++ct) R[ct] = f32x4{0.f, 0.f, 0.f, 0.f};
#pragma unroll
    for (int ks = 0; ks < NKS; ++ks) {
      const bf16x8 a = *(const bf16x8*)(smem + PMB + (d * 64 + 16 * B + fr) * XROW + (ks * 32 + 8 * hq) * 2);
#pragma unroll
      for (int ct = 0; ct < 4; ++ct) {
        const bf16x8 b = *(const bf16x8*)(smem + PXS + (d * 256 + (wid & 3) * 64 + ct * 16 + fr) * XROW + (ks * 32 + 8 * hq) * 2);
        R[ct] = __builtin_amdgcn_mfma_f32_16x16x32_bf16(a, b, R[ct], 0, 0, 0);
      }
    }
    float* rs = (float*)(smem + PRS + wid * 4352);
#pragma unroll
    for (int ct = 0; ct < 4; ++ct)
#pragma unroll
      for (int r = 0; r < 4; ++r) rs[(4 * hq + r) * 68 + ct * 16 + fr] = R[ct][r];
    asm volatile("s_waitcnt lgkmcnt(0)" ::: "memory");
#pragma unroll
    for (int r = 0; r < 16; ++r) acc[r] -= rs[r * 68 + lane];
  }
  const float4* md = (const float4*)(smem + PMD) + ((d * 4 + B) * 16) * 4;
#pragma unroll
  for (int r2 = 0; r2 < 15; ++r2) {
#pragma unroll
    for (int q = (r2 + 1) / 4; q < 4; ++q) {
      const float4 m = md[r2 * 4 + q];
      if (4 * q + 0 > r2) acc[4 * q + 0] -= m.x * acc[r2];
      if (4 * q + 1 > r2) acc[4 * q + 1] -= m.y * acc[r2];
      if (4 * q + 2 > r2) acc[4 * q + 2] -= m.z * acc[r2];
      if (4 * q + 3 > r2) acc[4 * q + 3] -= m.w * acc[r2];
    }
  }
  *(u32x4*)xcol = pack8(acc); *(u32x4*)(xcol + 16) = pack8(acc + 8);
  asm volatile("s_waitcnt lgkmcnt(0)" ::: "memory");
}

__device__ __forceinline__ void dn_prep_item(const Params& p, int l, int c, int h) {
  const int tid = tid_opaque(), wid = tid >> 6, lane = tid & 63;
  const int t0 = c * 64;
  LDS_BARRIER();
  float b_beta = 0.f, b_alpha = 0.f, b_A = 0.f, b_dtb = 0.f;
  if (wid < 2) {
    const int d = wid, ti = d ? 63 - lane : lane, t = t0 + ti;
    b_A = p.a_log[(l * 2 + d) * 8 + h]; b_dtb = p.dt_bias[(l * 2 + d) * 8 + h];
    b_beta = p.small[(size_t)t * 32 + d * 8 + h]; b_alpha = p.small[(size_t)t * 32 + 16 + d * 8 + h];
  }
  struct { u32x4 raw[3][2][3]; } R;
  {
    const int grp = tid & 15;
#pragma unroll
    for (int X = 0; X < 3; ++X)
#pragma unroll
      for (int pass = 0; pass < 2; ++pass)
#pragma unroll
        for (int k = -1; k <= 1; ++k) {
          const int r = (tid >> 4) + pass * 32, t = t0 + r, pos = tok_pos(t), L = tok_L(t);
          R.raw[X][pass][k + 1] = u32x4{0u, 0u, 0u, 0u};
          if (pos + k >= 0 && pos + k < L) R.raw[X][pass][k + 1] = *(const u32x4*)(p.P + (size_t)(t + k) * NP + X * 1024 + h * 128 + grp * 8);
        }
  }
  {
    const int grp = tid & 15;
    const float* wc = p.w_conv_dn + (size_t)l * 3 * 3072 + h * 128 + grp * 8;
#pragma unroll
    for (int X = 0; X < 3; ++X) {
      float w[3][8];
#pragma unroll
      for (int k = 0; k < 3; ++k) { *(float4*)&w[k][0] = *(const float4*)(wc + k * 3072 + X * 1024); *(float4*)&w[k][4] = *(const float4*)(wc + k * 3072 + X * 1024 + 4); }
#pragma unroll
      for (int pass = 0; pass < 2; ++pass) {
        const int r = (tid >> 4) + pass * 32;
        float acc[8] = {};
#pragma unroll
        for (int k = 0; k < 3; ++k) {
          float x[8]; unpack8(R.raw[X][pass][k], x);
#pragma unroll
          for (int q = 0; q < 8; ++q) acc[q] += w[k][q] * x[q];
        }
        float ss = 0;
#pragma unroll
        for (int q = 0; q < 8; ++q) { acc[q] = siluf_(acc[q]); ss += acc[q] * acc[q]; }
        if (X < 2) {
          ss += __shfl_xor(ss, 1); ss += __shfl_xor(ss, 2); ss += __shfl_xor(ss, 4); ss += __shfl_xor(ss, 8);
          const float nrm = rsqrtf(ss + EPS);
#pragma unroll
          for (int q = 0; q < 8; ++q) acc[q] *= nrm;
        }
        *(u32x4*)(smem + X * 17408 + r * LROW + grp * 16) = pack8hw(acc);
      }
    }
  }
  if (wid < 2) {
    const int d = wid;
    const float A = __expf(b_A);
    const float beta = sigmoidf_(b_beta);
    float g = -A * softplusf_(b_alpha + b_dtb);
#pragma unroll
    for (int o = 1; o < 64; o <<= 1) { const float v = __shfl_up(g, o); if (lane >= o) g += v; }
    float* G = (float*)(smem + PGC);
    const float eg_ = __expf(g);
    G[d * 64 + lane] = g; G[128 + d * 64 + lane] = beta; G[256 + d * 64 + lane] = eg_; G[384 + d * 64 + lane] = beta * eg_;
  }
  LDS_BARRIER();
  {
    const int mat = wid >> 2, rt = wid & 3, fr = lane & 15, fq = lane >> 4;
    const char* Ab = smem + (mat ? PQH : PKH);
    f32x4 acc[4];
#pragma unroll
    for (int ct = 0; ct < 4; ++ct) acc[ct] = f32x4{0.f, 0.f, 0.f, 0.f};
#pragma unroll
    for (int ks = 0; ks < 4; ++ks) {
      const bf16x8 a = *(const bf16x8*)(Ab + (rt * 16 + fr) * LROW + (ks * 32 + fq * 8) * 2);
#pragma unroll
      for (int ct = 0; ct < 4; ++ct) {
        const bf16x8 b = *(const bf16x8*)(smem + PKH + (ct * 16 + fr) * LROW + (ks * 32 + fq * 8) * 2);
        acc[ct] = __builtin_amdgcn_mfma_f32_16x16x32_bf16(a, b, acc[ct], 0, 0, 0);
      }
    }
    float* Dst = (float*)(smem + (mat ? PQK : PKK));
#pragma unroll
    for (int ct = 0; ct < 4; ++ct)
#pragma unroll
      for (int r = 0; r < 4; ++r) Dst[(rt * 16 + fq * 4 + r) * 65 + ct * 16 + fr] = acc[ct][r];
  }
  LDS_BARRIER();
  const int d = tid >> 8, e = tid & 255;
  const float* GC = (const float*)(smem + PGC) + d * 64;
  const float* BETA = (const float*)(smem + PGC) + 128 + d * 64;
  const float* EG = (const float*)(smem + PGC) + 256 + d * 64;
  const float* KKs = (const float*)(smem + PKK);
  const float* QKs = (const float*)(smem + PQK);
  char* rec = p.dnrec + (size_t)((c * 8 + h) * 2 + d) * REC_BYTES;
  {
    const int i = e >> 2, jq = e & 3, j0 = jq * 16, ti = d ? 63 - i : i, ib = i >> 4;
    const float bi = BETA[i], gi = GC[i];
    float mv[16];
#pragma unroll
    for (int jj = 0; jj < 16; ++jj) {
      const int j = j0 + jj, tj = d ? 63 - j : j;
      const float mraw = bi * KKs[ti * 65 + tj] * __expf(fminf(gi - GC[j], 0.f));
      mv[jj] = (j < i) ? mraw : 0.f;
    }
    float* mdt = (float*)(smem + PMD) + ((d * 4 + ib) * 16) * 16 + (i & 15);
    if (jq == ib) {
#pragma unroll
      for (int jj = 0; jj < 16; ++jj) mdt[jj * 16] = mv[jj];
    }
    float mo[16];
#pragma unroll
    for (int jj = 0; jj < 16; ++jj) mo[jj] = (jq < ib) ? mv[jj] : 0.f;
    char* mb = smem + PMB + (d * 64 + i) * XROW + j0 * 2;
    *(u32x4*)mb = pack8hw(mo); *(u32x4*)(mb + 16) = pack8hw(mo + 8);
#pragma unroll 1
    for (int rep = 0; rep < 2; ++rep) {
      const int f = e + rep * 256, ln = f & 63, fi = f >> 6, mt = fi >> 1, ks = fi & 1;
      const int ii = mt * 16 + (ln & 15), tii = d ? 63 - ii : ii, hq = ln >> 4;
      const float gii = GC[ii];
      float v[8];
#pragma unroll
      for (int j = 0; j < 8; ++j) {
        const int jp = ks * 32 + (j >> 2) * 16 + 4 * hq + (j & 3), tj = d ? 63 - jp : jp;
        const float qraw = SCALEQ * QKs[tii * 65 + tj] * __expf(fminf(gii - GC[jp], 0.f));
        v[j] = (jp <= ii) ? qraw : 0.f;
      }
      *(u32x4*)(rec + REC_QK + f * 16) = pack8hw(v);
    }
    if (e == 0) p.glast[(c * 8 + h) * 2 + d] = EG[63];
    const float gl = GC[63];
#pragma unroll 1
    for (int rep = 0; rep < 4; ++rep) {
      const int f = e + rep * 256, ln = f & 63, fi = f >> 6, hq = ln >> 4;
      {
        const int mt = fi >> 2, ks = fi & 3, ii = mt * 16 + (ln & 15), tii = d ? 63 - ii : ii;
        const float sc = SCALEQ * EG[ii];
        const char* qrow = smem + PQH + tii * LROW + (ks * 32 + 4 * hq) * 2;
        const u32x2 lo = *(const u32x2*)qrow, hi = *(const u32x2*)(qrow + 32);
        float v[8] = {__uint_as_float(lo[0] << 16), __uint_as_float(lo[0] & 0xffff0000u), __uint_as_float(lo[1] << 16), __uint_as_float(lo[1] & 0xffff0000u),
                      __uint_as_float(hi[0] << 16), __uint_as_float(hi[0] & 0xffff0000u), __uint_as_float(hi[1] << 16), __uint_as_float(hi[1] & 0xffff0000u)};
#pragma unroll
        for (int j = 0; j < 8; ++j) v[j] *= sc;
        *(u32x4*)(rec + REC_QD + f * 16) = pack8hw(v);
      }
      {
        const int mt = fi >> 1, ks = fi & 1, dk = mt * 16 + (ln & 15);
        float v[8];
#pragma unroll
        for (int j = 0; j < 8; ++j) {
          const int ip = ks * 32 + (j >> 2) * 16 + 4 * hq + (j & 3), tip = d ? 63 - ip : ip;
          v[j] = ld_bf(smem + PKH, tip * LROW + dk * 2) * __expf(gl - GC[ip]);
        }
        *(u32x4*)(rec + REC_KD + f * 16) = pack8hw(v);
      }
    }
  }
  LDS_BARRIER();
  {
    const int col = e & 127; const bool isw = e >= 128;
    const char* src = smem + (isw ? PKH : PVH) + col * 2;
    const float4* F4 = (const float4*)((const float*)(smem + PGC) + (isw ? 384 : 128) + d * 64);
    char* xcol = smem + PXS + (d * 256 + e) * XROW;
#pragma unroll
    for (int i8 = 0; i8 < 8; ++i8) {
      const float4 f0 = F4[i8 * 2], f1 = F4[i8 * 2 + 1];
      const float fs[8] = {f0.x, f0.y, f0.z, f0.w, f1.x, f1.y, f1.z, f1.w};
      float v[8];
#pragma unroll
      for (int q = 0; q < 8; ++q) { const int i = i8 * 8 + q, ti = d ? 63 - i : i; v[q] = ld_bf(src, ti * LROW) * fs[q]; }
      *(u32x4*)(xcol + i8 * 16) = pack8hw(v);
    }
  }
  LDS_BARRIER();
  solve_block<0>(d, e, wid, lane); solve_block<1>(d, e, wid, lane); solve_block<2>(d, e, wid, lane); solve_block<3>(d, e, wid, lane);
  LDS_BARRIER();
  {
    const char* XS = smem + PXS + d * 256 * XROW;
#pragma unroll 1
    for (int rep = 0; rep < 8; ++rep) {
      const int f = e + rep * 256, ln = f & 63, fi = f >> 6, ws = fi >> 2, rt = fi & 3;
      const int i0 = rt * 16 + 4 * (ln >> 4), dv = ws * 16 + (ln & 15);
      *(u32x2*)(rec + REC_U + f * 8) = *(const u32x2*)(XS + dv * XROW + i0 * 2);
    }
#pragma unroll 1
    for (int rep = 0; rep < 4; ++rep) {
      const int f = e + rep * 256, ln = f & 63, fi = f >> 6, mt = fi >> 2, ks = fi & 3, hq = ln >> 4;
      const char* wc = XS + (128 + ks * 32 + 4 * hq) * XROW + (mt * 16 + (ln & 15)) * 2;
      unsigned q[8];
#pragma unroll
      for (int j = 0; j < 8; ++j) q[j] = *(const bfr*)(wc + ((j >> 2) * 16 + (j & 3)) * XROW);
      u32x4 o = {q[0] | (q[1] << 16), q[2] | (q[3] << 16), q[4] | (q[5] << 16), q[6] | (q[7] << 16)};
      *(u32x4*)(rec + REC_W + f * 16) = o;
    }
  }
}

__device__ __forceinline__ bf16x8 pack_b(const f32x4& a, const f32x4& b) {
  u32x4 w = {pack2hw(a[0], a[1]), pack2hw(a[2], a[3]), pack2hw(b[0], b[1]), pack2hw(b[2], b[3])};
  return *reinterpret_cast<bf16x8*>(&w);
}

constexpr int SCAN_BUF = 73728;
#define SC_SCHED() __builtin_amdgcn_sched_barrier(0)
#define SC_WAITL(n) asm volatile("s_waitcnt lgkmcnt(" #n ")" ::: "memory")
__device__ __forceinline__ void dn_scan_item(const Params& p, int l, int s, int h, int d) {
  const int tid = tid_opaque(), wid = tid >> 6, lane = tid & 63, ws = wid, fr = lane & 15, hq = lane >> 4;
  const bool samp = s >= 16;
  const int N = samp ? 16 : 4, cb = samp ? 64 + (s - 16) * 16 : s * 4, tbase = samp ? NCTX + (s - 16) * 1024 : s * 256;
  const int cstep = d ? -1 : 1, c0 = cb + (d ? N - 1 : 0);
  auto recp = [&](int n) { return p.dnrec + (size_t)(((c0 + n * cstep) * 8 + h) * 2 + d) * REC_BYTES; };
  f32x4 S[8];
  if (samp) {
    const float* s0 = p.state_dn + ((((size_t)(s - 16) * DEPTH + l) * 2 + d) * 8 + h) * 16384;
#pragma unroll
    for (int dt = 0; dt < 8; ++dt) {
      const float* q = s0 + (dt * 16 + 4 * hq) * 128 + ws * 16 + fr;
      asm volatile("" : "+v"(q) :: "memory");
#pragma unroll
      for (int r = 0; r < 4; ++r) S[dt][r] = q[r * 128];
    }
  } else {
#pragma unroll
    for (int dt = 0; dt < 8; ++dt) S[dt] = f32x4{0.f, 0.f, 0.f, 0.f};
  }
  const float glv = p.glast[((c0 + (lane < N ? lane : 0) * cstep) * 8 + h) * 2 + d];
  __syncthreads();
#define SC_GLDS(rec, buf) do { _Pragma("unroll") for (int i = 0; i < 9; ++i) \
    __builtin_amdgcn_global_load_lds((const unsigned*)((rec) + (i * 512 + tid) * 16), (__attribute__((address_space(3))) unsigned*)(smem + (buf) * SCAN_BUF + (i * 512 + tid) * 16), 16, 0, 0); } while (0)
  SC_GLDS(recp(0), 0);
  SC_GLDS(recp(1), 1);
  asm volatile("s_waitcnt vmcnt(0)" ::: "memory");
  LDS_BARRIER();
#pragma unroll 1
  for (int n = 0; n < N; ++n) {
    const int c = c0 + n * cstep;
    const char* Lb = smem + (n & 1) * SCAN_BUF;
    const char* LW = Lb + REC_W + lane * 16;
    const float gl = __uint_as_float(__builtin_amdgcn_readlane(__float_as_uint(glv), n));
    f32x4 P[4], O[4];
#pragma unroll
    for (int rt = 0; rt < 4; ++rt) { P[rt] = f32x4{0.f, 0.f, 0.f, 0.f}; O[rt] = f32x4{0.f, 0.f, 0.f, 0.f}; }
    bf16x8 F[8];
#define SC_LOADWQ(ks) do { _Pragma("unroll") for (int rt = 0; rt < 4; ++rt) { F[rt] = *(const bf16x8*)(LW + ((rt * 4 + (ks)) * 64) * 16); F[4 + rt] = *(const bf16x8*)(LW + 16384 + ((rt * 4 + (ks)) * 64) * 16); } } while (0)
#define SC_MMAWQ(sb) do { _Pragma("unroll") for (int rt = 0; rt < 4; ++rt) { P[rt] = __builtin_amdgcn_mfma_f32_16x16x32_bf16(F[rt], sb, P[rt], 0, 0, 0); O[rt] = __builtin_amdgcn_mfma_f32_16x16x32_bf16(F[4 + rt], sb, O[rt], 0, 0, 0); } } while (0)
#pragma unroll
    for (int ks = 0; ks < 4; ++ks) {
      SC_LOADWQ(ks); SC_SCHED();
      const bf16x8 sb = pack_b(S[2 * ks], S[2 * ks + 1]);
      SC_WAITL(0); SC_SCHED(); SC_MMAWQ(sb); SC_SCHED();
    }
    u32x2 U[4];
#pragma unroll
    for (int rt = 0; rt < 4; ++rt) U[rt] = *(const u32x2*)(Lb + REC_U + (((ws * 4 + rt) * 64) + lane) * 8);
#pragma unroll
    for (int i = 0; i < 8; ++i) F[i] = *(const bf16x8*)(LW + 32768 + (i * 64) * 16);
    SC_SCHED(); SC_WAITL(0); SC_SCHED();
#pragma unroll
    for (int rt = 0; rt < 4; ++rt) {
      const u32x2 u = U[rt];
      P[rt][0] = __uint_as_float(u[0] << 16) - P[rt][0]; P[rt][1] = __uint_as_float(u[0] & 0xffff0000u) - P[rt][1];
      P[rt][2] = __uint_as_float(u[1] << 16) - P[rt][2]; P[rt][3] = __uint_as_float(u[1] & 0xffff0000u) - P[rt][3];
    }
    const bf16x8 vb0 = pack_b(P[0], P[1]), vb1 = pack_b(P[2], P[3]);
#pragma unroll
    for (int rt = 0; rt < 4; ++rt) {
      O[rt] = __builtin_amdgcn_mfma_f32_16x16x32_bf16(F[rt * 2 + 0], vb0, O[rt], 0, 0, 0);
      O[rt] = __builtin_amdgcn_mfma_f32_16x16x32_bf16(F[rt * 2 + 1], vb1, O[rt], 0, 0, 0);
    }
    SC_SCHED();
#pragma unroll
    for (int half = 0; half < 2; ++half) {
#pragma unroll
      for (int i = 0; i < 8; ++i) F[i] = *(const bf16x8*)(LW + 40960 + ((half * 8 + i) * 64) * 16);
      SC_SCHED(); SC_WAITL(0); SC_SCHED();
#pragma unroll
      for (int dq = 0; dq < 4; ++dq) {
        const int dt = half * 4 + dq;
        S[dt] *= gl;
        S[dt] = __builtin_amdgcn_mfma_f32_16x16x32_bf16(F[dq * 2 + 0], vb0, S[dt], 0, 0, 0);
        S[dt] = __builtin_amdgcn_mfma_f32_16x16x32_bf16(F[dq * 2 + 1], vb1, S[dt], 0, 0, 0);
      }
      SC_SCHED();
    }
    SC_SCHED();
    bfr* ob = p.opart + (size_t)d * NTOK * DM + (size_t)(c * 64) * DM + h * 128 + ws * 16 + fr;
#pragma unroll
    for (int rt = 0; rt < 4; ++rt) {
      const int ip0 = rt * 16 + 4 * hq;
      bfr* q = ob + (size_t)(d ? 63 - ip0 : ip0) * DM;
      const long stp = d ? -(long)DM : (long)DM;
#pragma unroll
      for (int r = 0; r < 4; ++r) q[r * stp] = f2bf(O[rt][r]);
    }
    asm volatile("s_waitcnt vmcnt(16)" ::: "memory");
    LDS_BARRIER();
    if (n + 2 < N) SC_GLDS(recp(n + 2), n & 1);
  }
#undef SC_GLDS
#undef SC_LOADWQ
#undef SC_MMAWQ
  if (!samp) {
    float* so = p.out_state + ((((size_t)s * DEPTH + l) * 2 + d) * 8 + h) * 16384;
#pragma unroll
    for (int dt = 0; dt < 8; ++dt) {
      float* q = so + (dt * 16 + 4 * hq) * 128 + ws * 16 + fr;
      asm volatile("" : "+v"(q) :: "memory");
#pragma unroll
      for (int r = 0; r < 4; ++r) q[r * 128] = S[dt][r];
    }
  }
  if (l == 1 && s == 16 && h == 0 && d == 0) GSTAMP(p.bar, 4);
  asm volatile("s_waitcnt vmcnt(0)" ::: "memory");
  __syncthreads();
  volatile __attribute__((address_space(3))) unsigned* flag = (volatile __attribute__((address_space(3))) unsigned*)(smem + XB_LDS_OFF + 8);
  if (tid == 0) {
    __builtin_amdgcn_fence(__ATOMIC_RELEASE, "agent");
    asm volatile("s_waitcnt vmcnt(0)" ::: "memory");
    const unsigned old = __hip_atomic_fetch_add(p.bar + 4096 + (l * 18 + s) * 8 + h, 1u, __ATOMIC_RELAXED, __HIP_MEMORY_SCOPE_AGENT);
    if (old == 1u) { __builtin_amdgcn_fence(__ATOMIC_ACQUIRE, "agent"); asm volatile("s_waitcnt vmcnt(0)" ::: "memory"); }
    *flag = old;
  }
  __syncthreads();
  const unsigned last = __builtin_amdgcn_readfirstlane(*flag);
  if (last == 1u && !samp) dn_finalize(p, l, tbase, 256, h, tid, NTHR);
}

__device__ __forceinline__ void dn_finalize_item(const Params& p, int l, int it) {
  const int tid = tid_opaque();
  const int s = 16 + (it >> 5), h = (it >> 2) & 7, qt = it & 3;
  __syncthreads();
  if (tid == 0) {
    unsigned* cnt = p.bar + 4096 + (l * 18 + s) * 8 + h; unsigned sp = 0;
    while (__hip_atomic_load(cnt, __ATOMIC_RELAXED, __HIP_MEMORY_SCOPE_AGENT) < 2u) { __builtin_amdgcn_s_sleep(2); if (++sp > (1u << 22)) { atomicAdd(&p.bar[XB_TMO], 1u); break; } }
    __builtin_amdgcn_fence(__ATOMIC_ACQUIRE, "agent");
    asm volatile("s_waitcnt vmcnt(0)" ::: "memory");
  }
  __syncthreads();
  dn_finalize(p, l, NCTX + (s - 16) * 1024 + qt * 256, 256, h, tid, NTHR);
}
constexpr int DYN_LDS = 163840;
#ifndef REP
#define REP 0
#endif
constexpr int CONV_A = 330, CONV_B = 330 + 768;
#ifndef USE_CG_SYNC
#define USE_CG_SYNC 1
#endif
#if USE_CG_SYNC
#define GRID_SYNC() do { cg::this_grid().sync(); } while (0)
#define GRID_SYNC_WT() GRID_SYNC()
#else
#define GRID_SYNC() do { unsigned* bar_; { PHASE_PARAMS(pb); bar_ = pb.bar; } xcd_barrier<true>(bar_); if (REP & 2048) xcd_barrier<true>(bar_); } while (0)
#define GRID_SYNC_WT() GRID_SYNC()
#endif

typedef const __attribute__((address_space(4))) Params* CParamsPtr;
#define PHASE_PARAMS(p) CParamsPtr p##_c = (CParamsPtr)__builtin_amdgcn_kernarg_segment_ptr(); asm volatile("" : "+s"(p##_c)); const Params& p = *(const Params*)p##_c

#define PF_LINES(base_ptr, nlines) do { const int g_ = bid * 512 + tid_opaque(); unsigned d0_ = 0, d1_ = 0; \
    if (g_ < (nlines)) { const char* q_ = (const char*)(base_ptr) + (size_t)g_ * 128; asm volatile("global_load_dword %0, %1, off" : "=v"(d0_) : "v"(q_) : "memory"); } \
    if ((nlines) > 131072 && g_ + 131072 < (nlines)) { const char* q_ = (const char*)(base_ptr) + (size_t)(g_ + 131072) * 128; asm volatile("global_load_dword %0, %1, off" : "=v"(d1_) : "v"(q_) : "memory"); } \
    asm volatile("s_waitcnt vmcnt(0)" ::: "memory"); asm volatile("" :: "v"(d0_), "v"(d1_)); } while (0)
__device__ __forceinline__ void panel_rows(const Params& p, int l, int mode, int bid) {
  const int tid = tid_opaque(), wid = tid >> 6, lane = tid & 63;
  const int pm = bid % 24, q = bid / 24;
  volatile __attribute__((address_space(3))) unsigned* flag = (volatile __attribute__((address_space(3))) unsigned*)(smem + XB_LDS_OFF + 8);
  asm volatile("s_waitcnt vmcnt(0)" ::: "memory");
  __syncthreads();
  if (tid == 0) {
    unsigned* cnt = p.bar + 9216 + ((l * 2 + (mode - 1)) * 24 + pm) * 16;
    __builtin_amdgcn_fence(__ATOMIC_RELEASE, "agent");
    asm volatile("s_waitcnt vmcnt(0)" ::: "memory");
    (void)__hip_atomic_fetch_add(cnt, 1u, __ATOMIC_RELAXED, __HIP_MEMORY_SCOPE_AGENT);
    unsigned sp = 0;
    while (__hip_atomic_load(cnt, __ATOMIC_RELAXED, __HIP_MEMORY_SCOPE_AGENT) < 8u) { __builtin_amdgcn_s_sleep(1); if (++sp > (1u << 22)) { atomicAdd(&p.bar[XB_TMO], 1u); break; } }
    __builtin_amdgcn_fence(__ATOMIC_ACQUIRE, "agent");
    asm volatile("s_waitcnt vmcnt(0)" ::: "memory");
    *flag = 1u;
  }
  __syncthreads();
  rows_at<4>(p, l, mode, pm * 256 + q * 32 + wid * 4, lane);
}

template <int l> __device__ __forceinline__ void run_layer(const int bid, const int nblk) {
  if (l == 1) TSTAMP(5);
  { PHASE_PARAMS(p); pg8::gemm_phase(pg8::Gemm{p.h, p.wt_in + (size_t)l * NPAD * DM, DM, DM, DM}, pg8::SchedIn{nblk, bid}, pg8::EpiIn{p.P, p.small}); }
#if REP & 1
#if REP & 65536
  { PHASE_PARAMS(p); pg8::gemm_phase(pg8::Gemm{p.h, p.wt_in + (size_t)l * NPAD * DM, DM, DM, DM}, pg8::SchedIn{nblk, bid}, pg8::EpiIn{p.P, p.small}); }
#else
  { PHASE_PARAMS(p); pg8::gemm_phase(pg8::Gemm{p.h, p.wt_in + (size_t)l * NPAD * DM, DM, DM, DM}, pg8::SchedIn{nblk, bid}, pg8::EpiIn{p.P, p.small}); }
#endif
#endif
  GRID_SYNC_WT(); if (l == 1) TSTAMP(6);
  { PHASE_PARAMS(p); for (int it = bid; it < 768; it += nblk) dn_prep_item(p, l, it >> 3, it & 7); }
#if REP & 2
  { PHASE_PARAMS(p); for (int it = bid; it < 768; it += nblk) dn_prep_item(p, l, it >> 3, it & 7); }
#endif
  if (l == 1) TSTAMP(15);
  { PHASE_PARAMS(p); for (int it = bid; it < 384; it += nblk) light_prep_item(p, l, it); }
#if REP & 4096
  { PHASE_PARAMS(p); for (int it = bid; it < 384; it += nblk) light_prep_item(p, l, it); }
#endif
  unsigned pf_ = 0;
  { PHASE_PARAMS(p); const int gid = bid * 512 + tid_opaque(); const char* q;
    if (gid < 98304) q = (const char*)p.h + (size_t)gid * 128;
    else if (gid < 114688) q = (const char*)(p.wt_in + (size_t)l * NPAD * DM + (size_t)42 * 256 * DM) + (size_t)(gid - 98304) * 128;
    else if (gid < 118784) q = (const char*)(p.wt_in + (size_t)l * NPAD * DM + (size_t)37 * 256 * DM) + (size_t)(gid - 114688) * 128;
    else q = (const char*)(p.wt_br + (size_t)(l * 3 + 1) * DM * DM) + (size_t)((gid - 118784) & 8191) * 128;
    asm volatile("global_load_dword %0, %1, off" : "=v"(pf_) : "v"(q) : "memory"); }
  GRID_SYNC(); if (l == 1) TSTAMP(7);
  asm volatile("" :: "v"(pf_));
#define P3_PULL(slotword, limit) \
      volatile __attribute__((address_space(3))) unsigned* qslot = (volatile __attribute__((address_space(3))) unsigned*)(smem + XB_LDS_OFF + 12); \
      __syncthreads(); \
      if (tid_opaque() == 0) { PHASE_PARAMS(pq); *qslot = __hip_atomic_fetch_add(pq.bar + 8192 + l * 8 + rep3 * 4 + (slotword), 1u, __ATOMIC_RELAXED, __HIP_MEMORY_SCOPE_AGENT); } \
      __syncthreads(); \
      const int it = __builtin_amdgcn_readfirstlane((int)*qslot); \
      if (it >= (limit)) break;
#pragma unroll 1
  for (int rep3 = 0; rep3 < ((REP & 4) ? 2 : 1); ++rep3) {
    if (bid < 64) { PHASE_PARAMS(p); attn_item(p, bid); }
    else {
      if (bid >= 192)
#pragma unroll 1
      for (int rr_ = 0; rr_ < ((REP & 131072) ? 2 : 1); ++rr_) {
        const int it = bid - 192; TSTAMP(1);
        if (it >= 32) { PHASE_PARAMS(p); const int k = it - 32; pg8::Unit u; if (k < 8) { u.pm = 16 + k; u.pn = 37; } else { u.pm = (k - 8) % 24; u.pn = 42 + (k - 8) / 24; } u.z = 0; u.ka = 0; u.kb = 0;
          pg8::gemm_phase(pg8::Gemm{p.h, p.wt_in + (size_t)l * NPAD * DM, DM, DM, DM}, pg8::SchedOne{u}, pg8::EpiIn{p.P, p.small}); }
        else { PHASE_PARAMS(p); pg8::Unit u; u.pm = it % 24; u.pn = it / 24; u.z = 1; u.ka = (size_t)NTOK * DM; u.kb = (size_t)DM * DM;
          pg8::gemm_phase(pg8::Gemm{p.obr, p.wt_br + (size_t)l * 3 * DM * DM, DM, DM, DM}, pg8::SchedOne{u}, pg8::EpiBr{p.a3, p.P}); }
      }
      TSTAMP(2);
#pragma unroll 1
      for (int j = bid - 64; j < 32 + 256; j += (bid < 96 ? 1000 : 160)) {
        PHASE_PARAMS(p);
        if (j < 32) dn_scan_item(p, l, 16 + (j >> 4), (j >> 1) & 7, j & 1); else { const int jj = j - 32; dn_scan_item(p, l, jj >> 4, (jj >> 1) & 7, jj & 1); }
      }
    }
    TSTAMP(3);
#define P3_TICKET(var) do { volatile __attribute__((address_space(3))) unsigned* qslot = (volatile __attribute__((address_space(3))) unsigned*)(smem + XB_LDS_OFF + 12); \
      __syncthreads(); \
      if (tid_opaque() == 0) { PHASE_PARAMS(pq); *qslot = __hip_atomic_fetch_add(pq.bar + 8192 + l * 8 + rep3 * 4 + 2, 1u, __ATOMIC_RELAXED, __HIP_MEMORY_SCOPE_AGENT); } \
      __syncthreads(); \
      var = __builtin_amdgcn_readfirstlane((int)*qslot); } while (0)
    int tk; P3_TICKET(tk);
#pragma unroll 1
    while (tk < 128) { { PHASE_PARAMS(p); attn_item(p, 64 + tk); } P3_TICKET(tk); }
#pragma unroll 1
    while (tk < 200) { const int itd = tk - 128 + 64;
      if (itd >= 32) { PHASE_PARAMS(p); const int k = itd - 32; pg8::Unit u; if (k < 8) { u.pm = 16 + k; u.pn = 37; } else { u.pm = (k - 8) % 24; u.pn = 42 + (k - 8) / 24; } u.z = 0; u.ka = 0; u.kb = 0;
        pg8::gemm_phase(pg8::Gemm{p.h, p.wt_in + (size_t)l * NPAD * DM, DM, DM, DM}, pg8::SchedOne{u}, pg8::EpiIn{p.P, p.small}); }
      else { PHASE_PARAMS(p); pg8::Unit u; u.pm = itd % 24; u.pn = itd / 24; u.z = 1; u.ka = (size_t)NTOK * DM; u.kb = (size_t)DM * DM;
        pg8::gemm_phase(pg8::Gemm{p.obr, p.wt_br + (size_t)l * 3 * DM * DM, DM, DM, DM}, pg8::SchedOne{u}, pg8::EpiBr{p.a3, p.P}); }
      P3_TICKET(tk);
    }
#pragma unroll 1
    while (tk < 264) { { PHASE_PARAMS(p); dn_finalize_item(p, l, tk - 200); } P3_TICKET(tk); }
#undef P3_TICKET
  }
#undef P3_PULL
  GRID_SYNC(); if (l == 1) TSTAMP(8);
  { PHASE_PARAMS(p); pg8::gemm_phase(pg8::Gemm{p.obr, p.wt_br + (size_t)l * 3 * DM * DM, DM, DM, DM}, pg8::SchedBr{nblk, bid}, pg8::EpiBr{p.a3, p.P}); }
#if REP & 8
  { PHASE_PARAMS(p); pg8::gemm_phase(pg8::Gemm{p.obr, p.wt_br + (size_t)l * 3 * DM * DM, DM, DM, DM}, pg8::SchedBr{nblk, bid}, pg8::EpiBr{p.a3, p.P}); }
#endif
  GRID_SYNC_WT(); if (l == 1) TSTAMP(9);
  { PHASE_PARAMS(p); pg8::gemm_phase(pg8::Gemm{p.a3, p.wt_out + (size_t)l * DM * 3072, 3072, 3072, 1536}, pg8::SchedSplit2<1536>{nblk, bid}, pg8::EpiPart{(bfr*)p.R}); }
  if (l + 1 < DEPTH && bid >= 192) { PHASE_PARAMS(p); for (int k = bid - 192; k < CONV_A; k += nblk - 192) convert_item(p, l + 1, k); }
#if REP & 16
  { PHASE_PARAMS(p); pg8::gemm_phase(pg8::Gemm{p.a3, p.wt_out + (size_t)l * DM * 3072, 3072, 3072, 1536}, pg8::SchedSplit2<1536>{nblk, bid}, pg8::EpiPart{(bfr*)p.R}); }
#endif
  GRID_SYNC_WT(); if (l == 1) TSTAMP(10);
  { PHASE_PARAMS(p); stage_row(p, l, 1, bid, nblk); }
  GRID_SYNC(); if (l == 1) TSTAMP(11);
  { PHASE_PARAMS(p); pg8::gemm_phase(pg8::Gemm{p.h, p.wt_up + (size_t)l * HID * DM, DM, DM, DM}, pg8::SchedUp{nblk, bid}, pg8::EpiUp{p.u2}); }
  if (l + 1 < DEPTH && bid >= 128) { PHASE_PARAMS(p); for (int k = CONV_A + bid - 128; k < CONV_B; k += 128) convert_item(p, l + 1, k); }
#if REP & 32
  { PHASE_PARAMS(p); pg8::gemm_phase(pg8::Gemm{p.h, p.wt_up + (size_t)l * HID * DM, DM, DM, DM}, pg8::SchedUp{nblk, bid}, pg8::EpiUp{p.u2}); }
#endif
  GRID_SYNC_WT(); if (l == 1) TSTAMP(12);
  { PHASE_PARAMS(p); pg8::gemm_phase(pg8::Gemm{p.u2, p.wt_dn + (size_t)l * DM * HID, HID, HID, 2048}, pg8::SchedSplit2<2048>{nblk, bid}, pg8::EpiPart{(bfr*)p.R}); }
  if (l + 1 < DEPTH && bid >= 192) { PHASE_PARAMS(p); for (int k = CONV_B + bid - 192; k < CONV_ITEMS; k += nblk - 192) convert_item(p, l + 1, k); }
  GRID_SYNC_WT(); if (l == 1) TSTAMP(13);
  { PHASE_PARAMS(p); stage_row(p, l, 2, bid, nblk); }
  if (l + 1 < DEPTH) GRID_SYNC(); if (l == 1) TSTAMP(14);
}

__global__ __launch_bounds__(512) void mega_kernel(Params p_arg) {
#if USE_CG_SYNC
  cg::grid_group grid = cg::this_grid();
#endif
  const int bid = blockIdx.x, nblk = gridDim.x;
#if !USE_CG_SYNC
  { PHASE_PARAMS(pb); xcd_barrier_post(pb.bar); }
  cg::this_grid().sync();
#endif
#ifdef DIAG_A
  if (threadIdx.x < 32) ((unsigned long long*)(smem + 163840 - 256))[threadIdx.x & 15] = 0ull;
  __syncthreads();
#endif
  { PHASE_PARAMS(p); stage_mod(p, bid, nblk, smem); }
#if REP & 8192
  { PHASE_PARAMS(p); stage_mod(p, bid, nblk, smem); }
#endif
  { PHASE_PARAMS(p); for (int it = bid; it < CONV_ITEMS; it += nblk) convert_item(p, 0, it); }
#if REP & 128
  { PHASE_PARAMS(p); for (int it = bid; it < CONV_ITEMS; it += nblk) convert_item(p, 0, it); }
#endif
  GRID_SYNC();
  { PHASE_PARAMS(p); stage_row(p, 0, 0, bid, nblk); }
#if REP & 16384
  { PHASE_PARAMS(p); stage_row(p, 0, 0, bid, nblk); }
#endif
  GRID_SYNC();
  run_layer<0>(bid, nblk); run_layer<1>(bid, nblk); run_layer<2>(bid, nblk); run_layer<3>(bid, nblk);
#ifdef DIAG_A
  __syncthreads();
  if (blockIdx.x == DIAG_BLK && threadIdx.x == 0) { const unsigned long long* ts_ = (const unsigned long long*)(smem + 163840 - 256); PHASE_PARAMS(pd); asm volatile("s_waitcnt vmcnt(0)" ::: "memory");
#ifdef DIAG_G
    const unsigned long long* gs_ = (const unsigned long long*)(pd.bar + 12288); const unsigned long long ta_ = __hip_atomic_load(gs_ + DIAG_A, __ATOMIC_RELAXED, __HIP_MEMORY_SCOPE_AGENT), tb_ = __hip_atomic_load(gs_ + DIAG_B, __ATOMIC_RELAXED, __HIP_MEMORY_SCOPE_AGENT);
    pd.xbuf[0] = 1000.0f * rintf(4.0f * log2f((float)(tb_ - ta_) * 10.0f));
#else
    pd.xbuf[(size_t)DIAG_BLK * 24 * 1024] = 1000.0f * rintf(4.0f * log2f((float)(ts_[DIAG_B] - ts_[DIAG_A]) * 10.0f));
#endif
  }
#endif
}

__global__ void diag_fill(float* out, long n, float v) { for (long i = blockIdx.x * 256L + threadIdx.x; i < n; i += gridDim.x * 256L) out[i] = (i == 0) ? v : 0.f; }
static size_t align_up(size_t x) { return (x + 255) & ~(size_t)255; }
static bool make_params(Params& p, void* const* d_in, void* d_out, void* d_ws, size_t ws_size) {
  const float** in = (const float**)d_in;
  p.x_prompt = in[0]; p.x_sample = in[1]; p.cache_k = in[2]; p.cache_v = in[3]; p.state_dn = in[4]; p.c = in[5]; p.c_ctx = in[6];
  p.w_mod = in[7]; p.b_mod = in[8]; p.g_pre_mix = in[9]; p.g_post_mix = in[10]; p.g_pre_mlp = in[11]; p.g_post_mlp = in[12];
  p.w_in = in[13]; p.w_conv_dn = in[14]; p.a_log = in[15]; p.dt_bias = in[16]; p.g_dn_out = in[17]; p.w_conv_sc = in[18];
  p.g_q = in[19]; p.g_k = in[20]; p.w_br_dn = in[21]; p.w_br_sc = in[22]; p.w_br_att = in[23]; p.w_out = in[24];
  p.w_mlp_up = in[25]; p.w_mlp_down = in[26];
  float* out = (float*)d_out;
  p.xbuf = out; p.out_ck = out + 6291456; p.out_cv = p.out_ck + 4194304; p.out_state = p.out_cv + 4194304;
  char* w = (char*)d_ws; size_t off = 0;
  auto take = [&](size_t bytes) { char* r = w + off; off = align_up(off + bytes); return r; };
  p.bar   = (unsigned*)take(65536);
  p.wt_in = (bfr*)take((size_t)DEPTH * NPAD * DM * 2);
  p.wt_br = (bfr*)take((size_t)DEPTH * 3 * DM * DM * 2);
  p.wt_out= (bfr*)take((size_t)DEPTH * DM * 3072 * 2);
  p.wt_up = (bfr*)take((size_t)DEPTH * HID * DM * 2);
  p.wt_dn = (bfr*)take((size_t)DEPTH * DM * HID * 2);
  p.mod   = (float*)take((size_t)DEPTH * 3 * 6144 * 4);
  p.h     = (bfr*)take((size_t)NTOK * DM * 2);
  p.P     = (bfr*)take((size_t)NTOK * NP * 2);
  p.u2    = p.P;
  p.small = (float*)take((size_t)NTOK * 32 * 4);
  p.dnrec = take((size_t)1536 * REC_BYTES);
  p.glast = (float*)take(1536 * 4);
  p.opart = (bfr*)take((size_t)2 * NTOK * DM * 2);
  p.obr   = (bfr*)take((size_t)3 * NTOK * DM * 2);
  p.Q     = (bfr*)take((size_t)NTOK * DM * 2);
  p.Kc    = (bfr*)take((size_t)NCTX * 256 * 2);
  p.Vc    = (bfr*)take((size_t)NCTX * 256 * 2);
  p.Ks    = (bfr*)take((size_t)2 * 1280 * 256 * 2);
  p.Vs    = (bfr*)take((size_t)2 * 1280 * 256 * 2);
  p.merged= (bfr*)take((size_t)NTOK * DM * 2);
  p.a3    = (bfr*)take((size_t)NTOK * 3072 * 2);
  p.R     = (float*)take((size_t)4 * NTOK * DM * 4);
  return off <= ws_size;
}
extern "C" void kernel_launch(void* const* d_in, const int* in_sizes, int n_in, void* d_out, int out_size, void* d_ws, size_t ws_size, hipStream_t stream) {
  Params p{};
  if (n_in != 27 || out_size != 31457280) { diag_fill<<<1024, 256, 0, stream>>>((float*)d_out, (long)out_size, 3.0e6f + n_in); return; }
  if (!make_params(p, d_in, d_out, d_ws, ws_size)) { diag_fill<<<1024, 256, 0, stream>>>((float*)d_out, (long)out_size, (float)(ws_size >> 20)); return; }
  static int grid_blocks = 0;
  if (!grid_blocks) {
    (void)hipFuncSetAttribute((const void*)mega_kernel, hipFuncAttributeMaxDynamicSharedMemorySize, DYN_LDS);
    int dev = 0, cus = 0, per_cu = 0;
    (void)hipGetDevice(&dev);
    (void)hipDeviceGetAttribute(&cus, hipDeviceAttributeMultiprocessorCount, dev);
    (void)hipOccupancyMaxActiveBlocksPerMultiprocessor(&per_cu, mega_kernel, 512, DYN_LDS);
    grid_blocks = (per_cu >= 1 && cus >= 256) ? 256 : cus * per_cu;
    if (grid_blocks <= 0) { fprintf(stderr, "kernel_launch: occupancy query gave cus %d per_cu %d\n", cus, per_cu); grid_blocks = 0; return; }
  }
  (void)hipMemsetAsync(p.bar, 0, 65536, stream);
  void* args[] = {&p};
  const hipError_t e = hipLaunchCooperativeKernel((void*)mega_kernel, dim3(grid_blocks), dim3(512), args, DYN_LDS, stream);
  if (e != hipSuccess) fprintf(stderr, "cooperative launch failed: %s (grid %d)\n", hipGetErrorString(e), grid_blocks);
}
```

```cpp
#define USE_CG_SYNC 0
#include <hip/hip_runtime.h>
#include <hip/hip_bf16.h>
#include <hip/hip_cooperative_groups.h>
#include <cstdio>
#include <cstdint>
namespace cg = cooperative_groups;

typedef unsigned short bfr;
using bf16x8 = __attribute__((ext_vector_type(8))) short;
using s16x4  = __attribute__((ext_vector_type(4))) short;
using f32x4  = __attribute__((ext_vector_type(4))) float;
using f32x16 = __attribute__((ext_vector_type(16))) float;
using u32x4  = __attribute__((ext_vector_type(4))) unsigned;
using u32x2  = __attribute__((ext_vector_type(2))) unsigned;

extern __shared__ __attribute__((aligned(16))) char smem[];
__device__ __forceinline__ char* smem_base() { return smem; }
constexpr int DM = 1024, NTOK = 6144, NCTX = 4096, DEPTH = 4;
constexpr int NIN = 11808;
constexpr int NP = 11776;
constexpr int NPAD = 12032;
constexpr int HID = 4096;
constexpr float EPS = 1e-6f;
constexpr int C_DQ = 0, C_DK = 1024, C_DV = 2048, C_DG = 3072, C_SB = 4096, C_SCG = 5120, C_SX = 6144,
              C_AQ = 7168, C_AK = 8192, C_AV = 8448, C_MG = 8704;

constexpr int REC_U = 0, REC_W = 16384, REC_QD = 32768, REC_QK = 49152, REC_KD = 57344, REC_BYTES = 73728;

struct Params {
  const float *x_prompt, *x_sample, *cache_k, *cache_v, *state_dn, *c, *c_ctx, *w_mod, *b_mod;
  const float *g_pre_mix, *g_post_mix, *g_pre_mlp, *g_post_mlp, *w_in, *w_conv_dn, *a_log, *dt_bias, *g_dn_out;
  const float *w_conv_sc, *g_q, *g_k, *w_br_dn, *w_br_sc, *w_br_att, *w_out, *w_mlp_up, *w_mlp_down;
  float *xbuf;
  float *out_ck, *out_cv, *out_state;
  bfr *wt_in, *wt_br, *wt_out, *wt_up, *wt_dn;
  float *mod;
  bfr *h;
  bfr *P;
  float *small;
  char *dnrec;
  float *glast;
  bfr *opart;
  bfr *obr;
  bfr *Q;
  bfr *Kc, *Vc;
  bfr *Ks, *Vs;
  bfr *merged;
  bfr *a3;
  float *R;
  bfr *u2;
  unsigned *bar;
};

__device__ __forceinline__ bfr f2bf(float f) { unsigned u = __float_as_uint(f); u += 0x7fffu + ((u >> 16) & 1u); return (bfr)(u >> 16); }
__device__ __forceinline__ float bf2f(bfr b) { return __uint_as_float(((unsigned)b) << 16); }
__device__ __forceinline__ unsigned pack2(float a, float b) { return (unsigned)f2bf(a) | ((unsigned)f2bf(b) << 16); }
__device__ __forceinline__ unsigned pack2hw(float a, float b) { unsigned r; asm("v_cvt_pk_bf16_f32 %0, %1, %2" : "=v"(r) : "v"(a), "v"(b)); return r; }
__device__ __forceinline__ float sigmoidf_(float x) { return 1.f / (1.f + __expf(-x)); }
__device__ __forceinline__ float siluf_(float x) { return x * __builtin_amdgcn_rcpf(1.f + __expf(-x)); }
__device__ __forceinline__ float softplusf_(float x) { return x > 20.f ? x : log1pf(__expf(x)); }

__device__ __forceinline__ int tok_modrow(int t) { return t < NCTX ? 0 : 1 + ((t - NCTX) >> 10); }
__device__ __forceinline__ int tok_L(int t) { return t < NCTX ? 256 : 1024; }
__device__ __forceinline__ int tok_pos(int t) { return t < NCTX ? (t & 255) : ((t - NCTX) & 1023); }

__host__ __device__ __forceinline__ int perm_col(int n) { return n < 4096 ? n : (n < 4128 ? NP + (n - 4096) : n - 32); }

__device__ __forceinline__ int tid_opaque() { int t = threadIdx.x; asm volatile("" : "+v"(t)); return t; }

#ifdef DIAG_A
#ifndef DIAG_BLK
#define DIAG_BLK 0
#endif
#define TSTAMP(k) do { if (blockIdx.x == DIAG_BLK && threadIdx.x == 0) { unsigned long long* ts_ = (unsigned long long*)(smem_base() + 163840 - 256); if (ts_[(k)] == 0ull) ts_[(k)] = wall_clock64(); } } while (0)
#else
#define TSTAMP(k) do {} while (0)
#endif

#ifdef DIAG_A
#define GSTAMP(bar, k) do { if (threadIdx.x == 0) __hip_atomic_store((unsigned long long*)((bar) + 12288) + (k), (unsigned long long)wall_clock64(), __ATOMIC_RELAXED, __HIP_MEMORY_SCOPE_AGENT); } while (0)
#else
#define GSTAMP(bar, k) do {} while (0)
#endif

#ifdef DIAG_G
#define GMAX(bar, k) do { if (threadIdx.x == 0) __hip_atomic_fetch_max((unsigned long long*)((bar) + 12288) + (k), (unsigned long long)wall_clock64(), __ATOMIC_RELAXED, __HIP_MEMORY_SCOPE_AGENT); } while (0)
#else
#define GMAX(bar, k) do {} while (0)
#endif
#define NTHR 512

__device__ __forceinline__ void stage_mod(const Params& p, int item0, int nitems, int w, int nw, char* lds) {
  float* s = (float*)lds;
  float* red = s + 3072;
  const int tid = tid_opaque();
  for (int i = tid; i < 3072; i += NTHR) { int j = i >> 10, k = i & 1023; float c = (j == 0) ? p.c_ctx[k] : p.c[(j - 1) * 1024 + k]; s[i] = siluf_(c); }
  __syncthreads();
  for (int item = item0 + w; item < item0 + nitems; item += nw) {
    const int l = item / 48, nb = item % 48, cq = tid & 31, ks = tid >> 5;
    const float* W = p.w_mod + ((size_t)l * 1024 + ks * 64) * 6144 + nb * 128 + cq * 4;
    float a[3][4] = {};
    for (int k = 0; k < 64; ++k) {
      const float4 w = *(const float4*)(W + (size_t)k * 6144);
#pragma unroll
      for (int j = 0; j < 3; ++j) { const float sv = s[j * 1024 + ks * 64 + k]; a[j][0] += sv * w.x; a[j][1] += sv * w.y; a[j][2] += sv * w.z; a[j][3] += sv * w.w; }
    }
    __syncthreads();
#pragma unroll
    for (int j = 0; j < 3; ++j)
#pragma unroll
      for (int q = 0; q < 4; ++q) red[(ks * 3 + j) * 128 + cq * 4 + q] = a[j][q];
    __syncthreads();
    if (tid < 384) { const int j = tid >> 7, n = tid & 127; float sum = 0; for (int q = 0; q < 16; ++q) sum += red[(q * 3 + j) * 128 + n];
      p.mod[(size_t)(l * 3 + j) * 6144 + nb * 128 + n] = sum + p.b_mod[l * 6144 + nb * 128 + n]; }
  }
  __syncthreads();
}

__device__ __forceinline__ float wave_sum(float v) {
#pragma unroll
  for (int o = 32; o > 0; o >>= 1) v += __shfl_xor(v, o);
  return v;
}

template <int NR>
__device__ __forceinline__ void rows_at(const Params& p, int l, int mode, int row0, int lane) {
  float4 x[NR][4], r[NR][4];
#pragma unroll
  for (int j = 0; j < NR; ++j) {
    const int row = row0 + j;
    if (l == 0 && mode <= 1) {
      const float* xin = row < NCTX ? p.x_prompt + (size_t)row * DM : p.x_sample + (size_t)(row - NCTX) * DM;
#pragma unroll
      for (int i = 0; i < 4; ++i) x[j][i] = *(const float4*)(xin + lane * 4 + 256 * i);
    } else {
      const bfr* xin = p.merged + (size_t)row * DM;
#pragma unroll
      for (int i = 0; i < 4; ++i) { const u32x2 a = *(const u32x2*)(xin + lane * 4 + 256 * i);
        x[j][i] = make_float4(__uint_as_float(a[0] << 16), __uint_as_float(a[0] & 0xffff0000u), __uint_as_float(a[1] << 16), __uint_as_float(a[1] & 0xffff0000u)); }
    }
    if (mode != 0) {
      const bfr* rr = (const bfr*)p.R + (size_t)row * DM;
#pragma unroll
      for (int i = 0; i < 4; ++i) { const u32x2 a = *(const u32x2*)(rr + lane * 4 + 256 * i), b = *(const u32x2*)(rr + (size_t)NTOK * DM + lane * 4 + 256 * i);
        r[j][i] = make_float4(__uint_as_float(a[0] << 16) + __uint_as_float(b[0] << 16), __uint_as_float(a[0] & 0xffff0000u) + __uint_as_float(b[0] & 0xffff0000u),
                              __uint_as_float(a[1] << 16) + __uint_as_float(b[1] << 16), __uint_as_float(a[1] & 0xffff0000u) + __uint_as_float(b[1] & 0xffff0000u)); }
    }
  }
  if (mode != 0) {
    const float* gpost = (mode == 1 ? p.g_post_mix : p.g_post_mlp) + l * DM;
    float4 g[4];
#pragma unroll
    for (int i = 0; i < 4; ++i) g[i] = *(const float4*)(gpost + lane * 4 + 256 * i);
#pragma unroll
    for (int j = 0; j < NR; ++j) {
      const int row = row0 + j;
      const float* gate = p.mod + (size_t)(l * 3 + tok_modrow(row)) * 6144 + (mode == 1 ? 2048 : 5120);
      float ss = 0;
#pragma unroll
      for (int i = 0; i < 4; ++i) ss += r[j][i].x * r[j][i].x + r[j][i].y * r[j][i].y + r[j][i].z * r[j][i].z + r[j][i].w * r[j][i].w;
      ss = wave_sum(ss);
      const float nrm = rsqrtf(ss * (1.f / DM) + EPS);
#pragma unroll
      for (int i = 0; i < 4; ++i) {
        const float4 gt = *(const float4*)(gate + lane * 4 + 256 * i);
        x[j][i].x += gt.x * (r[j][i].x * nrm * g[i].x); x[j][i].y += gt.y * (r[j][i].y * nrm * g[i].y); x[j][i].z += gt.z * (r[j][i].z * nrm * g[i].z); x[j][i].w += gt.w * (r[j][i].w * nrm * g[i].w);
        if (mode == 2 && l == DEPTH - 1) *(float4*)(p.xbuf + (size_t)row * DM + lane * 4 + 256 * i) = x[j][i];
        else { u32x2 o = {pack2hw(x[j][i].x, x[j][i].y), pack2hw(x[j][i].z, x[j][i].w)}; *(u32x2*)(p.merged + (size_t)row * DM + lane * 4 + 256 * i) = o; }
      }
    }
  }
  if (mode == 2 && l == DEPTH - 1) return;
  const int ln = (mode == 2) ? l + 1 : l;
  const float* gpre = (mode == 1 ? p.g_pre_mlp : p.g_pre_mix) + ln * DM;
  float4 gp[4];
#pragma unroll
  for (int i = 0; i < 4; ++i) gp[i] = *(const float4*)(gpre + lane * 4 + 256 * i);
#pragma unroll
  for (int j = 0; j < NR; ++j) {
    const int row = row0 + j;
    const float* modn = p.mod + (size_t)(ln * 3 + tok_modrow(row)) * 6144;
    const float* sh = modn + (mode == 1 ? 3072 : 0);
    const float* sc = modn + (mode == 1 ? 4096 : 1024);
    float ss = 0;
#pragma unroll
    for (int i = 0; i < 4; ++i) ss += x[j][i].x * x[j][i].x + x[j][i].y * x[j][i].y + x[j][i].z * x[j][i].z + x[j][i].w * x[j][i].w;
    ss = wave_sum(ss);
    const float nrm = rsqrtf(ss * (1.f / DM) + EPS);
#pragma unroll
    for (int i = 0; i < 4; ++i) {
      const float4 s1 = *(const float4*)(sc + lane * 4 + 256 * i), s0 = *(const float4*)(sh + lane * 4 + 256 * i);
      const float h0 = x[j][i].x * nrm * gp[i].x * (1.f + s1.x) + s0.x, h1 = x[j][i].y * nrm * gp[i].y * (1.f + s1.y) + s0.y;
      const float h2 = x[j][i].z * nrm * gp[i].z * (1.f + s1.z) + s0.z, h3 = x[j][i].w * nrm * gp[i].w * (1.f + s1.w) + s0.w;
      u32x2 o = {pack2hw(h0, h1), pack2hw(h2, h3)};
      *(u32x2*)(p.h + (size_t)row * DM + lane * 4 + 256 * i) = o;
    }
  }
}

__device__ __forceinline__ void stage_row(const Params& p, int l, int mode, int bid, int nblk) {
  const int tx_ = tid_opaque(), wid = tx_ >> 6, lane = tx_ & 63;
  const int row0 = (bid * 8 + wid) * 3;
  if (row0 >= NTOK) return;
  rows_at<3>(p, l, mode, row0, lane);
}

__device__ __forceinline__ void unpack8(const u32x4 v, float* f) {
#pragma unroll
  for (int i = 0; i < 4; ++i) { f[2 * i] = __uint_as_float(v[i] << 16); f[2 * i + 1] = __uint_as_float(v[i] & 0xffff0000u); }
}
__device__ __forceinline__ u32x4 pack8(const float* f) { u32x4 v = {pack2(f[0], f[1]), pack2(f[2], f[3]), pack2(f[4], f[5]), pack2(f[6], f[7])}; return v; }
__device__ __forceinline__ u32x4 pack8hw(const float* f) { u32x4 v = {pack2hw(f[0], f[1]), pack2hw(f[2], f[3]), pack2hw(f[4], f[5]), pack2hw(f[6], f[7])}; return v; }

__device__ __forceinline__ void light_prep_item(const Params& p, int l, int item) {
  const int tid = tid_opaque(), t0 = item * 16;
  const bool samp = t0 >= NCTX;
  {
    const float* wsc = p.w_conv_sc + (size_t)l * 3 * DM;
    bfr* scin = p.obr + (size_t)1 * NTOK * DM;
    const int g = tid & 127, rq = tid >> 7, r0 = rq * 4, tA = t0 + r0, posA = tok_pos(tA), L = tok_L(tA);
    u32x4 cg[6], cx[6], sbv[4];
#pragma unroll
    for (int k = 0; k < 6; ++k) {
      const int pos = posA + k - 1;
      cg[k] = u32x4{0u, 0u, 0u, 0u}; cx[k] = u32x4{0u, 0u, 0u, 0u};
      if (pos >= 0 && pos < L) { const bfr* row = p.P + (size_t)(tA + k - 1) * NP; cg[k] = *(const u32x4*)(row + C_SCG + g * 8); cx[k] = *(const u32x4*)(row + C_SX + g * 8); }
    }
#pragma unroll
    for (int r = 0; r < 4; ++r) sbv[r] = *(const u32x4*)(p.P + (size_t)(tA + r) * NP + C_SB + g * 8);
    float w[3][8];
#pragma unroll
    for (int k = 0; k < 3; ++k) { *(float4*)&w[k][0] = *(const float4*)(wsc + k * DM + g * 8); *(float4*)&w[k][4] = *(const float4*)(wsc + k * DM + g * 8 + 4); }
    float prod[6][8];
#pragma unroll
    for (int k = 0; k < 6; ++k) { float a[8], b[8]; unpack8(cg[k], a); unpack8(cx[k], b);
#pragma unroll
      for (int q = 0; q < 8; ++q) prod[k][q] = a[q] * b[q]; }
#pragma unroll
    for (int r = 0; r < 4; ++r) {
      float sb[8], acc[8]; unpack8(sbv[r], sb);
#pragma unroll
      for (int q = 0; q < 8; ++q) acc[q] = sb[q] * (w[0][q] * prod[r][q] + w[1][q] * prod[r + 1][q] + w[2][q] * prod[r + 2][q]);
      *(u32x4*)(scin + (size_t)(tA + r) * DM + g * 8) = pack8hw(acc);
    }
  }
  {
    const int sub = tid & 15;
    u32x4 xin[5];
#pragma unroll
    for (int it5 = 0; it5 < 5; ++it5) {
      const int pr = (tid >> 4) + it5 * 32, r = pr / 10, hh = pr % 10, t = t0 + r;
      xin[it5] = *(const u32x4*)(p.P + (size_t)t * NP + (hh < 8 ? C_AQ + hh * 128 : C_AK + (hh - 8) * 128) + sub * 8);
    }
#pragma unroll
    for (int it5 = 0; it5 < 5; ++it5) {
      const int pr = (tid >> 4) + it5 * 32;
      const int r = pr / 10, hh = pr % 10, t = t0 + r;
      const bool isq = hh < 8;
      float x[8]; unpack8(xin[it5], x);
      float ss = 0;
#pragma unroll
      for (int q = 0; q < 8; ++q) ss += x[q] * x[q];
      ss += __shfl_xor(ss, 1); ss += __shfl_xor(ss, 2); ss += __shfl_xor(ss, 4); ss += __shfl_xor(ss, 8);
      const float nrm = rsqrtf(ss * (1.f / 128.f) + EPS);
      const float* g = (isq ? p.g_q : p.g_k) + l * 128 + sub * 8;
#pragma unroll
      for (int q = 0; q < 8; ++q) x[q] = x[q] * nrm * g[q];
      if (samp) {
        const int pos = tok_pos(t);
        const float pidx = (sub < 8) ? (float)(pos >> 6) : (float)(pos & 63);
        const int s8 = sub & 7;
        const bool lo = s8 < 4;
        float y[8];
#pragma unroll
        for (int q = 0; q < 8; ++q) {
          const float other = __shfl_xor(x[q], 4);
          const int fi = (s8 & 3) * 8 + q;
          const float freq = exp2f(-(float)fi * (13.287712379549449f / 32.f));
          const float ang = pidx * freq;
          float sn, cs; __sincosf(ang, &sn, &cs);
          y[q] = lo ? (x[q] * cs - other * sn) : (other * sn + x[q] * cs);
        }
#pragma unroll
        for (int q = 0; q < 8; ++q) x[q] = y[q];
      }
      if (isq) {
        *(u32x4*)(p.Q + (size_t)t * DM + hh * 128 + sub * 8) = pack8hw(x);
      } else {
        const int kvh = hh - 8;
        if (!samp) {
          *(u32x4*)(p.Kc + (size_t)t * 256 + kvh * 128 + sub * 8) = pack8hw(x);
          const int b = t >> 8, pos = t & 255;
          float* o = p.out_ck + ((((size_t)b * DEPTH + l) * 256 + pos) * 2 + kvh) * 128 + sub * 8;
          *(float4*)o = make_float4(x[0], x[1], x[2], x[3]); *(float4*)(o + 4) = make_float4(x[4], x[5], x[6], x[7]);
        } else {
          const int s = t - NCTX, b = s >> 10, pos = s & 1023;
          *(u32x4*)(p.Ks + ((size_t)b * 1280 + 256 + pos) * 256 + kvh * 128 + sub * 8) = pack8hw(x);
        }
      }
    }
  }
  for (int idx = tid; idx < 16 * 32; idx += NTHR) {
    const int r = idx >> 5, g = idx & 31, t = t0 + r;
    const u32x4 v = *(const u32x4*)(p.P + (size_t)t * NP + C_AV + g * 8);
    if (!samp) {
      *(u32x4*)(p.Vc + (size_t)t * 256 + g * 8) = v;
      float f[8]; unpack8(v, f);
      const int b = t >> 8, pos = t & 255;
      float* o = p.out_cv + (((size_t)b * DEPTH + l) * 256 + pos) * 256 + g * 8;
      *(float4*)o = make_float4(f[0], f[1], f[2], f[3]); *(float4*)(o + 4) = make_float4(f[4], f[5], f[6], f[7]);
    } else {
      const int s = t - NCTX, b = s >> 10, pos = s & 1023;
      *(u32x4*)(p.Vs + ((size_t)b * 1280 + 256 + pos) * 256 + g * 8) = v;
    }
  }
  if (samp) {
    const int cs = item - 256, b = cs >> 6, pos0 = (cs & 63) * 4;
    for (int idx = tid; idx < 2 * 4 * 32; idx += NTHR) {
      const int which = idx >> 7, r = (idx >> 5) & 3, g = idx & 31, pos = pos0 + r;
      const float* src = (which ? p.cache_v : p.cache_k) + (((size_t)b * DEPTH + l) * 256 + pos) * 256 + g * 8;
      float f[8]; *(float4*)f = *(const float4*)src; *(float4*)(f + 4) = *(const float4*)(src + 4);
      *(u32x4*)((which ? p.Vs : p.Ks) + ((size_t)b * 1280 + pos) * 256 + g * 8) = pack8hw(f);
    }
  }
}

__device__ __forceinline__ void dn_finalize(const Params& p, int l, int t0, int n, int h, int tid0, int nthr) {
  const int sub = tid0 & 15, rpp = nthr / 16;
  const float* g = p.g_dn_out + l * 128 + sub * 8;
  float gv[8];
#pragma unroll
  for (int q = 0; q < 8; ++q) gv[q] = g[q];
  for (int r = tid0 >> 4; r < n; r += rpp * 4) {
    u32x4 va[4], vb[4], vg[4];
#pragma unroll
    for (int u = 0; u < 4; ++u) {
      const int t = t0 + r + u * rpp;
      va[u] = *(const u32x4*)(p.opart + (size_t)t * DM + h * 128 + sub * 8);
      vb[u] = *(const u32x4*)(p.opart + (size_t)NTOK * DM + (size_t)t * DM + h * 128 + sub * 8);
      vg[u] = *(const u32x4*)(p.P + (size_t)t * NP + C_DG + h * 128 + sub * 8);
    }
#pragma unroll
    for (int u = 0; u < 4; ++u) {
      const int t = t0 + r + u * rpp;
      float a[8], b[8], dg[8];
      unpack8(va[u], a); unpack8(vb[u], b); unpack8(vg[u], dg);
      float ss = 0;
#pragma unroll
      for (int q = 0; q < 8; ++q) { a[q] += b[q]; ss += a[q] * a[q]; }
      ss += __shfl_xor(ss, 1); ss += __shfl_xor(ss, 2); ss += __shfl_xor(ss, 4); ss += __shfl_xor(ss, 8);
      const float nrm = rsqrtf(ss * (1.f / 128.f) + EPS);
#pragma unroll
      for (int q = 0; q < 8; ++q) a[q] = a[q] * nrm * gv[q] * siluf_(dg[q]);
      *(u32x4*)(p.obr + (size_t)t * DM + h * 128 + sub * 8) = pack8hw(a);
    }
  }
}
constexpr int HT_BYTES = 128 * 64 * 2;

__device__ __forceinline__ int lds_byte(int r, int c) {
  int st = (r >> 4) * 2 + (c >> 5), rr = r & 15, cc = c & 31, ob = rr * 64 + cc * 2;
  return st * 1024 + (ob ^ (((ob >> 9) & 1) << 5));
}
__device__ __forceinline__ void stage_rc(int b, int& R, int& C) {
  int st = b / 1024, sb = b % 1024, swz = sb ^ (((sb >> 9) & 1) << 5);
  R = (st >> 1) * 16 + swz / 64; C = (st & 1) * 32 + (swz % 64) / 2;
}
__device__ __forceinline__ void stage_half(const bfr* G, long ld, int row0, int k0, int loff, int tx) {
#pragma unroll
  for (int i = 0; i < 2; ++i) {
    const int b = tx * 16 + i * 8192; int r, c; stage_rc(b, r, c);
    __builtin_amdgcn_global_load_lds((const unsigned*)(G + (long)(row0 + r) * ld + k0 + c), (__attribute__((address_space(3))) unsigned*)(smem + loff + b), 16, 0, 0);
  }
}

template <int NB, class AccT>
__device__ __forceinline__ void gemm_mainloop(const bfr* A, long lda, const bfr* Bt, long ldb, int K, int brow, int bcol, AccT& acc, int tx) {
  const int wid = tx >> 6, lane = tx & 63, wr = wid >> 2, wc = wid & 3, fr = lane & 15, fq = lane >> 4;
  constexpr int STG = (2 + NB) * HT_BYTES;
  const int nt = K / 64;
  auto stage = [&](int s, int kt) {
    stage_half(A, lda, brow, kt * 64, s * STG, tx);
    stage_half(A, lda, brow + 128, kt * 64, s * STG + HT_BYTES, tx);
#pragma unroll
    for (int j = 0; j < NB; ++j) stage_half(Bt, ldb, bcol + j * 128, kt * 64, s * STG + (2 + j) * HT_BYTES, tx);
  };
  stage(0, 0);
  asm volatile("s_waitcnt vmcnt(0)" ::: "memory");
  __syncthreads();
  for (int t = 0; t < nt; ++t) {
    const int s = t & 1;
    if (t + 1 < nt) stage(s ^ 1, t + 1);
    const char* base = smem + s * STG;
    bf16x8 Bf[NB][2][2];
#pragma unroll
    for (int j = 0; j < NB; ++j)
#pragma unroll
      for (int n = 0; n < 2; ++n)
#pragma unroll
        for (int k = 0; k < 2; ++k) Bf[j][n][k] = *(const bf16x8*)(base + (2 + j) * HT_BYTES + lds_byte(wc * 32 + n * 16 + fr, k * 32 + fq * 8));
#pragma unroll
    for (int ai = 0; ai < 2; ++ai) {
      bf16x8 Af[4][2];
#pragma unroll
      for (int m = 0; m < 4; ++m)
#pragma unroll
        for (int k = 0; k < 2; ++k) Af[m][k] = *(const bf16x8*)(base + ai * HT_BYTES + lds_byte(wr * 64 + m * 16 + fr, k * 32 + fq * 8));
#pragma unroll
      for (int j = 0; j < NB; ++j)
#pragma unroll
        for (int m = 0; m < 4; ++m)
#pragma unroll
          for (int n = 0; n < 2; ++n)
#pragma unroll
            for (int k = 0; k < 2; ++k) acc.a[ai][j][m][n] = __builtin_amdgcn_mfma_f32_16x16x32_bf16(Af[m][k], Bf[j][n][k], acc.a[ai][j][m][n], 0, 0, 0);
    }
    asm volatile("s_waitcnt vmcnt(0)" ::: "memory");
    __syncthreads();
  }
}
template <int NB> struct Acc { f32x4 a[2][NB][4][2]; };
template <int NB> __device__ __forceinline__ void acc_zero(Acc<NB>& acc) {
#pragma unroll
  for (int ai = 0; ai < 2; ++ai)
#pragma unroll
    for (int j = 0; j < NB; ++j)
#pragma unroll
      for (int m = 0; m < 4; ++m)
#pragma unroll
        for (int n = 0; n < 2; ++n) acc.a[ai][j][m][n] = f32x4{0.f, 0.f, 0.f, 0.f};
}
template <int NB, class F> __device__ __forceinline__ void acc_foreach(Acc<NB>& acc, int brow, int bcol, int tx, F f) {
  const int wid = tx >> 6, lane = tx & 63, wr = wid >> 2, wc = wid & 3, fr = lane & 15, fq = lane >> 4;
#pragma unroll
  for (int ai = 0; ai < 2; ++ai)
#pragma unroll
    for (int j = 0; j < NB; ++j)
#pragma unroll
      for (int m = 0; m < 4; ++m)
#pragma unroll
        for (int n = 0; n < 2; ++n)
#pragma unroll
          for (int q = 0; q < 4; ++q) f(brow + ai * 128 + wr * 64 + m * 16 + fq * 4 + q, bcol + j * 128 + wc * 32 + n * 16 + fr, acc.a[ai][j][m][n][q]);
}

template <class MapF>
__device__ __forceinline__ void convert_tile(const float* W, int N, int kt, int ntile, bfr* dst, int ldd, MapF mapf, int ncopy = 1, int cstride = 0) {
  float* tile = (float*)smem;
  const int tid = tid_opaque();
  __syncthreads();
  float4 v[8];
#pragma unroll
  for (int pass = 0; pass < 8; ++pass) {
    const int idx = tid + pass * 512, kr = idx >> 6, c4 = idx & 63, n = ntile * 256 + c4 * 4;
    v[pass] = make_float4(0.f, 0.f, 0.f, 0.f);
    if (n < N) v[pass] = *(const float4*)(W + (size_t)(kt * 64 + kr) * N + n);
  }
#pragma unroll
  for (int pass = 0; pass < 8; ++pass) {
    const int idx = tid + pass * 512, kr = idx >> 6, c4 = idx & 63;
    tile[kr * 257 + c4 * 4 + 0] = v[pass].x; tile[kr * 257 + c4 * 4 + 1] = v[pass].y; tile[kr * 257 + c4 * 4 + 2] = v[pass].z; tile[kr * 257 + c4 * 4 + 3] = v[pass].w;
  }
  __syncthreads();
#pragma unroll
  for (int rep = 0; rep < 4; ++rep) {
    const int nn = (tid >> 3) + rep * 64, kg = tid & 7, n = ntile * 256 + nn;
    if (n < N) {
      float f[8];
#pragma unroll
      for (int j = 0; j < 8; ++j) f[j] = tile[(kg * 8 + j) * 257 + nn];
      const u32x4 pk = pack8hw(f);
      for (int cp = 0; cp < ncopy; ++cp) *(u32x4*)(dst + (size_t)mapf(n) * ldd + cp * cstride + kt * 64 + kg * 8) = pk;
    }
  }
}
constexpr int CONV_ITEMS = 1576;
__device__ __forceinline__ void convert_item(const Params& p, int l, int it) {
  if (it < 752) { const int kt = it / 47, nt = it % 47; convert_tile(p.w_in + (size_t)l * DM * NIN, NIN, kt, nt, p.wt_in + (size_t)l * NPAD * DM, DM, [](int n) { return perm_col(n); }); }
  else if (it < 944) { const int j = it - 752, br = j >> 6, kt = (j >> 2) & 15, nt = j & 3;
    const float* W = p.w_br_dn; if (br == 1) W = p.w_br_sc; if (br == 2) W = p.w_br_att; W += (size_t)l * DM * DM;
    convert_tile(W, DM, kt, nt, p.wt_br + ((size_t)l * 3 + br) * DM * DM, DM, [](int n) { return n; }); }
  else if (it < 1008) { const int j = it - 944, kt = j >> 2, nt = j & 3; convert_tile(p.w_out + (size_t)l * DM * DM, DM, kt, nt, p.wt_out + (size_t)l * DM * 3072, 3072, [](int n) { return n; }, 3, 1024); }
  else if (it < 1264) { const int j = it - 1008, kt = j >> 4, nt = j & 15; convert_tile(p.w_mlp_up + (size_t)l * DM * HID, HID, kt, nt, p.wt_up + (size_t)l * HID * DM, DM, [](int n) { return n; }); }
  else if (it < 1520) { const int j = it - 1264, kt = j >> 2, nt = j & 3; convert_tile(p.w_mlp_down + (size_t)l * HID * DM, DM, kt, nt, p.wt_dn + (size_t)l * DM * HID, HID, [](int n) { return n; }); }
  else { const int j = it - 1520;
    bfr* d = p.wt_in + ((size_t)l * NPAD + NP + 32 + j * 4) * DM;
    *(u32x4*)(d + tid_opaque() * 8) = u32x4{0u, 0u, 0u, 0u}; }
}

__device__ __forceinline__ void gemm_in_tile(const Params& p, int l, int tile) {
  const int mt = tile % 24, nt = tile / 24, brow = mt * 256, bcol = nt * 256;
  const int tx = tid_opaque(); Acc<2> acc; acc_zero(acc);
  gemm_mainloop<2>(p.h, DM, p.wt_in + (size_t)l * NPAD * DM, DM, DM, brow, bcol, acc, tx);
  if (nt < 34) acc_foreach(acc, brow, bcol, tx, [&](int r, int c, float v) { p.P[(size_t)r * NP + c] = f2bf(v); });
  else if (nt < 46) acc_foreach(acc, brow, bcol, tx, [&](int r, int c, float v) { p.P[(size_t)r * NP + c] = f2bf(sigmoidf_(v)); });
  else acc_foreach(acc, brow, bcol, tx, [&](int r, int c, float v) { if (c < NP + 32) p.small[(size_t)r * 32 + (c - NP)] = v; });
}
__device__ __forceinline__ void gemm_up_tile(const Params& p, int l, int tile) {
  const int mt = tile % 24, nt = tile / 24, brow = mt * 256, bcol = nt * 256;
  const int tx = tid_opaque(); Acc<2> acc; acc_zero(acc);
  gemm_mainloop<2>(p.h, DM, p.wt_up + (size_t)l * HID * DM, DM, DM, brow, bcol, acc, tx);
  acc_foreach(acc, brow, bcol, tx, [&](int r, int c, float v) { const float x = fmaxf(v, 0.f); p.u2[(size_t)r * HID + c] = f2bf(x * x); });
}
__device__ __forceinline__ void gemm_out_tile(const Params& p, int l, int tile) {
  const int mt = tile % 24, nt = tile / 24, brow = mt * 256, bcol = nt * 128;
  const int tx = tid_opaque(); Acc<1> acc; acc_zero(acc);
  gemm_mainloop<1>(p.merged, DM, p.wt_out + (size_t)l * DM * DM, DM, DM, brow, bcol, acc, tx);
  acc_foreach(acc, brow, bcol, tx, [&](int r, int c, float v) { p.R[(size_t)r * DM + c] = v; });
}
__device__ __forceinline__ void gemm_down_tile(const Params& p, int l, int tile) {
  const int mt = tile % 24, nt = tile / 24, brow = mt * 256, bcol = nt * 128;
  const int tx = tid_opaque(); Acc<1> acc; acc_zero(acc);
  gemm_mainloop<1>(p.u2, HID, p.wt_dn + (size_t)l * DM * HID, HID, HID, brow, bcol, acc, tx);
  acc_foreach(acc, brow, bcol, tx, [&](int r, int c, float v) { p.R[(size_t)r * DM + c] = v; });
}
__device__ __forceinline__ void gemm_br_tile(const Params& p, int l, int tile) {
  const int mt = tile % 24, nt = tile / 24, brow = mt * 256, bcol = nt * 128;
  const int tx = tid_opaque(); Acc<1> tot; acc_zero(tot);
#pragma unroll 1
  for (int br = 0; br < 3; ++br) {
    Acc<1> acc; acc_zero(acc);
    gemm_mainloop<1>(p.obr + (size_t)br * NTOK * DM, DM, p.wt_br + ((size_t)l * 3 + br) * DM * DM, DM, DM, brow, bcol, acc, tx);
    const bfr* G = p.P + C_MG + br * DM;
    const int wid = tx >> 6, lane = tx & 63, wr = wid >> 2, wc = wid & 3, fr = lane & 15, fq = lane >> 4;
    const bfr* Gl = G + (size_t)(brow + wr * 64 + fq * 4) * NP + bcol + wc * 32 + fr;
#pragma unroll
    for (int ai = 0; ai < 2; ++ai)
#pragma unroll
      for (int m = 0; m < 4; ++m) {
        const bfr* Gm = Gl + (size_t)(ai * 128 + m * 16) * NP;
        asm volatile("" : "+v"(Gm) :: "memory");
#pragma unroll
        for (int n = 0; n < 2; ++n)
#pragma unroll
          for (int q = 0; q < 4; ++q) tot.a[ai][0][m][n][q] += bf2f(Gm[q * NP + n * 16]) * acc.a[ai][0][m][n][q];
      }
  }
  acc_foreach(tot, brow, bcol, tx, [&](int r, int c, float v) { p.merged[(size_t)r * DM + c] = f2bf(v); });
}
namespace pg8 {
#define PG8_LAS __attribute__((address_space(3)))
constexpr int BM = 256, BK = 64, HALF = 128, HTB = HALF * BK * 2, STAGE_BYTES = 8 * HTB;
__device__ __forceinline__ int perm32(int rho) { const int n = rho >> 4, i = rho & 15; return 8 * (i >> 2) + 4 * n + (i & 3); }
struct Unit { int pm, pn, z; size_t ka, kb; };
struct Gemm { const bfr* A; const bfr* Bt; int lda, ldb, K; };

template <class Epi, class Sched>
__device__ __forceinline__ void gemm_phase(const Gemm g, const Sched& S, const Epi& E) {
  PG8_LAS unsigned char* lds = (PG8_LAS unsigned char*)smem;
  const int tid = tid_opaque(), wid = __builtin_amdgcn_readfirstlane(tid >> 6), lane = tid & 63, wr = wid >> 2, wc = wid & 3, fr = lane & 15, fq = lane >> 4;
  const int K = g.K, nt = K / BK;
  unsigned voffA[2], voffB[2];
#pragma unroll
  for (int i = 0; i < 2; ++i) { int R, C; stage_rc(tid * 16 + i * 8192, R, C); const int Rb = Epi::PERM ? ((R & ~31) + perm32(R & 31)) : R;
    voffA[i] = (unsigned)(R * g.lda + C) * 2u; voffB[i] = (unsigned)(Rb * g.ldb + C) * 2u; }
  const size_t kstep = (size_t)(BK * 2);
  const size_t hstepA = (size_t)HALF * g.lda * 2, hstepB = (size_t)HALF * g.ldb * 2;
  const unsigned ldsw = (unsigned)wid * 1024u;
  const int aoff = lds_byte(wr * 64 + fr, fq * 8), boff = lds_byte(wc * 32 + fr, fq * 8);
#define PG8_SA(b, h) (((b) * 2 + (h)) * HTB)
#define PG8_SB(b, h) ((4 + (b) * 2 + (h)) * HTB)
#define PG8_STAGE(bufoff, gbase, voff) do { _Pragma("unroll") for (int _i = 0; _i < 2; ++_i) \
    __builtin_amdgcn_global_load_lds((const unsigned*)((const char*)(gbase) + (voff)[_i]), (PG8_LAS unsigned*)(lds + (bufoff) + ldsw + _i * 8192), 16, 0, 0); } while (0)
#define PG8_LDA(dst, b, h) do { _Pragma("unroll") for (int m = 0; m < 4; ++m) _Pragma("unroll") for (int k = 0; k < 2; ++k) dst[m][k] = *(const PG8_LAS bf16x8*)(lds + PG8_SA(b, h) + aoff + m * 2048 + k * 1024); } while (0)
#define PG8_LDB(dst, b, h) do { _Pragma("unroll") for (int n = 0; n < 2; ++n) _Pragma("unroll") for (int k = 0; k < 2; ++k) dst[n][k] = *(const PG8_LAS bf16x8*)(lds + PG8_SB(b, h) + boff + n * 2048 + k * 1024); } while (0)
#define PG8_MMA(ai, bj, At, Bt) do { __builtin_amdgcn_s_setprio(1); _Pragma("unroll") for (int m = 0; m < 4; ++m) _Pragma("unroll") for (int n = 0; n < 2; ++n) _Pragma("unroll") for (int k = 0; k < 2; ++k) \
    acc[ai][bj][m][n] = __builtin_amdgcn_mfma_f32_16x16x32_bf16(Bt[n][k], At[m][k], acc[ai][bj][m][n], 0, 0, 0); __builtin_amdgcn_s_setprio(0); } while (0)
#define PG8_WAIT_V(n) asm volatile("s_waitcnt vmcnt(" #n ")" ::: "memory")
#define PG8_WAIT_L(n) asm volatile("s_waitcnt lgkmcnt(" #n ")" ::: "memory")
#define PG8_BAR __builtin_amdgcn_s_barrier()
#define PG8_SCHED __builtin_amdgcn_sched_barrier(0)
  Unit cur, nxt; int ui = 0;
  __syncthreads();
  if (!S.next(0, cur)) return;
  f32x4 acc[2][2][4][2];
#pragma unroll
  for (int a = 0; a < 2; ++a)
#pragma unroll
    for (int b = 0; b < 2; ++b)
#pragma unroll
      for (int m = 0; m < 4; ++m)
#pragma unroll
        for (int n = 0; n < 2; ++n) acc[a][b][m][n] = (f32x4){0.f, 0.f, 0.f, 0.f};
  bf16x8 At[4][2], B0[2][2], B1[2][2];
  const char* cA = (const char*)(g.A + cur.ka) + (size_t)cur.pm * 2 * hstepA; const char* cB = (const char*)(g.Bt + cur.kb) + (size_t)cur.pn * 2 * hstepB;
  PG8_STAGE(PG8_SB(0, 0), cB, voffB); PG8_STAGE(PG8_SA(0, 0), cA, voffA); PG8_STAGE(PG8_SB(0, 1), cB + hstepB, voffB); PG8_STAGE(PG8_SA(0, 1), cA + hstepA, voffA);
  if (wr == 1) PG8_BAR;
  PG8_WAIT_V(4); PG8_BAR;
  PG8_STAGE(PG8_SB(1, 0), cB + kstep, voffB); PG8_STAGE(PG8_SA(1, 0), cA + kstep, voffA); PG8_STAGE(PG8_SB(1, 1), cB + hstepB + kstep, voffB);
  PG8_WAIT_V(6); PG8_BAR;
  for (;;) {
    const bool has_next = S.next(ui + 1, nxt);
    const char* nA = has_next ? (const char*)(g.A + nxt.ka) + (size_t)nxt.pm * 2 * hstepA : cA; const char* nB = has_next ? (const char*)(g.Bt + nxt.kb) + (size_t)nxt.pn * 2 * hstepB : cB;
    for (int t = 0; t < nt; t += 2) {
      const bool last = (t == nt - 2);
      const char* a1 = cA + (size_t)(t + 1) * kstep;
      const char* a2 = last ? nA : cA + (size_t)(t + 2) * kstep; const char* b2 = last ? nB : cB + (size_t)(t + 2) * kstep;
      const char* a3 = a2 + kstep; const char* b3 = b2 + kstep;
      PG8_LDB(B0, 0, 0); PG8_SCHED; PG8_LDA(At, 0, 0); PG8_STAGE(PG8_SA(1, 1), a1 + hstepA, voffA);
      PG8_WAIT_L(8); PG8_BAR; PG8_WAIT_L(0); PG8_MMA(0, 0, At, B0); PG8_BAR; PG8_SCHED;
      PG8_LDB(B1, 0, 1); PG8_STAGE(PG8_SB(0, 0), b2, voffB);
      PG8_BAR; PG8_WAIT_L(0); PG8_MMA(0, 1, At, B1); PG8_BAR;
      PG8_LDA(At, 0, 1); PG8_STAGE(PG8_SA(0, 0), a2, voffA);
      PG8_BAR; PG8_WAIT_L(0); PG8_MMA(1, 0, At, B0); PG8_BAR; PG8_SCHED;
      PG8_STAGE(PG8_SB(0, 1), b2 + hstepB, voffB);
      PG8_WAIT_V(6); PG8_BAR; PG8_MMA(1, 1, At, B1); PG8_BAR;
      PG8_LDB(B0, 1, 0); PG8_SCHED; PG8_LDA(At, 1, 0); PG8_STAGE(PG8_SA(0, 1), a2 + hstepA, voffA);
      PG8_WAIT_L(8); PG8_BAR; PG8_WAIT_L(0); PG8_MMA(0, 0, At, B0); PG8_BAR; PG8_SCHED;
      PG8_LDB(B1, 1, 1); PG8_STAGE(PG8_SB(1, 0), b3, voffB);
      PG8_BAR; PG8_WAIT_L(0); PG8_MMA(0, 1, At, B1); PG8_BAR;
      PG8_LDA(At, 1, 1); PG8_STAGE(PG8_SA(1, 0), a3, voffA);
      PG8_BAR; PG8_WAIT_L(0); PG8_MMA(1, 0, At, B0); PG8_BAR; PG8_SCHED;
      PG8_STAGE(PG8_SB(1, 1), b3 + hstepB, voffB);
      PG8_WAIT_V(6); PG8_BAR; PG8_MMA(1, 1, At, B1); PG8_BAR;
    }
    E(acc, cur, wr, wc, fr, fq);
    if (!has_next) break;
#pragma unroll
    for (int a = 0; a < 2; ++a)
#pragma unroll
      for (int b = 0; b < 2; ++b)
#pragma unroll
        for (int m = 0; m < 4; ++m)
#pragma unroll
          for (int n = 0; n < 2; ++n) acc[a][b][m][n] = (f32x4){0.f, 0.f, 0.f, 0.f};
    cur = nxt; cA = nA; cB = nB; ++ui;
  }
  PG8_WAIT_V(0);
  if (wr == 0) PG8_BAR;
  PG8_BAR;
#undef PG8_SA
#undef PG8_SB
#undef PG8_STAGE
#undef PG8_LDA
#undef PG8_LDB
#undef PG8_MMA
#undef PG8_WAIT_V
#undef PG8_WAIT_L
#undef PG8_BAR
#undef PG8_SCHED
}
__device__ __forceinline__ unsigned cvt_pk_bf16(float lo, float hi) { unsigned r; asm volatile("v_cvt_pk_bf16_f32 %0, %1, %2" : "=v"(r) : "v"(lo), "v"(hi)); return r; }
__device__ __forceinline__ u32x4 pk8(const f32x4 v0, const f32x4 v1) { u32x4 w; w.x = cvt_pk_bf16(v0[0], v0[1]); w.y = cvt_pk_bf16(v0[2], v0[3]); w.z = cvt_pk_bf16(v1[0], v1[1]); w.w = cvt_pk_bf16(v1[2], v1[3]); return w; }

__device__ __forceinline__ unsigned cvt_pk_bf16_n(float lo, float hi) { unsigned r; asm volatile("s_nop 1\n\tv_cvt_pk_bf16_f32 %0, %1, %2" : "=v"(r) : "v"(lo), "v"(hi)); return r; }
__device__ __forceinline__ u32x4 pk8n(const f32x4 v0, const f32x4 v1) { u32x4 w; w.x = cvt_pk_bf16_n(v0[0], v0[1]); w.y = cvt_pk_bf16_n(v0[2], v0[3]); w.z = cvt_pk_bf16_n(v1[0], v1[1]); w.w = cvt_pk_bf16_n(v1[2], v1[3]); return w; }
__device__ __forceinline__ float sigmoid_fast(float x) { return __builtin_amdgcn_rcpf(1.f + __expf(-x)); }
struct SchedIn { int G, c; __device__ __forceinline__ bool next(int i, Unit& u) const { const int L = i * G + c; if (L >= 1024) return false; u.z = 0; u.ka = 0; u.kb = 0;
  if (L < 936) { const int j = L / 24; u.pm = L % 24; u.pn = j < 34 ? j : (j < 38 ? j + 4 : 46); }
  else { const int e = L - 936; if (e < 72) { u.pm = e % 24; u.pn = 34 + e / 24; } else { u.pm = e - 72; u.pn = 37; } }
  return true; } };
struct SchedUp { int G, c; __device__ __forceinline__ bool next(int i, Unit& u) const { const int L = i * G + c; if (L >= 24 * 16) return false; u.pm = L % 24; u.pn = L / 24; u.z = 0; u.ka = 0; u.kb = 0; return true; } };
struct SchedBr { int G, c; __device__ __forceinline__ bool next(int i, Unit& u) const { const int L = i * G + c; if (L >= 256) return false; if (L >= 192) { const int k = 32 + (L - 192); u.pm = k % 24; u.pn = k / 24; u.z = 1; u.ka = (size_t)NTOK * DM; u.kb = (size_t)DM * DM; return true; } const int r = L / 24; u.pm = L % 24; u.pn = r & 3; u.z = (r >> 2) * 2;
  u.ka = (size_t)u.z * NTOK * DM; u.kb = (size_t)u.z * DM * DM; return true; } };
struct SchedOne { Unit u0; __device__ __forceinline__ bool next(int i, Unit& u) const { if (i != 0) return false; u = u0; return true; } };
template <int KH> struct SchedSplit2 { int G, c; __device__ __forceinline__ bool next(int i, Unit& u) const { const int L = i * G + c; if (L >= 24 * 8) return false; const int r = L / 24; u.pm = L % 24; u.pn = r & 3; u.z = r >> 2;
  u.ka = (size_t)u.z * KH; u.kb = (size_t)u.z * KH; return true; } };

struct EpiIn { static constexpr bool PERM = true; bfr* P; float* small;
  __device__ __forceinline__ void operator()(const f32x4 (&acc)[2][2][4][2], const Unit& u, int wr, int wc, int fr, int fq) const {
    const int row0 = u.pm * BM + wr * 64 + fr, col0 = u.pn * BM + wc * 32 + 8 * fq;
    if (u.pn < 46) {
      const bool sg = u.pn >= 34;
#pragma unroll
      for (int ai = 0; ai < 2; ++ai)
#pragma unroll
        for (int m = 0; m < 4; ++m) { bfr* rowp = P + (size_t)(row0 + ai * HALF + m * 16) * NP + col0;
#pragma unroll
          for (int bj = 0; bj < 2; ++bj) { f32x4 v0 = acc[ai][bj][m][0], v1 = acc[ai][bj][m][1];
            if (sg) {
#pragma unroll
              for (int j = 0; j < 4; ++j) { v0[j] = sigmoid_fast(v0[j]); v1[j] = sigmoid_fast(v1[j]); }
              *(u32x4*)(rowp + bj * HALF) = pk8n(v0, v1);
            } else *(u32x4*)(rowp + bj * HALF) = pk8(v0, v1); } }
    } else if (wc == 0) {
#pragma unroll
      for (int ai = 0; ai < 2; ++ai)
#pragma unroll
        for (int m = 0; m < 4; ++m) { float* rowp = small + (size_t)(row0 + ai * HALF + m * 16) * 32 + 8 * fq;
          *(f32x4*)rowp = acc[ai][0][m][0]; *(f32x4*)(rowp + 4) = acc[ai][0][m][1]; }
    }
  }
};
struct EpiUp { static constexpr bool PERM = true; bfr* O;
  __device__ __forceinline__ void operator()(const f32x4 (&acc)[2][2][4][2], const Unit& u, int wr, int wc, int fr, int fq) const {
    const int row0 = u.pm * BM + wr * 64 + fr, col0 = u.pn * BM + wc * 32 + 8 * fq;
#pragma unroll
    for (int ai = 0; ai < 2; ++ai)
#pragma unroll
      for (int m = 0; m < 4; ++m) { bfr* rowp = O + (size_t)(row0 + ai * HALF + m * 16) * HID + col0;
#pragma unroll
        for (int bj = 0; bj < 2; ++bj) { f32x4 v0 = acc[ai][bj][m][0], v1 = acc[ai][bj][m][1];
#pragma unroll
          for (int j = 0; j < 4; ++j) { const float a = fmaxf(v0[j], 0.f), b = fmaxf(v1[j], 0.f); v0[j] = a * a; v1[j] = b * b; }
          *(u32x4*)(rowp + bj * HALF) = pk8(v0, v1); } }
  }
};
struct EpiBr { static constexpr bool PERM = true; bfr* O; const bfr* P;
  __device__ __forceinline__ void operator()(const f32x4 (&acc)[2][2][4][2], const Unit& u, int wr, int wc, int fr, int fq) const {
    const int row0 = u.pm * BM + wr * 64 + fr, col0 = u.z * DM + u.pn * BM + wc * 32 + 8 * fq;
    u32x4 gv[2][4][2];
#pragma unroll
    for (int ai = 0; ai < 2; ++ai)
#pragma unroll
      for (int m = 0; m < 4; ++m) { const bfr* gp = P + (size_t)(row0 + ai * HALF + m * 16) * NP + C_MG + col0;
#pragma unroll
        for (int bj = 0; bj < 2; ++bj) gv[ai][m][bj] = *(const u32x4*)(gp + bj * HALF); }
#pragma unroll
    for (int ai = 0; ai < 2; ++ai)
#pragma unroll
      for (int m = 0; m < 4; ++m) { bfr* rowp = O + (size_t)(row0 + ai * HALF + m * 16) * 3072 + col0;
#pragma unroll
        for (int bj = 0; bj < 2; ++bj) { f32x4 v0 = acc[ai][bj][m][0], v1 = acc[ai][bj][m][1];
          float g[8]; unpack8(gv[ai][m][bj], g);
#pragma unroll
          for (int j = 0; j < 4; ++j) { v0[j] *= g[j]; v1[j] *= g[4 + j]; }
          *(u32x4*)(rowp + bj * HALF) = pk8(v0, v1); } }
  }
};
struct EpiF32 { static constexpr bool PERM = false; float* C;
  __device__ __forceinline__ void operator()(const f32x4 (&acc)[2][2][4][2], const Unit& u, int wr, int wc, int fr, int fq) const {
    const int row0 = u.pm * BM + wr * 64 + fr, col0 = u.pn * BM + wc * 32 + 4 * fq;
    float* Cz = C + (size_t)u.z * NTOK * DM;
#pragma unroll
    for (int ai = 0; ai < 2; ++ai)
#pragma unroll
      for (int m = 0; m < 4; ++m) { float* rowp = Cz + (size_t)(row0 + ai * HALF + m * 16) * DM + col0;
#pragma unroll
        for (int bj = 0; bj < 2; ++bj)
#pragma unroll
          for (int n = 0; n < 2; ++n) *(f32x4*)(rowp + bj * HALF + n * 16) = acc[ai][bj][m][n]; }
  }
};
struct EpiPart { static constexpr bool PERM = true; bfr* C;
  __device__ __forceinline__ void operator()(const f32x4 (&acc)[2][2][4][2], const Unit& u, int wr, int wc, int fr, int fq) const {
    const int row0 = u.pm * BM + wr * 64 + fr, col0 = u.pn * BM + wc * 32 + 8 * fq;
    bfr* Cz = C + (size_t)u.z * NTOK * DM;
#pragma unroll
    for (int ai = 0; ai < 2; ++ai)
#pragma unroll
      for (int m = 0; m < 4; ++m) { bfr* rowp = Cz + (size_t)(row0 + ai * HALF + m * 16) * DM + col0;
#pragma unroll
        for (int bj = 0; bj < 2; ++bj) *(u32x4*)(rowp + bj * HALF) = pk8(acc[ai][bj][m][0], acc[ai][bj][m][1]); }
  }
};
}
namespace att {
constexpr int D = 128, NW = 8, QBLK = 32, KVBLK = 64;
constexpr float SCALE = 0.088388347648318440f;
constexpr float THR = 8.f;
constexpr int SDEPTH = 1;
constexpr int LDQ = 1024, LDK = 256, LDO = 1024;
constexpr size_t SHM_V = KVBLK * D * 2, SHM_K = KVBLK * D * 2, SHM_ATTN = 2 * SHM_V + 2 * SHM_K + NW * 64 * 4;
using bf16 = bfr;
using f32x8  = __attribute__((ext_vector_type(8))) float;
#define KSWZ(row, colB) ((row) * 256 + ((colB) ^ (((row) & 7) << 4)))
#define SBAR() __builtin_amdgcn_sched_barrier(0)
__device__ __forceinline__ int crow(int r, int hi) { return (r & 3) + 8 * (r >> 2) + 4 * hi; }
__device__ __forceinline__ unsigned cvtpk(float lo, float hi) {
  unsigned r; asm volatile("v_cvt_pk_bf16_f32 %0, %1, %2" : "=v"(r) : "v"(lo), "v"(hi)); return r;
}
template <typename TIn> struct Stage;
template <> struct Stage<bf16>  { using T = bf16x8;
  __device__ static __forceinline__ T ld8(const bf16* p) { return *reinterpret_cast<const bf16x8*>(p); }
  __device__ static __forceinline__ bf16x8 tobf(T x) { return x; } };
template <> struct Stage<float> { using T = f32x8;
  __device__ static __forceinline__ T ld8(const float* p) { return *reinterpret_cast<const f32x8*>(p); }
  __device__ static __forceinline__ bf16x8 tobf(T x) {
    u32x4 w = {cvtpk(x[0], x[1]), cvtpk(x[2], x[3]), cvtpk(x[4], x[5]), cvtpk(x[6], x[7])}; return *reinterpret_cast<bf16x8*>(&w); } };

__device__ __forceinline__ void partialSM(f32x16& p0, f32x16& p1, float& m_reg, float& mn, float& alpha) {
  constexpr float C = SCALE * 1.4426950408889634f;
  float pmax = p0[0]; for (int r = 1; r < 16; ++r) pmax = fmaxf(pmax, p0[r]); for (int r = 0; r < 16; ++r) pmax = fmaxf(pmax, p1[r]);
  { auto rr = __builtin_amdgcn_permlane32_swap(__float_as_uint(pmax), __float_as_uint(pmax), false, false);
    pmax = fmaxf(__uint_as_float(rr[0]), __uint_as_float(rr[1])); }
  if (__builtin_expect(__all(pmax - m_reg <= THR / SCALE), 1)) { mn = m_reg; alpha = 1.f; }
  else { mn = fmaxf(m_reg, pmax); alpha = __builtin_amdgcn_exp2f((m_reg - mn) * C); m_reg = mn; }
  float mnC = -mn * C;
  for (int r = 0; r < 16; ++r) p0[r] = fmaf(p0[r], C, mnC); for (int r = 0; r < 16; ++r) p1[r] = fmaf(p1[r], C, mnC);
  for (int r = 0; r < 16; ++r) p0[r] = __builtin_amdgcn_exp2f(p0[r]);
}
__device__ __forceinline__ void finishSM(f32x16& p0, f32x16& p1, float alpha, float& l_reg, bf16x8& pa0, bf16x8& pa1, bf16x8& pa2, bf16x8& pa3) {
  for (int r = 0; r < 16; ++r) p1[r] = __builtin_amdgcn_exp2f(p1[r]);
  float ps = 0; for (int r = 0; r < 16; ++r) ps += p0[r]; for (int r = 0; r < 16; ++r) ps += p1[r];
  { auto rr = __builtin_amdgcn_permlane32_swap(__float_as_uint(ps), __float_as_uint(ps), false, false);
    ps = __uint_as_float(rr[0]) + __uint_as_float(rr[1]); }
  l_reg = l_reg * alpha + ps;
#define PK4(P, BASE, OUT) do { unsigned a0 = cvtpk(P[BASE + 0], P[BASE + 1]), a1 = cvtpk(P[BASE + 2], P[BASE + 3]);   \
    unsigned b0 = cvtpk(P[BASE + 4], P[BASE + 5]), b1 = cvtpk(P[BASE + 6], P[BASE + 7]);                              \
    auto r0 = __builtin_amdgcn_permlane32_swap(a0, b0, false, false); auto r1 = __builtin_amdgcn_permlane32_swap(a1, b1, false, false); \
    u32x4 w = {r0[0], r1[0], r0[1], r1[1]}; OUT = *reinterpret_cast<bf16x8*>(&w); } while (0)
  PK4(p0, 0, pa0); PK4(p0, 8, pa1); PK4(p1, 0, pa2); PK4(p1, 8, pa3);
#undef PK4
}
__device__ __forceinline__ void qkt(f32x16& p0, f32x16& p1, const bf16* Ks, const bf16x8* qr, int r32, int hi) {
  p0 = f32x16{}; p1 = f32x16{};
  for (int d0 = 0; d0 < 8; ++d0) { int cb = (d0 * 16 + hi * 8) * 2;
    bf16x8 b0 = *reinterpret_cast<const bf16x8*>((const char*)Ks + KSWZ(r32, cb));
    bf16x8 b1 = *reinterpret_cast<const bf16x8*>((const char*)Ks + KSWZ(32 + r32, cb));
    p0 = __builtin_amdgcn_mfma_f32_32x32x16_bf16(b0, qr[d0], p0, 0, 0, 0);
    p1 = __builtin_amdgcn_mfma_f32_32x32x16_bf16(b1, qr[d0], p1, 0, 0, 0); }
}
__device__ __forceinline__ int v_st(int k, int c) { const int kk = (k & ~0xC) | ((k & 4) << 1) | ((k & 8) >> 1); return ((kk >> 3) * 4 + (c >> 5)) * 512 + ((kk & 7) * 32 + (c & 31)) * 2; }
__device__ __forceinline__ int v_rd_base(int lane) { return ((lane & 3) << 3) | (((lane >> 2) & 3) << 6) | (((lane >> 4) & 1) << 5) | (((lane >> 5) & 1) << 8); }
constexpr int v_rd_off(int d0, int ks, int half) { return d0 * 512 + ks * 4096 + half * 2048; }
template <int OFF> __device__ __forceinline__ s16x4 tr_read(int vb) {
  s16x4 r; asm volatile("ds_read_b64_tr_b16 %0, %1 offset:%2" : "=&v"(r) : "v"(vb), "i"(OFF) : "memory"); return r;
}
template <int D0> __device__ __forceinline__ void pv_one(f32x16& od, int vb, bf16x8 pa0, bf16x8 pa1, bf16x8 pa2, bf16x8 pa3) {
  const s16x4 l0 = tr_read<v_rd_off(D0, 0, 0)>(vb), h0 = tr_read<v_rd_off(D0, 0, 1)>(vb), l1 = tr_read<v_rd_off(D0, 1, 0)>(vb), h1 = tr_read<v_rd_off(D0, 1, 1)>(vb);
  const s16x4 l2 = tr_read<v_rd_off(D0, 2, 0)>(vb), h2 = tr_read<v_rd_off(D0, 2, 1)>(vb), l3 = tr_read<v_rd_off(D0, 3, 0)>(vb), h3 = tr_read<v_rd_off(D0, 3, 1)>(vb);
  asm volatile("s_waitcnt lgkmcnt(0)" ::: "memory"); SBAR();
#define PK(L, H) (bf16x8){L[0], L[1], L[2], L[3], H[0], H[1], H[2], H[3]}
  od = __builtin_amdgcn_mfma_f32_32x32x16_bf16(pa0, PK(l0, h0), od, 0, 0, 0);
  od = __builtin_amdgcn_mfma_f32_32x32x16_bf16(pa1, PK(l1, h1), od, 0, 0, 0);
  od = __builtin_amdgcn_mfma_f32_32x32x16_bf16(pa2, PK(l2, h2), od, 0, 0, 0);
  od = __builtin_amdgcn_mfma_f32_32x32x16_bf16(pa3, PK(l3, h3), od, 0, 0, 0);
#undef PK
}
__device__ __forceinline__ void pv_d0(f32x16* o, int vb, bf16x8 pa0, bf16x8 pa1, bf16x8 pa2, bf16x8 pa3) {
  pv_one<0>(o[0], vb, pa0, pa1, pa2, pa3); pv_one<1>(o[1], vb, pa0, pa1, pa2, pa3); pv_one<2>(o[2], vb, pa0, pa1, pa2, pa3); pv_one<3>(o[3], vb, pa0, pa1, pa2, pa3);
}

template <typename TQ>
__device__ __forceinline__ void attn_dense_body(const TQ* __restrict__ Qb, const bf16* __restrict__ Kh, const bf16* __restrict__ Vh,
                                                bfr* __restrict__ Ob, int seq, char* lds) {
  using St = Stage<bf16>; using SQ = Stage<TQ>;
  const int tid = tid_opaque(), wid = tid >> 6, lane = tid & 63, r32 = lane & 31, hi = lane >> 5;
  bf16* V_lds = (bf16*)lds; bf16* K_lds = (bf16*)(lds + 2 * SHM_V);
  float* ws = (float*)(lds + 2 * SHM_V + 2 * SHM_K) + wid * 64; float* li_l = ws; float* al_l = ws + 32;
  float m_reg = -1e30f, l_reg = 0; f32x16 o[4] = {}; bf16x8 qr[8];
  const TQ* Qw = Qb + (long)(wid * QBLK + r32) * LDQ + hi * 8;
#pragma unroll
  for (int d0 = 0; d0 < 8; ++d0) qr[d0] = SQ::tobf(SQ::ld8(Qw + d0 * 16));
  const int sr = tid >> 4, sc = (tid & 15) * 8, vst0 = v_st(sr, sc), vst1 = v_st(32 + sr, sc);
  const int vb0 = (int)(uintptr_t)V_lds + v_rd_base(lane);
  struct { typename St::T vs0, vs1, ks0, ks1; } sr_[SDEPTH];
#define SLOAD(i, k0) do { sr_[i].vs0 = St::ld8(&Vh[(long)((k0) + sr) * LDK + sc]); sr_[i].vs1 = St::ld8(&Vh[(long)((k0) + 32 + sr) * LDK + sc]); \
    sr_[i].ks0 = St::ld8(&Kh[(long)((k0) + sr) * LDK + sc]); sr_[i].ks1 = St::ld8(&Kh[(long)((k0) + 32 + sr) * LDK + sc]); } while (0)
#define SWRITE(b, i) do { *(bf16x8*)((char*)V_lds + (b) * SHM_V + vst0) = St::tobf(sr_[i].vs0);          \
    *(bf16x8*)((char*)V_lds + (b) * SHM_V + vst1) = St::tobf(sr_[i].vs1); int kc = sc * 2;               \
    *(bf16x8*)((char*)K_lds + (b) * SHM_K + KSWZ(sr, kc)) = St::tobf(sr_[i].ks0);                       \
    *(bf16x8*)((char*)K_lds + (b) * SHM_K + KSWZ(32 + sr, kc)) = St::tobf(sr_[i].ks1); } while (0)
#define SWAIT() do { if constexpr (SDEPTH == 2) asm volatile("s_waitcnt vmcnt(4)" ::: "memory"); else asm volatile("s_waitcnt vmcnt(0)" ::: "memory"); } while (0)
#define RESC(a) do { if (__any((a) < 1.f)) { if (hi == 0) al_l[r32] = (a); asm volatile("s_waitcnt lgkmcnt(0)" ::: "memory"); \
    for (int d = 0; d < 4; ++d) for (int r = 0; r < 16; ++r) o[d][r] *= al_l[crow(r, hi)]; } } while (0)
  f32x16 pA0, pA1, pB0, pB1; float mnA, mnB, alA, alB; bf16x8 pa0, pa1, pa2, pa3; const int NT = seq / KVBLK;
  constexpr int SE = 0, SO = SDEPTH - 1;
  SLOAD(SE, 0); asm volatile("s_waitcnt vmcnt(0)" ::: "memory"); SWRITE(0, SE); __syncthreads();
  qkt(pA0, pA1, K_lds, qr, r32, hi); partialSM(pA0, pA1, m_reg, mnA, alA);
  SLOAD(SO, KVBLK); if constexpr (SDEPTH == 2) { if (2 < NT) SLOAD(SE, 2 * KVBLK); }
  SWAIT(); SWRITE(1, SO); __syncthreads();
  for (int j = 1; j + 1 < NT; j += 2) {
    SBAR(); qkt(pB0, pB1, (bf16*)((char*)K_lds + SHM_K), qr, r32, hi);
    finishSM(pA0, pA1, alA, l_reg, pa0, pa1, pa2, pa3); SBAR();
    SLOAD(SO, (j + SDEPTH) * KVBLK); SBAR();
    pv_d0(o, vb0, pa0, pa1, pa2, pa3); partialSM(pB0, pB1, m_reg, mnB, alB);
    __syncthreads(); SWAIT(); SWRITE(0, SE);
    RESC(alB); __syncthreads();
    SBAR(); qkt(pA0, pA1, K_lds, qr, r32, hi);
    finishSM(pB0, pB1, alB, l_reg, pa0, pa1, pa2, pa3); SBAR();
    if (SDEPTH == 1 || j + 3 < NT) SLOAD(SE, (j + 1 + SDEPTH) * KVBLK); SBAR();
    pv_d0(o, vb0 + (int)SHM_V, pa0, pa1, pa2, pa3); partialSM(pA0, pA1, m_reg, mnA, alA);
    __syncthreads(); SWAIT(); SWRITE(1, SO);
    RESC(alA); __syncthreads();
  }
  SBAR(); qkt(pB0, pB1, (bf16*)((char*)K_lds + SHM_K), qr, r32, hi);
  finishSM(pA0, pA1, alA, l_reg, pa0, pa1, pa2, pa3); SBAR();
  pv_d0(o, vb0, pa0, pa1, pa2, pa3); partialSM(pB0, pB1, m_reg, mnB, alB);
  __syncthreads(); RESC(alB);
  finishSM(pB0, pB1, alB, l_reg, pa0, pa1, pa2, pa3); SBAR();
  pv_d0(o, vb0 + (int)SHM_V, pa0, pa1, pa2, pa3);
  if (hi == 0) li_l[r32] = l_reg; asm volatile("s_waitcnt lgkmcnt(0)" ::: "memory");
  float rli[16];
#pragma unroll
  for (int r = 0; r < 16; ++r) rli[r] = __builtin_amdgcn_rcpf(li_l[crow(r, hi)]);
  bfr* Ow = Ob + (long)(wid * QBLK) * LDO;
#pragma unroll
  for (int r = 0; r < 16; ++r) { int orow = crow(r, hi);
    for (int d0 = 0; d0 < 4; ++d0) Ow[(long)orow * LDO + d0 * 32 + r32] = f2bf(o[d0][r] * rli[r]); }
#undef SLOAD
#undef SWRITE
#undef SWAIT
#undef RESC
}

}

__device__ __forceinline__ void attn_item(const Params& p, int item) {
  __syncthreads();
  if (item < 64) {
    const int b = item >> 5, h = (item >> 2) & 7, qb = item & 3; const size_t t0 = NCTX + b * 1024 + qb * 256;
    att::attn_dense_body<bfr>(p.Q + t0 * DM + h * 128, p.Ks + (size_t)b * 1280 * 256 + (h >> 2) * 128, p.Vs + (size_t)b * 1280 * 256 + (h >> 2) * 128,
                              p.obr + (size_t)2 * NTOK * DM + t0 * DM + h * 128, 1280, smem);
  } else {
    const int j = item - 64, b = j >> 3, h = j & 7; const size_t t0 = b * 256;
    att::attn_dense_body<bfr>(p.Q + t0 * DM + h * 128, p.Kc + (size_t)b * 256 * 256 + (h >> 2) * 128, p.Vc + (size_t)b * 256 * 256 + (h >> 2) * 128,
                              p.obr + (size_t)2 * NTOK * DM + t0 * DM + h * 128, 256, smem);
  }
}
#define XB_TMO      128
#define XB_XCNT(j)  (256  + 64 * (j))
#define XB_XSUB(j)  (1280 + 64 * (j))
#define XB_XGEN(j)  (2304 + 64 * (j))
#define XB_TOP      3328
#define XB_TOPGEN   3392
#define XCD_BAR_WORDS 3456
#define XB_SPIN_CAP (1u << 20)
#define LAS __attribute__((address_space(3)))
constexpr int XB_LDS_OFF = 163840 - 16;

__device__ __forceinline__ unsigned xb_ld(unsigned* p)              { return __hip_atomic_load(p, __ATOMIC_RELAXED, __HIP_MEMORY_SCOPE_AGENT); }
__device__ __forceinline__ unsigned xb_add(unsigned* p, unsigned v) { return __hip_atomic_fetch_add(p, v, __ATOMIC_RELAXED, __HIP_MEMORY_SCOPE_AGENT); }
__device__ __forceinline__ unsigned xb_xcc_id() { return (unsigned)__builtin_amdgcn_s_getreg((3 << 11) | 20) & 0xFu; }
#define XB_SPIN(cond, bar) do { unsigned _sp = 0; while (cond) { __builtin_amdgcn_s_sleep(1); \
    if ((++_sp & 255u) == 0u) { if (xb_ld(&(bar)[XB_TMO])) break; if (_sp > XB_SPIN_CAP) { atomicAdd(&(bar)[XB_TMO], 1u); break; } } } } while (0)

__device__ __forceinline__ void xcd_barrier_post(unsigned* bar) {
  volatile LAS unsigned* st = (volatile LAS unsigned*)(smem + XB_LDS_OFF);
  if (tid_opaque() == 0) { st[0] = 0u; st[1] = 0u; (void)xb_add(&bar[XB_XCNT(xb_xcc_id())], 1u); }
  __syncthreads();
}
__device__ __forceinline__ void xcd_barrier_complete(unsigned* bar, unsigned x, unsigned& nloc, unsigned& nx) {
  const unsigned G = gridDim.x * gridDim.y * gridDim.z;
  unsigned sum, cnt, mine, sp = 0u;
  for (;;) {
    sum = 0u; cnt = 0u; mine = 0u;
#pragma unroll
    for (unsigned j = 0; j < 16; ++j) { const unsigned c = xb_ld(&bar[XB_XCNT(j)]); sum += c; cnt += (c > 0u) ? 1u : 0u; mine = (j == x) ? c : mine; }
    if (sum == G) break;
    __builtin_amdgcn_s_sleep(1);
    if ((++sp & 255u) == 0u) { if (xb_ld(&bar[XB_TMO])) break; if (sp > XB_SPIN_CAP) { atomicAdd(&bar[XB_TMO], 1u); break; } }
  }
  nloc = mine > 0u ? mine : 1u; nx = cnt > 0u ? cnt : 1u;
}
template <bool REL = true>
__device__ __forceinline__ void xcd_barrier(unsigned* bar) {
  asm volatile("s_waitcnt vmcnt(0)" ::: "memory");
  __syncthreads();
  if (tid_opaque() == 0) {
    volatile LAS unsigned* st = (volatile LAS unsigned*)(smem + XB_LDS_OFF);
    const unsigned x = xb_xcc_id();
    __builtin_amdgcn_s_waitcnt(0);
    unsigned nloc = st[0], nx = st[1];
    if (nloc == 0u) { xcd_barrier_complete(bar, x, nloc, nx); st[0] = nloc; st[1] = nx; }
    const unsigned old = xb_add(&bar[XB_XSUB(x)], 1u);
    const unsigned gen = old / nloc;
    if (old + 1u == (gen + 1u) * nloc) {
      if (REL) { __builtin_amdgcn_fence(__ATOMIC_RELEASE, "agent"); asm volatile("s_waitcnt vmcnt(0)" ::: "memory"); }
      const unsigned og = xb_add(&bar[XB_TOP], 1u);
      const unsigned tg = og / nx;
      if (og + 1u == (tg + 1u) * nx) xb_add(&bar[XB_TOPGEN], 1u);
      else XB_SPIN(xb_ld(&bar[XB_TOPGEN]) == tg, bar);
      xb_add(&bar[XB_XGEN(x)], 1u);
      __builtin_amdgcn_fence(__ATOMIC_ACQUIRE, "agent");
      asm volatile("s_waitcnt vmcnt(0)" ::: "memory");
    } else {
      XB_SPIN(xb_ld(&bar[XB_XGEN(x)]) == gen, bar);
      __builtin_amdgcn_fence(__ATOMIC_ACQUIRE, "agent");
      asm volatile("s_waitcnt vmcnt(0)" ::: "memory");
    }
  }
  __syncthreads();
}
constexpr float SCALEQ = 0.08838834764831845f;
constexpr int PQH = 0, PKH = 17408, PVH = 34816, PKK = 52224, PQK = 68864, PXS = 52224, PMD = 125952, PMB = 134144, PGC = 152576, PRS = 0;
constexpr int XROW = 144;
#define LDS_BARRIER() do { asm volatile("s_waitcnt lgkmcnt(0)" ::: "memory"); __builtin_amdgcn_s_barrier(); asm volatile("" ::: "memory"); } while (0)
constexpr int LROW = 272;

__device__ __forceinline__ float ld_bf(const char* base, int byteoff) { return bf2f(*(const bfr*)(base + byteoff)); }

template <int B>
__device__ __forceinline__ void solve_block(int d, int e, int wid, int lane) {
  const int fr = lane & 15, hq = lane >> 4;
  char* xcol = smem + PXS + (d * 256 + e) * XROW + 16 * B * 2;
  float acc[16];
  { const u32x4 a = *(const u32x4*)xcol, b = *(const u32x4*)(xcol + 16); unpack8(a, acc); unpack8(b, acc + 8); }
  if (B > 0) {
    constexpr int NKS = (B + 1) / 2;
    f32x4 R[4];
#pragma unroll
    for (int ct = 0; ct < 4; ++ct) R[ct] = f32x4{0.f, 0.f, 0.f, 0.f};
#pragma unroll
    for (int ks = 0; ks < NKS; ++ks) {
      const bf16x8 a = *(const bf16x8*)(smem + PMB + (d * 64 + 16 * B + fr) * XROW + (ks * 32 + 8 * hq) * 2);
#pragma unroll
      for (int ct = 0; ct < 4; ++ct) {
        const bf16x8 b = *(const bf16x8*)(smem + PXS + (d * 256 + (wid & 3) * 64 + ct * 16 + fr) * XROW + (ks * 32 + 8 * hq) * 2);
        R[ct] = __builtin_amdgcn_mfma_f32_16x16x32_bf16(a, b, R[ct], 0, 0, 0);
      }
    }
    float* rs = (float*)(smem + PRS + wid * 4352);
#pragma unroll
    for (int ct = 0; ct < 4; ++ct)
#pragma unroll
      for (int r = 0; r < 4; ++r) rs[(4 * hq + r) * 68 + ct * 16 + fr] = R[ct][r];
    asm volatile("s_waitcnt lgkmcnt(0)" ::: "memory");
#pragma unroll
    for (int r = 0; r < 16; ++r) acc[r] -= rs[r * 68 + lane];
  }
  const float4* md = (const float4*)(smem + PMD) + ((d * 4 + B) * 16) * 4;
#pragma unroll
  for (int r2 = 0; r2 < 15; ++r2) {
#pragma unroll
    for (int q = (r2 + 1) / 4; q < 4; ++q) {
      const float4 m = md[r2 * 4 + q];
      if (4 * q + 0 > r2) acc[4 * q + 0] -= m.x * acc[r2];
      if (4 * q + 1 > r2) acc[4 * q + 1] -= m.y * acc[r2];
      if (4 * q + 2 > r2) acc[4 * q + 2] -= m.z * acc[r2];
      if (4 * q + 3 > r2) acc[4 * q + 3] -= m.w * acc[r2];
    }
  }
  *(u32x4*)xcol = pack8(acc); *(u32x4*)(xcol + 16) = pack8(acc + 8);
  asm volatile("s_waitcnt lgkmcnt(0)" ::: "memory");
}

__device__ __forceinline__ void dn_prep_item(const Params& p, int l, int c, int h) {
  const int tid = tid_opaque(), wid = tid >> 6, lane = tid & 63;
  const int t0 = c * 64;
  LDS_BARRIER();
  float b_beta = 0.f, b_alpha = 0.f, b_A = 0.f, b_dtb = 0.f;
  if (wid < 2) {
    const int d = wid, ti = d ? 63 - lane : lane, t = t0 + ti;
    b_A = p.a_log[(l * 2 + d) * 8 + h]; b_dtb = p.dt_bias[(l * 2 + d) * 8 + h];
    b_beta = p.small[(size_t)t * 32 + d * 8 + h]; b_alpha = p.small[(size_t)t * 32 + 16 + d * 8 + h];
  }
  struct { u32x4 raw[3][2][3]; } R;
  {
    const int grp = tid & 15;
#pragma unroll
    for (int X = 0; X < 3; ++X)
#pragma unroll
      for (int pass = 0; pass < 2; ++pass)
#pragma unroll
        for (int k = -1; k <= 1; ++k) {
          const int r = (tid >> 4) + pass * 32, t = t0 + r, pos = tok_pos(t), L = tok_L(t);
          R.raw[X][pass][k + 1] = u32x4{0u, 0u, 0u, 0u};
          if (pos + k >= 0 && pos + k < L) R.raw[X][pass][k + 1] = *(const u32x4*)(p.P + (size_t)(t + k) * NP + X * 1024 + h * 128 + grp * 8);
        }
  }
  {
    const int grp = tid & 15;
    const float* wc = p.w_conv_dn + (size_t)l * 3 * 3072 + h * 128 + grp * 8;
#pragma unroll
    for (int X = 0; X < 3; ++X) {
      float w[3][8];
#pragma unroll
      for (int k = 0; k < 3; ++k) { *(float4*)&w[k][0] = *(const float4*)(wc + k * 3072 + X * 1024); *(float4*)&w[k][4] = *(const float4*)(wc + k * 3072 + X * 1024 + 4); }
#pragma unroll
      for (int pass = 0; pass < 2; ++pass) {
        const int r = (tid >> 4) + pass * 32;
        float acc[8] = {};
#pragma unroll
        for (int k = 0; k < 3; ++k) {
          float x[8]; unpack8(R.raw[X][pass][k], x);
#pragma unroll
          for (int q = 0; q < 8; ++q) acc[q] += w[k][q] * x[q];
        }
        float ss = 0;
#pragma unroll
        for (int q = 0; q < 8; ++q) { acc[q] = siluf_(acc[q]); ss += acc[q] * acc[q]; }
        if (X < 2) {
          ss += __shfl_xor(ss, 1); ss += __shfl_xor(ss, 2); ss += __shfl_xor(ss, 4); ss += __shfl_xor(ss, 8);
          const float nrm = rsqrtf(ss + EPS);
#pragma unroll
          for (int q = 0; q < 8; ++q) acc[q] *= nrm;
        }
        *(u32x4*)(smem + X * 17408 + r * LROW + grp * 16) = pack8hw(acc);
      }
    }
  }
  if (wid < 2) {
    const int d = wid;
    const float A = __expf(b_A);
    const float beta = sigmoidf_(b_beta);
    float g = -A * softplusf_(b_alpha + b_dtb);
#pragma unroll
    for (int o = 1; o < 64; o <<= 1) { const float v = __shfl_up(g, o); if (lane >= o) g += v; }
    float* G = (float*)(smem + PGC);
    const float eg_ = __expf(g);
    G[d * 64 + lane] = g; G[128 + d * 64 + lane] = beta; G[256 + d * 64 + lane] = eg_; G[384 + d * 64 + lane] = beta * eg_;
  }
  LDS_BARRIER();
  {
    const int mat = wid >> 2, rt = wid & 3, fr = lane & 15, fq = lane >> 4;
    const char* Ab = smem + (mat ? PQH : PKH);
    f32x4 acc[4];
#pragma unroll
    for (int ct = 0; ct < 4; ++ct) acc[ct] = f32x4{0.f, 0.f, 0.f, 0.f};
#pragma unroll
    for (int ks = 0; ks < 4; ++ks) {
      const bf16x8 a = *(const bf16x8*)(Ab + (rt * 16 + fr) * LROW + (ks * 32 + fq * 8) * 2);
#pragma unroll
      for (int ct = 0; ct < 4; ++ct) {
        const bf16x8 b = *(const bf16x8*)(smem + PKH + (ct * 16 + fr) * LROW + (ks * 32 + fq * 8) * 2);
        acc[ct] = __builtin_amdgcn_mfma_f32_16x16x32_bf16(a, b, acc[ct], 0, 0, 0);
      }
    }
    float* Dst = (float*)(smem + (mat ? PQK : PKK));
#pragma unroll
    for (int ct = 0; ct < 4; ++ct)
#pragma unroll
      for (int r = 0; r < 4; ++r) Dst[(rt * 16 + fq * 4 + r) * 65 + ct * 16 + fr] = acc[ct][r];
  }
  LDS_BARRIER();
  const int d = tid >> 8, e = tid & 255;
  const float* GC = (const float*)(smem + PGC) + d * 64;
  const float* BETA = (const float*)(smem + PGC) + 128 + d * 64;
  const float* EG = (const float*)(smem + PGC) + 256 + d * 64;
  const float* KKs = (const float*)(smem + PKK);
  const float* QKs = (const float*)(smem + PQK);
  char* rec = p.dnrec + (size_t)((c * 8 + h) * 2 + d) * REC_BYTES;
  {
    const int i = e >> 2, jq = e & 3, j0 = jq * 16, ti = d ? 63 - i : i, ib = i >> 4;
    const float bi = BETA[i], gi = GC[i];
    float mv[16];
#pragma unroll
    for (int jj = 0; jj < 16; ++jj) {
      const int j = j0 + jj, tj = d ? 63 - j : j;
      const float mraw = bi * KKs[ti * 65 + tj] * __expf(fminf(gi - GC[j], 0.f));
      mv[jj] = (j < i) ? mraw : 0.f;
    }
    float* mdt = (float*)(smem + PMD) + ((d * 4 + ib) * 16) * 16 + (i & 15);
    if (jq == ib) {
#pragma unroll
      for (int jj = 0; jj < 16; ++jj) mdt[jj * 16] = mv[jj];
    }
    float mo[16];
#pragma unroll
    for (int jj = 0; jj < 16; ++jj) mo[jj] = (jq < ib) ? mv[jj] : 0.f;
    char* mb = smem + PMB + (d * 64 + i) * XROW + j0 * 2;
    *(u32x4*)mb = pack8hw(mo); *(u32x4*)(mb + 16) = pack8hw(mo + 8);
#pragma unroll 1
    for (int rep = 0; rep < 2; ++rep) {
      const int f = e + rep * 256, ln = f & 63, fi = f >> 6, mt = fi >> 1, ks = fi & 1;
      const int ii = mt * 16 + (ln & 15), tii = d ? 63 - ii : ii, hq = ln >> 4;
      const float gii = GC[ii];
      float v[8];
#pragma unroll
      for (int j = 0; j < 8; ++j) {
        const int jp = ks * 32 + (j >> 2) * 16 + 4 * hq + (j & 3), tj = d ? 63 - jp : jp;
        const float qraw = SCALEQ * QKs[tii * 65 + tj] * __expf(fminf(gii - GC[jp], 0.f));
        v[j] = (jp <= ii) ? qraw : 0.f;
      }
      *(u32x4*)(rec + REC_QK + f * 16) = pack8hw(v);
    }
    if (e == 0) p.glast[(c * 8 + h) * 2 + d] = EG[63];
    const float gl = GC[63];
#pragma unroll 1
    for (int rep = 0; rep < 4; ++rep) {
      const int f = e + rep * 256, ln = f & 63, fi = f >> 6, hq = ln >> 4;
      {
        const int mt = fi >> 2, ks = fi & 3, ii = mt * 16 + (ln & 15), tii = d ? 63 - ii : ii;
        const float sc = SCALEQ * EG[ii];
        const char* qrow = smem + PQH + tii * LROW + (ks * 32 + 4 * hq) * 2;
        const u32x2 lo = *(const u32x2*)qrow, hi = *(const u32x2*)(qrow + 32);
        float v[8] = {__uint_as_float(lo[0] << 16), __uint_as_float(lo[0] & 0xffff0000u), __uint_as_float(lo[1] << 16), __uint_as_float(lo[1] & 0xffff0000u),
                      __uint_as_float(hi[0] << 16), __uint_as_float(hi[0] & 0xffff0000u), __uint_as_float(hi[1] << 16), __uint_as_float(hi[1] & 0xffff0000u)};
#pragma unroll
        for (int j = 0; j < 8; ++j) v[j] *= sc;
        *(u32x4*)(rec + REC_QD + f * 16) = pack8hw(v);
      }
      {
        const int mt = fi >> 1, ks = fi & 1, dk = mt * 16 + (ln & 15);
        float v[8];
#pragma unroll
        for (int j = 0; j < 8; ++j) {
          const int ip = ks * 32 + (j >> 2) * 16 + 4 * hq + (j & 3), tip = d ? 63 - ip : ip;
          v[j] = ld_bf(smem + PKH, tip * LROW + dk * 2) * __expf(gl - GC[ip]);
        }
        *(u32x4*)(rec + REC_KD + f * 16) = pack8hw(v);
      }
    }
  }
  LDS_BARRIER();
  {
    const int col = e & 127; const bool isw = e >= 128;
    const char* src = smem + (isw ? PKH : PVH) + col * 2;
    const float4* F4 = (const float4*)((const float*)(smem + PGC) + (isw ? 384 : 128) + d * 64);
    char* xcol = smem + PXS + (d * 256 + e) * XROW;
#pragma unroll
    for (int i8 = 0; i8 < 8; ++i8) {
      const float4 f0 = F4[i8 * 2], f1 = F4[i8 * 2 + 1];
      const float fs[8] = {f0.x, f0.y, f0.z, f0.w, f1.x, f1.y, f1.z, f1.w};
      float v[8];
#pragma unroll
      for (int q = 0; q < 8; ++q) { const int i = i8 * 8 + q, ti = d ? 63 - i : i; v[q] = ld_bf(src, ti * LROW) * fs[q]; }
      *(u32x4*)(xcol + i8 * 16) = pack8hw(v);
    }
  }
  LDS_BARRIER();
  solve_block<0>(d, e, wid, lane); solve_block<1>(d, e, wid, lane); solve_block<2>(d, e, wid, lane); solve_block<3>(d, e, wid, lane);
  LDS_BARRIER();
  {
    const char* XS = smem + PXS + d * 256 * XROW;
#pragma unroll 1
    for (int rep = 0; rep < 8; ++rep) {
      const int f = e + rep * 256, ln = f & 63, fi = f >> 6, ws = fi >> 2, rt = fi & 3;
      const int i0 = rt * 16 + 4 * (ln >> 4), dv = ws * 16 + (ln & 15);
      *(u32x2*)(rec + REC_U + f * 8) = *(const u32x2*)(XS + dv * XROW + i0 * 2);
    }
#pragma unroll 1
    for (int rep = 0; rep < 4; ++rep) {
      const int f = e + rep * 256, ln = f & 63, fi = f >> 6, mt = fi >> 2, ks = fi & 3, hq = ln >> 4;
      const char* wc = XS + (128 + ks * 32 + 4 * hq) * XROW + (mt * 16 + (ln & 15)) * 2;
      unsigned q[8];
#pragma unroll
      for (int j = 0; j < 8; ++j) q[j] = *(const bfr*)(wc + ((j >> 2) * 16 + (j & 3)) * XROW);
      u32x4 o = {q[0] | (q[1] << 16), q[2] | (q[3] << 16), q[4] | (q[5] << 16), q[6] | (q[7] << 16)};
      *(u32x4*)(rec + REC_W + f * 16) = o;
    }
  }
}

__device__ __forceinline__ bf16x8 pack_b(const f32x4& a, const f32x4& b) {
  u32x4 w = {pack2hw(a[0], a[1]), pack2hw(a[2], a[3]), pack2hw(b[0], b[1]), pack2hw(b[2], b[3])};
  return *reinterpret_cast<bf16x8*>(&w);
}

constexpr int SCAN_BUF = 73728;
#define SC_SCHED() __builtin_amdgcn_sched_barrier(0)
#define SC_WAITL(n) asm volatile("s_waitcnt lgkmcnt(" #n ")" ::: "memory")
__device__ __forceinline__ void dn_scan_item(const Params& p, int l, int s, int h, int d) {
  const int tid = tid_opaque(), wid = tid >> 6, lane = tid & 63, ws = wid, fr = lane & 15, hq = lane >> 4;
  const bool samp = s >= 16;
  const int N = samp ? 16 : 4, cb = samp ? 64 + (s - 16) * 16 : s * 4, tbase = samp ? NCTX + (s - 16) * 1024 : s * 256;
  const int cstep = d ? -1 : 1, c0 = cb + (d ? N - 1 : 0);
  auto recp = [&](int n) { return p.dnrec + (size_t)(((c0 + n * cstep) * 8 + h) * 2 + d) * REC_BYTES; };
  f32x4 S[8];
  if (samp) {
    const float* s0 = p.state_dn + ((((size_t)(s - 16) * DEPTH + l) * 2 + d) * 8 + h) * 16384;
#pragma unroll
    for (int dt = 0; dt < 8; ++dt) {
      const float* q = s0 + (dt * 16 + 4 * hq) * 128 + ws * 16 + fr;
      asm volatile("" : "+v"(q) :: "memory");
#pragma unroll
      for (int r = 0; r < 4; ++r) S[dt][r] = q[r * 128];
    }
  } else {
#pragma unroll
    for (int dt = 0; dt < 8; ++dt) S[dt] = f32x4{0.f, 0.f, 0.f, 0.f};
  }
  const float glv = p.glast[((c0 + (lane < N ? lane : 0) * cstep) * 8 + h) * 2 + d];
  __syncthreads();
#define SC_GLDS(rec, buf) do { _Pragma("unroll") for (int i = 0; i < 9; ++i) \
    __builtin_amdgcn_global_load_lds((const unsigned*)((rec) + (i * 512 + tid) * 16), (__attribute__((address_space(3))) unsigned*)(smem + (buf) * SCAN_BUF + (i * 512 + tid) * 16), 16, 0, 0); } while (0)
  SC_GLDS(recp(0), 0);
  SC_GLDS(recp(1), 1);
  asm volatile("s_waitcnt vmcnt(0)" ::: "memory");
  LDS_BARRIER();
#pragma unroll 1
  for (int n = 0; n < N; ++n) {
    const int c = c0 + n * cstep;
    const char* Lb = smem + (n & 1) * SCAN_BUF;
    const char* LW = Lb + REC_W + lane * 16;
    const float gl = __uint_as_float(__builtin_amdgcn_readlane(__float_as_uint(glv), n));
    f32x4 P[4], O[4];
#pragma unroll
    for (int rt = 0; rt < 4; ++rt) { P[rt] = f32x4{0.f, 0.f, 0.f, 0.f}; O[rt] = f32x4{0.f, 0.f, 0.f, 0.f}; }
    bf16x8 F[8];
#define SC_LOADWQ(ks) do { _Pragma("unroll") for (int rt = 0; rt < 4; ++rt) { F[rt] = *(const bf16x8*)(LW + ((rt * 4 + (ks)) * 64) * 16); F[4 + rt] = *(const bf16x8*)(LW + 16384 + ((rt * 4 + (ks)) * 64) * 16); } } while (0)
#define SC_MMAWQ(sb) do { _Pragma("unroll") for (int rt = 0; rt < 4; ++rt) { P[rt] = __builtin_amdgcn_mfma_f32_16x16x32_bf16(F[rt], sb, P[rt], 0, 0, 0); O[rt] = __builtin_amdgcn_mfma_f32_16x16x32_bf16(F[4 + rt], sb, O[rt], 0, 0, 0); } } while (0)
#pragma unroll
    for (int ks = 0; ks < 4; ++ks) {
      SC_LOADWQ(ks); SC_SCHED();
      const bf16x8 sb = pack_b(S[2 * ks], S[2 * ks + 1]);
      SC_WAITL(0); SC_SCHED(); SC_MMAWQ(sb); SC_SCHED();
    }
    u32x2 U[4];
#pragma unroll
    for (int rt = 0; rt < 4; ++rt) U[rt] = *(const u32x2*)(Lb + REC_U + (((ws * 4 + rt) * 64) + lane) * 8);
#pragma unroll
    for (int i = 0; i < 8; ++i) F[i] = *(const bf16x8*)(LW + 32768 + (i * 64) * 16);
    SC_SCHED(); SC_WAITL(0); SC_SCHED();
#pragma unroll
    for (int rt = 0; rt < 4; ++rt) {
      const u32x2 u = U[rt];
      P[rt][0] = __uint_as_float(u[0] << 16) - P[rt][0]; P[rt][1] = __uint_as_float(u[0] & 0xffff0000u) - P[rt][1];
      P[rt][2] = __uint_as_float(u[1] << 16) - P[rt][2]; P[rt][3] = __uint_as_float(u[1] & 0xffff0000u) - P[rt][3];
    }
    const bf16x8 vb0 = pack_b(P[0], P[1]), vb1 = pack_b(P[2], P[3]);
#pragma unroll
    for (int rt = 0; rt < 4; ++rt) {
      O[rt] = __builtin_amdgcn_mfma_f32_16x16x32_bf16(F[rt * 2 + 0], vb0, O[rt], 0, 0, 0);
      O[rt] = __builtin_amdgcn_mfma_f32_16x16x32_bf16(F[rt * 2 + 1], vb1, O[rt], 0, 0, 0);
    }
    SC_SCHED();
#pragma unroll
    for (int half = 0; half < 2; ++half) {
#pragma unroll
      for (int i = 0; i < 8; ++i) F[i] = *(const bf16x8*)(LW + 40960 + ((half * 8 + i) * 64) * 16);
      SC_SCHED(); SC_WAITL(0); SC_SCHED();
#pragma unroll
      for (int dq = 0; dq < 4; ++dq) {
        const int dt = half * 4 + dq;
        S[dt] *= gl;
        S[dt] = __builtin_amdgcn_mfma_f32_16x16x32_bf16(F[dq * 2 + 0], vb0, S[dt], 0, 0, 0);
        S[dt] = __builtin_amdgcn_mfma_f32_16x16x32_bf16(F[dq * 2 + 1], vb1, S[dt], 0, 0, 0);
      }
      SC_SCHED();
    }
    SC_SCHED();
    bfr* ob = p.opart + (size_t)d * NTOK * DM + (size_t)(c * 64) * DM + h * 128 + ws * 16 + fr;
#pragma unroll
    for (int rt = 0; rt < 4; ++rt) {
      const int ip0 = rt * 16 + 4 * hq;
      bfr* q = ob + (size_t)(d ? 63 - ip0 : ip0) * DM;
      const long stp = d ? -(long)DM : (long)DM;
#pragma unroll
      for (int r = 0; r < 4; ++r) q[r * stp] = f2bf(O[rt][r]);
    }
    asm volatile("s_waitcnt vmcnt(16)" ::: "memory");
    LDS_BARRIER();
    if (n + 2 < N) SC_GLDS(recp(n + 2), n & 1);
  }
#undef SC_GLDS
#undef SC_LOADWQ
#undef SC_MMAWQ
  if (!samp) {
    float* so = p.out_state + ((((size_t)s * DEPTH + l) * 2 + d) * 8 + h) * 16384;
#pragma unroll
    for (int dt = 0; dt < 8; ++dt) {
      float* q = so + (dt * 16 + 4 * hq) * 128 + ws * 16 + fr;
      asm volatile("" : "+v"(q) :: "memory");
#pragma unroll
      for (int r = 0; r < 4; ++r) q[r * 128] = S[dt][r];
    }
  }
  if (l == 1 && s == 16 && h == 0 && d == 0) GSTAMP(p.bar, 4);
  asm volatile("s_waitcnt vmcnt(0)" ::: "memory");
  __syncthreads();
  volatile __attribute__((address_space(3))) unsigned* flag = (volatile __attribute__((address_space(3))) unsigned*)(smem + XB_LDS_OFF + 8);
  if (tid == 0) {
    __builtin_amdgcn_fence(__ATOMIC_RELEASE, "agent");
    asm volatile("s_waitcnt vmcnt(0)" ::: "memory");
    const unsigned old = __hip_atomic_fetch_add(p.bar + 4096 + (l * 18 + s) * 8 + h, 1u, __ATOMIC_RELAXED, __HIP_MEMORY_SCOPE_AGENT);
    if (old == 1u) { __builtin_amdgcn_fence(__ATOMIC_ACQUIRE, "agent"); asm volatile("s_waitcnt vmcnt(0)" ::: "memory"); }
    *flag = old;
  }
  __syncthreads();
  const unsigned last = __builtin_amdgcn_readfirstlane(*flag);
  if (last == 1u && !samp) dn_finalize(p, l, tbase, 256, h, tid, NTHR);
}

__device__ __forceinline__ void dn_finalize_item(const Params& p, int l, int it) {
  const int tid = tid_opaque();
  const int s = 16 + (it >> 5), h = (it >> 2) & 7, qt = it & 3;
  __syncthreads();
  if (tid == 0) {
    unsigned* cnt = p.bar + 4096 + (l * 18 + s) * 8 + h; unsigned sp = 0;
    while (__hip_atomic_load(cnt, __ATOMIC_RELAXED, __HIP_MEMORY_SCOPE_AGENT) < 2u) { __builtin_amdgcn_s_sleep(2); if (++sp > (1u << 22)) { atomicAdd(&p.bar[XB_TMO], 1u); break; } }
    __builtin_amdgcn_fence(__ATOMIC_ACQUIRE, "agent");
    asm volatile("s_waitcnt vmcnt(0)" ::: "memory");
  }
  __syncthreads();
  dn_finalize(p, l, NCTX + (s - 16) * 1024 + qt * 256, 256, h, tid, NTHR);
}
constexpr int DYN_LDS = 163840;
#ifndef REP
#define REP 0
#endif
constexpr int CONV_A = 330, CONV_B = 330 + 768;
#ifndef USE_CG_SYNC
#define USE_CG_SYNC 1
#endif
#if USE_CG_SYNC
#define GRID_SYNC() do { cg::this_grid().sync(); } while (0)
#define GRID_SYNC_WT() GRID_SYNC()
#else
#define GRID_SYNC() do { unsigned* bar_; { PHASE_PARAMS(pb); bar_ = pb.bar; } xcd_barrier<true>(bar_); if (REP & 2048) xcd_barrier<true>(bar_); } while (0)
#define GRID_SYNC_WT() GRID_SYNC()
#endif

typedef const __attribute__((address_space(4))) Params* CParamsPtr;
#define PHASE_PARAMS(p) CParamsPtr p##_c = (CParamsPtr)__builtin_amdgcn_kernarg_segment_ptr(); asm volatile("" : "+s"(p##_c)); const Params& p = *(const Params*)p##_c

#define PF_LINES(base_ptr, nlines) do { const int g_ = bid * 512 + tid_opaque(); unsigned d0_ = 0, d1_ = 0; \
    if (g_ < (nlines)) { const char* q_ = (const char*)(base_ptr) + (size_t)g_ * 128; asm volatile("global_load_dword %0, %1, off" : "=v"(d0_) : "v"(q_) : "memory"); } \
    if ((nlines) > 131072 && g_ + 131072 < (nlines)) { const char* q_ = (const char*)(base_ptr) + (size_t)(g_ + 131072) * 128; asm volatile("global_load_dword %0, %1, off" : "=v"(d1_) : "v"(q_) : "memory"); } \
    asm volatile("s_waitcnt vmcnt(0)" ::: "memory"); asm volatile("" :: "v"(d0_), "v"(d1_)); } while (0)
__device__ __forceinline__ void panel_rows(const Params& p, int l, int mode, int bid) {
  const int tid = tid_opaque(), wid = tid >> 6, lane = tid & 63;
  const int pm = bid % 24, q = bid / 24;
  volatile __attribute__((address_space(3))) unsigned* flag = (volatile __attribute__((address_space(3))) unsigned*)(smem + XB_LDS_OFF + 8);
  asm volatile("s_waitcnt vmcnt(0)" ::: "memory");
  __syncthreads();
  if (tid == 0) {
    unsigned* cnt = p.bar + 9216 + ((l * 2 + (mode - 1)) * 24 + pm) * 16;
    __builtin_amdgcn_fence(__ATOMIC_RELEASE, "agent");
    asm volatile("s_waitcnt vmcnt(0)" ::: "memory");
    (void)__hip_atomic_fetch_add(cnt, 1u, __ATOMIC_RELAXED, __HIP_MEMORY_SCOPE_AGENT);
    unsigned sp = 0;
    while (__hip_atomic_load(cnt, __ATOMIC_RELAXED, __HIP_MEMORY_SCOPE_AGENT) < 8u) { __builtin_amdgcn_s_sleep(1); if (++sp > (1u << 22)) { atomicAdd(&p.bar[XB_TMO], 1u); break; } }
    __builtin_amdgcn_fence(__ATOMIC_ACQUIRE, "agent");
    asm volatile("s_waitcnt vmcnt(0)" ::: "memory");
    *flag = 1u;
  }
  __syncthreads();
  rows_at<4>(p, l, mode, pm * 256 + q * 32 + wid * 4, lane);
}

template <int l> __device__ __forceinline__ void run_layer(const int bid, const int nblk) {
  if (l == 1) TSTAMP(5);
  { PHASE_PARAMS(p); pg8::gemm_phase(pg8::Gemm{p.h, p.wt_in + (size_t)l * NPAD * DM, DM, DM, DM}, pg8::SchedIn{nblk, bid}, pg8::EpiIn{p.P, p.small}); }
#if REP & 1
#if REP & 65536
  { PHASE_PARAMS(p); pg8::gemm_phase(pg8::Gemm{p.h, p.wt_in + (size_t)l * NPAD * DM, DM, DM, DM}, pg8::SchedIn{nblk, bid}, pg8::EpiIn{p.P, p.small}); }
#else
  { PHASE_PARAMS(p); pg8::gemm_phase(pg8::Gemm{p.h, p.wt_in + (size_t)l * NPAD * DM, DM, DM, DM}, pg8::SchedIn{nblk, bid}, pg8::EpiIn{p.P, p.small}); }
#endif
#endif
  GRID_SYNC_WT(); if (l == 1) TSTAMP(6);
  { PHASE_PARAMS(p); for (int it = bid; it < 768; it += nblk) dn_prep_item(p, l, it >> 3, it & 7); }
#if REP & 2
  { PHASE_PARAMS(p); for (int it = bid; it < 768; it += nblk) dn_prep_item(p, l, it >> 3, it & 7); }
#endif
  if (l == 1) TSTAMP(15);
  { PHASE_PARAMS(p); for (int it = bid; it < 384; it += nblk) light_prep_item(p, l, it); }
#if REP & 4096
  { PHASE_PARAMS(p); for (int it = bid; it < 384; it += nblk) light_prep_item(p, l, it); }
#endif
  unsigned pf_ = 0;
  { PHASE_PARAMS(p); const int gid = bid * 512 + tid_opaque(); const char* q;
    if (gid < 98304) q = (const char*)p.h + (size_t)gid * 128;
    else if (gid < 114688) q = (const char*)(p.wt_in + (size_t)l * NPAD * DM + (size_t)42 * 256 * DM) + (size_t)(gid - 98304) * 128;
    else if (gid < 118784) q = (const char*)(p.wt_in + (size_t)l * NPAD * DM + (size_t)37 * 256 * DM) + (size_t)(gid - 114688) * 128;
    else q = (const char*)(p.wt_br + (size_t)(l * 3 + 1) * DM * DM) + (size_t)((gid - 118784) & 8191) * 128;
    asm volatile("global_load_dword %0, %1, off" : "=v"(pf_) : "v"(q) : "memory"); }
  GRID_SYNC(); if (l == 1) TSTAMP(7);
  asm volatile("" :: "v"(pf_));
#define P3_PULL(slotword, limit) \
      volatile __attribute__((address_space(3))) unsigned* qslot = (volatile __attribute__((address_space(3))) unsigned*)(smem + XB_LDS_OFF + 12); \
      __syncthreads(); \
      if (tid_opaque() == 0) { PHASE_PARAMS(pq); *qslot = __hip_atomic_fetch_add(pq.bar + 8192 + l * 8 + rep3 * 4 + (slotword), 1u, __ATOMIC_RELAXED, __HIP_MEMORY_SCOPE_AGENT); } \
      __syncthreads(); \
      const int it = __builtin_amdgcn_readfirstlane((int)*qslot); \
      if (it >= (limit)) break;
#pragma unroll 1
  for (int rep3 = 0; rep3 < ((REP & 4) ? 2 : 1); ++rep3) {
    if (bid < 64) { PHASE_PARAMS(p); attn_item(p, bid); }
    else {
      if (bid >= 192)
#pragma unroll 1
      for (int rr_ = 0; rr_ < ((REP & 131072) ? 2 : 1); ++rr_) {
        const int it = bid - 192; TSTAMP(1);
        if (it >= 32) { PHASE_PARAMS(p); const int k = it - 32; pg8::Unit u; if (k < 8) { u.pm = 16 + k; u.pn = 37; } else { u.pm = (k - 8) % 24; u.pn = 42 + (k - 8) / 24; } u.z = 0; u.ka = 0; u.kb = 0;
          pg8::gemm_phase(pg8::Gemm{p.h, p.wt_in + (size_t)l * NPAD * DM, DM, DM, DM}, pg8::SchedOne{u}, pg8::EpiIn{p.P, p.small}); }
        else { PHASE_PARAMS(p); pg8::Unit u; u.pm = it % 24; u.pn = it / 24; u.z = 1; u.ka = (size_t)NTOK * DM; u.kb = (size_t)DM * DM;
          pg8::gemm_phase(pg8::Gemm{p.obr, p.wt_br + (size_t)l * 3 * DM * DM, DM, DM, DM}, pg8::SchedOne{u}, pg8::EpiBr{p.a3, p.P}); }
      }
      TSTAMP(2);
#pragma unroll 1
      for (int j = bid - 64; j < 32 + 256; j += (bid < 96 ? 1000 : 160)) {
        PHASE_PARAMS(p);
        if (j < 32) dn_scan_item(p, l, 16 + (j >> 4), (j >> 1) & 7, j & 1); else { const int jj = j - 32; dn_scan_item(p, l, jj >> 4, (jj >> 1) & 7, jj & 1); }
      }
    }
    TSTAMP(3);
#define P3_TICKET(var) do { volatile __attribute__((address_space(3))) unsigned* qslot = (volatile __attribute__((address_space(3))) unsigned*)(smem + XB_LDS_OFF + 12); \
      __syncthreads(); \
      if (tid_opaque() == 0) { PHASE_PARAMS(pq); *qslot = __hip_atomic_fetch_add(pq.bar + 8192 + l * 8 + rep3 * 4 + 2, 1u, __ATOMIC_RELAXED, __HIP_MEMORY_SCOPE_AGENT); } \
      __syncthreads(); \
      var = __builtin_amdgcn_readfirstlane((int)*qslot); } while (0)
    int tk; P3_TICKET(tk);
#pragma unroll 1
    while (tk < 128) { { PHASE_PARAMS(p); attn_item(p, 64 + tk); } P3_TICKET(tk); }
#pragma unroll 1
    while (tk < 200) { const int itd = tk - 128 + 64;
      if (itd >= 32) { PHASE_PARAMS(p); const int k = itd - 32; pg8::Unit u; if (k < 8) { u.pm = 16 + k; u.pn = 37; } else { u.pm = (k - 8) % 24; u.pn = 42 + (k - 8) / 24; } u.z = 0; u.ka = 0; u.kb = 0;
        pg8::gemm_phase(pg8::Gemm{p.h, p.wt_in + (size_t)l * NPAD * DM, DM, DM, DM}, pg8::SchedOne{u}, pg8::EpiIn{p.P, p.small}); }
      else { PHASE_PARAMS(p); pg8::Unit u; u.pm = itd % 24; u.pn = itd / 24; u.z = 1; u.ka = (size_t)NTOK * DM; u.kb = (size_t)DM * DM;
        pg8::gemm_phase(pg8::Gemm{p.obr, p.wt_br + (size_t)l * 3 * DM * DM, DM, DM, DM}, pg8::SchedOne{u}, pg8::EpiBr{p.a3, p.P}); }
      P3_TICKET(tk);
    }
#pragma unroll 1
    while (tk < 264) { { PHASE_PARAMS(p); dn_finalize_item(p, l, tk - 200); } P3_TICKET(tk); }
#undef P3_TICKET
  }
#undef P3_PULL
  GRID_SYNC(); if (l == 1) TSTAMP(8);
  { PHASE_PARAMS(p); pg8::gemm_phase(pg8::Gemm{p.obr, p.wt_br + (size_t)l * 3 * DM * DM, DM, DM, DM}, pg8::SchedBr{nblk, bid}, pg8::EpiBr{p.a3, p.P}); }
#if REP & 8
  { PHASE_PARAMS(p); pg8::gemm_phase(pg8::Gemm{p.obr, p.wt_br + (size_t)l * 3 * DM * DM, DM, DM, DM}, pg8::SchedBr{nblk, bid}, pg8::EpiBr{p.a3, p.P}); }
#endif
  GRID_SYNC_WT(); if (l == 1) TSTAMP(9);
  { PHASE_PARAMS(p); pg8::gemm_phase(pg8::Gemm{p.a3, p.wt_out + (size_t)l * DM * 3072, 3072, 3072, 1536}, pg8::SchedSplit2<1536>{nblk, bid}, pg8::EpiPart{(bfr*)p.R}); }
  if (l + 1 < DEPTH && bid >= 192) { PHASE_PARAMS(p); for (int k = bid - 192; k < CONV_A; k += nblk - 192) convert_item(p, l + 1, k); }
#if REP & 16
  { PHASE_PARAMS(p); pg8::gemm_phase(pg8::Gemm{p.a3, p.wt_out + (size_t)l * DM * 3072, 3072, 3072, 1536}, pg8::SchedSplit2<1536>{nblk, bid}, pg8::EpiPart{(bfr*)p.R}); }
#endif
  GRID_SYNC_WT(); if (l == 1) TSTAMP(10);
  { PHASE_PARAMS(p); stage_row(p, l, 1, bid, nblk); }
  GRID_SYNC(); if (l == 1) TSTAMP(11);
  { PHASE_PARAMS(p); pg8::gemm_phase(pg8::Gemm{p.h, p.wt_up + (size_t)l * HID * DM, DM, DM, DM}, pg8::SchedUp{nblk, bid}, pg8::EpiUp{p.u2}); }
  if (l + 1 < DEPTH && bid >= 128) { PHASE_PARAMS(p); for (int k = CONV_A + bid - 128; k < CONV_B; k += 128) convert_item(p, l + 1, k); }
#if REP & 32
  { PHASE_PARAMS(p); pg8::gemm_phase(pg8::Gemm{p.h, p.wt_up + (size_t)l * HID * DM, DM, DM, DM}, pg8::SchedUp{nblk, bid}, pg8::EpiUp{p.u2}); }
#endif
  GRID_SYNC_WT(); if (l == 1) TSTAMP(12);
  { PHASE_PARAMS(p); pg8::gemm_phase(pg8::Gemm{p.u2, p.wt_dn + (size_t)l * DM * HID, HID, HID, 2048}, pg8::SchedSplit2<2048>{nblk, bid}, pg8::EpiPart{(bfr*)p.R}); }
  if (l + 1 < DEPTH && bid >= 192) { PHASE_PARAMS(p); for (int k = CONV_B + bid - 192; k < CONV_ITEMS; k += nblk - 192) convert_item(p, l + 1, k); __syncthreads(); stage_mod(p, (l + 1) * 48, 48, bid - 192, nblk - 192, smem); }
  GRID_SYNC_WT(); if (l == 1) TSTAMP(13);
  { PHASE_PARAMS(p); stage_row(p, l, 2, bid, nblk); }
  if (l + 1 < DEPTH) GRID_SYNC(); if (l == 1) TSTAMP(14);
}

__global__ __launch_bounds__(512) void mega_kernel(Params p_arg) {
#if USE_CG_SYNC
  cg::grid_group grid = cg::this_grid();
#endif
  const int bid = blockIdx.x, nblk = gridDim.x;
#if !USE_CG_SYNC
  { PHASE_PARAMS(pb); xcd_barrier_post(pb.bar); }
  cg::this_grid().sync();
#endif
#ifdef DIAG_A
  if (threadIdx.x < 32) ((unsigned long long*)(smem + 163840 - 256))[threadIdx.x & 15] = 0ull;
  __syncthreads();
#endif
  { PHASE_PARAMS(p); stage_mod(p, 0, 48, bid, nblk, smem); }
  { PHASE_PARAMS(p); for (int it = bid; it < CONV_ITEMS; it += nblk) convert_item(p, 0, it); }
#if REP & 128
  { PHASE_PARAMS(p); for (int it = bid; it < CONV_ITEMS; it += nblk) convert_item(p, 0, it); }
#endif
  GRID_SYNC();
  { PHASE_PARAMS(p); stage_row(p, 0, 0, bid, nblk); }
#if REP & 16384
  { PHASE_PARAMS(p); stage_row(p, 0, 0, bid, nblk); }
#endif
  GRID_SYNC();
  run_layer<0>(bid, nblk); run_layer<1>(bid, nblk); run_layer<2>(bid, nblk); run_layer<3>(bid, nblk);
#ifdef DIAG_A
  __syncthreads();
  if (blockIdx.x == DIAG_BLK && threadIdx.x == 0) { const unsigned long long* ts_ = (const unsigned long long*)(smem + 163840 - 256); PHASE_PARAMS(pd); asm volatile("s_waitcnt vmcnt(0)" ::: "memory");
#ifdef DIAG_G
    const unsigned long long* gs_ = (const unsigned long long*)(pd.bar + 12288); const unsigned long long ta_ = __hip_atomic_load(gs_ + DIAG_A, __ATOMIC_RELAXED, __HIP_MEMORY_SCOPE_AGENT), tb_ = __hip_atomic_load(gs_ + DIAG_B, __ATOMIC_RELAXED, __HIP_MEMORY_SCOPE_AGENT);
    pd.xbuf[0] = 1000.0f * rintf(4.0f * log2f((float)(tb_ - ta_) * 10.0f));
#else
    pd.xbuf[(size_t)DIAG_BLK * 24 * 1024] = 1000.0f * rintf(4.0f * log2f((float)(ts_[DIAG_B] - ts_[DIAG_A]) * 10.0f));
#endif
  }
#endif
}

__global__ void diag_fill(float* out, long n, float v) { for (long i = blockIdx.x * 256L + threadIdx.x; i < n; i += gridDim.x * 256L) out[i] = (i == 0) ? v : 0.f; }
static size_t align_up(size_t x) { return (x + 255) & ~(size_t)255; }
static bool make_params(Params& p, void* const* d_in, void* d_out, void* d_ws, size_t ws_size) {
  const float** in = (const float**)d_in;
  p.x_prompt = in[0]; p.x_sample = in[1]; p.cache_k = in[2]; p.cache_v = in[3]; p.state_dn = in[4]; p.c = in[5]; p.c_ctx = in[6];
  p.w_mod = in[7]; p.b_mod = in[8]; p.g_pre_mix = in[9]; p.g_post_mix = in[10]; p.g_pre_mlp = in[11]; p.g_post_mlp = in[12];
  p.w_in = in[13]; p.w_conv_dn = in[14]; p.a_log = in[15]; p.dt_bias = in[16]; p.g_dn_out = in[17]; p.w_conv_sc = in[18];
  p.g_q = in[19]; p.g_k = in[20]; p.w_br_dn = in[21]; p.w_br_sc = in[22]; p.w_br_att = in[23]; p.w_out = in[24];
  p.w_mlp_up = in[25]; p.w_mlp_down = in[26];
  float* out = (float*)d_out;
  p.xbuf = out; p.out_ck = out + 6291456; p.out_cv = p.out_ck + 4194304; p.out_state = p.out_cv + 4194304;
  char* w = (char*)d_ws; size_t off = 0;
  auto take = [&](size_t bytes) { char* r = w + off; off = align_up(off + bytes); return r; };
  p.bar   = (unsigned*)take(65536);
  p.wt_in = (bfr*)take((size_t)DEPTH * NPAD * DM * 2);
  p.wt_br = (bfr*)take((size_t)DEPTH * 3 * DM * DM * 2);
  p.wt_out= (bfr*)take((size_t)DEPTH * DM * 3072 * 2);
  p.wt_up = (bfr*)take((size_t)DEPTH * HID * DM * 2);
  p.wt_dn = (bfr*)take((size_t)DEPTH * DM * HID * 2);
  p.mod   = (float*)take((size_t)DEPTH * 3 * 6144 * 4);
  p.h     = (bfr*)take((size_t)NTOK * DM * 2);
  p.P     = (bfr*)take((size_t)NTOK * NP * 2);
  p.u2    = p.P;
  p.small = (float*)take((size_t)NTOK * 32 * 4);
  p.dnrec = take((size_t)1536 * REC_BYTES);
  p.glast = (float*)take(1536 * 4);
  p.opart = (bfr*)take((size_t)2 * NTOK * DM * 2);
  p.obr   = (bfr*)take((size_t)3 * NTOK * DM * 2);
  p.Q     = (bfr*)take((size_t)NTOK * DM * 2);
  p.Kc    = (bfr*)take((size_t)NCTX * 256 * 2);
  p.Vc    = (bfr*)take((size_t)NCTX * 256 * 2);
  p.Ks    = (bfr*)take((size_t)2 * 1280 * 256 * 2);
  p.Vs    = (bfr*)take((size_t)2 * 1280 * 256 * 2);
  p.merged= (bfr*)take((size_t)NTOK * DM * 2);
  p.a3    = (bfr*)take((size_t)NTOK * 3072 * 2);
  p.R     = (float*)take((size_t)4 * NTOK * DM * 4);
  return off <= ws_size;
}
extern "C" void kernel_launch(void* const* d_in, const int* in_sizes, int n_in, void* d_out, int out_size, void* d_ws, size_t ws_size, hipStream_t stream) {
  Params p{};
  if (n_in != 27 || out_size != 31457280) { diag_fill<<<1024, 256, 0, stream>>>((float*)d_out, (long)out_size, 3.0e6f + n_in); return; }
  if (!make_params(p, d_in, d_out, d_ws, ws_size)) { diag_fill<<<1024, 256, 0, stream>>>((float*)d_out, (long)out_size, (float)(ws_size >> 20)); return; }
  static int grid_blocks = 0;
  if (!grid_blocks) {
    (void)hipFuncSetAttribute((const void*)mega_kernel, hipFuncAttributeMaxDynamicSharedMemorySize, DYN_LDS);
    int dev = 0, cus = 0, per_cu = 0;
    (void)hipGetDevice(&dev);
    (void)hipDeviceGetAttribute(&cus, hipDeviceAttributeMultiprocessorCount, dev);
    (void)hipOccupancyMaxActiveBlocksPerMultiprocessor(&per_cu, mega_kernel, 512, DYN_LDS);
    grid_blocks = (per_cu >= 1 && cus >= 256) ? 256 : cus * per_cu;
    if (grid_blocks <= 0) { fprintf(stderr, "kernel_launch: occupancy query gave cus %d per_cu %d\n", cus, per_cu); grid_blocks = 0; return; }
  }
  (void)hipMemsetAsync(p.bar, 0, 65536, stream);
  void* args[] = {&p};
  const hipError_t e = hipLaunchCooperativeKernel((void*)mega_kernel, dim3(grid_blocks), dim3(512), args, DYN_LDS, stream);
  if (e != hipSuccess) fprintf(stderr, "cooperative launch failed: %s (grid %d)\n", hipGetErrorString(e), grid_blocks);
}
```

```cpp
#define USE_CG_SYNC 0
#include <hip/hip_runtime.h>
#include <hip/hip_bf16.h>
#include <hip/hip_cooperative_groups.h>
#include <cstdio>
#include <cstdint>
namespace cg = cooperative_groups;

typedef unsigned short bfr;
using bf16x8 = __attribute__((ext_vector_type(8))) short;
using s16x4  = __attribute__((ext_vector_type(4))) short;
using f32x4  = __attribute__((ext_vector_type(4))) float;
using f32x16 = __attribute__((ext_vector_type(16))) float;
using u32x4  = __attribute__((ext_vector_type(4))) unsigned;
using u32x2  = __attribute__((ext_vector_type(2))) unsigned;

extern __shared__ __attribute__((aligned(16))) char smem[];
__device__ __forceinline__ char* smem_base() { return smem; }
constexpr int DM = 1024, NTOK = 6144, NCTX = 4096, DEPTH = 4;
constexpr int NIN = 11808;
constexpr int NP = 11776;
constexpr int NPAD = 12032;
constexpr int HID = 4096;
constexpr float EPS = 1e-6f;
constexpr int C_DQ = 0, C_DK = 1024, C_DV = 2048, C_DG = 3072, C_SB = 4096, C_SCG = 5120, C_SX = 6144,
              C_AQ = 7168, C_AK = 8192, C_AV = 8448, C_MG = 8704;

constexpr int REC_U = 0, REC_W = 16384, REC_QD = 32768, REC_QK = 49152, REC_KD = 57344, REC_BYTES = 73728;

struct Params {
  const float *x_prompt, *x_sample, *cache_k, *cache_v, *state_dn, *c, *c_ctx, *w_mod, *b_mod;
  const float *g_pre_mix, *g_post_mix, *g_pre_mlp, *g_post_mlp, *w_in, *w_conv_dn, *a_log, *dt_bias, *g_dn_out;
  const float *w_conv_sc, *g_q, *g_k, *w_br_dn, *w_br_sc, *w_br_att, *w_out, *w_mlp_up, *w_mlp_down;
  float *xbuf;
  float *out_ck, *out_cv, *out_state;
  bfr *wt_in, *wt_br, *wt_out, *wt_up, *wt_dn;
  float *mod;
  bfr *h;
  bfr *P;
  float *small;
  char *dnrec;
  float *glast;
  bfr *opart;
  bfr *obr;
  bfr *Q;
  bfr *Kc, *Vc;
  bfr *Ks, *Vs;
  bfr *merged;
  bfr *a3;
  float *R;
  bfr *u2;
  unsigned *bar;
};

__device__ __forceinline__ bfr f2bf(float f) { unsigned u = __float_as_uint(f); u += 0x7fffu + ((u >> 16) & 1u); return (bfr)(u >> 16); }
__device__ __forceinline__ float bf2f(bfr b) { return __uint_as_float(((unsigned)b) << 16); }
__device__ __forceinline__ unsigned pack2(float a, float b) { return (unsigned)f2bf(a) | ((unsigned)f2bf(b) << 16); }
__device__ __forceinline__ unsigned pack2hw(float a, float b) { unsigned r; asm("v_cvt_pk_bf16_f32 %0, %1, %2" : "=v"(r) : "v"(a), "v"(b)); return r; }
__device__ __forceinline__ float sigmoidf_(float x) { return 1.f / (1.f + __expf(-x)); }
__device__ __forceinline__ float siluf_(float x) { return x * __builtin_amdgcn_rcpf(1.f + __expf(-x)); }
__device__ __forceinline__ float softplusf_(float x) { return x > 20.f ? x : log1pf(__expf(x)); }

__device__ __forceinline__ int tok_modrow(int t) { return t < NCTX ? 0 : 1 + ((t - NCTX) >> 10); }
__device__ __forceinline__ int tok_L(int t) { return t < NCTX ? 256 : 1024; }
__device__ __forceinline__ int tok_pos(int t) { return t < NCTX ? (t & 255) : ((t - NCTX) & 1023); }

__host__ __device__ __forceinline__ int perm_col(int n) { return n < 4096 ? n : (n < 4128 ? NP + (n - 4096) : n - 32); }

__device__ __forceinline__ int tid_opaque() { int t = threadIdx.x; asm volatile("" : "+v"(t)); return t; }

#ifdef DIAG_A
#ifndef DIAG_BLK
#define DIAG_BLK 0
#endif
#define TSTAMP(k) do { if (blockIdx.x == DIAG_BLK && threadIdx.x == 0) { unsigned long long* ts_ = (unsigned long long*)(smem_base() + 163840 - 256); if (ts_[(k)] == 0ull) ts_[(k)] = wall_clock64(); } } while (0)
#else
#define TSTAMP(k) do {} while (0)
#endif

#ifdef DIAG_A
#define GSTAMP(bar, k) do { if (threadIdx.x == 0) __hip_atomic_store((unsigned long long*)((bar) + 12288) + (k), (unsigned long long)wall_clock64(), __ATOMIC_RELAXED, __HIP_MEMORY_SCOPE_AGENT); } while (0)
#else
#define GSTAMP(bar, k) do {} while (0)
#endif

#ifdef DIAG_G
#define GMAX(bar, k) do { if (threadIdx.x == 0) __hip_atomic_fetch_max((unsigned long long*)((bar) + 12288) + (k), (unsigned long long)wall_clock64(), __ATOMIC_RELAXED, __HIP_MEMORY_SCOPE_AGENT); } while (0)
#else
#define GMAX(bar, k) do {} while (0)
#endif
#define NTHR 512

__device__ __forceinline__ void stage_mod(const Params& p, int item0, int nitems, int w, int nw, char* lds) {
  float* s = (float*)lds;
  float* red = s + 3072;
  const int tid = tid_opaque();
  for (int i = tid; i < 3072; i += NTHR) { int j = i >> 10, k = i & 1023; float c = (j == 0) ? p.c_ctx[k] : p.c[(j - 1) * 1024 + k]; s[i] = siluf_(c); }
  __syncthreads();
  for (int item = item0 + w; item < item0 + nitems; item += nw) {
    const int l = item / 48, nb = item % 48, cq = tid & 31, ks = tid >> 5;
    const float* W = p.w_mod + ((size_t)l * 1024 + ks * 64) * 6144 + nb * 128 + cq * 4;
    float a[3][4] = {};
    for (int k = 0; k < 64; ++k) {
      const float4 w = *(const float4*)(W + (size_t)k * 6144);
#pragma unroll
      for (int j = 0; j < 3; ++j) { const float sv = s[j * 1024 + ks * 64 + k]; a[j][0] += sv * w.x; a[j][1] += sv * w.y; a[j][2] += sv * w.z; a[j][3] += sv * w.w; }
    }
    __syncthreads();
#pragma unroll
    for (int j = 0; j < 3; ++j)
#pragma unroll
      for (int q = 0; q < 4; ++q) red[(ks * 3 + j) * 128 + cq * 4 + q] = a[j][q];
    __syncthreads();
    if (tid < 384) { const int j = tid >> 7, n = tid & 127; float sum = 0; for (int q = 0; q < 16; ++q) sum += red[(q * 3 + j) * 128 + n];
      p.mod[(size_t)(l * 3 + j) * 6144 + nb * 128 + n] = sum + p.b_mod[l * 6144 + nb * 128 + n]; }
  }
  __syncthreads();
}

__device__ __forceinline__ float wave_sum(float v) {
#pragma unroll
  for (int o = 32; o > 0; o >>= 1) v += __shfl_xor(v, o);
  return v;
}

template <int NR>
__device__ __forceinline__ void rows_at(const Params& p, int l, int mode, int row0, int lane) {
  float4 x[NR][4], r[NR][4];
#pragma unroll
  for (int j = 0; j < NR; ++j) {
    const int row = row0 + j;
    if (l == 0 && mode <= 1) {
      const float* xin = row < NCTX ? p.x_prompt + (size_t)row * DM : p.x_sample + (size_t)(row - NCTX) * DM;
#pragma unroll
      for (int i = 0; i < 4; ++i) x[j][i] = *(const float4*)(xin + lane * 4 + 256 * i);
    } else {
      const bfr* xin = p.merged + (size_t)row * DM;
#pragma unroll
      for (int i = 0; i < 4; ++i) { const u32x2 a = *(const u32x2*)(xin + lane * 4 + 256 * i);
        x[j][i] = make_float4(__uint_as_float(a[0] << 16), __uint_as_float(a[0] & 0xffff0000u), __uint_as_float(a[1] << 16), __uint_as_float(a[1] & 0xffff0000u)); }
    }
    if (mode != 0) {
      const bfr* rr = (const bfr*)p.R + (size_t)row * DM;
#pragma unroll
      for (int i = 0; i < 4; ++i) { const u32x2 a = *(const u32x2*)(rr + lane * 4 + 256 * i), b = *(const u32x2*)(rr + (size_t)NTOK * DM + lane * 4 + 256 * i);
        r[j][i] = make_float4(__uint_as_float(a[0] << 16) + __uint_as_float(b[0] << 16), __uint_as_float(a[0] & 0xffff0000u) + __uint_as_float(b[0] & 0xffff0000u),
                              __uint_as_float(a[1] << 16) + __uint_as_float(b[1] << 16), __uint_as_float(a[1] & 0xffff0000u) + __uint_as_float(b[1] & 0xffff0000u)); }
    }
  }
  if (mode != 0) {
    const float* gpost = (mode == 1 ? p.g_post_mix : p.g_post_mlp) + l * DM;
    float4 g[4];
#pragma unroll
    for (int i = 0; i < 4; ++i) g[i] = *(const float4*)(gpost + lane * 4 + 256 * i);
#pragma unroll
    for (int j = 0; j < NR; ++j) {
      const int row = row0 + j;
      const float* gate = p.mod + (size_t)(l * 3 + tok_modrow(row)) * 6144 + (mode == 1 ? 2048 : 5120);
      float ss = 0;
#pragma unroll
      for (int i = 0; i < 4; ++i) ss += r[j][i].x * r[j][i].x + r[j][i].y * r[j][i].y + r[j][i].z * r[j][i].z + r[j][i].w * r[j][i].w;
      ss = wave_sum(ss);
      const float nrm = rsqrtf(ss * (1.f / DM) + EPS);
#pragma unroll
      for (int i = 0; i < 4; ++i) {
        const float4 gt = *(const float4*)(gate + lane * 4 + 256 * i);
        x[j][i].x += gt.x * (r[j][i].x * nrm * g[i].x); x[j][i].y += gt.y * (r[j][i].y * nrm * g[i].y); x[j][i].z += gt.z * (r[j][i].z * nrm * g[i].z); x[j][i].w += gt.w * (r[j][i].w * nrm * g[i].w);
        if (mode == 2 && l == DEPTH - 1) *(float4*)(p.xbuf + (size_t)row * DM + lane * 4 + 256 * i) = x[j][i];
        else { u32x2 o = {pack2hw(x[j][i].x, x[j][i].y), pack2hw(x[j][i].z, x[j][i].w)}; *(u32x2*)(p.merged + (size_t)row * DM + lane * 4 + 256 * i) = o; }
      }
    }
  }
  if (mode == 2 && l == DEPTH - 1) return;
  const int ln = (mode == 2) ? l + 1 : l;
  const float* gpre = (mode == 1 ? p.g_pre_mlp : p.g_pre_mix) + ln * DM;
  float4 gp[4];
#pragma unroll
  for (int i = 0; i < 4; ++i) gp[i] = *(const float4*)(gpre + lane * 4 + 256 * i);
#pragma unroll
  for (int j = 0; j < NR; ++j) {
    const int row = row0 + j;
    const float* modn = p.mod + (size_t)(ln * 3 + tok_modrow(row)) * 6144;
    const float* sh = modn + (mode == 1 ? 3072 : 0);
    const float* sc = modn + (mode == 1 ? 4096 : 1024);
    float ss = 0;
#pragma unroll
    for (int i = 0; i < 4; ++i) ss += x[j][i].x * x[j][i].x + x[j][i].y * x[j][i].y + x[j][i].z * x[j][i].z + x[j][i].w * x[j][i].w;
    ss = wave_sum(ss);
    const float nrm = rsqrtf(ss * (1.f / DM) + EPS);
#pragma unroll
    for (int i = 0; i < 4; ++i) {
      const float4 s1 = *(const float4*)(sc + lane * 4 + 256 * i), s0 = *(const float4*)(sh + lane * 4 + 256 * i);
      const float h0 = x[j][i].x * nrm * gp[i].x * (1.f + s1.x) + s0.x, h1 = x[j][i].y * nrm * gp[i].y * (1.f + s1.y) + s0.y;
      const float h2 = x[j][i].z * nrm * gp[i].z * (1.f + s1.z) + s0.z, h3 = x[j][i].w * nrm * gp[i].w * (1.f + s1.w) + s0.w;
      u32x2 o = {pack2hw(h0, h1), pack2hw(h2, h3)};
      *(u32x2*)(p.h + (size_t)row * DM + lane * 4 + 256 * i) = o;
    }
  }
}

__device__ __forceinline__ void stage_row(const Params& p, int l, int mode, int bid, int nblk) {
  const int tx_ = tid_opaque(), wid = tx_ >> 6, lane = tx_ & 63;
  const int row0 = (bid * 8 + wid) * 3;
  if (row0 >= NTOK) return;
  rows_at<3>(p, l, mode, row0, lane);
}

__device__ __forceinline__ void unpack8(const u32x4 v, float* f) {
#pragma unroll
  for (int i = 0; i < 4; ++i) { f[2 * i] = __uint_as_float(v[i] << 16); f[2 * i + 1] = __uint_as_float(v[i] & 0xffff0000u); }
}
__device__ __forceinline__ u32x4 pack8(const float* f) { u32x4 v = {pack2(f[0], f[1]), pack2(f[2], f[3]), pack2(f[4], f[5]), pack2(f[6], f[7])}; return v; }
__device__ __forceinline__ u32x4 pack8hw(const float* f) { u32x4 v = {pack2hw(f[0], f[1]), pack2hw(f[2], f[3]), pack2hw(f[4], f[5]), pack2hw(f[6], f[7])}; return v; }

__device__ __forceinline__ void light_prep_item(const Params& p, int l, int item) {
  const int tid = tid_opaque(), t0 = item * 16;
  const bool samp = t0 >= NCTX;
  {
    const float* wsc = p.w_conv_sc + (size_t)l * 3 * DM;
    bfr* scin = p.obr + (size_t)1 * NTOK * DM;
    const int g = tid & 127, rq = tid >> 7, r0 = rq * 4, tA = t0 + r0, posA = tok_pos(tA), L = tok_L(tA);
    u32x4 cg[6], cx[6], sbv[4];
#pragma unroll
    for (int k = 0; k < 6; ++k) {
      const int pos = posA + k - 1;
      cg[k] = u32x4{0u, 0u, 0u, 0u}; cx[k] = u32x4{0u, 0u, 0u, 0u};
      if (pos >= 0 && pos < L) { const bfr* row = p.P + (size_t)(tA + k - 1) * NP; cg[k] = *(const u32x4*)(row + C_SCG + g * 8); cx[k] = *(const u32x4*)(row + C_SX + g * 8); }
    }
#pragma unroll
    for (int r = 0; r < 4; ++r) sbv[r] = *(const u32x4*)(p.P + (size_t)(tA + r) * NP + C_SB + g * 8);
    float w[3][8];
#pragma unroll
    for (int k = 0; k < 3; ++k) { *(float4*)&w[k][0] = *(const float4*)(wsc + k * DM + g * 8); *(float4*)&w[k][4] = *(const float4*)(wsc + k * DM + g * 8 + 4); }
    float prod[6][8];
#pragma unroll
    for (int k = 0; k < 6; ++k) { float a[8], b[8]; unpack8(cg[k], a); unpack8(cx[k], b);
#pragma unroll
      for (int q = 0; q < 8; ++q) prod[k][q] = a[q] * b[q]; }
#pragma unroll
    for (int r = 0; r < 4; ++r) {
      float sb[8], acc[8]; unpack8(sbv[r], sb);
#pragma unroll
      for (int q = 0; q < 8; ++q) acc[q] = sb[q] * (w[0][q] * prod[r][q] + w[1][q] * prod[r + 1][q] + w[2][q] * prod[r + 2][q]);
      *(u32x4*)(scin + (size_t)(tA + r) * DM + g * 8) = pack8hw(acc);
    }
  }
  {
    const int sub = tid & 15;
    u32x4 xin[5];
#pragma unroll
    for (int it5 = 0; it5 < 5; ++it5) {
      const int pr = (tid >> 4) + it5 * 32, r = pr / 10, hh = pr % 10, t = t0 + r;
      xin[it5] = *(const u32x4*)(p.P + (size_t)t * NP + (hh < 8 ? C_AQ + hh * 128 : C_AK + (hh - 8) * 128) + sub * 8);
    }
#pragma unroll
    for (int it5 = 0; it5 < 5; ++it5) {
      const int pr = (tid >> 4) + it5 * 32;
      const int r = pr / 10, hh = pr % 10, t = t0 + r;
      const bool isq = hh < 8;
      float x[8]; unpack8(xin[it5], x);
      float ss = 0;
#pragma unroll
      for (int q = 0; q < 8; ++q) ss += x[q] * x[q];
      ss += __shfl_xor(ss, 1); ss += __shfl_xor(ss, 2); ss += __shfl_xor(ss, 4); ss += __shfl_xor(ss, 8);
      const float nrm = rsqrtf(ss * (1.f / 128.f) + EPS);
      const float* g = (isq ? p.g_q : p.g_k) + l * 128 + sub * 8;
#pragma unroll
      for (int q = 0; q < 8; ++q) x[q] = x[q] * nrm * g[q];
      if (samp) {
        const int pos = tok_pos(t);
        const float pidx = (sub < 8) ? (float)(pos >> 6) : (float)(pos & 63);
        const int s8 = sub & 7;
        const bool lo = s8 < 4;
        float y[8];
#pragma unroll
        for (int q = 0; q < 8; ++q) {
          const float other = __shfl_xor(x[q], 4);
          const int fi = (s8 & 3) * 8 + q;
          const float freq = exp2f(-(float)fi * (13.287712379549449f / 32.f));
          const float ang = pidx * freq;
          float sn, cs; __sincosf(ang, &sn, &cs);
          y[q] = lo ? (x[q] * cs - other * sn) : (other * sn + x[q] * cs);
        }
#pragma unroll
        for (int q = 0; q < 8; ++q) x[q] = y[q];
      }
      if (isq) {
        *(u32x4*)(p.Q + (size_t)t * DM + hh * 128 + sub * 8) = pack8hw(x);
      } else {
        const int kvh = hh - 8;
        if (!samp) {
          *(u32x4*)(p.Kc + (size_t)t * 256 + kvh * 128 + sub * 8) = pack8hw(x);
          const int b = t >> 8, pos = t & 255;
          float* o = p.out_ck + ((((size_t)b * DEPTH + l) * 256 + pos) * 2 + kvh) * 128 + sub * 8;
          *(float4*)o = make_float4(x[0], x[1], x[2], x[3]); *(float4*)(o + 4) = make_float4(x[4], x[5], x[6], x[7]);
        } else {
          const int s = t - NCTX, b = s >> 10, pos = s & 1023;
          *(u32x4*)(p.Ks + ((size_t)b * 1280 + 256 + pos) * 256 + kvh * 128 + sub * 8) = pack8hw(x);
        }
      }
    }
  }
  for (int idx = tid; idx < 16 * 32; idx += NTHR) {
    const int r = idx >> 5, g = idx & 31, t = t0 + r;
    const u32x4 v = *(const u32x4*)(p.P + (size_t)t * NP + C_AV + g * 8);
    if (!samp) {
      *(u32x4*)(p.Vc + (size_t)t * 256 + g * 8) = v;
      float f[8]; unpack8(v, f);
      const int b = t >> 8, pos = t & 255;
      float* o = p.out_cv + (((size_t)b * DEPTH + l) * 256 + pos) * 256 + g * 8;
      *(float4*)o = make_float4(f[0], f[1], f[2], f[3]); *(float4*)(o + 4) = make_float4(f[4], f[5], f[6], f[7]);
    } else {
      const int s = t - NCTX, b = s >> 10, pos = s & 1023;
      *(u32x4*)(p.Vs + ((size_t)b * 1280 + 256 + pos) * 256 + g * 8) = v;
    }
  }
  if (samp) {
    const int cs = item - 256, b = cs >> 6, pos0 = (cs & 63) * 4;
    for (int idx = tid; idx < 2 * 4 * 32; idx += NTHR) {
      const int which = idx >> 7, r = (idx >> 5) & 3, g = idx & 31, pos = pos0 + r;
      const float* src = (which ? p.cache_v : p.cache_k) + (((size_t)b * DEPTH + l) * 256 + pos) * 256 + g * 8;
      float f[8]; *(float4*)f = *(const float4*)src; *(float4*)(f + 4) = *(const float4*)(src + 4);
      *(u32x4*)((which ? p.Vs : p.Ks) + ((size_t)b * 1280 + pos) * 256 + g * 8) = pack8hw(f);
    }
  }
}

__device__ __forceinline__ void dn_finalize(const Params& p, int l, int t0, int n, int h, int tid0, int nthr) {
  const int sub = tid0 & 15, rpp = nthr / 16;
  const float* g = p.g_dn_out + l * 128 + sub * 8;
  float gv[8];
#pragma unroll
  for (int q = 0; q < 8; ++q) gv[q] = g[q];
  for (int r = tid0 >> 4; r < n; r += rpp * 4) {
    u32x4 va[4], vb[4], vg[4];
#pragma unroll
    for (int u = 0; u < 4; ++u) {
      const int t = t0 + r + u * rpp;
      va[u] = *(const u32x4*)(p.opart + (size_t)t * DM + h * 128 + sub * 8);
      vb[u] = *(const u32x4*)(p.opart + (size_t)NTOK * DM + (size_t)t * DM + h * 128 + sub * 8);
      vg[u] = *(const u32x4*)(p.P + (size_t)t * NP + C_DG + h * 128 + sub * 8);
    }
#pragma unroll
    for (int u = 0; u < 4; ++u) {
      const int t = t0 + r + u * rpp;
      float a[8], b[8], dg[8];
      unpack8(va[u], a); unpack8(vb[u], b); unpack8(vg[u], dg);
      float ss = 0;
#pragma unroll
      for (int q = 0; q < 8; ++q) { a[q] += b[q]; ss += a[q] * a[q]; }
      ss += __shfl_xor(ss, 1); ss += __shfl_xor(ss, 2); ss += __shfl_xor(ss, 4); ss += __shfl_xor(ss, 8);
      const float nrm = rsqrtf(ss * (1.f / 128.f) + EPS);
#pragma unroll
      for (int q = 0; q < 8; ++q) a[q] = a[q] * nrm * gv[q] * siluf_(dg[q]);
      *(u32x4*)(p.obr + (size_t)t * DM + h * 128 + sub * 8) = pack8hw(a);
    }
  }
}
constexpr int HT_BYTES = 128 * 64 * 2;

__device__ __forceinline__ int lds_byte(int r, int c) {
  int st = (r >> 4) * 2 + (c >> 5), rr = r & 15, cc = c & 31, ob = rr * 64 + cc * 2;
  return st * 1024 + (ob ^ (((ob >> 9) & 1) << 5));
}
__device__ __forceinline__ void stage_rc(int b, int& R, int& C) {
  int st = b / 1024, sb = b % 1024, swz = sb ^ (((sb >> 9) & 1) << 5);
  R = (st >> 1) * 16 + swz / 64; C = (st & 1) * 32 + (swz % 64) / 2;
}
__device__ __forceinline__ void stage_half(const bfr* G, long ld, int row0, int k0, int loff, int tx) {
#pragma unroll
  for (int i = 0; i < 2; ++i) {
    const int b = tx * 16 + i * 8192; int r, c; stage_rc(b, r, c);
    __builtin_amdgcn_global_load_lds((const unsigned*)(G + (long)(row0 + r) * ld + k0 + c), (__attribute__((address_space(3))) unsigned*)(smem + loff + b), 16, 0, 0);
  }
}

template <int NB, class AccT>
__device__ __forceinline__ void gemm_mainloop(const bfr* A, long lda, const bfr* Bt, long ldb, int K, int brow, int bcol, AccT& acc, int tx) {
  const int wid = tx >> 6, lane = tx & 63, wr = wid >> 2, wc = wid & 3, fr = lane & 15, fq = lane >> 4;
  constexpr int STG = (2 + NB) * HT_BYTES;
  const int nt = K / 64;
  auto stage = [&](int s, int kt) {
    stage_half(A, lda, brow, kt * 64, s * STG, tx);
    stage_half(A, lda, brow + 128, kt * 64, s * STG + HT_BYTES, tx);
#pragma unroll
    for (int j = 0; j < NB; ++j) stage_half(Bt, ldb, bcol + j * 128, kt * 64, s * STG + (2 + j) * HT_BYTES, tx);
  };
  stage(0, 0);
  asm volatile("s_waitcnt vmcnt(0)" ::: "memory");
  __syncthreads();
  for (int t = 0; t < nt; ++t) {
    const int s = t & 1;
    if (t + 1 < nt) stage(s ^ 1, t + 1);
    const char* base = smem + s * STG;
    bf16x8 Bf[NB][2][2];
#pragma unroll
    for (int j = 0; j < NB; ++j)
#pragma unroll
      for (int n = 0; n < 2; ++n)
#pragma unroll
        for (int k = 0; k < 2; ++k) Bf[j][n][k] = *(const bf16x8*)(base + (2 + j) * HT_BYTES + lds_byte(wc * 32 + n * 16 + fr, k * 32 + fq * 8));
#pragma unroll
    for (int ai = 0; ai < 2; ++ai) {
      bf16x8 Af[4][2];
#pragma unroll
      for (int m = 0; m < 4; ++m)
#pragma unroll
        for (int k = 0; k < 2; ++k) Af[m][k] = *(const bf16x8*)(base + ai * HT_BYTES + lds_byte(wr * 64 + m * 16 + fr, k * 32 + fq * 8));
#pragma unroll
      for (int j = 0; j < NB; ++j)
#pragma unroll
        for (int m = 0; m < 4; ++m)
#pragma unroll
          for (int n = 0; n < 2; ++n)
#pragma unroll
            for (int k = 0; k < 2; ++k) acc.a[ai][j][m][n] = __builtin_amdgcn_mfma_f32_16x16x32_bf16(Af[m][k], Bf[j][n][k], acc.a[ai][j][m][n], 0, 0, 0);
    }
    asm volatile("s_waitcnt vmcnt(0)" ::: "memory");
    __syncthreads();
  }
}
template <int NB> struct Acc { f32x4 a[2][NB][4][2]; };
template <int NB> __device__ __forceinline__ void acc_zero(Acc<NB>& acc) {
#pragma unroll
  for (int ai = 0; ai < 2; ++ai)
#pragma unroll
    for (int j = 0; j < NB; ++j)
#pragma unroll
      for (int m = 0; m < 4; ++m)
#pragma unroll
        for (int n = 0; n < 2; ++n) acc.a[ai][j][m][n] = f32x4{0.f, 0.f, 0.f, 0.f};
}
template <int NB, class F> __device__ __forceinline__ void acc_foreach(Acc<NB>& acc, int brow, int bcol, int tx, F f) {
  const int wid = tx >> 6, lane = tx & 63, wr = wid >> 2, wc = wid & 3, fr = lane & 15, fq = lane >> 4;
#pragma unroll
  for (int ai = 0; ai < 2; ++ai)
#pragma unroll
    for (int j = 0; j < NB; ++j)
#pragma unroll
      for (int m = 0; m < 4; ++m)
#pragma unroll
        for (int n = 0; n < 2; ++n)
#pragma unroll
          for (int q = 0; q < 4; ++q) f(brow + ai * 128 + wr * 64 + m * 16 + fq * 4 + q, bcol + j * 128 + wc * 32 + n * 16 + fr, acc.a[ai][j][m][n][q]);
}

template <class MapF>
__device__ __forceinline__ void convert_tile(const float* W, int N, int kt, int ntile, bfr* dst, int ldd, MapF mapf, int ncopy = 1, int cstride = 0) {
  float* tile = (float*)smem;
  const int tid = tid_opaque();
  __syncthreads();
  float4 v[8];
#pragma unroll
  for (int pass = 0; pass < 8; ++pass) {
    const int idx = tid + pass * 512, kr = idx >> 6, c4 = idx & 63, n = ntile * 256 + c4 * 4;
    v[pass] = make_float4(0.f, 0.f, 0.f, 0.f);
    if (n < N) v[pass] = *(const float4*)(W + (size_t)(kt * 64 + kr) * N + n);
  }
#pragma unroll
  for (int pass = 0; pass < 8; ++pass) {
    const int idx = tid + pass * 512, kr = idx >> 6, c4 = idx & 63;
    tile[kr * 257 + c4 * 4 + 0] = v[pass].x; tile[kr * 257 + c4 * 4 + 1] = v[pass].y; tile[kr * 257 + c4 * 4 + 2] = v[pass].z; tile[kr * 257 + c4 * 4 + 3] = v[pass].w;
  }
  __syncthreads();
#pragma unroll
  for (int rep = 0; rep < 4; ++rep) {
    const int nn = (tid >> 3) + rep * 64, kg = tid & 7, n = ntile * 256 + nn;
    if (n < N) {
      float f[8];
#pragma unroll
      for (int j = 0; j < 8; ++j) f[j] = tile[(kg * 8 + j) * 257 + nn];
      const u32x4 pk = pack8hw(f);
      for (int cp = 0; cp < ncopy; ++cp) *(u32x4*)(dst + (size_t)mapf(n) * ldd + cp * cstride + kt * 64 + kg * 8) = pk;
    }
  }
}
constexpr int CONV_ITEMS = 1576;
__device__ __forceinline__ void convert_item(const Params& p, int l, int it) {
  if (it < 752) { const int kt = it / 47, nt = it % 47; convert_tile(p.w_in + (size_t)l * DM * NIN, NIN, kt, nt, p.wt_in + (size_t)l * NPAD * DM, DM, [](int n) { return perm_col(n); }); }
  else if (it < 944) { const int j = it - 752, br = j >> 6, kt = (j >> 2) & 15, nt = j & 3;
    const float* W = p.w_br_dn; if (br == 1) W = p.w_br_sc; if (br == 2) W = p.w_br_att; W += (size_t)l * DM * DM;
    convert_tile(W, DM, kt, nt, p.wt_br + ((size_t)l * 3 + br) * DM * DM, DM, [](int n) { return n; }); }
  else if (it < 1008) { const int j = it - 944, kt = j >> 2, nt = j & 3; convert_tile(p.w_out + (size_t)l * DM * DM, DM, kt, nt, p.wt_out + (size_t)l * DM * 3072, 3072, [](int n) { return n; }, 3, 1024); }
  else if (it < 1264) { const int j = it - 1008, kt = j >> 4, nt = j & 15; convert_tile(p.w_mlp_up + (size_t)l * DM * HID, HID, kt, nt, p.wt_up + (size_t)l * HID * DM, DM, [](int n) { return n; }); }
  else if (it < 1520) { const int j = it - 1264, kt = j >> 2, nt = j & 3; convert_tile(p.w_mlp_down + (size_t)l * HID * DM, DM, kt, nt, p.wt_dn + (size_t)l * DM * HID, HID, [](int n) { return n; }); }
  else { const int j = it - 1520;
    bfr* d = p.wt_in + ((size_t)l * NPAD + NP + 32 + j * 4) * DM;
    *(u32x4*)(d + tid_opaque() * 8) = u32x4{0u, 0u, 0u, 0u}; }
}

__device__ __forceinline__ void gemm_in_tile(const Params& p, int l, int tile) {
  const int mt = tile % 24, nt = tile / 24, brow = mt * 256, bcol = nt * 256;
  const int tx = tid_opaque(); Acc<2> acc; acc_zero(acc);
  gemm_mainloop<2>(p.h, DM, p.wt_in + (size_t)l * NPAD * DM, DM, DM, brow, bcol, acc, tx);
  if (nt < 34) acc_foreach(acc, brow, bcol, tx, [&](int r, int c, float v) { p.P[(size_t)r * NP + c] = f2bf(v); });
  else if (nt < 46) acc_foreach(acc, brow, bcol, tx, [&](int r, int c, float v) { p.P[(size_t)r * NP + c] = f2bf(sigmoidf_(v)); });
  else acc_foreach(acc, brow, bcol, tx, [&](int r, int c, float v) { if (c < NP + 32) p.small[(size_t)r * 32 + (c - NP)] = v; });
}
__device__ __forceinline__ void gemm_up_tile(const Params& p, int l, int tile) {
  const int mt = tile % 24, nt = tile / 24, brow = mt * 256, bcol = nt * 256;
  const int tx = tid_opaque(); Acc<2> acc; acc_zero(acc);
  gemm_mainloop<2>(p.h, DM, p.wt_up + (size_t)l * HID * DM, DM, DM, brow, bcol, acc, tx);
  acc_foreach(acc, brow, bcol, tx, [&](int r, int c, float v) { const float x = fmaxf(v, 0.f); p.u2[(size_t)r * HID + c] = f2bf(x * x); });
}
__device__ __forceinline__ void gemm_out_tile(const Params& p, int l, int tile) {
  const int mt = tile % 24, nt = tile / 24, brow = mt * 256, bcol = nt * 128;
  const int tx = tid_opaque(); Acc<1> acc; acc_zero(acc);
  gemm_mainloop<1>(p.merged, DM, p.wt_out + (size_t)l * DM * DM, DM, DM, brow, bcol, acc, tx);
  acc_foreach(acc, brow, bcol, tx, [&](int r, int c, float v) { p.R[(size_t)r * DM + c] = v; });
}
__device__ __forceinline__ void gemm_down_tile(const Params& p, int l, int tile) {
  const int mt = tile % 24, nt = tile / 24, brow = mt * 256, bcol = nt * 128;
  const int tx = tid_opaque(); Acc<1> acc; acc_zero(acc);
  gemm_mainloop<1>(p.u2, HID, p.wt_dn + (size_t)l * DM * HID, HID, HID, brow, bcol, acc, tx);
  acc_foreach(acc, brow, bcol, tx, [&](int r, int c, float v) { p.R[(size_t)r * DM + c] = v; });
}
__device__ __forceinline__ void gemm_br_tile(const Params& p, int l, int tile) {
  const int mt = tile % 24, nt = tile / 24, brow = mt * 256, bcol = nt * 128;
  const int tx = tid_opaque(); Acc<1> tot; acc_zero(tot);
#pragma unroll 1
  for (int br = 0; br < 3; ++br) {
    Acc<1> acc; acc_zero(acc);
    gemm_mainloop<1>(p.obr + (size_t)br * NTOK * DM, DM, p.wt_br + ((size_t)l * 3 + br) * DM * DM, DM, DM, brow, bcol, acc, tx);
    const bfr* G = p.P + C_MG + br * DM;
    const int wid = tx >> 6, lane = tx & 63, wr = wid >> 2, wc = wid & 3, fr = lane & 15, fq = lane >> 4;
    const bfr* Gl = G + (size_t)(brow + wr * 64 + fq * 4) * NP + bcol + wc * 32 + fr;
#pragma unroll
    for (int ai = 0; ai < 2; ++ai)
#pragma unroll
      for (int m = 0; m < 4; ++m) {
        const bfr* Gm = Gl + (size_t)(ai * 128 + m * 16) * NP;
        asm volatile("" : "+v"(Gm) :: "memory");
#pragma unroll
        for (int n = 0; n < 2; ++n)
#pragma unroll
          for (int q = 0; q < 4; ++q) tot.a[ai][0][m][n][q] += bf2f(Gm[q * NP + n * 16]) * acc.a[ai][0][m][n][q];
      }
  }
  acc_foreach(tot, brow, bcol, tx, [&](int r, int c, float v) { p.merged[(size_t)r * DM + c] = f2bf(v); });
}
namespace pg8 {
#define PG8_LAS __attribute__((address_space(3)))
constexpr int BM = 256, BK = 64, HALF = 128, HTB = HALF * BK * 2, STAGE_BYTES = 8 * HTB;
__device__ __forceinline__ int perm32(int rho) { const int n = rho >> 4, i = rho & 15; return 8 * (i >> 2) + 4 * n + (i & 3); }
struct Unit { int pm, pn, z; size_t ka, kb; };
struct Gemm { const bfr* A; const bfr* Bt; int lda, ldb, K; };

template <class Epi, class Sched>
__device__ __forceinline__ void gemm_phase(const Gemm g, const Sched& S, const Epi& E) {
  PG8_LAS unsigned char* lds = (PG8_LAS unsigned char*)smem;
  const int tid = tid_opaque(), wid = __builtin_amdgcn_readfirstlane(tid >> 6), lane = tid & 63, wr = wid >> 2, wc = wid & 3, fr = lane & 15, fq = lane >> 4;
  const int K = g.K, nt = K / BK;
  unsigned voffA[2], voffB[2];
#pragma unroll
  for (int i = 0; i < 2; ++i) { int R, C; stage_rc(tid * 16 + i * 8192, R, C); const int Rb = Epi::PERM ? ((R & ~31) + perm32(R & 31)) : R;
    voffA[i] = (unsigned)(R * g.lda + C) * 2u; voffB[i] = (unsigned)(Rb * g.ldb + C) * 2u; }
  const size_t kstep = (size_t)(BK * 2);
  const size_t hstepA = (size_t)HALF * g.lda * 2, hstepB = (size_t)HALF * g.ldb * 2;
  const unsigned ldsw = (unsigned)wid * 1024u;
  const int aoff = lds_byte(wr * 64 + fr, fq * 8), boff = lds_byte(wc * 32 + fr, fq * 8);
#define PG8_SA(b, h) (((b) * 2 + (h)) * HTB)
#define PG8_SB(b, h) ((4 + (b) * 2 + (h)) * HTB)
#define PG8_STAGE(bufoff, gbase, voff) do { _Pragma("unroll") for (int _i = 0; _i < 2; ++_i) \
    __builtin_amdgcn_global_load_lds((const unsigned*)((const char*)(gbase) + (voff)[_i]), (PG8_LAS unsigned*)(lds + (bufoff) + ldsw + _i * 8192), 16, 0, 0); } while (0)
#define PG8_LDA(dst, b, h) do { _Pragma("unroll") for (int m = 0; m < 4; ++m) _Pragma("unroll") for (int k = 0; k < 2; ++k) dst[m][k] = *(const PG8_LAS bf16x8*)(lds + PG8_SA(b, h) + aoff + m * 2048 + k * 1024); } while (0)
#define PG8_LDB(dst, b, h) do { _Pragma("unroll") for (int n = 0; n < 2; ++n) _Pragma("unroll") for (int k = 0; k < 2; ++k) dst[n][k] = *(const PG8_LAS bf16x8*)(lds + PG8_SB(b, h) + boff + n * 2048 + k * 1024); } while (0)
#define PG8_MMA(ai, bj, At, Bt) do { __builtin_amdgcn_s_setprio(1); _Pragma("unroll") for (int m = 0; m < 4; ++m) _Pragma("unroll") for (int n = 0; n < 2; ++n) _Pragma("unroll") for (int k = 0; k < 2; ++k) \
    acc[ai][bj][m][n] = __builtin_amdgcn_mfma_f32_16x16x32_bf16(Bt[n][k], At[m][k], acc[ai][bj][m][n], 0, 0, 0); __builtin_amdgcn_s_setprio(0); } while (0)
#define PG8_WAIT_V(n) asm volatile("s_waitcnt vmcnt(" #n ")" ::: "memory")
#define PG8_WAIT_L(n) asm volatile("s_waitcnt lgkmcnt(" #n ")" ::: "memory")
#define PG8_BAR __builtin_amdgcn_s_barrier()
#define PG8_SCHED __builtin_amdgcn_sched_barrier(0)
  Unit cur, nxt; int ui = 0;
  __syncthreads();
  if (!S.next(0, cur)) return;
  f32x4 acc[2][2][4][2];
#pragma unroll
  for (int a = 0; a < 2; ++a)
#pragma unroll
    for (int b = 0; b < 2; ++b)
#pragma unroll
      for (int m = 0; m < 4; ++m)
#pragma unroll
        for (int n = 0; n < 2; ++n) acc[a][b][m][n] = (f32x4){0.f, 0.f, 0.f, 0.f};
  bf16x8 At[4][2], B0[2][2], B1[2][2];
  const char* cA = (const char*)(g.A + cur.ka) + (size_t)cur.pm * 2 * hstepA; const char* cB = (const char*)(g.Bt + cur.kb) + (size_t)cur.pn * 2 * hstepB;
  PG8_STAGE(PG8_SB(0, 0), cB, voffB); PG8_STAGE(PG8_SA(0, 0), cA, voffA); PG8_STAGE(PG8_SB(0, 1), cB + hstepB, voffB); PG8_STAGE(PG8_SA(0, 1), cA + hstepA, voffA);
  if (wr == 1) PG8_BAR;
  PG8_WAIT_V(4); PG8_BAR;
  PG8_STAGE(PG8_SB(1, 0), cB + kstep, voffB); PG8_STAGE(PG8_SA(1, 0), cA + kstep, voffA); PG8_STAGE(PG8_SB(1, 1), cB + hstepB + kstep, voffB);
  PG8_WAIT_V(6); PG8_BAR;
  for (;;) {
    const bool has_next = S.next(ui + 1, nxt);
    const char* nA = has_next ? (const char*)(g.A + nxt.ka) + (size_t)nxt.pm * 2 * hstepA : cA; const char* nB = has_next ? (const char*)(g.Bt + nxt.kb) + (size_t)nxt.pn * 2 * hstepB : cB;
    for (int t = 0; t < nt; t += 2) {
      const bool last = (t == nt - 2);
      const char* a1 = cA + (size_t)(t + 1) * kstep;
      const char* a2 = last ? nA : cA + (size_t)(t + 2) * kstep; const char* b2 = last ? nB : cB + (size_t)(t + 2) * kstep;
      const char* a3 = a2 + kstep; const char* b3 = b2 + kstep;
      PG8_LDB(B0, 0, 0); PG8_SCHED; PG8_LDA(At, 0, 0); PG8_STAGE(PG8_SA(1, 1), a1 + hstepA, voffA);
      PG8_WAIT_L(8); PG8_BAR; PG8_WAIT_L(0); PG8_MMA(0, 0, At, B0); PG8_BAR; PG8_SCHED;
      PG8_LDB(B1, 0, 1); PG8_STAGE(PG8_SB(0, 0), b2, voffB);
      PG8_BAR; PG8_WAIT_L(0); PG8_MMA(0, 1, At, B1); PG8_BAR;
      PG8_LDA(At, 0, 1); PG8_STAGE(PG8_SA(0, 0), a2, voffA);
      PG8_BAR; PG8_WAIT_L(0); PG8_MMA(1, 0, At, B0); PG8_BAR; PG8_SCHED;
      PG8_STAGE(PG8_SB(0, 1), b2 + hstepB, voffB);
      PG8_WAIT_V(6); PG8_BAR; PG8_MMA(1, 1, At, B1); PG8_BAR;
      PG8_LDB(B0, 1, 0); PG8_SCHED; PG8_LDA(At, 1, 0); PG8_STAGE(PG8_SA(0, 1), a2 + hstepA, voffA);
      PG8_WAIT_L(8); PG8_BAR; PG8_WAIT_L(0); PG8_MMA(0, 0, At, B0); PG8_BAR; PG8_SCHED;
      PG8_LDB(B1, 1, 1); PG8_STAGE(PG8_SB(1, 0), b3, voffB);
      PG8_BAR; PG8_WAIT_L(0); PG8_MMA(0, 1, At, B1); PG8_BAR;
      PG8_LDA(At, 1, 1); PG8_STAGE(PG8_SA(1, 0), a3, voffA);
      PG8_BAR; PG8_WAIT_L(0); PG8_MMA(1, 0, At, B0); PG8_BAR; PG8_SCHED;
      PG8_STAGE(PG8_SB(1, 1), b3 + hstepB, voffB);
      PG8_WAIT_V(6); PG8_BAR; PG8_MMA(1, 1, At, B1); PG8_BAR;
    }
    E(acc, cur, wr, wc, fr, fq);
    if (!has_next) break;
#pragma unroll
    for (int a = 0; a < 2; ++a)
#pragma unroll
      for (int b = 0; b < 2; ++b)
#pragma unroll
        for (int m = 0; m < 4; ++m)
#pragma unroll
          for (int n = 0; n < 2; ++n) acc[a][b][m][n] = (f32x4){0.f, 0.f, 0.f, 0.f};
    cur = nxt; cA = nA; cB = nB; ++ui;
  }
  PG8_WAIT_V(0);
  if (wr == 0) PG8_BAR;
  PG8_BAR;
#undef PG8_SA
#undef PG8_SB
#undef PG8_STAGE
#undef PG8_LDA
#undef PG8_LDB
#undef PG8_MMA
#undef PG8_WAIT_V
#undef PG8_WAIT_L
#undef PG8_BAR
#undef PG8_SCHED
}
__device__ __forceinline__ unsigned cvt_pk_bf16(float lo, float hi) { unsigned r; asm volatile("v_cvt_pk_bf16_f32 %0, %1, %2" : "=v"(r) : "v"(lo), "v"(hi)); return r; }
__device__ __forceinline__ u32x4 pk8(const f32x4 v0, const f32x4 v1) { u32x4 w; w.x = cvt_pk_bf16(v0[0], v0[1]); w.y = cvt_pk_bf16(v0[2], v0[3]); w.z = cvt_pk_bf16(v1[0], v1[1]); w.w = cvt_pk_bf16(v1[2], v1[3]); return w; }

__device__ __forceinline__ unsigned cvt_pk_bf16_n(float lo, float hi) { unsigned r; asm volatile("s_nop 1\n\tv_cvt_pk_bf16_f32 %0, %1, %2" : "=v"(r) : "v"(lo), "v"(hi)); return r; }
__device__ __forceinline__ u32x4 pk8n(const f32x4 v0, const f32x4 v1) { u32x4 w; w.x = cvt_pk_bf16_n(v0[0], v0[1]); w.y = cvt_pk_bf16_n(v0[2], v0[3]); w.z = cvt_pk_bf16_n(v1[0], v1[1]); w.w = cvt_pk_bf16_n(v1[2], v1[3]); return w; }
__device__ __forceinline__ float sigmoid_fast(float x) { return __builtin_amdgcn_rcpf(1.f + __expf(-x)); }
struct SchedIn { int G, c; __device__ __forceinline__ bool next(int i, Unit& u) const { const int L = i * G + c; if (L >= 1024) return false; u.z = 0; u.ka = 0; u.kb = 0;
  if (L < 936) { const int j = L / 24; u.pm = L % 24; u.pn = j < 34 ? j : (j < 38 ? j + 4 : 46); }
  else { const int e = L - 936; if (e < 72) { u.pm = e % 24; u.pn = 34 + e / 24; } else { u.pm = e - 72; u.pn = 37; } }
  return true; } };
struct SchedUp { int G, c; __device__ __forceinline__ bool next(int i, Unit& u) const { const int L = i * G + c; if (L >= 24 * 16) return false; u.pm = L % 24; u.pn = L / 24; u.z = 0; u.ka = 0; u.kb = 0; return true; } };
struct SchedBr { int G, c; __device__ __forceinline__ bool next(int i, Unit& u) const { const int L = i * G + c; if (L >= 256) return false; if (L >= 192) { const int k = 32 + (L - 192); u.pm = k % 24; u.pn = k / 24; u.z = 1; u.ka = (size_t)NTOK * DM; u.kb = (size_t)DM * DM; return true; } const int r = L / 24; u.pm = L % 24; u.pn = r & 3; u.z = (r >> 2) * 2;
  u.ka = (size_t)u.z * NTOK * DM; u.kb = (size_t)u.z * DM * DM; return true; } };
struct SchedOne { Unit u0; __device__ __forceinline__ bool next(int i, Unit& u) const { if (i != 0) return false; u = u0; return true; } };
template <int KH> struct SchedSplit2 { int G, c; __device__ __forceinline__ bool next(int i, Unit& u) const { const int L = i * G + c; if (L >= 24 * 8) return false; const int r = L / 24; u.pm = L % 24; u.pn = r & 3; u.z = r >> 2;
  u.ka = (size_t)u.z * KH; u.kb = (size_t)u.z * KH; return true; } };

struct EpiIn { static constexpr bool PERM = true; bfr* P; float* small;
  __device__ __forceinline__ void operator()(const f32x4 (&acc)[2][2][4][2], const Unit& u, int wr, int wc, int fr, int fq) const {
    const int row0 = u.pm * BM + wr * 64 + fr, col0 = u.pn * BM + wc * 32 + 8 * fq;
    if (u.pn < 46) {
      const bool sg = u.pn >= 34;
#pragma unroll
      for (int ai = 0; ai < 2; ++ai)
#pragma unroll
        for (int m = 0; m < 4; ++m) { bfr* rowp = P + (size_t)(row0 + ai * HALF + m * 16) * NP + col0;
#pragma unroll
          for (int bj = 0; bj < 2; ++bj) { f32x4 v0 = acc[ai][bj][m][0], v1 = acc[ai][bj][m][1];
            if (sg) {
#pragma unroll
              for (int j = 0; j < 4; ++j) { v0[j] = sigmoid_fast(v0[j]); v1[j] = sigmoid_fast(v1[j]); }
              *(u32x4*)(rowp + bj * HALF) = pk8n(v0, v1);
            } else *(u32x4*)(rowp + bj * HALF) = pk8(v0, v1); } }
    } else if (wc == 0) {
#pragma unroll
      for (int ai = 0; ai < 2; ++ai)
#pragma unroll
        for (int m = 0; m < 4; ++m) { float* rowp = small + (size_t)(row0 + ai * HALF + m * 16) * 32 + 8 * fq;
          *(f32x4*)rowp = acc[ai][0][m][0]; *(f32x4*)(rowp + 4) = acc[ai][0][m][1]; }
    }
  }
};
struct EpiUp { static constexpr bool PERM = true; bfr* O;
  __device__ __forceinline__ void operator()(const f32x4 (&acc)[2][2][4][2], const Unit& u, int wr, int wc, int fr, int fq) const {
    const int row0 = u.pm * BM + wr * 64 + fr, col0 = u.pn * BM + wc * 32 + 8 * fq;
#pragma unroll
    for (int ai = 0; ai < 2; ++ai)
#pragma unroll
      for (int m = 0; m < 4; ++m) { bfr* rowp = O + (size_t)(row0 + ai * HALF + m * 16) * HID + col0;
#pragma unroll
        for (int bj = 0; bj < 2; ++bj) { f32x4 v0 = acc[ai][bj][m][0], v1 = acc[ai][bj][m][1];
#pragma unroll
          for (int j = 0; j < 4; ++j) { const float a = fmaxf(v0[j], 0.f), b = fmaxf(v1[j], 0.f); v0[j] = a * a; v1[j] = b * b; }
          *(u32x4*)(rowp + bj * HALF) = pk8(v0, v1); } }
  }
};
struct EpiBr { static constexpr bool PERM = true; bfr* O; const bfr* P;
  __device__ __forceinline__ void operator()(const f32x4 (&acc)[2][2][4][2], const Unit& u, int wr, int wc, int fr, int fq) const {
    const int row0 = u.pm * BM + wr * 64 + fr, col0 = u.z * DM + u.pn * BM + wc * 32 + 8 * fq;
    u32x4 gv[2][4][2];
#pragma unroll
    for (int ai = 0; ai < 2; ++ai)
#pragma unroll
      for (int m = 0; m < 4; ++m) { const bfr* gp = P + (size_t)(row0 + ai * HALF + m * 16) * NP + C_MG + col0;
#pragma unroll
        for (int bj = 0; bj < 2; ++bj) gv[ai][m][bj] = *(const u32x4*)(gp + bj * HALF); }
#pragma unroll
    for (int ai = 0; ai < 2; ++ai)
#pragma unroll
      for (int m = 0; m < 4; ++m) { bfr* rowp = O + (size_t)(row0 + ai * HALF + m * 16) * 3072 + col0;
#pragma unroll
        for (int bj = 0; bj < 2; ++bj) { f32x4 v0 = acc[ai][bj][m][0], v1 = acc[ai][bj][m][1];
          float g[8]; unpack8(gv[ai][m][bj], g);
#pragma unroll
          for (int j = 0; j < 4; ++j) { v0[j] *= g[j]; v1[j] *= g[4 + j]; }
          *(u32x4*)(rowp + bj * HALF) = pk8(v0, v1); } }
  }
};
struct EpiF32 { static constexpr bool PERM = false; float* C;
  __device__ __forceinline__ void operator()(const f32x4 (&acc)[2][2][4][2], const Unit& u, int wr, int wc, int fr, int fq) const {
    const int row0 = u.pm * BM + wr * 64 + fr, col0 = u.pn * BM + wc * 32 + 4 * fq;
    float* Cz = C + (size_t)u.z * NTOK * DM;
#pragma unroll
    for (int ai = 0; ai < 2; ++ai)
#pragma unroll
      for (int m = 0; m < 4; ++m) { float* rowp = Cz + (size_t)(row0 + ai * HALF + m * 16) * DM + col0;
#pragma unroll
        for (int bj = 0; bj < 2; ++bj)
#pragma unroll
          for (int n = 0; n < 2; ++n) *(f32x4*)(rowp + bj * HALF + n * 16) = acc[ai][bj][m][n]; }
  }
};
struct EpiPart { static constexpr bool PERM = true; bfr* C;
  __device__ __forceinline__ void operator()(const f32x4 (&acc)[2][2][4][2], const Unit& u, int wr, int wc, int fr, int fq) const {
    const int row0 = u.pm * BM + wr * 64 + fr, col0 = u.pn * BM + wc * 32 + 8 * fq;
    bfr* Cz = C + (size_t)u.z * NTOK * DM;
#pragma unroll
    for (int ai = 0; ai < 2; ++ai)
#pragma unroll
      for (int m = 0; m < 4; ++m) { bfr* rowp = Cz + (size_t)(row0 + ai * HALF + m * 16) * DM + col0;
#pragma unroll
        for (int bj = 0; bj < 2; ++bj) *(u32x4*)(rowp + bj * HALF) = pk8(acc[ai][bj][m][0], acc[ai][bj][m][1]); }
  }
};
}
namespace att {
constexpr int D = 128, NW = 8, QBLK = 32, KVBLK = 64;
constexpr float SCALE = 0.088388347648318440f;
constexpr float THR = 8.f;
constexpr int SDEPTH = 1;
constexpr int LDQ = 1024, LDK = 256, LDO = 1024;
constexpr size_t SHM_V = KVBLK * D * 2, SHM_K = KVBLK * D * 2, SHM_ATTN = 2 * SHM_V + 2 * SHM_K + NW * 64 * 4;
using bf16 = bfr;
using f32x8  = __attribute__((ext_vector_type(8))) float;
#define KSWZ(row, colB) ((row) * 256 + ((colB) ^ (((row) & 7) << 4)))
#define SBAR() __builtin_amdgcn_sched_barrier(0)
__device__ __forceinline__ int crow(int r, int hi) { return (r & 3) + 8 * (r >> 2) + 4 * hi; }
__device__ __forceinline__ unsigned cvtpk(float lo, float hi) {
  unsigned r; asm volatile("v_cvt_pk_bf16_f32 %0, %1, %2" : "=v"(r) : "v"(lo), "v"(hi)); return r;
}
template <typename TIn> struct Stage;
template <> struct Stage<bf16>  { using T = bf16x8;
  __device__ static __forceinline__ T ld8(const bf16* p) { return *reinterpret_cast<const bf16x8*>(p); }
  __device__ static __forceinline__ bf16x8 tobf(T x) { return x; } };
template <> struct Stage<float> { using T = f32x8;
  __device__ static __forceinline__ T ld8(const float* p) { return *reinterpret_cast<const f32x8*>(p); }
  __device__ static __forceinline__ bf16x8 tobf(T x) {
    u32x4 w = {cvtpk(x[0], x[1]), cvtpk(x[2], x[3]), cvtpk(x[4], x[5]), cvtpk(x[6], x[7])}; return *reinterpret_cast<bf16x8*>(&w); } };

__device__ __forceinline__ void partialSM(f32x16& p0, f32x16& p1, float& m_reg, float& mn, float& alpha) {
  constexpr float C = SCALE * 1.4426950408889634f;
  float pmax = p0[0]; for (int r = 1; r < 16; ++r) pmax = fmaxf(pmax, p0[r]); for (int r = 0; r < 16; ++r) pmax = fmaxf(pmax, p1[r]);
  { auto rr = __builtin_amdgcn_permlane32_swap(__float_as_uint(pmax), __float_as_uint(pmax), false, false);
    pmax = fmaxf(__uint_as_float(rr[0]), __uint_as_float(rr[1])); }
  if (__builtin_expect(__all(pmax - m_reg <= THR / SCALE), 1)) { mn = m_reg; alpha = 1.f; }
  else { mn = fmaxf(m_reg, pmax); alpha = __builtin_amdgcn_exp2f((m_reg - mn) * C); m_reg = mn; }
  float mnC = -mn * C;
  for (int r = 0; r < 16; ++r) p0[r] = fmaf(p0[r], C, mnC); for (int r = 0; r < 16; ++r) p1[r] = fmaf(p1[r], C, mnC);
  for (int r = 0; r < 16; ++r) p0[r] = __builtin_amdgcn_exp2f(p0[r]);
}
__device__ __forceinline__ void finishSM(f32x16& p0, f32x16& p1, float alpha, float& l_reg, bf16x8& pa0, bf16x8& pa1, bf16x8& pa2, bf16x8& pa3) {
  for (int r = 0; r < 16; ++r) p1[r] = __builtin_amdgcn_exp2f(p1[r]);
  float ps = 0; for (int r = 0; r < 16; ++r) ps += p0[r]; for (int r = 0; r < 16; ++r) ps += p1[r];
  { auto rr = __builtin_amdgcn_permlane32_swap(__float_as_uint(ps), __float_as_uint(ps), false, false);
    ps = __uint_as_float(rr[0]) + __uint_as_float(rr[1]); }
  l_reg = l_reg * alpha + ps;
#define PK4(P, BASE, OUT) do { unsigned a0 = cvtpk(P[BASE + 0], P[BASE + 1]), a1 = cvtpk(P[BASE + 2], P[BASE + 3]);   \
    unsigned b0 = cvtpk(P[BASE + 4], P[BASE + 5]), b1 = cvtpk(P[BASE + 6], P[BASE + 7]);                              \
    auto r0 = __builtin_amdgcn_permlane32_swap(a0, b0, false, false); auto r1 = __builtin_amdgcn_permlane32_swap(a1, b1, false, false); \
    u32x4 w = {r0[0], r1[0], r0[1], r1[1]}; OUT = *reinterpret_cast<bf16x8*>(&w); } while (0)
  PK4(p0, 0, pa0); PK4(p0, 8, pa1); PK4(p1, 0, pa2); PK4(p1, 8, pa3);
#undef PK4
}
__device__ __forceinline__ void qkt(f32x16& p0, f32x16& p1, const bf16* Ks, const bf16x8* qr, int r32, int hi) {
  p0 = f32x16{}; p1 = f32x16{};
  for (int d0 = 0; d0 < 8; ++d0) { int cb = (d0 * 16 + hi * 8) * 2;
    bf16x8 b0 = *reinterpret_cast<const bf16x8*>((const char*)Ks + KSWZ(r32, cb));
    bf16x8 b1 = *reinterpret_cast<const bf16x8*>((const char*)Ks + KSWZ(32 + r32, cb));
    p0 = __builtin_amdgcn_mfma_f32_32x32x16_bf16(b0, qr[d0], p0, 0, 0, 0);
    p1 = __builtin_amdgcn_mfma_f32_32x32x16_bf16(b1, qr[d0], p1, 0, 0, 0); }
}
__device__ __forceinline__ int v_st(int k, int c) { const int kk = (k & ~0xC) | ((k & 4) << 1) | ((k & 8) >> 1); return ((kk >> 3) * 4 + (c >> 5)) * 512 + ((kk & 7) * 32 + (c & 31)) * 2; }
__device__ __forceinline__ int v_rd_base(int lane) { return ((lane & 3) << 3) | (((lane >> 2) & 3) << 6) | (((lane >> 4) & 1) << 5) | (((lane >> 5) & 1) << 8); }
constexpr int v_rd_off(int d0, int ks, int half) { return d0 * 512 + ks * 4096 + half * 2048; }
template <int OFF> __device__ __forceinline__ s16x4 tr_read(int vb) {
  s16x4 r; asm volatile("ds_read_b64_tr_b16 %0, %1 offset:%2" : "=&v"(r) : "v"(vb), "i"(OFF) : "memory"); return r;
}
template <int D0> __device__ __forceinline__ void pv_one(f32x16& od, int vb, bf16x8 pa0, bf16x8 pa1, bf16x8 pa2, bf16x8 pa3) {
  const s16x4 l0 = tr_read<v_rd_off(D0, 0, 0)>(vb), h0 = tr_read<v_rd_off(D0, 0, 1)>(vb), l1 = tr_read<v_rd_off(D0, 1, 0)>(vb), h1 = tr_read<v_rd_off(D0, 1, 1)>(vb);
  const s16x4 l2 = tr_read<v_rd_off(D0, 2, 0)>(vb), h2 = tr_read<v_rd_off(D0, 2, 1)>(vb), l3 = tr_read<v_rd_off(D0, 3, 0)>(vb), h3 = tr_read<v_rd_off(D0, 3, 1)>(vb);
  asm volatile("s_waitcnt lgkmcnt(0)" ::: "memory"); SBAR();
#define PK(L, H) (bf16x8){L[0], L[1], L[2], L[3], H[0], H[1], H[2], H[3]}
  od = __builtin_amdgcn_mfma_f32_32x32x16_bf16(pa0, PK(l0, h0), od, 0, 0, 0);
  od = __builtin_amdgcn_mfma_f32_32x32x16_bf16(pa1, PK(l1, h1), od, 0, 0, 0);
  od = __builtin_amdgcn_mfma_f32_32x32x16_bf16(pa2, PK(l2, h2), od, 0, 0, 0);
  od = __builtin_amdgcn_mfma_f32_32x32x16_bf16(pa3, PK(l3, h3), od, 0, 0, 0);
#undef PK
}
__device__ __forceinline__ void pv_d0(f32x16* o, int vb, bf16x8 pa0, bf16x8 pa1, bf16x8 pa2, bf16x8 pa3) {
  pv_one<0>(o[0], vb, pa0, pa1, pa2, pa3); pv_one<1>(o[1], vb, pa0, pa1, pa2, pa3); pv_one<2>(o[2], vb, pa0, pa1, pa2, pa3); pv_one<3>(o[3], vb, pa0, pa1, pa2, pa3);
}

template <typename TQ>
__device__ __forceinline__ void attn_dense_body(const TQ* __restrict__ Qb, const bf16* __restrict__ Kh, const bf16* __restrict__ Vh,
                                                bfr* __restrict__ Ob, int seq, char* lds) {
  using St = Stage<bf16>; using SQ = Stage<TQ>;
  const int tid = tid_opaque(), wid = tid >> 6, lane = tid & 63, r32 = lane & 31, hi = lane >> 5;
  bf16* V_lds = (bf16*)lds; bf16* K_lds = (bf16*)(lds + 2 * SHM_V);
  float* ws = (float*)(lds + 2 * SHM_V + 2 * SHM_K) + wid * 64; float* li_l = ws; float* al_l = ws + 32;
  float m_reg = -1e30f, l_reg = 0; f32x16 o[4] = {}; bf16x8 qr[8];
  const TQ* Qw = Qb + (long)(wid * QBLK + r32) * LDQ + hi * 8;
#pragma unroll
  for (int d0 = 0; d0 < 8; ++d0) qr[d0] = SQ::tobf(SQ::ld8(Qw + d0 * 16));
  const int sr = tid >> 4, sc = (tid & 15) * 8, vst0 = v_st(sr, sc), vst1 = v_st(32 + sr, sc);
  const int vb0 = (int)(uintptr_t)V_lds + v_rd_base(lane);
  struct { typename St::T vs0, vs1, ks0, ks1; } sr_[SDEPTH];
#define SLOAD(i, k0) do { sr_[i].vs0 = St::ld8(&Vh[(long)((k0) + sr) * LDK + sc]); sr_[i].vs1 = St::ld8(&Vh[(long)((k0) + 32 + sr) * LDK + sc]); \
    sr_[i].ks0 = St::ld8(&Kh[(long)((k0) + sr) * LDK + sc]); sr_[i].ks1 = St::ld8(&Kh[(long)((k0) + 32 + sr) * LDK + sc]); } while (0)
#define SWRITE(b, i) do { *(bf16x8*)((char*)V_lds + (b) * SHM_V + vst0) = St::tobf(sr_[i].vs0);          \
    *(bf16x8*)((char*)V_lds + (b) * SHM_V + vst1) = St::tobf(sr_[i].vs1); int kc = sc * 2;               \
    *(bf16x8*)((char*)K_lds + (b) * SHM_K + KSWZ(sr, kc)) = St::tobf(sr_[i].ks0);                       \
    *(bf16x8*)((char*)K_lds + (b) * SHM_K + KSWZ(32 + sr, kc)) = St::tobf(sr_[i].ks1); } while (0)
#define SWAIT() do { if constexpr (SDEPTH == 2) asm volatile("s_waitcnt vmcnt(4)" ::: "memory"); else asm volatile("s_waitcnt vmcnt(0)" ::: "memory"); } while (0)
#define RESC(a) do { if (__any((a) < 1.f)) { if (hi == 0) al_l[r32] = (a); asm volatile("s_waitcnt lgkmcnt(0)" ::: "memory"); \
    for (int d = 0; d < 4; ++d) for (int r = 0; r < 16; ++r) o[d][r] *= al_l[crow(r, hi)]; } } while (0)
  f32x16 pA0, pA1, pB0, pB1; float mnA, mnB, alA, alB; bf16x8 pa0, pa1, pa2, pa3; const int NT = seq / KVBLK;
  constexpr int SE = 0, SO = SDEPTH - 1;
  SLOAD(SE, 0); asm volatile("s_waitcnt vmcnt(0)" ::: "memory"); SWRITE(0, SE); __syncthreads();
  qkt(pA0, pA1, K_lds, qr, r32, hi); partialSM(pA0, pA1, m_reg, mnA, alA);
  SLOAD(SO, KVBLK); if constexpr (SDEPTH == 2) { if (2 < NT) SLOAD(SE, 2 * KVBLK); }
  SWAIT(); SWRITE(1, SO); __syncthreads();
  for (int j = 1; j + 1 < NT; j += 2) {
    SBAR(); qkt(pB0, pB1, (bf16*)((char*)K_lds + SHM_K), qr, r32, hi);
    finishSM(pA0, pA1, alA, l_reg, pa0, pa1, pa2, pa3); SBAR();
    SLOAD(SO, (j + SDEPTH) * KVBLK); SBAR();
    pv_d0(o, vb0, pa0, pa1, pa2, pa3); partialSM(pB0, pB1, m_reg, mnB, alB);
    __syncthreads(); SWAIT(); SWRITE(0, SE);
    RESC(alB); __syncthreads();
    SBAR(); qkt(pA0, pA1, K_lds, qr, r32, hi);
    finishSM(pB0, pB1, alB, l_reg, pa0, pa1, pa2, pa3); SBAR();
    if (SDEPTH == 1 || j + 3 < NT) SLOAD(SE, (j + 1 + SDEPTH) * KVBLK); SBAR();
    pv_d0(o, vb0 + (int)SHM_V, pa0, pa1, pa2, pa3); partialSM(pA0, pA1, m_reg, mnA, alA);
    __syncthreads(); SWAIT(); SWRITE(1, SO);
    RESC(alA); __syncthreads();
  }
  SBAR(); qkt(pB0, pB1, (bf16*)((char*)K_lds + SHM_K), qr, r32, hi);
  finishSM(pA0, pA1, alA, l_reg, pa0, pa1, pa2, pa3); SBAR();
  pv_d0(o, vb0, pa0, pa1, pa2, pa3); partialSM(pB0, pB1, m_reg, mnB, alB);
  __syncthreads(); RESC(alB);
  finishSM(pB0, pB1, alB, l_reg, pa0, pa1, pa2, pa3); SBAR();
  pv_d0(o, vb0 + (int)SHM_V, pa0, pa1, pa2, pa3);
  if (hi == 0) li_l[r32] = l_reg; asm volatile("s_waitcnt lgkmcnt(0)" ::: "memory");
  float rli[16];
#pragma unroll
  for (int r = 0; r < 16; ++r) rli[r] = __builtin_amdgcn_rcpf(li_l[crow(r, hi)]);
  bfr* Ow = Ob + (long)(wid * QBLK) * LDO;
#pragma unroll
  for (int r = 0; r < 16; ++r) { int orow = crow(r, hi);
    for (int d0 = 0; d0 < 4; ++d0) Ow[(long)orow * LDO + d0 * 32 + r32] = f2bf(o[d0][r] * rli[r]); }
#undef SLOAD
#undef SWRITE
#undef SWAIT
#undef RESC
}

}

__device__ __forceinline__ void attn_item(const Params& p, int item) {
  __syncthreads();
  if (item < 64) {
    const int b = item >> 5, h = (item >> 2) & 7, qb = item & 3; const size_t t0 = NCTX + b * 1024 + qb * 256;
    att::attn_dense_body<bfr>(p.Q + t0 * DM + h * 128, p.Ks + (size_t)b * 1280 * 256 + (h >> 2) * 128, p.Vs + (size_t)b * 1280 * 256 + (h >> 2) * 128,
                              p.obr + (size_t)2 * NTOK * DM + t0 * DM + h * 128, 1280, smem);
  } else {
    const int j = item - 64, b = j >> 3, h = j & 7; const size_t t0 = b * 256;
    att::attn_dense_body<bfr>(p.Q + t0 * DM + h * 128, p.Kc + (size_t)b * 256 * 256 + (h >> 2) * 128, p.Vc + (size_t)b * 256 * 256 + (h >> 2) * 128,
                              p.obr + (size_t)2 * NTOK * DM + t0 * DM + h * 128, 256, smem);
  }
}
#define XB_TMO      128
#define XB_XCNT(j)  (256  + 64 * (j))
#define XB_XSUB(j)  (1280 + 64 * (j))
#define XB_XGEN(j)  (2304 + 64 * (j))
#define XB_TOP      3328
#define XB_TOPGEN   3392
#define XCD_BAR_WORDS 3456
#define XB_SPIN_CAP (1u << 20)
#define LAS __attribute__((address_space(3)))
constexpr int XB_LDS_OFF = 163840 - 16;

__device__ __forceinline__ unsigned xb_ld(unsigned* p)              { return __hip_atomic_load(p, __ATOMIC_RELAXED, __HIP_MEMORY_SCOPE_AGENT); }
__device__ __forceinline__ unsigned xb_add(unsigned* p, unsigned v) { return __hip_atomic_fetch_add(p, v, __ATOMIC_RELAXED, __HIP_MEMORY_SCOPE_AGENT); }
__device__ __forceinline__ unsigned xb_xcc_id() { return (unsigned)__builtin_amdgcn_s_getreg((3 << 11) | 20) & 0xFu; }
#define XB_SPIN(cond, bar) do { unsigned _sp = 0; while (cond) { __builtin_amdgcn_s_sleep(1); \
    if ((++_sp & 255u) == 0u) { if (xb_ld(&(bar)[XB_TMO])) break; if (_sp > XB_SPIN_CAP) { atomicAdd(&(bar)[XB_TMO], 1u); break; } } } } while (0)

__device__ __forceinline__ void xcd_barrier_post(unsigned* bar) {
  volatile LAS unsigned* st = (volatile LAS unsigned*)(smem + XB_LDS_OFF);
  if (tid_opaque() == 0) { st[0] = 0u; st[1] = 0u; (void)xb_add(&bar[XB_XCNT(xb_xcc_id())], 1u); }
  __syncthreads();
}
__device__ __forceinline__ void xcd_barrier_complete(unsigned* bar, unsigned x, unsigned& nloc, unsigned& nx) {
  const unsigned G = gridDim.x * gridDim.y * gridDim.z;
  unsigned sum, cnt, mine, sp = 0u;
  for (;;) {
    sum = 0u; cnt = 0u; mine = 0u;
#pragma unroll
    for (unsigned j = 0; j < 16; ++j) { const unsigned c = xb_ld(&bar[XB_XCNT(j)]); sum += c; cnt += (c > 0u) ? 1u : 0u; mine = (j == x) ? c : mine; }
    if (sum == G) break;
    __builtin_amdgcn_s_sleep(1);
    if ((++sp & 255u) == 0u) { if (xb_ld(&bar[XB_TMO])) break; if (sp > XB_SPIN_CAP) { atomicAdd(&bar[XB_TMO], 1u); break; } }
  }
  nloc = mine > 0u ? mine : 1u; nx = cnt > 0u ? cnt : 1u;
}
template <bool REL = true>
__device__ __forceinline__ void xcd_barrier(unsigned* bar) {
  asm volatile("s_waitcnt vmcnt(0)" ::: "memory");
  __syncthreads();
  if (tid_opaque() == 0) {
    volatile LAS unsigned* st = (volatile LAS unsigned*)(smem + XB_LDS_OFF);
    const unsigned x = xb_xcc_id();
    __builtin_amdgcn_s_waitcnt(0);
    unsigned nloc = st[0], nx = st[1];
    if (nloc == 0u) { xcd_barrier_complete(bar, x, nloc, nx); st[0] = nloc; st[1] = nx; }
    const unsigned old = xb_add(&bar[XB_XSUB(x)], 1u);
    const unsigned gen = old / nloc;
    if (old + 1u == (gen + 1u) * nloc) {
      if (REL) { __builtin_amdgcn_fence(__ATOMIC_RELEASE, "agent"); asm volatile("s_waitcnt vmcnt(0)" ::: "memory"); }
      const unsigned og = xb_add(&bar[XB_TOP], 1u);
      const unsigned tg = og / nx;
      if (og + 1u == (tg + 1u) * nx) xb_add(&bar[XB_TOPGEN], 1u);
      else XB_SPIN(xb_ld(&bar[XB_TOPGEN]) == tg, bar);
      xb_add(&bar[XB_XGEN(x)], 1u);
      __builtin_amdgcn_fence(__ATOMIC_ACQUIRE, "agent");
      asm volatile("s_waitcnt vmcnt(0)" ::: "memory");
    } else {
      XB_SPIN(xb_ld(&bar[XB_XGEN(x)]) == gen, bar);
      __builtin_amdgcn_fence(__ATOMIC_ACQUIRE, "agent");
      asm volatile("s_waitcnt vmcnt(0)" ::: "memory");
    }
  }
  __syncthreads();
}
constexpr float SCALEQ = 0.08838834764831845f;
constexpr int PQH = 0, PKH = 17408, PVH = 34816, PKK = 52224, PQK = 68864, PXS = 52224, PMD = 125952, PMB = 134144, PGC = 152576, PRS = 0;
constexpr int XROW = 144;
#define LDS_BARRIER() do { asm volatile("s_waitcnt lgkmcnt(0)" ::: "memory"); __builtin_amdgcn_s_barrier(); asm volatile("" ::: "memory"); } while (0)
constexpr int LROW = 272;

__device__ __forceinline__ float ld_bf(const char* base, int byteoff) { return bf2f(*(const bfr*)(base + byteoff)); }

template <int B>
__device__ __forceinline__ void solve_block(int d, int e, int wid, int lane) {
  const int fr = lane & 15, hq = lane >> 4;
  char* xcol = smem + PXS + (d * 256 + e) * XROW + 16 * B * 2;
  float acc[16];
  { const u32x4 a = *(const u32x4*)xcol, b = *(const u32x4*)(xcol + 16); unpack8(a, acc); unpack8(b, acc + 8); }
  if (B > 0) {
    constexpr int NKS = (B + 1) / 2;
    f32x4 R[4];
#pragma unroll
    for (int ct = 0; ct < 4; ++ct) R[ct] = f32x4{0.f, 0.f, 0.f, 0.f};
#pragma unroll
    for (int ks = 0; ks < NKS; ++ks) {
      const bf16x8 a = *(const bf16x8*)(smem + PMB + (d * 64 + 16 * B + fr) * XROW + (ks * 32 + 8 * hq) * 2);
#pragma unroll
      for (int ct = 0; ct < 4; ++ct) {
        const bf16x8 b = *(const bf16x8*)(smem + PXS + (d * 256 + (wid & 3) * 64 + ct * 16 + fr) * XROW + (ks * 32 + 8 * hq) * 2);
        R[ct] = __builtin_amdgcn_mfma_f32_16x16x32_bf16(a, b, R[ct], 0, 0, 0);
      }
    }
    float* rs = (float*)(smem + PRS + wid * 4352);
#pragma unroll
    for (int ct = 0; ct < 4; ++ct)
#pragma unroll
      for (int r = 0; r < 4; ++r) rs[(4 * hq + r) * 68 + ct * 16 + fr] = R[ct][r];
    asm volatile("s_waitcnt lgkmcnt(0)" ::: "memory");
#pragma unroll
    for (int r = 0; r < 16; ++r) acc[r] -= rs[r * 68 + lane];
  }
  const float4* md = (const float4*)(smem + PMD) + ((d * 4 + B) * 16) * 4;
#pragma unroll
  for (int r2 = 0; r2 < 15; ++r2) {
#pragma unroll
    for (int q = (r2 + 1) / 4; q < 4; ++q) {
      const float4 m = md[r2 * 4 + q];
      if (4 * q + 0 > r2) acc[4 * q + 0] -= m.x * acc[r2];
      if (4 * q + 1 > r2) acc[4 * q + 1] -= m.y * acc[r2];
      if (4 * q + 2 > r2) acc[4 * q + 2] -= m.z * acc[r2];
      if (4 * q + 3 > r2) acc[4 * q + 3] -= m.w * acc[r2];
    }
  }
  *(u32x4*)xcol = pack8(acc); *(u32x4*)(xcol + 16) = pack8(acc + 8);
  asm volatile("s_waitcnt lgkmcnt(0)" ::: "memory");
}

__device__ __forceinline__ void dn_prep_item(const Params& p, int l, int c, int h) {
  const int tid = tid_opaque(), wid = tid >> 6, lane = tid & 63;
  const int t0 = c * 64;
  LDS_BARRIER();
  float b_beta = 0.f, b_alpha = 0.f, b_A = 0.f, b_dtb = 0.f;
  if (wid < 2) {
    const int d = wid, ti = d ? 63 - lane : lane, t = t0 + ti;
    b_A = p.a_log[(l * 2 + d) * 8 + h]; b_dtb = p.dt_bias[(l * 2 + d) * 8 + h];
    b_beta = p.small[(size_t)t * 32 + d * 8 + h]; b_alpha = p.small[(size_t)t * 32 + 16 + d * 8 + h];
  }
  struct { u32x4 raw[3][2][3]; } R;
  {
    const int grp = tid & 15;
#pragma unroll
    for (int X = 0; X < 3; ++X)
#pragma unroll
      for (int pass = 0; pass < 2; ++pass)
#pragma unroll
        for (int k = -1; k <= 1; ++k) {
          const int r = (tid >> 4) + pass * 32, t = t0 + r, pos = tok_pos(t), L = tok_L(t);
          R.raw[X][pass][k + 1] = u32x4{0u, 0u, 0u, 0u};
          if (pos + k >= 0 && pos + k < L) R.raw[X][pass][k + 1] = *(const u32x4*)(p.P + (size_t)(t + k) * NP + X * 1024 + h * 128 + grp * 8);
        }
  }
  {
    const int grp = tid & 15;
    const float* wc = p.w_conv_dn + (size_t)l * 3 * 3072 + h * 128 + grp * 8;
#pragma unroll
    for (int X = 0; X < 3; ++X) {
      float w[3][8];
#pragma unroll
      for (int k = 0; k < 3; ++k) { *(float4*)&w[k][0] = *(const float4*)(wc + k * 3072 + X * 1024); *(float4*)&w[k][4] = *(const float4*)(wc + k * 3072 + X * 1024 + 4); }
#pragma unroll
      for (int pass = 0; pass < 2; ++pass) {
        const int r = (tid >> 4) + pass * 32;
        float acc[8] = {};
#pragma unroll
        for (int k = 0; k < 3; ++k) {
          float x[8]; unpack8(R.raw[X][pass][k], x);
#pragma unroll
          for (int q = 0; q < 8; ++q) acc[q] += w[k][q] * x[q];
        }
        float ss = 0;
#pragma unroll
        for (int q = 0; q < 8; ++q) { acc[q] = siluf_(acc[q]); ss += acc[q] * acc[q]; }
        if (X < 2) {
          ss += __shfl_xor(ss, 1); ss += __shfl_xor(ss, 2); ss += __shfl_xor(ss, 4); ss += __shfl_xor(ss, 8);
          const float nrm = rsqrtf(ss + EPS);
#pragma unroll
          for (int q = 0; q < 8; ++q) acc[q] *= nrm;
        }
        *(u32x4*)(smem + X * 17408 + r * LROW + grp * 16) = pack8hw(acc);
      }
    }
  }
  if (wid < 2) {
    const int d = wid;
    const float A = __expf(b_A);
    const float beta = sigmoidf_(b_beta);
    float g = -A * softplusf_(b_alpha + b_dtb);
#pragma unroll
    for (int o = 1; o < 64; o <<= 1) { const float v = __shfl_up(g, o); if (lane >= o) g += v; }
    float* G = (float*)(smem + PGC);
    const float eg_ = __expf(g);
    G[d * 64 + lane] = g; G[128 + d * 64 + lane] = beta; G[256 + d * 64 + lane] = eg_; G[384 + d * 64 + lane] = beta * eg_;
  }
  LDS_BARRIER();
  {
    const int mat = wid >> 2, rt = wid & 3, fr = lane & 15, fq = lane >> 4;
    const char* Ab = smem + (mat ? PQH : PKH);
    f32x4 acc[4];
#pragma unroll
    for (int ct = 0; ct < 4; ++ct) acc[ct] = f32x4{0.f, 0.f, 0.f, 0.f};
#pragma unroll
    for (int ks = 0; ks < 4; ++ks) {
      const bf16x8 a = *(const bf16x8*)(Ab + (rt * 16 + fr) * LROW + (ks * 32 + fq * 8) * 2);
#pragma unroll
      for (int ct = 0; ct < 4; ++ct) {
        const bf16x8 b = *(const bf16x8*)(smem + PKH + (ct * 16 + fr) * LROW + (ks * 32 + fq * 8) * 2);
        acc[ct] = __builtin_amdgcn_mfma_f32_16x16x32_bf16(a, b, acc[ct], 0, 0, 0);
      }
    }
    float* Dst = (float*)(smem + (mat ? PQK : PKK));
#pragma unroll
    for (int ct = 0; ct < 4; ++ct)
#pragma unroll
      for (int r = 0; r < 4; ++r) Dst[(rt * 16 + fq * 4 + r) * 65 + ct * 16 + fr] = acc[ct][r];
  }
  LDS_BARRIER();
  const int d = tid >> 8, e = tid & 255;
  const float* GC = (const float*)(smem + PGC) + d * 64;
  const float* BETA = (const float*)(smem + PGC) + 128 + d * 64;
  const float* EG = (const float*)(smem + PGC) + 256 + d * 64;
  const float* KKs = (const float*)(smem + PKK);
  const float* QKs = (const float*)(smem + PQK);
  char* rec = p.dnrec + (size_t)((c * 8 + h) * 2 + d) * REC_BYTES;
  {
    const int i = e >> 2, jq = e & 3, j0 = jq * 16, ti = d ? 63 - i : i, ib = i >> 4;
    const float bi = BETA[i], gi = GC[i];
    float mv[16];
#pragma unroll
    for (int jj = 0; jj < 16; ++jj) {
      const int j = j0 + jj, tj = d ? 63 - j : j;
      const float mraw = bi * KKs[ti * 65 + tj] * __expf(fminf(gi - GC[j], 0.f));
      mv[jj] = (j < i) ? mraw : 0.f;
    }
    float* mdt = (float*)(smem + PMD) + ((d * 4 + ib) * 16) * 16 + (i & 15);
    if (jq == ib) {
#pragma unroll
      for (int jj = 0; jj < 16; ++jj) mdt[jj * 16] = mv[jj];
    }
    float mo[16];
#pragma unroll
    for (int jj = 0; jj < 16; ++jj) mo[jj] = (jq < ib) ? mv[jj] : 0.f;
    char* mb = smem + PMB + (d * 64 + i) * XROW + j0 * 2;
    *(u32x4*)mb = pack8hw(mo); *(u32x4*)(mb + 16) = pack8hw(mo + 8);
#pragma unroll 1
    for (int rep = 0; rep < 2; ++rep) {
      const int f = e + rep * 256, ln = f & 63, fi = f >> 6, mt = fi >> 1, ks = fi & 1;
      const int ii = mt * 16 + (ln & 15), tii = d ? 63 - ii : ii, hq = ln >> 4;
      const float gii = GC[ii];
      float v[8];
#pragma unroll
      for (int j = 0; j < 8; ++j) {
        const int jp = ks * 32 + (j >> 2) * 16 + 4 * hq + (j & 3), tj = d ? 63 - jp : jp;
        const float qraw = SCALEQ * QKs[tii * 65 + tj] * __expf(fminf(gii - GC[jp], 0.f));
        v[j] = (jp <= ii) ? qraw : 0.f;
      }
      *(u32x4*)(rec + REC_QK + f * 16) = pack8hw(v);
    }
    if (e == 0) p.glast[(c * 8 + h) * 2 + d] = EG[63];
    const float gl = GC[63];
#pragma unroll 1
    for (int rep = 0; rep < 4; ++rep) {
      const int f = e + rep * 256, ln = f & 63, fi = f >> 6, hq = ln >> 4;
      {
        const int mt = fi >> 2, ks = fi & 3, ii = mt * 16 + (ln & 15), tii = d ? 63 - ii : ii;
        const float sc = SCALEQ * EG[ii];
        const char* qrow = smem + PQH + tii * LROW + (ks * 32 + 4 * hq) * 2;
        const u32x2 lo = *(const u32x2*)qrow, hi = *(const u32x2*)(qrow + 32);
        float v[8] = {__uint_as_float(lo[0] << 16), __uint_as_float(lo[0] & 0xffff0000u), __uint_as_float(lo[1] << 16), __uint_as_float(lo[1] & 0xffff0000u),
                      __uint_as_float(hi[0] << 16), __uint_as_float(hi[0] & 0xffff0000u), __uint_as_float(hi[1] << 16), __uint_as_float(hi[1] & 0xffff0000u)};
#pragma unroll
        for (int j = 0; j < 8; ++j) v[j] *= sc;
        *(u32x4*)(rec + REC_QD + f * 16) = pack8hw(v);
      }
      {
        const int mt = fi >> 1, ks = fi & 1, dk = mt * 16 + (ln & 15);
        float v[8];
#pragma unroll
        for (int j = 0; j < 8; ++j) {
          const int ip = ks * 32 + (j >> 2) * 16 + 4 * hq + (j & 3), tip = d ? 63 - ip : ip;
          v[j] = ld_bf(smem + PKH, tip * LROW + dk * 2) * __expf(gl - GC[ip]);
        }
        *(u32x4*)(rec + REC_KD + f * 16) = pack8hw(v);
      }
    }
  }
  LDS_BARRIER();
  {
    const int col = e & 127; const bool isw = e >= 128;
    const char* src = smem + (isw ? PKH : PVH) + col * 2;
    const float4* F4 = (const float4*)((const float*)(smem + PGC) + (isw ? 384 : 128) + d * 64);
    char* xcol = smem + PXS + (d * 256 + e) * XROW;
#pragma unroll
    for (int i8 = 0; i8 < 8; ++i8) {
      const float4 f0 = F4[i8 * 2], f1 = F4[i8 * 2 + 1];
      const float fs[8] = {f0.x, f0.y, f0.z, f0.w, f1.x, f1.y, f1.z, f1.w};
      float v[8];
#pragma unroll
      for (int q = 0; q < 8; ++q) { const int i = i8 * 8 + q, ti = d ? 63 - i : i; v[q] = ld_bf(src, ti * LROW) * fs[q]; }
      *(u32x4*)(xcol + i8 * 16) = pack8hw(v);
    }
  }
  LDS_BARRIER();
  solve_block<0>(d, e, wid, lane); solve_block<1>(d, e, wid, lane); solve_block<2>(d, e, wid, lane); solve_block<3>(d, e, wid, lane);
  LDS_BARRIER();
  {
    const char* XS = smem + PXS + d * 256 * XROW;
#pragma unroll 1
    for (int rep = 0; rep < 8; ++rep) {
      const int f = e + rep * 256, ln = f & 63, fi = f >> 6, ws = fi >> 2, rt = fi & 3;
      const int i0 = rt * 16 + 4 * (ln >> 4), dv = ws * 16 + (ln & 15);
      *(u32x2*)(rec + REC_U + f * 8) = *(const u32x2*)(XS + dv * XROW + i0 * 2);
    }
#pragma unroll 1
    for (int rep = 0; rep < 4; ++rep) {
      const int f = e + rep * 256, ln = f & 63, fi = f >> 6, mt = fi >> 2, ks = fi & 3, hq = ln >> 4;
      const char* wc = XS + (128 + ks * 32 + 4 * hq) * XROW + (mt * 16 + (ln & 15)) * 2;
      unsigned q[8];
#pragma unroll
      for (int j = 0; j < 8; ++j) q[j] = *(const bfr*)(wc + ((j >> 2) * 16 + (j & 3)) * XROW);
      u32x4 o = {q[0] | (q[1] << 16), q[2] | (q[3] << 16), q[4] | (q[5] << 16), q[6] | (q[7] << 16)};
      *(u32x4*)(rec + REC_W + f * 16) = o;
    }
  }
}

__device__ __forceinline__ bf16x8 pack_b(const f32x4& a, const f32x4& b) {
  u32x4 w = {pack2hw(a[0], a[1]), pack2hw(a[2], a[3]), pack2hw(b[0], b[1]), pack2hw(b[2], b[3])};
  return *reinterpret_cast<bf16x8*>(&w);
}

constexpr int SCAN_BUF = 73728;
#define SC_SCHED() __builtin_amdgcn_sched_barrier(0)
#define SC_WAITL(n) asm volatile("s_waitcnt lgkmcnt(" #n ")" ::: "memory")
__device__ __forceinline__ void dn_scan_item(const Params& p, int l, int s, int h, int d) {
  const int tid = tid_opaque(), wid = tid >> 6, lane = tid & 63, ws = wid, fr = lane & 15, hq = lane >> 4;
  const bool samp = s >= 16;
  const int N = samp ? 16 : 4, cb = samp ? 64 + (s - 16) * 16 : s * 4, tbase = samp ? NCTX + (s - 16) * 1024 : s * 256;
  const int cstep = d ? -1 : 1, c0 = cb + (d ? N - 1 : 0);
  auto recp = [&](int n) { return p.dnrec + (size_t)(((c0 + n * cstep) * 8 + h) * 2 + d) * REC_BYTES; };
  f32x4 S[8];
  if (samp) {
    const float* s0 = p.state_dn + ((((size_t)(s - 16) * DEPTH + l) * 2 + d) * 8 + h) * 16384;
#pragma unroll
    for (int dt = 0; dt < 8; ++dt) {
      const float* q = s0 + (dt * 16 + 4 * hq) * 128 + ws * 16 + fr;
      asm volatile("" : "+v"(q) :: "memory");
#pragma unroll
      for (int r = 0; r < 4; ++r) S[dt][r] = q[r * 128];
    }
  } else {
#pragma unroll
    for (int dt = 0; dt < 8; ++dt) S[dt] = f32x4{0.f, 0.f, 0.f, 0.f};
  }
  const float glv = p.glast[((c0 + (lane < N ? lane : 0) * cstep) * 8 + h) * 2 + d];
  __syncthreads();
#define SC_GLDS(rec, buf) do { _Pragma("unroll") for (int i = 0; i < 9; ++i) \
    __builtin_amdgcn_global_load_lds((const unsigned*)((rec) + (i * 512 + tid) * 16), (__attribute__((address_space(3))) unsigned*)(smem + (buf) * SCAN_BUF + (i * 512 + tid) * 16), 16, 0, 0); } while (0)
  SC_GLDS(recp(0), 0);
  SC_GLDS(recp(1), 1);
  asm volatile("s_waitcnt vmcnt(0)" ::: "memory");
  LDS_BARRIER();
#pragma unroll 1
  for (int n = 0; n < N; ++n) {
    const int c = c0 + n * cstep;
    const char* Lb = smem + (n & 1) * SCAN_BUF;
    const char* LW = Lb + REC_W + lane * 16;
    const float gl = __uint_as_float(__builtin_amdgcn_readlane(__float_as_uint(glv), n));
    f32x4 P[4], O[4];
#pragma unroll
    for (int rt = 0; rt < 4; ++rt) { P[rt] = f32x4{0.f, 0.f, 0.f, 0.f}; O[rt] = f32x4{0.f, 0.f, 0.f, 0.f}; }
    bf16x8 F[8];
#define SC_LOADWQ(ks) do { _Pragma("unroll") for (int rt = 0; rt < 4; ++rt) { F[rt] = *(const bf16x8*)(LW + ((rt * 4 + (ks)) * 64) * 16); F[4 + rt] = *(const bf16x8*)(LW + 16384 + ((rt * 4 + (ks)) * 64) * 16); } } while (0)
#define SC_MMAWQ(sb) do { _Pragma("unroll") for (int rt = 0; rt < 4; ++rt) { P[rt] = __builtin_amdgcn_mfma_f32_16x16x32_bf16(F[rt], sb, P[rt], 0, 0, 0); O[rt] = __builtin_amdgcn_mfma_f32_16x16x32_bf16(F[4 + rt], sb, O[rt], 0, 0, 0); } } while (0)
#pragma unroll
    for (int ks = 0; ks < 4; ++ks) {
      SC_LOADWQ(ks); SC_SCHED();
      const bf16x8 sb = pack_b(S[2 * ks], S[2 * ks + 1]);
      SC_WAITL(0); SC_SCHED(); SC_MMAWQ(sb); SC_SCHED();
    }
    u32x2 U[4];
#pragma unroll
    for (int rt = 0; rt < 4; ++rt) U[rt] = *(const u32x2*)(Lb + REC_U + (((ws * 4 + rt) * 64) + lane) * 8);
#pragma unroll
    for (int i = 0; i < 8; ++i) F[i] = *(const bf16x8*)(LW + 32768 + (i * 64) * 16);
    SC_SCHED(); SC_WAITL(0); SC_SCHED();
#pragma unroll
    for (int rt = 0; rt < 4; ++rt) {
      const u32x2 u = U[rt];
      P[rt][0] = __uint_as_float(u[0] << 16) - P[rt][0]; P[rt][1] = __uint_as_float(u[0] & 0xffff0000u) - P[rt][1];
      P[rt][2] = __uint_as_float(u[1] << 16) - P[rt][2]; P[rt][3] = __uint_as_float(u[1] & 0xffff0000u) - P[rt][3];
    }
    const bf16x8 vb0 = pack_b(P[0], P[1]), vb1 = pack_b(P[2], P[3]);
#pragma unroll
    for (int rt = 0; rt < 4; ++rt) {
      O[rt] = __builtin_amdgcn_mfma_f32_16x16x32_bf16(F[rt * 2 + 0], vb0, O[rt], 0, 0, 0);
      O[rt] = __builtin_amdgcn_mfma_f32_16x16x32_bf16(F[rt * 2 + 1], vb1, O[rt], 0, 0, 0);
    }
    SC_SCHED();
#pragma unroll
    for (int half = 0; half < 2; ++half) {
#pragma unroll
      for (int i = 0; i < 8; ++i) F[i] = *(const bf16x8*)(LW + 40960 + ((half * 8 + i) * 64) * 16);
      SC_SCHED(); SC_WAITL(0); SC_SCHED();
#pragma unroll
      for (int dq = 0; dq < 4; ++dq) {
        const int dt = half * 4 + dq;
        S[dt] *= gl;
        S[dt] = __builtin_amdgcn_mfma_f32_16x16x32_bf16(F[dq * 2 + 0], vb0, S[dt], 0, 0, 0);
        S[dt] = __builtin_amdgcn_mfma_f32_16x16x32_bf16(F[dq * 2 + 1], vb1, S[dt], 0, 0, 0);
      }
      SC_SCHED();
    }
    SC_SCHED();
    bfr* ob = p.opart + (size_t)d * NTOK * DM + (size_t)(c * 64) * DM + h * 128 + ws * 16 + fr;
#pragma unroll
    for (int rt = 0; rt < 4; ++rt) {
      const int ip0 = rt * 16 + 4 * hq;
      bfr* q = ob + (size_t)(d ? 63 - ip0 : ip0) * DM;
      const long stp = d ? -(long)DM : (long)DM;
#pragma unroll
      for (int r = 0; r < 4; ++r) q[r * stp] = f2bf(O[rt][r]);
    }
    asm volatile("s_waitcnt vmcnt(16)" ::: "memory");
    LDS_BARRIER();
    if (n + 2 < N) SC_GLDS(recp(n + 2), n & 1);
  }
#undef SC_GLDS
#undef SC_LOADWQ
#undef SC_MMAWQ
  if (!samp) {
    float* so = p.out_state + ((((size_t)s * DEPTH + l) * 2 + d) * 8 + h) * 16384;
#pragma unroll
    for (int dt = 0; dt < 8; ++dt) {
      float* q = so + (dt * 16 + 4 * hq) * 128 + ws * 16 + fr;
      asm volatile("" : "+v"(q) :: "memory");
#pragma unroll
      for (int r = 0; r < 4; ++r) q[r * 128] = S[dt][r];
    }
  }
  if (l == 1 && s == 16 && h == 0 && d == 0) GSTAMP(p.bar, 4);
  asm volatile("s_waitcnt vmcnt(0)" ::: "memory");
  __syncthreads();
  volatile __attribute__((address_space(3))) unsigned* flag = (volatile __attribute__((address_space(3))) unsigned*)(smem + XB_LDS_OFF + 8);
  if (tid == 0) {
    __builtin_amdgcn_fence(__ATOMIC_RELEASE, "agent");
    asm volatile("s_waitcnt vmcnt(0)" ::: "memory");
    const unsigned old = __hip_atomic_fetch_add(p.bar + 4096 + (l * 18 + s) * 8 + h, 1u, __ATOMIC_RELAXED, __HIP_MEMORY_SCOPE_AGENT);
    if (old == 1u) { __builtin_amdgcn_fence(__ATOMIC_ACQUIRE, "agent"); asm volatile("s_waitcnt vmcnt(0)" ::: "memory"); }
    *flag = old;
  }
  __syncthreads();
  const unsigned last = __builtin_amdgcn_readfirstlane(*flag);
  if (last == 1u && !samp) dn_finalize(p, l, tbase, 256, h, tid, NTHR);
}

__device__ __forceinline__ void dn_finalize_item(const Params& p, int l, int it) {
  const int tid = tid_opaque();
  const int s = 16 + (it >> 5), h = (it >> 2) & 7, qt = it & 3;
  __syncthreads();
  if (tid == 0) {
    unsigned* cnt = p.bar + 4096 + (l * 18 + s) * 8 + h; unsigned sp = 0;
    while (__hip_atomic_load(cnt, __ATOMIC_RELAXED, __HIP_MEMORY_SCOPE_AGENT) < 2u) { __builtin_amdgcn_s_sleep(2); if (++sp > (1u << 22)) { atomicAdd(&p.bar[XB_TMO], 1u); break; } }
    __builtin_amdgcn_fence(__ATOMIC_ACQUIRE, "agent");
    asm volatile("s_waitcnt vmcnt(0)" ::: "memory");
  }
  __syncthreads();
  dn_finalize(p, l, NCTX + (s - 16) * 1024 + qt * 256, 256, h, tid, NTHR);
}
constexpr int DYN_LDS = 163840;
#ifndef REP
#define REP 0
#endif
constexpr int CONV_A = 330, CONV_B = 330 + 768;
#ifndef USE_CG_SYNC
#define USE_CG_SYNC 1
#endif
#if USE_CG_SYNC
#define GRID_SYNC() do { cg::this_grid().sync(); } while (0)
#define GRID_SYNC_WT() GRID_SYNC()
#else
#define GRID_SYNC() do { unsigned* bar_; { PHASE_PARAMS(pb); bar_ = pb.bar; } xcd_barrier<true>(bar_); if (REP & 2048) xcd_barrier<true>(bar_); } while (0)
#define GRID_SYNC_WT() GRID_SYNC()
#endif

typedef const __attribute__((address_space(4))) Params* CParamsPtr;
#define PHASE_PARAMS(p) CParamsPtr p##_c = (CParamsPtr)__builtin_amdgcn_kernarg_segment_ptr(); asm volatile("" : "+s"(p##_c)); const Params& p = *(const Params*)p##_c

#define PF_LINES(base_ptr, nlines) do { const int g_ = bid * 512 + tid_opaque(); unsigned d0_ = 0, d1_ = 0; \
    if (g_ < (nlines)) { const char* q_ = (const char*)(base_ptr) + (size_t)g_ * 128; asm volatile("global_load_dword %0, %1, off" : "=v"(d0_) : "v"(q_) : "memory"); } \
    if ((nlines) > 131072 && g_ + 131072 < (nlines)) { const char* q_ = (const char*)(base_ptr) + (size_t)(g_ + 131072) * 128; asm volatile("global_load_dword %0, %1, off" : "=v"(d1_) : "v"(q_) : "memory"); } \
    asm volatile("s_waitcnt vmcnt(0)" ::: "memory"); asm volatile("" :: "v"(d0_), "v"(d1_)); } while (0)
__device__ __forceinline__ void panel_rows(const Params& p, int l, int mode, int bid) {
  const int tid = tid_opaque(), wid = tid >> 6, lane = tid & 63;
  const int pm = bid % 24, q = bid / 24;
  volatile __attribute__((address_space(3))) unsigned* flag = (volatile __attribute__((address_space(3))) unsigned*)(smem + XB_LDS_OFF + 8);
  asm volatile("s_waitcnt vmcnt(0)" ::: "memory");
  __syncthreads();
  if (tid == 0) {
    unsigned* cnt = p.bar + 9216 + ((l * 2 + (mode - 1)) * 24 + pm) * 16;
    __builtin_amdgcn_fence(__ATOMIC_RELEASE, "agent");
    asm volatile("s_waitcnt vmcnt(0)" ::: "memory");
    (void)__hip_atomic_fetch_add(cnt, 1u, __ATOMIC_RELAXED, __HIP_MEMORY_SCOPE_AGENT);
    unsigned sp = 0;
    while (__hip_atomic_load(cnt, __ATOMIC_RELAXED, __HIP_MEMORY_SCOPE_AGENT) < 8u) { __builtin_amdgcn_s_sleep(1); if (++sp > (1u << 22)) { atomicAdd(&p.bar[XB_TMO], 1u); break; } }
    __builtin_amdgcn_fence(__ATOMIC_ACQUIRE, "agent");
    asm volatile("s_waitcnt vmcnt(0)" ::: "memory");
    *flag = 1u;
  }
  __syncthreads();
  rows_at<4>(p, l, mode, pm * 256 + q * 32 + wid * 4, lane);
}

template <int l> __device__ __forceinline__ void run_layer(const int bid, const int nblk) {
  if (l == 1) TSTAMP(5);
  { PHASE_PARAMS(p); pg8::gemm_phase(pg8::Gemm{p.h, p.wt_in + (size_t)l * NPAD * DM, DM, DM, DM}, pg8::SchedIn{nblk, bid}, pg8::EpiIn{p.P, p.small}); }
#if REP & 1
#if REP & 65536
  { PHASE_PARAMS(p); pg8::gemm_phase(pg8::Gemm{p.h, p.wt_in + (size_t)l * NPAD * DM, DM, DM, DM}, pg8::SchedIn{nblk, bid}, pg8::EpiIn{p.P, p.small}); }
#else
  { PHASE_PARAMS(p); pg8::gemm_phase(pg8::Gemm{p.h, p.wt_in + (size_t)l * NPAD * DM, DM, DM, DM}, pg8::SchedIn{nblk, bid}, pg8::EpiIn{p.P, p.small}); }
#endif
#endif
  GRID_SYNC_WT(); if (l == 1) TSTAMP(6);
  { PHASE_PARAMS(p); for (int it = bid; it < 768; it += nblk) dn_prep_item(p, l, it >> 3, it & 7); }
#if REP & 2
  { PHASE_PARAMS(p); for (int it = bid; it < 768; it += nblk) dn_prep_item(p, l, it >> 3, it & 7); }
#endif
  if (l == 1) TSTAMP(15);
  { PHASE_PARAMS(p); for (int it = bid; it < 384; it += nblk) light_prep_item(p, l, it); }
#if REP & 4096
  { PHASE_PARAMS(p); for (int it = bid; it < 384; it += nblk) light_prep_item(p, l, it); }
#endif
  unsigned pf_ = 0;
  { PHASE_PARAMS(p); const int gid = bid * 512 + tid_opaque(); const char* q;
    if (gid < 98304) q = (const char*)p.h + (size_t)gid * 128;
    else if (gid < 114688) q = (const char*)(p.wt_in + (size_t)l * NPAD * DM + (size_t)42 * 256 * DM) + (size_t)(gid - 98304) * 128;
    else if (gid < 118784) q = (const char*)(p.wt_in + (size_t)l * NPAD * DM + (size_t)37 * 256 * DM) + (size_t)(gid - 114688) * 128;
    else q = (const char*)(p.wt_br + (size_t)(l * 3 + 1) * DM * DM) + (size_t)((gid - 118784) & 8191) * 128;
    asm volatile("global_load_dword %0, %1, off" : "=v"(pf_) : "v"(q) : "memory"); }
  GRID_SYNC(); if (l == 1) TSTAMP(7);
  asm volatile("" :: "v"(pf_));
#define P3_PULL(slotword, limit) \
      volatile __attribute__((address_space(3))) unsigned* qslot = (volatile __attribute__((address_space(3))) unsigned*)(smem + XB_LDS_OFF + 12); \
      __syncthreads(); \
      if (tid_opaque() == 0) { PHASE_PARAMS(pq); *qslot = __hip_atomic_fetch_add(pq.bar + 8192 + l * 8 + rep3 * 4 + (slotword), 1u, __ATOMIC_RELAXED, __HIP_MEMORY_SCOPE_AGENT); } \
      __syncthreads(); \
      const int it = __builtin_amdgcn_readfirstlane((int)*qslot); \
      if (it >= (limit)) break;
#pragma unroll 1
  for (int rep3 = 0; rep3 < ((REP & 4) ? 2 : 1); ++rep3) {
    if (bid < 64) { PHASE_PARAMS(p); attn_item(p, bid); }
    else {
      if (bid >= 192)
#pragma unroll 1
      for (int rr_ = 0; rr_ < ((REP & 131072) ? 2 : 1); ++rr_) {
        const int it = bid - 192; TSTAMP(1);
        if (it >= 32) { PHASE_PARAMS(p); const int k = it - 32; pg8::Unit u; if (k < 8) { u.pm = 16 + k; u.pn = 37; } else { u.pm = (k - 8) % 24; u.pn = 42 + (k - 8) / 24; } u.z = 0; u.ka = 0; u.kb = 0;
          pg8::gemm_phase(pg8::Gemm{p.h, p.wt_in + (size_t)l * NPAD * DM, DM, DM, DM}, pg8::SchedOne{u}, pg8::EpiIn{p.P, p.small}); }
        else { PHASE_PARAMS(p); pg8::Unit u; u.pm = it % 24; u.pn = it / 24; u.z = 1; u.ka = (size_t)NTOK * DM; u.kb = (size_t)DM * DM;
          pg8::gemm_phase(pg8::Gemm{p.obr, p.wt_br + (size_t)l * 3 * DM * DM, DM, DM, DM}, pg8::SchedOne{u}, pg8::EpiBr{p.a3, p.P}); }
      }
      TSTAMP(2);
#pragma unroll 1
      for (int j = (bid < 96 ? bid - 64 : (bid < 192 ? 32 + bid - 96 : 1000)); j < 32 + 256; j += (bid < 96 ? 1000 : 96)) {
        PHASE_PARAMS(p);
        if (j < 32) dn_scan_item(p, l, 16 + (j >> 4), (j >> 1) & 7, j & 1); else { const int jj = j - 32; dn_scan_item(p, l, jj >> 4, (jj >> 1) & 7, jj & 1); }
      }
    }
    TSTAMP(3);
#define P3_TICKET(var) do { volatile __attribute__((address_space(3))) unsigned* qslot = (volatile __attribute__((address_space(3))) unsigned*)(smem + XB_LDS_OFF + 12); \
      __syncthreads(); \
      if (tid_opaque() == 0) { PHASE_PARAMS(pq); *qslot = __hip_atomic_fetch_add(pq.bar + 8192 + l * 8 + rep3 * 4 + 2, 1u, __ATOMIC_RELAXED, __HIP_MEMORY_SCOPE_AGENT); } \
      __syncthreads(); \
      var = __builtin_amdgcn_readfirstlane((int)*qslot); } while (0)
    int tk; P3_TICKET(tk);
#pragma unroll 1
    while (tk < 128) { { PHASE_PARAMS(p); attn_item(p, 64 + tk); } P3_TICKET(tk); }
#pragma unroll 1
    while (tk < 200) { const int itd = tk - 128 + 64;
      if (itd >= 32) { PHASE_PARAMS(p); const int k = itd - 32; pg8::Unit u; if (k < 8) { u.pm = 16 + k; u.pn = 37; } else { u.pm = (k - 8) % 24; u.pn = 42 + (k - 8) / 24; } u.z = 0; u.ka = 0; u.kb = 0;
        pg8::gemm_phase(pg8::Gemm{p.h, p.wt_in + (size_t)l * NPAD * DM, DM, DM, DM}, pg8::SchedOne{u}, pg8::EpiIn{p.P, p.small}); }
      else { PHASE_PARAMS(p); pg8::Unit u; u.pm = itd % 24; u.pn = itd / 24; u.z = 1; u.ka = (size_t)NTOK * DM; u.kb = (size_t)DM * DM;
        pg8::gemm_phase(pg8::Gemm{p.obr, p.wt_br + (size_t)l * 3 * DM * DM, DM, DM, DM}, pg8::SchedOne{u}, pg8::EpiBr{p.a3, p.P}); }
      P3_TICKET(tk);
    }
#pragma unroll 1
    while (tk < 264) { { PHASE_PARAMS(p); dn_finalize_item(p, l, tk - 200); } P3_TICKET(tk); }
#undef P3_TICKET
  }
#undef P3_PULL
  GRID_SYNC(); if (l == 1) TSTAMP(8);
  { PHASE_PARAMS(p); pg8::gemm_phase(pg8::Gemm{p.obr, p.wt_br + (size_t)l * 3 * DM * DM, DM, DM, DM}, pg8::SchedBr{nblk, bid}, pg8::EpiBr{p.a3, p.P}); }
#if REP & 8
  { PHASE_PARAMS(p); pg8::gemm_phase(pg8::Gemm{p.obr, p.wt_br + (size_t)l * 3 * DM * DM, DM, DM, DM}, pg8::SchedBr{nblk, bid}, pg8::EpiBr{p.a3, p.P}); }
#endif
  GRID_SYNC_WT(); if (l == 1) TSTAMP(9);
  { PHASE_PARAMS(p); pg8::gemm_phase(pg8::Gemm{p.a3, p.wt_out + (size_t)l * DM * 3072, 3072, 3072, 1536}, pg8::SchedSplit2<1536>{nblk, bid}, pg8::EpiPart{(bfr*)p.R}); }
  if (l + 1 < DEPTH && bid >= 192) { PHASE_PARAMS(p); for (int k = bid - 192; k < CONV_A; k += nblk - 192) convert_item(p, l + 1, k); }
#if REP & 16
  { PHASE_PARAMS(p); pg8::gemm_phase(pg8::Gemm{p.a3, p.wt_out + (size_t)l * DM * 3072, 3072, 3072, 1536}, pg8::SchedSplit2<1536>{nblk, bid}, pg8::EpiPart{(bfr*)p.R}); }
#endif
  GRID_SYNC_WT(); if (l == 1) TSTAMP(10);
  { PHASE_PARAMS(p); stage_row(p, l, 1, bid, nblk); }
  GRID_SYNC(); if (l == 1) TSTAMP(11);
  { PHASE_PARAMS(p); pg8::gemm_phase(pg8::Gemm{p.h, p.wt_up + (size_t)l * HID * DM, DM, DM, DM}, pg8::SchedUp{nblk, bid}, pg8::EpiUp{p.u2}); }
  if (l + 1 < DEPTH && bid >= 128) { PHASE_PARAMS(p); for (int k = CONV_A + bid - 128; k < CONV_B; k += 128) convert_item(p, l + 1, k); }
#if REP & 32
  { PHASE_PARAMS(p); pg8::gemm_phase(pg8::Gemm{p.h, p.wt_up + (size_t)l * HID * DM, DM, DM, DM}, pg8::SchedUp{nblk, bid}, pg8::EpiUp{p.u2}); }
#endif
  GRID_SYNC_WT(); if (l == 1) TSTAMP(12);
  { PHASE_PARAMS(p); pg8::gemm_phase(pg8::Gemm{p.u2, p.wt_dn + (size_t)l * DM * HID, HID, HID, 2048}, pg8::SchedSplit2<2048>{nblk, bid}, pg8::EpiPart{(bfr*)p.R}); }
  if (l + 1 < DEPTH && bid >= 192) { PHASE_PARAMS(p); for (int k = CONV_B + bid - 192; k < CONV_ITEMS; k += nblk - 192) convert_item(p, l + 1, k); __syncthreads(); stage_mod(p, (l + 1) * 48, 48, bid - 192, nblk - 192, smem); }
  GRID_SYNC_WT(); if (l == 1) TSTAMP(13);
  { PHASE_PARAMS(p); stage_row(p, l, 2, bid, nblk); }
  if (l + 1 < DEPTH) GRID_SYNC(); if (l == 1) TSTAMP(14);
}

__global__ __launch_bounds__(512) void mega_kernel(Params p_arg) {
#if USE_CG_SYNC
  cg::grid_group grid = cg::this_grid();
#endif
  const int bid = blockIdx.x, nblk = gridDim.x;
#if !USE_CG_SYNC
  { PHASE_PARAMS(pb); xcd_barrier_post(pb.bar); }
  cg::this_grid().sync();
#endif
#ifdef DIAG_A
  if (threadIdx.x < 32) ((unsigned long long*)(smem + 163840 - 256))[threadIdx.x & 15] = 0ull;
  __syncthreads();
#endif
  { PHASE_PARAMS(p); stage_mod(p, 0, 48, bid, nblk, smem); }
  { PHASE_PARAMS(p); for (int it = bid; it < CONV_ITEMS; it += nblk) convert_item(p, 0, it); }
#if REP & 128
  { PHASE_PARAMS(p); for (int it = bid; it < CONV_ITEMS; it += nblk) convert_item(p, 0, it); }
#endif
  GRID_SYNC();
  { PHASE_PARAMS(p); stage_row(p, 0, 0, bid, nblk); }
#if REP & 16384
  { PHASE_PARAMS(p); stage_row(p, 0, 0, bid, nblk); }
#endif
  GRID_SYNC();
  run_layer<0>(bid, nblk); run_layer<1>(bid, nblk); run_layer<2>(bid, nblk); run_layer<3>(bid, nblk);
#ifdef DIAG_A
  __syncthreads();
  if (blockIdx.x == DIAG_BLK && threadIdx.x == 0) { const unsigned long long* ts_ = (const unsigned long long*)(smem + 163840 - 256); PHASE_PARAMS(pd); asm volatile("s_waitcnt vmcnt(0)" ::: "memory");
#ifdef DIAG_G
    const unsigned long long* gs_ = (const unsigned long long*)(pd.bar + 12288); const unsigned long long ta_ = __hip_atomic_load(gs_ + DIAG_A, __ATOMIC_RELAXED, __HIP_MEMORY_SCOPE_AGENT), tb_ = __hip_atomic_load(gs_ + DIAG_B, __ATOMIC_RELAXED, __HIP_MEMORY_SCOPE_AGENT);
    pd.xbuf[0] = 1000.0f * rintf(4.0f * log2f((float)(tb_ - ta_) * 10.0f));
#else
    pd.xbuf[(size_t)DIAG_BLK * 24 * 1024] = 1000.0f * rintf(4.0f * log2f((float)(ts_[DIAG_B] - ts_[DIAG_A]) * 10.0f));
#endif
  }
#endif
}

__global__ void diag_fill(float* out, long n, float v) { for (long i = blockIdx.x * 256L + threadIdx.x; i < n; i += gridDim.x * 256L) out[i] = (i == 0) ? v : 0.f; }
static size_t align_up(size_t x) { return (x + 255) & ~(size_t)255; }
static bool make_params(Params& p, void* const* d_in, void* d_out, void* d_ws, size_t ws_size) {
  const float** in = (const float**)d_in;
  p.x_prompt = in[0]; p.x_sample = in[1]; p.cache_k = in[2]; p.cache_v = in[3]; p.state_dn = in[4]; p.c = in[5]; p.c_ctx = in[6];
  p.w_mod = in[7]; p.b_mod = in[8]; p.g_pre_mix = in[9]; p.g_post_mix = in[10]; p.g_pre_mlp = in[11]; p.g_post_mlp = in[12];
  p.w_in = in[13]; p.w_conv_dn = in[14]; p.a_log = in[15]; p.dt_bias = in[16]; p.g_dn_out = in[17]; p.w_conv_sc = in[18];
  p.g_q = in[19]; p.g_k = in[20]; p.w_br_dn = in[21]; p.w_br_sc = in[22]; p.w_br_att = in[23]; p.w_out = in[24];
  p.w_mlp_up = in[25]; p.w_mlp_down = in[26];
  float* out = (float*)d_out;
  p.xbuf = out; p.out_ck = out + 6291456; p.out_cv = p.out_ck + 4194304; p.out_state = p.out_cv + 4194304;
  char* w = (char*)d_ws; size_t off = 0;
  auto take = [&](size_t bytes) { char* r = w + off; off = align_up(off + bytes); return r; };
  p.bar   = (unsigned*)take(65536);
  p.wt_in = (bfr*)take((size_t)DEPTH * NPAD * DM * 2);
  p.wt_br = (bfr*)take((size_t)DEPTH * 3 * DM * DM * 2);
  p.wt_out= (bfr*)take((size_t)DEPTH * DM * 3072 * 2);
  p.wt_up = (bfr*)take((size_t)DEPTH * HID * DM * 2);
  p.wt_dn = (bfr*)take((size_t)DEPTH * DM * HID * 2);
  p.mod   = (float*)take((size_t)DEPTH * 3 * 6144 * 4);
  p.h     = (bfr*)take((size_t)NTOK * DM * 2);
  p.P     = (bfr*)take((size_t)NTOK * NP * 2);
  p.u2    = p.P;
  p.small = (float*)take((size_t)NTOK * 32 * 4);
  p.dnrec = take((size_t)1536 * REC_BYTES);
  p.glast = (float*)take(1536 * 4);
  p.opart = (bfr*)take((size_t)2 * NTOK * DM * 2);
  p.obr   = (bfr*)take((size_t)3 * NTOK * DM * 2);
  p.Q     = (bfr*)take((size_t)NTOK * DM * 2);
  p.Kc    = (bfr*)take((size_t)NCTX * 256 * 2);
  p.Vc    = (bfr*)take((size_t)NCTX * 256 * 2);
  p.Ks    = (bfr*)take((size_t)2 * 1280 * 256 * 2);
  p.Vs    = (bfr*)take((size_t)2 * 1280 * 256 * 2);
  p.merged= (bfr*)take((size_t)NTOK * DM * 2);
  p.a3    = (bfr*)take((size_t)NTOK * 3072 * 2);
  p.R     = (float*)take((size_t)4 * NTOK * DM * 4);
  return off <= ws_size;
}
extern "C" void kernel_launch(void* const* d_in, const int* in_sizes, int n_in, void* d_out, int out_size, void* d_ws, size_t ws_size, hipStream_t stream) {
  Params p{};
  if (n_in != 27 || out_size != 31457280) { diag_fill<<<1024, 256, 0, stream>>>((float*)d_out, (long)out_size, 3.0e6f + n_in); return; }
  if (!make_params(p, d_in, d_out, d_ws, ws_size)) { diag_fill<<<1024, 256, 0, stream>>>((float*)d_out, (long)out_size, (float)(ws_size >> 20)); return; }
  static int grid_blocks = 0;
  if (!grid_blocks) {
    (void)hipFuncSetAttribute((const void*)mega_kernel, hipFuncAttributeMaxDynamicSharedMemorySize, DYN_LDS);
    int dev = 0, cus = 0, per_cu = 0;
    (void)hipGetDevice(&dev);
    (void)hipDeviceGetAttribute(&cus, hipDeviceAttributeMultiprocessorCount, dev);
    (void)hipOccupancyMaxActiveBlocksPerMultiprocessor(&per_cu, mega_kernel, 512, DYN_LDS);
    grid_blocks = (per_cu >= 1 && cus >= 256) ? 256 : cus * per_cu;
    if (grid_blocks <= 0) { fprintf(stderr, "kernel_launch: occupancy query gave cus %d per_cu %d\n", cus, per_cu); grid_blocks = 0; return; }
  }
  (void)hipMemsetAsync(p.bar, 0, 65536, stream);
  void* args[] = {&p};
  const hipError_t e = hipLaunchCooperativeKernel((void*)mega_kernel, dim3(grid_blocks), dim3(512), args, DYN_LDS, stream);
  if (e != hipSuccess) fprintf(stderr, "cooperative launch failed: %s (grid %d)\n", hipGetErrorString(e), grid_blocks);
}
```
